# Optimizing an MI355X kernel written in HIP

```python
import jax, jax.numpy as jnp
from jax import lax
import numpy as np

D_MODEL = 2048
BATCH = 2
SEQ = 8192
DEPTH = 4

GRID_W = 64
CTX_LEN = 256
HEAD_DIM = 64
A_HEADS = 8
B_HEADS = 8
B_KV_HEADS = 2
C_HEADS = 16
A_WIDTH = A_HEADS * HEAD_DIM
B_WIDTH = B_HEADS * HEAD_DIM
B_KV_WIDTH = B_KV_HEADS * HEAD_DIM
C_WIDTH = C_HEADS * HEAD_DIM
MIX_WIDTH = A_WIDTH + B_WIDTH + C_WIDTH
NA_KH = 8
NA_KW = 16
DECAY_LORA = 64
ICLR_LORA = 64
GATE_LORA = 160
D_FF = 5632
ROPE_PAIRS = HEAD_DIM // 4
ROPE_THETA = 10000.0
Q_BLOCK = 128
NORM_EPS = 1e-6
LNX_EPS = 64e-5
RW_SIZES = (3 * C_WIDTH, 2 * DECAY_LORA, 2 * ICLR_LORA, GATE_LORA)
RW_COLS = sum(RW_SIZES)
IN_SIZES = (A_WIDTH, A_WIDTH, A_WIDTH, B_WIDTH, B_KV_WIDTH, B_KV_WIDTH, RW_COLS)
IN_COLS = sum(IN_SIZES)

kernel_name = 'hybrid_natten_gqa_rwkv7_dit_block'


def split_cols(z, sizes):
    return jnp.split(z, np.cumsum(sizes)[:-1].tolist(), axis=-1)


def rms_normalize(x, eps=NORM_EPS):
    xf = x.astype(jnp.float32)
    return xf * lax.rsqrt(jnp.mean(xf * xf, axis=-1, keepdims=True) + eps)


def rmsnorm(x, gain):
    return (rms_normalize(x) * gain.astype(jnp.float32)).astype(x.dtype)


def group_rmsnorm(parts, gain):
    y = jnp.concatenate([rms_normalize(p) for p in parts], axis=-1)
    return (y * gain.astype(jnp.float32)).astype(parts[0].dtype)


def heads(z, n):
    return z.reshape(z.shape[:2] + (n, HEAD_DIM))


def shift_prev(f):
    pad = [(0, 0)] * f.ndim
    pad[1] = (1, 0)
    return jnp.pad(f[:, :-1], pad)


def shift_next(f):
    pad = [(0, 0)] * f.ndim
    pad[1] = (0, 1)
    return jnp.pad(f[:, 1:], pad)


def dwconv3(f, w, b):
    return shift_prev(f) * w[0] + f * w[1] + shift_next(f) * w[2] + b


def rope_tables(length):
    pos = jnp.arange(length)
    inv_freq = ROPE_THETA ** (-jnp.arange(ROPE_PAIRS, dtype=jnp.float32) / ROPE_PAIRS)
    ang_row = (pos // GRID_W).astype(jnp.float32)[:, None] * inv_freq[None, :]
    ang_col = (pos % GRID_W).astype(jnp.float32)[:, None] * inv_freq[None, :]
    ang = jnp.concatenate([ang_row, ang_col], axis=-1)
    return jnp.cos(ang), jnp.sin(ang)


def apply_rope(x, cos, sin):
    B_, L, H, Dh = x.shape
    xs = x.astype(jnp.float32).reshape(B_, L, H, 2, 2, ROPE_PAIRS)
    x1, x2 = xs[..., 0, :], xs[..., 1, :]
    c = cos.reshape(L, 2, ROPE_PAIRS)[None, :, None]
    s = sin.reshape(L, 2, ROPE_PAIRS)[None, :, None]
    out = jnp.stack([x1 * c - x2 * s, x1 * s + x2 * c], axis=-2)
    return out.reshape(B_, L, H, Dh).astype(x.dtype)


def dense_attention(q, k, v):
    B_, T, Hq, Dh = q.shape
    Hk = k.shape[2]
    qg = q.reshape(B_, T, Hk, Hq // Hk, Dh)
    s = jnp.einsum('btkgd,bskd->bkgts', qg, k).astype(jnp.float32) * (Dh ** -0.5)
    p = jax.nn.softmax(s, axis=-1).astype(v.dtype)
    o = jnp.einsum('bkgts,bskd->btkgd', p, v)
    return o.reshape(B_, T, Hq * Dh)


def gqa_block_sweep(q, k, v, k_ctx, v_ctx):
    B_, L, H, Dh = q.shape
    k_all = jnp.concatenate([k_ctx, k], axis=1)
    v_all = jnp.concatenate([v_ctx, v], axis=1)
    q_blocks = jnp.moveaxis(q.reshape(B_, L // Q_BLOCK, Q_BLOCK, H, Dh), 1, 0)
    o = lax.map(lambda qb: dense_attention(qb, k_all, v_all), q_blocks)
    return jnp.moveaxis(o, 0, 1).reshape(B_, L, H * Dh)


def neighborhood_attention(q, k, v, k_ctx, v_ctx, rpb):
    B_, L, H, Dh = q.shape
    rows = L // GRID_W
    kh = min(NA_KH, rows)
    scale = Dh ** -0.5
    qg = q.reshape(B_, rows, GRID_W, H, Dh)
    row_ids = jnp.arange(rows)
    row_start = jnp.clip(row_ids - kh // 2, 0, rows - kh)
    key_rows = row_start[:, None] + jnp.arange(kh)[None, :]
    k_blk = k.reshape(B_, rows, GRID_W, H, Dh)[:, key_rows]
    v_blk = v.reshape(B_, rows, GRID_W, H, Dh)[:, key_rows]
    col = jnp.arange(GRID_W)
    col_start = jnp.clip(col - NA_KW // 2, 0, GRID_W - NA_KW)
    in_win = (col[None, :] >= col_start[:, None]) & (col[None, :] < col_start[:, None] + NA_KW)
    row_off = key_rows - row_ids[:, None] + (NA_KH - 1)
    col_off = jnp.clip(col[None, :] - col[:, None], -(NA_KW - 1), NA_KW - 1) + (NA_KW - 1)
    bias = rpb.astype(jnp.float32)[:, row_off[:, None, :, None], col_off[None, :, None, :]]
    s = jnp.einsum('bixhd,bijyhd->bhixjy', qg, k_blk).astype(jnp.float32) * scale + bias
    s = jnp.where(in_win[:, None, :], s, -jnp.inf)
    s_ctx = jnp.einsum('bixhd,bchd->bhixc', qg, k_ctx).astype(jnp.float32) * scale
    m = jnp.maximum(jnp.max(s, axis=(-2, -1)), jnp.max(s_ctx, axis=-1))
    e_loc = jnp.exp(s - m[..., None, None])
    e_ctx = jnp.exp(s_ctx - m[..., None])
    denom = jnp.sum(e_loc, axis=(-2, -1)) + jnp.sum(e_ctx, axis=-1)
    p_loc = (e_loc / denom[..., None, None]).astype(v.dtype)
    p_ctx = (e_ctx / denom[..., None]).astype(v.dtype)
    o = jnp.einsum('bhixjy,bijyhd->bixhd', p_loc, v_blk) + jnp.einsum('bhixc,bchd->bixhd', p_ctx, v_ctx)
    return o.reshape(B_, L, H * Dh)


def rwkv7_features(f, mu_rkv, mu_w, mu_a, mu_g, w0, w2, a0, a2, g2, k_k, k_a):
    B_, T, _ = f.shape
    rkv, wd, ad, gd = split_cols(f, RW_SIZES)
    rkv_nb = jnp.stack([shift_prev(rkv), shift_next(rkv)], axis=2)
    rkv = rkv[:, :, None] + mu_rkv * (rkv_nb - rkv[:, :, None])
    wd = wd.reshape(B_, T, 2, DECAY_LORA)
    wd = wd + mu_w * (jnp.stack([shift_prev(wd[:, :, 0]), shift_next(wd[:, :, 1])], axis=2) - wd)
    ad = ad.reshape(B_, T, 2, ICLR_LORA)
    ad = ad + mu_a * (jnp.stack([shift_prev(ad[:, :, 0]), shift_next(ad[:, :, 1])], axis=2) - ad)
    gd = gd + mu_g[0] * (shift_prev(gd) - gd) + mu_g[1] * (shift_next(gd) - gd)
    r, k, v = jnp.split(rkv, 3, axis=-1)
    w_log = -jax.nn.softplus(-(w0 + jnp.einsum('btdr,drc->btdc', jnp.tanh(wd), w2))) - 0.5
    decay = jnp.exp(-jnp.exp(w_log.astype(jnp.float32)))
    a = jax.nn.sigmoid(a0 + jnp.einsum('btdr,drc->btdc', ad, a2))
    g = jax.nn.sigmoid(gd) @ g2
    hd = lambda z: z.reshape(B_, T, 2, C_HEADS, HEAD_DIM)
    kk = hd(k * k_k).astype(jnp.float32)
    kk = kk / jnp.maximum(jnp.sqrt(jnp.sum(kk * kk, axis=-1, keepdims=True)), 1e-12)
    k = k * (1 + (a - 1) * k_a)
    return hd(r), hd(decay), hd(k), hd(v), kk, hd(a), g


def rwkv7_scan(state0, r, decay, k, v, kk, a):
    def to_time_major(z):
        z = jnp.concatenate([z[:, :, :1], jnp.flip(z[:, :, 1:], axis=1)], axis=2)
        return jnp.moveaxis(z.astype(jnp.float32), 1, 0)
    xs = tuple(to_time_major(z) for z in (r, decay, k, v, -kk, kk * a))

    def step(S, inp):
        r_t, w_t, k_t, v_t, a_t, b_t = inp
        sa = jnp.einsum('bdhvk,bdhk->bdhv', S, a_t)
        S = S * w_t[..., None, :] + sa[..., None] * b_t[..., None, :] + v_t[..., None] * k_t[..., None, :]
        return S, jnp.einsum('bdhvk,bdhk->bdhv', S, r_t)

    state, ys = lax.scan(step, state0, xs)
    ys = jnp.moveaxis(ys, 0, 1)
    ys = jnp.concatenate([ys[:, :, :1], jnp.flip(ys[:, :, 1:], axis=1)], axis=2)
    return ys, state


def rwkv7_readout(ys, r, k, v, g, r_k, lnx_g, lnx_b):
    B_, T = ys.shape[:2]
    y = jnp.sum(ys, axis=2)
    mean = jnp.mean(y, axis=-1, keepdims=True)
    var = jnp.mean(jnp.square(y - mean), axis=-1, keepdims=True)
    y = ((y - mean) * lax.rsqrt(var + LNX_EPS)).reshape(B_, T, C_WIDTH) * lnx_g + lnx_b
    bonus = jnp.sum(r * k * r_k, axis=-1, keepdims=True) * v
    y = y + jnp.sum(bonus, axis=2).reshape(B_, T, C_WIDTH)
    return (y * g).astype(g.dtype)


def rwkv7_mixer(f_ctx, f_lat, mu_rkv, mu_w, mu_a, mu_g, w0, w2, a0, a2, g2, k_k, k_a, r_k, lnx_g, lnx_b):
    fc = rwkv7_features(f_ctx, mu_rkv, mu_w, mu_a, mu_g, w0, w2, a0, a2, g2, k_k, k_a)
    fl = rwkv7_features(f_lat, mu_rkv, mu_w, mu_a, mu_g, w0, w2, a0, a2, g2, k_k, k_a)
    state0 = jnp.zeros((f_ctx.shape[0], 2, C_HEADS, HEAD_DIM, HEAD_DIM), jnp.float32)
    ys_c, state_c = rwkv7_scan(state0, *fc[:6])
    ys_l, _ = rwkv7_scan(state_c, *fl[:6])
    out_c = rwkv7_readout(ys_c, fc[0], fc[2], fc[3], fc[6], r_k, lnx_g, lnx_b)
    out_l = rwkv7_readout(ys_l, fl[0], fl[2], fl[3], fl[6], r_k, lnx_g, lnx_b)
    return out_c, out_l


def conv_glu(xn, up, conv_w, conv_b, down):
    u, val = jnp.split(xn @ up, 2, axis=-1)
    u = dwconv3(u, conv_w, conv_b)
    return (jax.nn.gelu(u, approximate=False) * val) @ down


def setup_inputs(seed: int = 0) -> dict:
    key = jax.random.key(seed)
    ks = iter(jax.random.split(key, 48))
    D = D_MODEL

    def nrm(shape, s):
        return jax.random.normal(next(ks), shape, jnp.float32) * s

    def uni(shape):
        return jax.random.uniform(next(ks), shape, jnp.float32)

    return {
        'x': nrm((BATCH, SEQ, D), 1.0),
        'c': nrm((BATCH, D), 1.0),
        'ctx': nrm((BATCH, CTX_LEN, D), 1.0),
        'c_ctx': nrm((D,), 1.0),
        'ada_w': nrm((DEPTH, D, 6 * D), 0.5 * D ** -0.5),
        'ada_b': nrm((DEPTH, 6 * D), 0.02),
        'norm1_g': 1.0 + nrm((DEPTH, D), 0.02),
        'norm2_g': 1.0 + nrm((DEPTH, D), 0.02),
        'w_in': nrm((DEPTH, D, IN_COLS), D ** -0.5),
        'na_rpb': nrm((DEPTH, A_HEADS, 2 * NA_KH - 1, 2 * NA_KW - 1), 0.2),
        'q_gain': 1.0 + nrm((DEPTH, HEAD_DIM), 0.02),
        'k_gain': 1.0 + nrm((DEPTH, HEAD_DIM), 0.02),
        'rw_mu_rkv': uni((DEPTH, 2, 3 * C_WIDTH)),
        'rw_mu_w': uni((DEPTH, 2, DECAY_LORA)),
        'rw_mu_a': uni((DEPTH, 2, ICLR_LORA)),
        'rw_mu_g': uni((DEPTH, 2, GATE_LORA)),
        'rw_w0': -2.0 + nrm((DEPTH, 2, C_WIDTH), 0.5),
        'rw_w2': nrm((DEPTH, 2, DECAY_LORA, C_WIDTH), 0.5 * DECAY_LORA ** -0.5),
        'rw_a0': nrm((DEPTH, 2, C_WIDTH), 0.2),
        'rw_a2': nrm((DEPTH, 2, ICLR_LORA, C_WIDTH), ICLR_LORA ** -0.5),
        'rw_g2': nrm((DEPTH, GATE_LORA, C_WIDTH), GATE_LORA ** -0.5),
        'rw_k_k': 0.85 + nrm((DEPTH, C_WIDTH), 0.05),
        'rw_k_a': 1.0 + nrm((DEPTH, C_WIDTH), 0.05),
        'rw_r_k': nrm((DEPTH, C_HEADS, HEAD_DIM), 0.1),
        'rw_lnx_g': 1.0 + nrm((DEPTH, C_WIDTH), 0.02),
        'rw_lnx_b': nrm((DEPTH, C_WIDTH), 0.02),
        'grp_g': 1.0 + nrm((DEPTH, MIX_WIDTH), 0.02),
        'w_out': nrm((DEPTH, MIX_WIDTH, D), MIX_WIDTH ** -0.5),
        'ffn_up': nrm((DEPTH, D, 2 * D_FF), D ** -0.5),
        'ffn_conv_w': nrm((DEPTH, 3, D_FF), 0.5),
        'ffn_conv_b': nrm((DEPTH, D_FF), 0.02),
        'ffn_down': nrm((DEPTH, D_FF, D), D_FF ** -0.5),
        'final_g': 1.0 + nrm((D,), 0.02),
    }


def reference(x, c, ctx, c_ctx, ada_w, ada_b, norm1_g, norm2_g, w_in, na_rpb, q_gain, k_gain,
              rw_mu_rkv, rw_mu_w, rw_mu_a, rw_mu_g, rw_w0, rw_w2, rw_a0, rw_a2, rw_g2,
              rw_k_k, rw_k_a, rw_r_k, rw_lnx_g, rw_lnx_b, grp_g, w_out,
              ffn_up, ffn_conv_w, ffn_conv_b, ffn_down, final_g):
    L = x.shape[1]
    cos, sin = rope_tables(L)
    h, hc = x, ctx
    cond_lat = jax.nn.silu(c)[:, None, :]
    cond_ctx = jax.nn.silu(c_ctx)[None, None, :]
    for l in range(DEPTH):
        update_ctx = l < DEPTH - 1
        sh1, sc1, gt1, sh2, sc2, gt2 = jnp.split(cond_lat @ ada_w[l] + ada_b[l], 6, axis=-1)
        csh1, csc1, cgt1, csh2, csc2, cgt2 = jnp.split(cond_ctx @ ada_w[l] + ada_b[l], 6, axis=-1)

        xn = rmsnorm(h, norm1_g[l]) * (1 + sc1) + sh1
        xnc = rmsnorm(hc, norm1_g[l]) * (1 + csc1) + csh1
        qa, ka, va, qb, kb, vb, fr = split_cols(xn @ w_in[l], IN_SIZES)
        qac, kac, vac, qbc, kbc, vbc, frc = split_cols(xnc @ w_in[l], IN_SIZES)

        ka_c, va_c = heads(kac, A_HEADS), heads(vac, A_HEADS)
        out_a = neighborhood_attention(heads(qa, A_HEADS), heads(ka, A_HEADS), heads(va, A_HEADS),
                                       ka_c, va_c, na_rpb[l])
        kb_c = rmsnorm(heads(kbc, B_KV_HEADS), k_gain[l])
        vb_c = heads(vbc, B_KV_HEADS)
        q_b = apply_rope(rmsnorm(heads(qb, B_HEADS), q_gain[l]), cos, sin)
        k_b = apply_rope(rmsnorm(heads(kb, B_KV_HEADS), k_gain[l]), cos, sin)
        out_b = gqa_block_sweep(q_b, k_b, heads(vb, B_KV_HEADS), kb_c, vb_c)
        out_c_ctx, out_c = rwkv7_mixer(frc, fr, rw_mu_rkv[l], rw_mu_w[l], rw_mu_a[l], rw_mu_g[l],
                                       rw_w0[l], rw_w2[l], rw_a0[l], rw_a2[l], rw_g2[l],
                                       rw_k_k[l], rw_k_a[l], rw_r_k[l], rw_lnx_g[l], rw_lnx_b[l])
        mix = group_rmsnorm((out_a, out_b, out_c), grp_g[l]) @ w_out[l]
        h = h + gt1 * mix

        xn2 = rmsnorm(h, norm2_g[l]) * (1 + sc2) + sh2
        h = h + gt2 * conv_glu(xn2, ffn_up[l], ffn_conv_w[l], ffn_conv_b[l], ffn_down[l])

        if update_ctx:
            out_a_c = dense_attention(heads(qac, A_HEADS), ka_c, va_c)
            out_b_c = dense_attention(rmsnorm(heads(qbc, B_HEADS), q_gain[l]), kb_c, vb_c)
            mix_c = group_rmsnorm((out_a_c, out_b_c, out_c_ctx), grp_g[l]) @ w_out[l]
            hc = hc + cgt1 * mix_c
            xnc2 = rmsnorm(hc, norm2_g[l]) * (1 + csc2) + csh2
            hc = hc + cgt2 * conv_glu(xnc2, ffn_up[l], ffn_conv_w[l], ffn_conv_b[l], ffn_down[l])
    return rmsnorm(h, final_g)
```

```cpp
#include <hip/hip_runtime.h>
#include <hip/hip_bf16.h>
#include <cstdio>
#include <cstdint>
#include <cmath>
namespace pg8 {
#define PG8_LAS __attribute__((address_space(3)))
typedef unsigned short bf16_t;
typedef short bf16x8 __attribute__((ext_vector_type(8)));
typedef float f32x4 __attribute__((ext_vector_type(4)));
typedef unsigned u32x4 __attribute__((ext_vector_type(4)));
constexpr int BM = 256, BK = 64, HALF = 128, HTB = HALF * BK * 2  , STAGE_BYTES = 8 * HTB, NXCD = 8, WGM = 8;

__host__ __device__ __forceinline__ int lds_byte(int r, int c) { const int st = (r >> 4) * 2 + (c >> 5), rr = r & 15, cc = c & 31, ob = rr * 64 + cc * 2; return st * 1024 + (ob ^ (((ob >> 9) & 1) << 5)); }
__host__ __device__ __forceinline__ void stage_rc(int b, int& R, int& C) { const int st = b / 1024, sb = b % 1024, swz = sb ^ (((sb >> 9) & 1) << 5); R = (st >> 1) * 16 + swz / 64; C = (st & 1) * 32 + (swz % 64) / 2; }
__host__ __device__ __forceinline__ int perm32(int rho) { const int n = rho >> 4, i = rho & 15; return 8 * (i >> 2) + 4 * n + (i & 3); }

struct Unit { int pm, pn, kb; };
struct Gemm { const bf16_t* A; const bf16_t* Bt; int M, N, K; int ld = 0; };

struct StaticOrder {
    int nM, nN, nwg, G, c;
    __host__ __device__ void init(int M, int N, int G_, int c_) { nM = M / BM; nN = N / BM; nwg = nM * nN; G = G_; c = c_; }
    __host__ __device__ bool next(int i, Unit& u) const {
        const long L = (long)i * G + c; if (L >= nwg) return false;
        int wgid = (int)L; { const int q = nwg / NXCD, r = nwg % NXCD, xcd = wgid % NXCD, off = wgid / NXCD; wgid = (xcd < r ? xcd * (q + 1) : r * (q + 1) + (xcd - r) * q) + off; }
        const int nig = WGM * nN, gid = wgid / nig, fm = gid * WGM, gsz = (nM - fm) < WGM ? (nM - fm) : WGM;
        u.pm = fm + ((wgid % nig) % gsz); u.pn = (wgid % nig) / gsz; u.kb = 0; return true;
    }
    __device__ __forceinline__ void a_ready(const Unit&) const {}
    __device__ __forceinline__ void done(const Unit&) const {}
};

__device__ __forceinline__ unsigned cvt_pk_bf16(float lo, float hi) { unsigned r; asm volatile("v_cvt_pk_bf16_f32 %0, %1, %2" : "=v"(r) : "v"(lo), "v"(hi)); return r; }
typedef float f32x2 __attribute__((ext_vector_type(2)));
__device__ __forceinline__ f32x2 gelu_pk(f32x2 v) {
    const f32x2 av = __builtin_elementwise_abs(v), d = av * 0.2316418882f + 1.0f;
    f32x2 t; t.x = __builtin_amdgcn_rcpf(d.x); t.y = __builtin_amdgcn_rcpf(d.y);
    f32x2 q = t * 0.5307027145f + (-0.7265760135f); q = q * t + 0.7107068705f; q = q * t + (-0.142248368f); q = q * t + 0.127414796f; q = q * t;
    const f32x2 s = (v * v) * (-0.72134752044f);
    f32x2 e; e.x = __builtin_amdgcn_exp2f(s.x); e.y = __builtin_amdgcn_exp2f(s.y);
    const f32x2 m = v * (q * e), r = v - m;
    f32x2 o; o.x = v.x < 0.f ? m.x : r.x; o.y = v.y < 0.f ? m.y : r.y; return o;
}

template <int ACT  > struct EpiBf16 {
    static constexpr bool PERM = true, AFTER_DRAIN = false; static_assert(ACT == 0 || ACT == 1, "EpiBf16: ACT is 0 (none) or 1 (gelu_pk)");
    bf16_t* O; int ldc; const float* bias; int split_cols; size_t split_stride; float scale0;
    __device__ __forceinline__ void operator()(const f32x4 (&acc)[2][2][4][2], const Unit& u, int wr, int wc, int fr, int fq) const {
        const int row0 = u.pm * BM + wr * 64 + fr; int colt = u.pn * BM; bf16_t* base = O;
        float sc = 1.f; if (split_cols) { const int t = colt / split_cols; base += (size_t)t * split_stride; colt -= t * split_cols; if (t == 0) sc = scale0; }
        const int col0 = colt + wc * 32 + 8 * fq, bcol0 = u.pn * BM + wc * 32 + 8 * fq;
        f32x4 bv[2][2];
#pragma unroll
        for (int bj = 0; bj < 2; ++bj)
#pragma unroll
            for (int n = 0; n < 2; ++n) bv[bj][n] = bias ? *(const f32x4*)(bias + bcol0 + bj * HALF + 4 * n) : (f32x4){0.f, 0.f, 0.f, 0.f};
#pragma unroll
        for (int ai = 0; ai < 2; ++ai)
#pragma unroll
            for (int m = 0; m < 4; ++m) { bf16_t* rowp = base + (size_t)(row0 + ai * HALF + m * 16) * ldc + col0;
#pragma unroll
                for (int bj = 0; bj < 2; ++bj) { f32x4 v0 = acc[ai][bj][m][0] + bv[bj][0], v1 = acc[ai][bj][m][1] + bv[bj][1];
                    if (ACT == 1) { f32x2 a = gelu_pk((f32x2){v0[0], v0[1]}), b = gelu_pk((f32x2){v0[2], v0[3]}), c = gelu_pk((f32x2){v1[0], v1[1]}), d = gelu_pk((f32x2){v1[2], v1[3]});
                        v0 = (f32x4){a.x, a.y, b.x, b.y}; v1 = (f32x4){c.x, c.y, d.x, d.y}; }
                    v0 = v0 * sc; v1 = v1 * sc; u32x4 w; w.x = cvt_pk_bf16(v0[0], v0[1]); w.y = cvt_pk_bf16(v0[2], v0[3]); w.z = cvt_pk_bf16(v1[0], v1[1]); w.w = cvt_pk_bf16(v1[2], v1[3]);
                    *(u32x4*)(rowp + bj * HALF) = w; } }
    }
};
template <class Epi, class Sched, bool ALIGN_EPI = false, bool SP2 = false>
__device__ __forceinline__ void gemm_phase(PG8_LAS unsigned char* lds, const Gemm g, const Sched& S, const Epi& E, int wave_in) {
    int ln_; asm volatile("v_mbcnt_lo_u32_b32 %0, -1, 0\n\tv_mbcnt_hi_u32_b32 %0, -1, %0" : "=v"(ln_)); asm volatile("" : "+s"(wave_in)); int tid_ = wave_in * 64 + ln_;
    const int tid = tid_, wid = __builtin_amdgcn_readfirstlane(tid >> 6), lane = tid & 63, wr = wid >> 2, wc = wid & 3, fr = lane & 15, fq = lane >> 4;
    const int K = g.ld ? g.ld : g.K, nt = g.K / BK;
    unsigned voffA[2], voffB[2];
#pragma unroll
    for (int i = 0; i < 2; ++i) { int R, C; stage_rc(tid * 16 + i * 8192, R, C); const int Rb = Epi::PERM ? ((R & ~31) + perm32(R & 31)) : R;
        voffA[i] = (unsigned)(R * K + C) * 2u; voffB[i] = (unsigned)(Rb * K + C) * 2u; }
    const size_t kstep = (size_t)(BK * 2);
    const size_t hstep = (size_t)HALF * K * 2;
    const size_t tstep = 2 * hstep;
    const unsigned ldsw = (unsigned)wid * 1024u;
    const int aoff = lds_byte(wr * 64 + fr, fq * 8), boff = lds_byte(wc * 32 + fr, fq * 8);
#define PG8_SA(b, h) (((b) * 2 + (h)) * HTB)
#define PG8_SB(b, h) ((4 + (b) * 2 + (h)) * HTB)
#define PG8_STAGE(bufoff, gbase, voff) do { _Pragma("unroll") for (int _i = 0; _i < 2; ++_i) \
        __builtin_amdgcn_global_load_lds((const unsigned*)((const char*)(gbase) + (voff)[_i]), (PG8_LAS unsigned*)(lds + (bufoff) + ldsw + _i * 8192), 16, 0, 0); } while (0)
#define PG8_LDA(dst, b, h) do { _Pragma("unroll") for (int m = 0; m < 4; ++m) _Pragma("unroll") for (int k = 0; k < 2; ++k) dst[m][k] = *(const PG8_LAS bf16x8*)(lds + PG8_SA(b, h) + aoff + m * 2048 + k * 1024); } while (0)
#define PG8_LDB(dst, b, h) do { _Pragma("unroll") for (int n = 0; n < 2; ++n) _Pragma("unroll") for (int k = 0; k < 2; ++k) dst[n][k] = *(const PG8_LAS bf16x8*)(lds + PG8_SB(b, h) + boff + n * 2048 + k * 1024); } while (0)
#define PG8_MMA(ai, bj, At, Bt) do { __builtin_amdgcn_s_setprio(1); _Pragma("unroll") for (int m = 0; m < 4; ++m) _Pragma("unroll") for (int n = 0; n < 2; ++n) _Pragma("unroll") for (int k = 0; k < 2; ++k) \
        acc[ai][bj][m][n] = __builtin_amdgcn_mfma_f32_16x16x32_bf16(Bt[n][k], At[m][k], acc[ai][bj][m][n], 0, 0, 0); __builtin_amdgcn_s_setprio(0); } while (0)
#define PG8_WAIT_V(n) asm volatile("s_waitcnt vmcnt(" #n ")" ::: "memory")
#define PG8_WAIT_L(n) asm volatile("s_waitcnt lgkmcnt(" #n ")" ::: "memory")
#define PG8_BAR __builtin_amdgcn_s_barrier()
#define PG8_SCHED __builtin_amdgcn_sched_barrier(0)
    Unit cur, nxt; int ui = 0;
    if (!S.next(0, cur)) return;
    f32x4 acc[2][2][4][2];
#pragma unroll
    for (int a = 0; a < 2; ++a)
#pragma unroll
        for (int b = 0; b < 2; ++b)
#pragma unroll
            for (int m = 0; m < 4; ++m)
#pragma unroll
                for (int n = 0; n < 2; ++n) acc[a][b][m][n] = (f32x4){0.f, 0.f, 0.f, 0.f};
    bf16x8 At[4][2], B0[2][2], B1[2][2];
    const char* cA = (const char*)g.A + (size_t)cur.pm * tstep + (size_t)cur.kb * 2; const char* cB = (const char*)g.Bt + (size_t)cur.pn * tstep + (size_t)cur.kb * 2;
    S.a_ready(cur);
    if constexpr (SP2) {
        PG8_STAGE(PG8_SB(0, 0), cB, voffB); PG8_STAGE(PG8_SB(0, 1), cB + hstep, voffB); PG8_STAGE(PG8_SA(0, 0), cA, voffA); PG8_STAGE(PG8_SA(0, 1), cA + hstep, voffA);
        if (wr == 1) PG8_BAR;
        PG8_WAIT_V(2); PG8_BAR;
        PG8_STAGE(PG8_SB(1, 0), cB + kstep, voffB); PG8_STAGE(PG8_SA(1, 0), cA + kstep, voffA); PG8_STAGE(PG8_SB(1, 1), cB + hstep + kstep, voffB);
        PG8_WAIT_V(6); PG8_BAR;
    } else {
        PG8_STAGE(PG8_SB(0, 0), cB, voffB); PG8_STAGE(PG8_SA(0, 0), cA, voffA); PG8_STAGE(PG8_SB(0, 1), cB + hstep, voffB); PG8_STAGE(PG8_SA(0, 1), cA + hstep, voffA);
        if (wr == 1) PG8_BAR;
        PG8_WAIT_V(4); PG8_BAR;
        PG8_STAGE(PG8_SB(1, 0), cB + kstep, voffB); PG8_STAGE(PG8_SA(1, 0), cA + kstep, voffA); PG8_STAGE(PG8_SB(1, 1), cB + hstep + kstep, voffB);
        PG8_WAIT_V(6); PG8_BAR;
    }
    for (;;) {
        const bool has_next = S.next(ui + 1, nxt);
        const char* nA = has_next ? (const char*)g.A + (size_t)nxt.pm * tstep + (size_t)nxt.kb * 2 : cA; const char* nB = has_next ? (const char*)g.Bt + (size_t)nxt.pn * tstep + (size_t)nxt.kb * 2 : cB;
        for (int t = 0; t < nt; t += 2) {
            const bool last = (t == nt - 2);
            const char* a1 = cA + (size_t)(t + 1) * kstep;
            const char* a2 = last ? nA : cA + (size_t)(t + 2) * kstep; const char* b2 = last ? nB : cB + (size_t)(t + 2) * kstep;
            const char* a3 = a2 + kstep; const char* b3 = b2 + kstep;
            if (last && has_next) S.a_ready(nxt);
            if constexpr (SP2) {
            PG8_LDB(B0, 0, 0); PG8_LDB(B1, 0, 1); PG8_SCHED; PG8_LDA(At, 0, 0); PG8_STAGE(PG8_SA(1, 1), a1 + hstep, voffA);
            PG8_WAIT_V(8); PG8_WAIT_L(0); PG8_BAR; PG8_MMA(0, 0, At, B0); PG8_MMA(0, 1, At, B1); PG8_BAR; PG8_SCHED;
            PG8_LDA(At, 0, 1); PG8_STAGE(PG8_SB(0, 0), b2, voffB); PG8_STAGE(PG8_SB(0, 1), b2 + hstep, voffB); PG8_STAGE(PG8_SA(0, 0), a2, voffA);
            PG8_WAIT_V(8); PG8_WAIT_L(0); PG8_BAR; PG8_MMA(1, 0, At, B0); PG8_MMA(1, 1, At, B1); PG8_BAR; PG8_SCHED;
            PG8_LDB(B0, 1, 0); PG8_LDB(B1, 1, 1); PG8_SCHED; PG8_LDA(At, 1, 0); PG8_STAGE(PG8_SA(0, 1), a2 + hstep, voffA);
            PG8_WAIT_V(8); PG8_WAIT_L(0); PG8_BAR; PG8_MMA(0, 0, At, B0); PG8_MMA(0, 1, At, B1); PG8_BAR; PG8_SCHED;
            PG8_LDA(At, 1, 1); PG8_STAGE(PG8_SB(1, 0), b3, voffB); PG8_STAGE(PG8_SB(1, 1), b3 + hstep, voffB); PG8_STAGE(PG8_SA(1, 0), a3, voffA);
            PG8_WAIT_V(8); PG8_WAIT_L(0); PG8_BAR; PG8_MMA(1, 0, At, B0); PG8_MMA(1, 1, At, B1); PG8_BAR; PG8_SCHED;
            } else {
            PG8_LDB(B0, 0, 0); PG8_SCHED; PG8_LDA(At, 0, 0); PG8_STAGE(PG8_SA(1, 1), a1 + hstep, voffA);
            PG8_WAIT_L(8); PG8_BAR; PG8_WAIT_L(0); PG8_MMA(0, 0, At, B0); PG8_BAR; PG8_SCHED;
            PG8_LDB(B1, 0, 1); PG8_STAGE(PG8_SB(0, 0), b2, voffB);
            PG8_BAR; PG8_WAIT_L(0); PG8_MMA(0, 1, At, B1); PG8_BAR;
            PG8_LDA(At, 0, 1); PG8_STAGE(PG8_SA(0, 0), a2, voffA);
            PG8_BAR; PG8_WAIT_L(0); PG8_MMA(1, 0, At, B0); PG8_BAR; PG8_SCHED;
            PG8_STAGE(PG8_SB(0, 1), b2 + hstep, voffB);
            PG8_WAIT_V(6); PG8_BAR; PG8_MMA(1, 1, At, B1); PG8_BAR;
            PG8_LDB(B0, 1, 0); PG8_SCHED; PG8_LDA(At, 1, 0); PG8_STAGE(PG8_SA(0, 1), a2 + hstep, voffA);
            PG8_WAIT_L(8); PG8_BAR; PG8_WAIT_L(0); PG8_MMA(0, 0, At, B0); PG8_BAR; PG8_SCHED;
            PG8_LDB(B1, 1, 1); PG8_STAGE(PG8_SB(1, 0), b3, voffB);
            PG8_BAR; PG8_WAIT_L(0); PG8_MMA(0, 1, At, B1); PG8_BAR;
            PG8_LDA(At, 1, 1); PG8_STAGE(PG8_SA(1, 0), a3, voffA);
            PG8_BAR; PG8_WAIT_L(0); PG8_MMA(1, 0, At, B0); PG8_BAR; PG8_SCHED;
            PG8_STAGE(PG8_SB(1, 1), b3 + hstep, voffB);
            PG8_WAIT_V(6); PG8_BAR; PG8_MMA(1, 1, At, B1); PG8_BAR;
            }
        }
        if constexpr (ALIGN_EPI) { if (wr == 0) PG8_BAR; }
        if constexpr (!Epi::AFTER_DRAIN) { E(acc, cur, wr, wc, fr, fq); S.done(cur); }
        if (!has_next) break;
#pragma unroll
        for (int a = 0; a < 2; ++a)
#pragma unroll
            for (int b = 0; b < 2; ++b)
#pragma unroll
                for (int m = 0; m < 4; ++m)
#pragma unroll
                    for (int n = 0; n < 2; ++n) acc[a][b][m][n] = (f32x4){0.f, 0.f, 0.f, 0.f};
        cur = nxt; cA = nA; cB = nB; ++ui;
        if constexpr (ALIGN_EPI) { if (wr == 1) PG8_BAR; }
    }
    PG8_WAIT_V(0);
    if constexpr (!ALIGN_EPI) { if (wr == 0) PG8_BAR; }
    PG8_BAR;
    if constexpr (Epi::AFTER_DRAIN) { E.fused(acc, cur, wr, wc, fr, fq, lds, wid, lane); S.done(cur); }
#undef PG8_SA
#undef PG8_SB
#undef PG8_STAGE
#undef PG8_LDA
#undef PG8_LDB
#undef PG8_MMA
#undef PG8_WAIT_V
#undef PG8_WAIT_L
#undef PG8_BAR
#undef PG8_SCHED
}
}

constexpr int NWAVES = 8;
constexpr int DM = 2048, NB = 2, SEQ = 8192, DEPTH = 4, GRIDW = 64, CTXL = 256, HD = 64;
constexpr int MLAT = NB * SEQ, MCTX = NB * CTXL, MALL = MLAT + MCTX;
constexpr int INC = 5792, INP = 5888;
constexpr int C_QA = 0, C_KA = 512, C_VA = 1024, C_QB = 1536, C_KB = 2048, C_VB = 2176, C_R = 2304, C_K = 3328, C_V = 4352, C_WD = 5376, C_AD = 5504, C_GD = 5632;
constexpr int CW = 1024;
constexpr int DFF = 5632, UPN = 2 * DFF;
constexpr int SKV = CTXL + SEQ;
constexpr int MODW = 6 * DM;
constexpr float LOG2E = 1.4426950408889634f;
constexpr float QSCALE = 0.125f * LOG2E;

constexpr size_t MiB = 1u << 20;
constexpr size_t WS_CTL = 0, CTL_ZERO_BYTES = 1 * MiB;
constexpr size_t WS_MOD = 1 * MiB;
constexpr size_t WS_MODP = 2 * MiB;
constexpr size_t WS_WIN = 12 * MiB;
constexpr size_t WS_WOUT = 104 * MiB;
constexpr size_t WS_WUP = 136 * MiB;
constexpr size_t WS_WDN = 312 * MiB;
constexpr size_t WS_H = 400 * MiB;
constexpr size_t WS_XN = 1111 * MiB;
constexpr size_t WS_Y1 = 532 * MiB;
constexpr size_t WS_QBP = 722 * MiB;
constexpr size_t WS_KBP = 739 * MiB;
constexpr size_t WS_VBP = 744 * MiB;
constexpr size_t WS_OA = 749 * MiB;
constexpr size_t WS_OB = 766 * MiB;
constexpr size_t WS_WDEC = 783 * MiB;
constexpr size_t WS_AIC = 849 * MiB;
constexpr size_t WS_G = 915 * MiB;
constexpr size_t WS_YS = 948 * MiB;
constexpr size_t WS_MIX = 1177 * MiB;
constexpr size_t WS_U = 532 * MiB;
constexpr size_t WS_HB = 895 * MiB;
constexpr size_t WS_VAT = 1080 * MiB;
constexpr size_t WS_LW = 1097 * MiB;
constexpr size_t WS_OC = 1243 * MiB;
constexpr size_t WS_GK = 1101 * MiB;
constexpr size_t WS_BIAS1 = 1102 * MiB;
constexpr size_t WS_BIAS3 = 1103 * MiB;
constexpr size_t WS_SS = 256 * 1024;
constexpr size_t WS_SSP = 1104 * MiB;
constexpr size_t WS_RS = 1109 * MiB;
constexpr size_t WS_PART = 1309 * MiB;
constexpr size_t WS_VBT = 1110 * MiB;
constexpr size_t WS_CK = 1111 * MiB;
constexpr size_t WS_CKS = 1498 * MiB;
constexpr size_t WS_END = 1530 * MiB;
static_assert(WS_U + (size_t)MALL * UPN * 2 <= WS_HB && WS_HB + (size_t)MALL * DFF * 2 <= WS_VAT, "overlay map");
constexpr int CW_BAR = 4096;
static_assert(WS_SS + (size_t)DEPTH * 2 * MALL * 4 <= CTL_ZERO_BYTES && (size_t)(CW_BAR + 3456) * 4 <= WS_SS, "control-region map");

constexpr int RING_BYTES = 131072;
constexpr int LDSCTL_OFF = RING_BYTES, MISC_OFF = LDSCTL_OFF + 320;
constexpr int LDS_BYTES = 147456;

#define GAS __attribute__((address_space(1)))
#define LAS __attribute__((address_space(3)))
typedef unsigned short bf16;
typedef unsigned v4u __attribute__((ext_vector_type(4)));
typedef unsigned v2u __attribute__((ext_vector_type(2)));
typedef float f32x4 __attribute__((ext_vector_type(4)));
typedef GAS unsigned gu32;
#define RLX_AGENT __ATOMIC_RELAXED, __HIP_MEMORY_SCOPE_AGENT
#define LDS_WAIT() asm volatile("s_waitcnt lgkmcnt(0)" ::: "memory")
#define VM_WAIT() asm volatile("s_waitcnt vmcnt(0)" ::: "memory")
__device__ __forceinline__ unsigned f2bf(float f) { unsigned u = __builtin_bit_cast(unsigned, f); return (u + 0x7fffu + ((u >> 16) & 1u)) >> 16; }
__device__ __forceinline__ unsigned pk2(float lo, float hi) { return f2bf(lo) | (f2bf(hi) << 16); }
__device__ __forceinline__ float bf2f(bf16 u) { return __uint_as_float((unsigned)u << 16); }
__device__ __forceinline__ float bflo(unsigned w) { return __uint_as_float(w << 16); }
__device__ __forceinline__ float bfhi(unsigned w) { return __uint_as_float(w & 0xffff0000u); }
template <int CTRL> __device__ __forceinline__ float dpp_f(float v) { return __builtin_bit_cast(float, __builtin_amdgcn_update_dpp(0, __builtin_bit_cast(int, v), CTRL, 0xF, 0xF, true)); }
__device__ __forceinline__ float sum16(float v) { v += dpp_f<0xB1>(v); v += dpp_f<0x4E>(v); v += dpp_f<0x141>(v); v += dpp_f<0x140>(v); return v; }
__device__ __forceinline__ float sum64(float v) { v = sum16(v); const int b = __builtin_bit_cast(int, v);
    return (__builtin_bit_cast(float, __builtin_amdgcn_readlane(b, 0)) + __builtin_bit_cast(float, __builtin_amdgcn_readlane(b, 16))) + (__builtin_bit_cast(float, __builtin_amdgcn_readlane(b, 32)) + __builtin_bit_cast(float, __builtin_amdgcn_readlane(b, 48))); }
__device__ __forceinline__ float wave_sum(float v) { return sum64(v); }
typedef float f32x2 __attribute__((ext_vector_type(2)));
__device__ __forceinline__ float sigmoidf_(float x) { return 1.f / (1.f + __expf(-x)); }

namespace attn_body {
using bf16=__hip_bfloat16;
using bf16x8=__attribute__((ext_vector_type(8)))short;
using s16x4=__attribute__((ext_vector_type(4)))short;
using f32x16=__attribute__((ext_vector_type(16)))float;
using u32x4=__attribute__((ext_vector_type(4)))unsigned;
constexpr int D=64,QP=512,KP=128,OP=512,SEQQ=8192,SEQK=8448;
constexpr int NW=8,QBLK=32,QB=QBLK*NW,KVBLK=64,NQB=SEQQ/QB;
constexpr int ATTN_UNIT_ROWS=QB;
__device__ __forceinline__ int crow(int r,int hi){return (r&3)+8*(r>>2)+4*hi;}
#define SBAR() __builtin_amdgcn_sched_barrier(0)
__device__ __forceinline__ void cmask(f32x16&p0,f32x16&p1,int jb,int qrel,int hi){
  const float NEG=-INFINITY; int kb=64*jb+4*hi;
  #pragma unroll
  for(int r=0;r<16;++r){int kv=kb+(r&3)+8*(r>>2); if(kv>qrel)p0[r]=NEG; if(kv+32>qrel)p1[r]=NEG;}
}

constexpr int NSLOT=3, SLOTB=8192;
constexpr int LDS_K=0, LDS_V=NSLOT*SLOTB, LDS_WS=2*NSLOT*SLOTB, LDS_OST=LDS_WS+NW*64*4, LDS_BYTES=LDS_OST+NW*4096;
constexpr float C2=0.125f*1.4426950408889634f;
__device__ __forceinline__ void glds16(const void*gsrc,unsigned lds_dst){unsigned keep;
  asm volatile("s_mov_b32 %0, m0\n\ts_mov_b32 m0, %2\n\ts_nop 0\n\tglobal_load_lds_dwordx4 %1, off\n\ts_mov_b32 m0, %0":"=&s"(keep):"v"(gsrc),"s"(lds_dst):"memory");}
__device__ __forceinline__ float max3f(float a,float b,float c){float r;asm("v_max3_f32 %0, %1, %2, %3":"=v"(r):"v"(a),"v"(b),"v"(c));return r;}
__device__ __forceinline__ float max2f(float a,float b){float r;asm("v_max_f32_e32 %0, %1, %2":"=v"(r):"v"(a),"v"(b));return r;}
__device__ __forceinline__ float fadd_s(float a,float b){float r;asm("v_add_f32_e32 %0, %1, %2":"=v"(r):"v"(a),"v"(b));return r;}
__device__ __forceinline__ float fsub_s(float a,float b){float r;asm("v_sub_f32_e32 %0, %1, %2":"=v"(r):"v"(a),"v"(b));return r;}
typedef float f32x2_t __attribute__((ext_vector_type(2))); typedef __bf16 bf16x2_t __attribute__((ext_vector_type(2)));
__device__ __forceinline__ unsigned cvtpk_s(float lo,float hi){f32x2_t v={lo,hi};bf16x2_t b=__builtin_convertvector(v,bf16x2_t);return __builtin_bit_cast(unsigned,b);}
#define WAIT_BAR(N) asm volatile("s_waitcnt vmcnt(" #N ") lgkmcnt(0)\n\ts_barrier":::"memory")

__device__ __forceinline__ void qkt(f32x16&p0,f32x16&p1,const char*Kslot,const bf16x8*qr,const f32x16&negm,int r32,int hi){
  const char*kb=Kslot+hi*1024+r32*16;
  #pragma unroll
  for(int d0=0;d0<4;++d0){
    const bf16x8 b0=*reinterpret_cast<const bf16x8*>(kb+d0*2048);
    const bf16x8 b1=*reinterpret_cast<const bf16x8*>(kb+d0*2048+512);
    if(d0==0){p0=__builtin_amdgcn_mfma_f32_32x32x16_bf16(b0,qr[0],negm,0,0,0);p1=__builtin_amdgcn_mfma_f32_32x32x16_bf16(b1,qr[0],negm,0,0,0);}
    else{p0=__builtin_amdgcn_mfma_f32_32x32x16_bf16(b0,qr[d0],p0,0,0,0);p1=__builtin_amdgcn_mfma_f32_32x32x16_bf16(b1,qr[d0],p1,0,0,0);}}
}
typedef __attribute__((address_space(3))) const char* lds_cptr;
typedef short v4i16_t __attribute__((ext_vector_type(4)));
__device__ __forceinline__ void kload8(bf16x8*kf,lds_cptr kp){
  kf[0]=*(const __attribute__((address_space(3))) bf16x8*)(kp);      kf[1]=*(const __attribute__((address_space(3))) bf16x8*)(kp+512);
  kf[2]=*(const __attribute__((address_space(3))) bf16x8*)(kp+2048); kf[3]=*(const __attribute__((address_space(3))) bf16x8*)(kp+2560);
  kf[4]=*(const __attribute__((address_space(3))) bf16x8*)(kp+4096); kf[5]=*(const __attribute__((address_space(3))) bf16x8*)(kp+4608);
  kf[6]=*(const __attribute__((address_space(3))) bf16x8*)(kp+6144); kf[7]=*(const __attribute__((address_space(3))) bf16x8*)(kp+6656);
}
__device__ __forceinline__ void kload2(bf16x8*kf,lds_cptr kp,int j){ kf[2*j]=*(const __attribute__((address_space(3))) bf16x8*)(kp+j*2048); kf[2*j+1]=*(const __attribute__((address_space(3))) bf16x8*)(kp+j*2048+512); }
__device__ __forceinline__ s16x4 vtr(lds_cptr p){ return __builtin_bit_cast(s16x4,__builtin_amdgcn_ds_read_tr16_b64_v4i16((__attribute__((address_space(3))) v4i16_t*)p)); }
__device__ __forceinline__ float rowmax(const f32x16&p0,const f32x16&p1){
  float a=max3f(p0[0],p0[1],p1[0]),b=max3f(p0[2],p0[3],p1[1]);a=max3f(a,p1[2],p1[3]);
  #pragma unroll
  for(int r=4;r<16;r+=4){a=max3f(a,p0[r],p0[r+1]);b=max3f(b,p0[r+2],p0[r+3]);a=max3f(a,p1[r],p1[r+1]);b=max3f(b,p1[r+2],p1[r+3]);}
  const float m=max2f(a,b);
  auto rr=__builtin_amdgcn_permlane32_swap(__float_as_uint(m),__float_as_uint(m),false,false);
  return max2f(__uint_as_float(rr[0]),__uint_as_float(rr[1]));
}
__device__ __forceinline__ void pv(f32x16*o,int vb,bf16x8 pa0,bf16x8 pa1,bf16x8 pa2,bf16x8 pa3){
  #pragma unroll
  for(int d0=0;d0<2;++d0){s16x4 lo[4],hi[4];
    #pragma unroll
    for(int ks=0;ks<4;++ks){
      asm volatile("ds_read_b64_tr_b16 %0,%1 offset:%c2":"=&v"(lo[ks]):"v"(vb),"i"(d0*4096+ks*1024):"memory");
      asm volatile("ds_read_b64_tr_b16 %0,%1 offset:%c2":"=&v"(hi[ks]):"v"(vb),"i"(d0*4096+ks*1024+512):"memory");}
    asm volatile("s_waitcnt lgkmcnt(0)":::"memory");SBAR();
    #define PK(k) (bf16x8){lo[k][0],lo[k][1],lo[k][2],lo[k][3],hi[k][0],hi[k][1],hi[k][2],hi[k][3]}
    o[d0]=__builtin_amdgcn_mfma_f32_32x32x16_bf16(pa0,PK(0),o[d0],0,0,0);
    o[d0]=__builtin_amdgcn_mfma_f32_32x32x16_bf16(pa1,PK(1),o[d0],0,0,0);
    o[d0]=__builtin_amdgcn_mfma_f32_32x32x16_bf16(pa2,PK(2),o[d0],0,0,0);
    o[d0]=__builtin_amdgcn_mfma_f32_32x32x16_bf16(pa3,PK(3),o[d0],0,0,0);
    #undef PK
  }
}

#ifndef ATTN_STORE16
#define ATTN_STORE16(p,v) (*(u32x4*)(p)=(v))
#endif
template<int THRL> __device__ __forceinline__ void attn_unit(int b,int h,int qb,const bf16*Q,const bf16*__restrict__ K,const bf16*__restrict__ V,bf16*O,char*shm,int wave_in){
  int ln_; asm volatile("v_mbcnt_lo_u32_b32 %0, -1, 0\n\tv_mbcnt_hi_u32_b32 %0, -1, %0" : "=v"(ln_)); asm volatile("" : "+s"(wave_in)); int tid_=wave_in*64+ln_; const int tid=tid_,lane=tid&63,r32=lane&31,hi=lane>>5; const int wid=__builtin_amdgcn_readfirstlane(tid>>6);
  const long rowq=(long)b*SEQQ, rowk=(long)b*SEQK; const int q0=qb*QB;
  const bf16*Qw=Q+(rowq+q0+wid*QBLK)*QP+h*D;
  const bf16*Kh=K+rowk*KP+(h>>2)*D,*Vh=V+rowk*KP+(h>>2)*D;
  const unsigned lds0=(unsigned)(uintptr_t)shm;
  float*wsf=(float*)(shm+LDS_WS)+wid*64;
  const bf16*ksrc=Kh+(long)lane*KP+wid*8;
  const bf16*vsrc=Vh+(long)(16*(wid&3)+(lane>>2))*KP+(wid>>2)*32+(lane&3)*8;
  const unsigned kdst=lds0+LDS_K+wid*1024, vdst=lds0+LDS_V+wid*1024;
  #define DMA_K(t,slot) glds16(ksrc+(long)(t)*KVBLK*KP,(unsigned)__builtin_amdgcn_readfirstlane(kdst+(slot)))
  #define DMA_V(t,slot) glds16(vsrc+(long)(t)*KVBLK*KP,(unsigned)__builtin_amdgcn_readfirstlane(vdst+(slot)))
  const int vb0=(int)(lds0+LDS_V)+((lane>>4)&1)*32+(lane&3)*8+(4*hi+((lane&15)>>2))*64;
  const char*Kbase=shm+LDS_K; bf16x8 kf[8];
  const lds_cptr shm3=(lds_cptr)shm; const lds_cptr kp0=shm3+LDS_K+hi*1024+r32*16; const lds_cptr vp0=shm3+LDS_V+((lane>>4)&1)*32+(lane&3)*8+(4*hi+((lane&15)>>2))*64;
  constexpr int NT=SEQK/KVBLK;
  DMA_K(0,0);DMA_V(0,0);DMA_K(1,SLOTB);
  bf16x8 qr[4];
  #pragma unroll
  for(int d0=0;d0<4;++d0)qr[d0]=*reinterpret_cast<const bf16x8*>(&Qw[(long)r32*QP+d0*16+hi*8]);
  float mhat=0.f,l_reg=0.f;f32x16 o[2];o[0]=f32x16{};o[1]=f32x16{};f32x16 negm=f32x16{};asm volatile("":"+v"(negm));

  #define CMASK(P0,P1,t) do{}while(0)
  bool resc=false;
  #define START(P0,P1) do{ const float rm=rowmax(P0,P1); resc=false; \
    { const float dl=rm; mhat=fadd_s(mhat,dl); \
      _Pragma("unroll") for(int r=0;r<16;++r){P0[r]=fsub_s(P0[r],dl);P1[r]=fsub_s(P1[r],dl);} \
      _Pragma("unroll") for(int r=0;r<16;++r)negm[r]=-mhat; asm volatile("":"+v"(negm)); } \
    _Pragma("unroll") for(int r=0;r<16;++r)P0[r]=__builtin_amdgcn_exp2f(P0[r]); }while(0)
  #define RESC() do{ if(resc){ asm volatile("s_waitcnt lgkmcnt(0)":::"memory"); \
      _Pragma("unroll") for(int d_=0;d_<2;++d_) _Pragma("unroll") for(int r=0;r<16;++r)o[d_][r]*=wsf[crow(r,hi)]; } }while(0)
  f32x16 pA0,pA1,pB0,pB1;
  int sl_prev=0,sl_cur=0,sl_next=SLOTB;
  #define ROT() do{sl_prev=sl_cur;sl_cur=sl_next;sl_next=(sl_next==(NSLOT-1)*SLOTB)?0:sl_next+SLOTB;}while(0)
  DMA_K(2,2*SLOTB);
  WAIT_BAR(3);
  qkt(pA0,pA1,Kbase,qr,negm,r32,hi);asm volatile("s_nop 15\n\ts_nop 7":"+v"(pA0),"+v"(pA1));CMASK(pA0,pA1,0);
  START(pA0,pA1);
  _Pragma("unroll") for(int r=0;r<16;++r)pA1[r]=__builtin_amdgcn_exp2f(pA1[r]);
  WAIT_BAR(0);
  DMA_K(3,0);DMA_V(1,SLOTB);
  ROT();
  kload8(kf,kp0+sl_cur);
  WAIT_BAR(2);
  s16x4 vlo[8],vhi[8]; u32x4 pw0,pw1,pw2,pw3;
  #define PKW(P,B) cvtpk_s(P[B],P[B+1])
  #define PAF(k) __builtin_bit_cast(bf16x8,pw##k)
  #define VFR(i) (bf16x8){vlo[i][0],vlo[i][1],vlo[i][2],vlo[i][3],vhi[i][0],vhi[i][1],vhi[i][2],vhi[i][3]}
  #define PIN(x) asm volatile("":"+v"(x))
  #define MX3(a,b,c) __builtin_fmaxf(__builtin_fmaxf((a),(b)),(c))
  #define GAPA(MF,A0,A1,A2,A3,W0,W1,PW) do{ MF; sacc+=A0; sacc+=A1; sacc+=A2; sacc+=A3; PIN(sacc); W0; W1; PIN(PW); SBAR(); }while(0)
  #define EX(v) __builtin_amdgcn_exp2f(v)
  #define GAPB(MF,X,B) do{ MF; X[B]=EX(X[B]); X[B+1]=EX(X[B+1]); X[B+2]=EX(X[B+2]); X[B+3]=EX(X[B+3]); PIN(X); SBAR(); }while(0)
  #define VRD(i) do{ vlo[i]=vtr(vp_+(((i)>>2)*4096+((i)&3)*1024)); vhi[i]=vtr(vp_+(((i)>>2)*4096+((i)&3)*1024+512)); }while(0)
  #define KRD(G,j) do{ if(G){ kload2(kf,kp0+sl_next,j); SBAR(); } }while(0)
  #define STEP(C0,C1,P0,P1,t,GK,GV,GL) do{ SBAR(); \
    const lds_cptr vp_=vp0+sl_prev; \
    VRD(0); SBAR(); float sacc=(P0[0]+P0[1]); \
    GAPA(C0=__builtin_amdgcn_mfma_f32_32x32x16_bf16(kf[0],qr[0],negm,0,0,0), P0[2],P0[3],P0[4],P0[5],     pw0[0]=PKW(P0,0), pw0[1]=PKW(P0,2), pw0); \
    VRD(4); SBAR(); GAPA(C1=__builtin_amdgcn_mfma_f32_32x32x16_bf16(kf[1],qr[0],negm,0,0,0), P0[6],P0[7],P0[8],P0[9],     pw0[2]=PKW(P0,4), pw0[3]=PKW(P0,6), pw0); \
    VRD(1); SBAR(); GAPA(C0=__builtin_amdgcn_mfma_f32_32x32x16_bf16(kf[2],qr[1],C0,0,0,0),   P0[10],P0[11],P0[12],P0[13], pw1[0]=PKW(P0,8), pw1[1]=PKW(P0,10), pw1); \
    VRD(5); SBAR(); GAPA(C1=__builtin_amdgcn_mfma_f32_32x32x16_bf16(kf[3],qr[1],C1,0,0,0),   P0[14],P0[15],P1[0],P1[1],   pw1[2]=PKW(P0,12),pw1[3]=PKW(P0,14), pw1); \
    VRD(2); SBAR(); GAPA(C0=__builtin_amdgcn_mfma_f32_32x32x16_bf16(kf[4],qr[2],C0,0,0,0),   P1[2],P1[3],P1[4],P1[5],     pw2[0]=PKW(P1,0), pw2[1]=PKW(P1,2), pw2); \
    VRD(6); SBAR(); GAPA(C1=__builtin_amdgcn_mfma_f32_32x32x16_bf16(kf[5],qr[2],C1,0,0,0),   P1[6],P1[7],P1[8],P1[9],     pw2[2]=PKW(P1,4), pw2[3]=PKW(P1,6), pw2); \
    VRD(3); SBAR(); GAPA(C0=__builtin_amdgcn_mfma_f32_32x32x16_bf16(kf[6],qr[3],C0,0,0,0),   P1[10],P1[11],P1[12],P1[13], pw3[0]=PKW(P1,8), pw3[1]=PKW(P1,10), pw3); \
    VRD(7); SBAR(); GAPA(C1=__builtin_amdgcn_mfma_f32_32x32x16_bf16(kf[7],qr[3],C1,0,0,0),   P1[14],P1[15],0.f,0.f,       pw3[2]=PKW(P1,12),pw3[3]=PKW(P1,14), pw3); \
    l_reg+=sacc; \
    if(GK){DMA_K((t)+3,sl_cur);} if(GV){DMA_V((t)+1,sl_next);} \
    CMASK(C0,C1,t); \
    { float a=MX3(C0[0],C0[1],C1[0]),b=MX3(C0[2],C0[3],C1[1]); a=MX3(a,C1[2],C1[3]); \
      _Pragma("unroll") for(int r=4;r<16;r+=4){a=MX3(a,C0[r],C0[r+1]);b=MX3(b,C0[r+2],C0[r+3]);a=MX3(a,C1[r],C1[r+1]);b=MX3(b,C1[r+2],C1[r+3]);} \
      float rm=__builtin_fmaxf(a,b); { auto rr=__builtin_amdgcn_permlane32_swap(__float_as_uint(rm),__float_as_uint(rm),false,false); rm=__builtin_fmaxf(__uint_as_float(rr[0]),__uint_as_float(rr[1])); } \
      resc=false; \
      if(__builtin_expect(__any(rm>(float)THRL),0)){ const float dl=__builtin_fmaxf(rm,0.f); mhat+=dl; \
        _Pragma("unroll") for(int r=0;r<16;++r){C0[r]-=dl;C1[r]-=dl;} \
        _Pragma("unroll") for(int r=0;r<16;++r)negm[r]=-mhat; asm volatile("":"+v"(negm)); \
        const float f=__builtin_amdgcn_exp2f(-dl); l_reg*=f; if(hi==0)wsf[r32]=f; resc=true; } } \
    SBAR(); \
    GAPB(o[0]=__builtin_amdgcn_mfma_f32_32x32x16_bf16(PAF(0),VFR(0),o[0],0,0,0), C0,0); \
    GAPB(o[1]=__builtin_amdgcn_mfma_f32_32x32x16_bf16(PAF(0),VFR(4),o[1],0,0,0), C0,4); \
    KRD(GL,0); GAPB(o[0]=__builtin_amdgcn_mfma_f32_32x32x16_bf16(PAF(1),VFR(1),o[0],0,0,0), C0,8); \
    KRD(GL,1); GAPB(o[1]=__builtin_amdgcn_mfma_f32_32x32x16_bf16(PAF(1),VFR(5),o[1],0,0,0), C0,12); \
    KRD(GL,2); GAPB(o[0]=__builtin_amdgcn_mfma_f32_32x32x16_bf16(PAF(2),VFR(2),o[0],0,0,0), C1,0); \
    KRD(GL,3); GAPB(o[1]=__builtin_amdgcn_mfma_f32_32x32x16_bf16(PAF(2),VFR(6),o[1],0,0,0), C1,4); \
    GAPB(o[0]=__builtin_amdgcn_mfma_f32_32x32x16_bf16(PAF(3),VFR(3),o[0],0,0,0), C1,8); \
    GAPB(o[1]=__builtin_amdgcn_mfma_f32_32x32x16_bf16(PAF(3),VFR(7),o[1],0,0,0), C1,12); \
    }while(0)
  int t=1;
  #undef CMASK
  #define CMASK(P0,P1,t) do{}while(0)
  for(;t+5<NT;t+=2){
    STEP(pB0,pB1,pA0,pA1,t,true,true,true);     WAIT_BAR(2); RESC(); ROT();
    STEP(pA0,pA1,pB0,pB1,t+1,true,true,true);   WAIT_BAR(2); RESC(); ROT();
  }
  #undef CMASK
  #define CMASK(P0,P1,t) do{}while(0)
  #define ENDW(tt) do{ if((tt)+3<NT){WAIT_BAR(2);} else if((tt)+2<NT){WAIT_BAR(1);} else {WAIT_BAR(0);} }while(0)
  for(;t+1<NT;t+=2){
    STEP(pB0,pB1,pA0,pA1,t,(t+3<NT),(t+1<NT),(t+1<NT));       ENDW(t);   RESC(); ROT();
    STEP(pA0,pA1,pB0,pB1,t+1,(t+4<NT),(t+2<NT),(t+2<NT));     ENDW(t+1); RESC(); ROT();
  }
  STEP(pB0,pB1,pA0,pA1,NT-1,false,false,false); RESC();
  { float sacc=pB0[0]+pB0[1]; _Pragma("unroll") for(int r=2;r<16;++r)sacc+=pB0[r]; _Pragma("unroll") for(int r=0;r<16;++r)sacc+=pB1[r]; l_reg+=sacc;
    pw0=(u32x4){PKW(pB0,0),PKW(pB0,2),PKW(pB0,4),PKW(pB0,6)};pw1=(u32x4){PKW(pB0,8),PKW(pB0,10),PKW(pB0,12),PKW(pB0,14)};pw2=(u32x4){PKW(pB1,0),PKW(pB1,2),PKW(pB1,4),PKW(pB1,6)};pw3=(u32x4){PKW(pB1,8),PKW(pB1,10),PKW(pB1,12),PKW(pB1,14)};
    SBAR(); pv(o,vb0+sl_cur,PAF(0),PAF(1),PAF(2),PAF(3)); }
  #undef PKW
  #undef PAF
  #undef VFR
  #undef PIN
  #undef MX3
  #undef GAPA
  #undef GAPB
  #undef EX
  #undef VRD
  #undef KRD
  #undef STEP
  #undef ENDW
  {auto rr=__builtin_amdgcn_permlane32_swap(__float_as_uint(l_reg),__float_as_uint(l_reg),false,false);l_reg=__uint_as_float(rr[0])+__uint_as_float(rr[1]);}
  if(hi==0)wsf[32+r32]=l_reg;asm volatile("s_waitcnt lgkmcnt(0)":::"memory");
  float rli[16];
  #pragma unroll
  for(int r=0;r<16;++r)rli[r]=__builtin_amdgcn_rcpf(wsf[32+crow(r,hi)]);
  bf16*Ow=O+(rowq+q0+wid*QBLK)*OP+h*D;
  { bf16*stg=(bf16*)(shm+LDS_OST)+wid*2048;
    #pragma unroll
    for(int r=0;r<16;++r){const int orow=crow(r,hi);
      #pragma unroll
      for(int d0=0;d0<2;++d0)stg[orow*64+d0*32+r32]=__float2bfloat16(o[d0][r]*rli[r]);}
    asm volatile("s_waitcnt lgkmcnt(0)":::"memory");
    #pragma unroll
    for(int i=0;i<4;++i){const int row=i*8+(lane>>3),ch=lane&7; const u32x4 v=*(const u32x4*)(stg+row*64+ch*8); ATTN_STORE16(Ow+(long)row*OP+ch*8,v);} }
  asm volatile("s_waitcnt lgkmcnt(0)\n\ts_barrier":::"memory");
  #undef DMA_K
  #undef DMA_V
  #undef CMASK
  #undef START
  #undef RESC
  #undef ROT
}
constexpr int ATTN_LDS_BYTES=LDS_BYTES;
struct AttnTensors { const bf16* Q; const bf16* K; const bf16* V; bf16* O; };
template<int THRL=8> __device__ __forceinline__ void attn_phase(char*lds,const AttnTensors&T,int vcu,int G,int wave_in){
  for(int u=vcu;u<2*8*NQB;u+=G){ attn_unit<THRL>(u>>8,(u>>5)&7,u&31,T.Q,T.K,T.V,T.O,lds,wave_in); }
}
#undef SBAR
#undef WAIT_BAR
}
#define XB_TMO      128
#define XB_XCNT(j)  (256  + 64 * (j))
#define XB_XSUB(j)  (1280 + 64 * (j))
#define XB_XGEN(j)  (2304 + 64 * (j))
#define XB_TOP      3328
#define XB_TOPGEN   3392
#define XCD_BAR_WORDS 3456
#define XB_SPIN_CAP (1u << 18)

__device__ __forceinline__ unsigned xb_ld(unsigned* p)              { return __hip_atomic_load(p, __ATOMIC_RELAXED, __HIP_MEMORY_SCOPE_AGENT); }
__device__ __forceinline__ unsigned xb_add(unsigned* p, unsigned v) { return __hip_atomic_fetch_add(p, v, __ATOMIC_RELAXED, __HIP_MEMORY_SCOPE_AGENT); }
__device__ __forceinline__ unsigned xb_xcc_id() { return (unsigned)__builtin_amdgcn_s_getreg((3 << 11) | 20) & 0xFu; }
#define XB_SPIN(cond, bar) do { unsigned _sp = 0; while (cond) { __builtin_amdgcn_s_sleep(1); \
    if ((++_sp & 255u) == 0u) { if (xb_ld(&(bar)[XB_TMO])) break; if (_sp > XB_SPIN_CAP) { atomicAdd(&(bar)[XB_TMO], 1u); break; } } } } while (0)

struct XcdBarrier {
    unsigned* bar; unsigned x;
    int wv;
    volatile LAS unsigned* st;
};

__device__ __forceinline__ bool xb_thread0(int wv) { int ln_; asm volatile("v_mbcnt_lo_u32_b32 %0, -1, 0\n\tv_mbcnt_hi_u32_b32 %0, -1, %0" : "=v"(ln_)); return wv == 0 && ln_ == 0; }
__device__ __forceinline__ XcdBarrier xcd_barrier_post(unsigned* bar, volatile LAS unsigned* st, int wv) {
    XcdBarrier b; b.bar = bar; b.x = xb_xcc_id(); b.st = st; b.wv = wv;
    if (xb_thread0(wv)) (void)xb_add(&bar[XB_XCNT(b.x)], 1u);
    return b;
}
__device__ __forceinline__ void xcd_barrier_complete(unsigned* bar, unsigned x, unsigned& nloc, unsigned& nx) {
    const unsigned G = gridDim.x * gridDim.y * gridDim.z;
    unsigned sum, cnt, mine, sp = 0u;
    for (;;) {
        sum = 0u; cnt = 0u; mine = 0u;
#pragma unroll
        for (unsigned j = 0; j < 16; ++j) { const unsigned c = xb_ld(&bar[XB_XCNT(j)]); sum += c; cnt += (c > 0u) ? 1u : 0u; mine = (j == x) ? c : mine; }
        if (sum == G) break;
        __builtin_amdgcn_s_sleep(1);
        if ((++sp & 255u) == 0u) { if (xb_ld(&bar[XB_TMO])) break; if (sp > XB_SPIN_CAP) { atomicAdd(&bar[XB_TMO], 1u); break; } }
    }
    nloc = mine > 0u ? mine : 1u; nx = cnt > 0u ? cnt : 1u;
}

__device__ __forceinline__ void xcd_barrier(const XcdBarrier& b) {
    asm volatile("s_waitcnt vmcnt(0)" ::: "memory");
    __syncthreads();
    if (xb_thread0(b.wv)) {
        unsigned* bar = b.bar;
        __builtin_amdgcn_s_waitcnt(0);
        unsigned nloc = b.st[0], nx = b.st[1];
        if (nloc == 0u) { xcd_barrier_complete(bar, b.x, nloc, nx); b.st[0] = nloc; b.st[1] = nx; }
        const unsigned old = xb_add(&bar[XB_XSUB(b.x)], 1u);
        const unsigned gen = old / nloc;
        if (old + 1u == (gen + 1u) * nloc) {
            __builtin_amdgcn_fence(__ATOMIC_RELEASE, "agent");
            asm volatile("s_waitcnt vmcnt(0)" ::: "memory");
            const unsigned og = xb_add(&bar[XB_TOP], 1u);
            const unsigned tg = og / nx;
            if (og + 1u == (tg + 1u) * nx) xb_add(&bar[XB_TOPGEN], 1u);
            else XB_SPIN(xb_ld(&bar[XB_TOPGEN]) == tg, bar);
            __builtin_amdgcn_fence(__ATOMIC_ACQUIRE, "agent");
            xb_add(&bar[XB_XGEN(b.x)], 1u);
            asm volatile("s_waitcnt vmcnt(0)" ::: "memory");
        } else {
            XB_SPIN(xb_ld(&bar[XB_XGEN(b.x)]) == gen, bar);
            __builtin_amdgcn_fence(__ATOMIC_ACQUIRE, "agent");
            asm volatile("s_waitcnt vmcnt(0)" ::: "memory");
        }
    }
    __syncthreads();
}

struct Args { const float* in[33]; float* out; unsigned char* ws; int gp_lo, gp_hi, use_bar, pad; };
enum { I_X = 0, I_C, I_CTX, I_CCTX, I_ADAW, I_ADAB, I_N1G, I_N2G, I_WIN, I_RPB, I_QG, I_KG, I_MURKV, I_MUW, I_MUA, I_MUG, I_W0, I_W2, I_A0, I_A2, I_G2,
       I_KK, I_KA, I_RK, I_LNXG, I_LNXB, I_GRPG, I_WOUT, I_FUP, I_CONVW, I_CONVB, I_FDN, I_FING };
struct Frame {
    LAS unsigned char* lds;
    int tid, lane, wave, vcu, G;
    GAS unsigned char* ws;
};
#define WSP(T, off) ((T*)(GAS T*)(f.ws + (off)))
__device__ __forceinline__ const float* karg_in(int idx) {
    const GAS float* p; const void* ka = (const void*)__builtin_amdgcn_kernarg_segment_ptr();
    asm volatile("s_load_dwordx2 %0, %1, %2\n\ts_waitcnt lgkmcnt(0)" : "=s"(p) : "s"(ka), "i"(idx * 8) : "memory");
    return (const float*)p;
}
__device__ __forceinline__ void launder_ws(Frame& f) {
    GAS unsigned char* w = f.ws; int wv = f.wave, v = f.vcu, g = f.G, ln;
    asm volatile("" : "+s"(w), "+s"(wv), "+s"(v), "+s"(g));
    asm volatile("v_mbcnt_lo_u32_b32 %0, -1, 0\n\tv_mbcnt_hi_u32_b32 %0, -1, %0" : "=v"(ln));
    f.ws = w; f.wave = wv; f.lane = ln; f.tid = wv * 64 + ln; f.vcu = v; f.G = g;
}

struct RowInfo { int t, T, b, isctx; };
__device__ __forceinline__ RowInfo row_info(int m) {
    RowInfo r;
    if (m < MLAT) { r.b = m >> 13; r.t = m & (SEQ - 1); r.T = SEQ; r.isctx = 0; }
    else { const int mm = m - MLAT; r.b = mm >> 8; r.t = mm & (CTXL - 1); r.T = CTXL; r.isctx = 1; }
    return r;
}

__device__ __forceinline__ void transpose_item(const float* W, int K, int N, bf16* WT, LAS float* scr, int item, int lane) {
    const int nblk = N / 32, kb = item / nblk, nb = item % nblk, k0 = 64 * kb, n0 = 32 * nb;
    float tv[32];
#pragma unroll
    for (int i = 0; i < 32; ++i) { const int kk = 2 * i + (lane >> 5); tv[i] = W[(size_t)(k0 + kk) * N + n0 + (lane & 31)]; }
#pragma unroll
    for (int i = 0; i < 32; ++i) { const int kk = 2 * i + (lane >> 5); scr[kk * 33 + (lane & 31)] = tv[i]; }
    LDS_WAIT(); asm volatile("" ::: "memory");
    const int c = lane & 7;
#pragma unroll
    for (int j = 0; j < 4; ++j) { const int n = (lane >> 3) + 8 * j; const LAS float* s = scr + (8 * c) * 33 + n;
        v4u o; o.x = pk2(s[0 * 33], s[1 * 33]); o.y = pk2(s[2 * 33], s[3 * 33]); o.z = pk2(s[4 * 33], s[5 * 33]); o.w = pk2(s[6 * 33], s[7 * 33]);
        *(v4u*)(WT + (size_t)(n0 + n) * K + k0 + 8 * c) = o; }
    LDS_WAIT(); asm volatile("" ::: "memory");
}
__device__ __forceinline__ void ph_convert(Frame& f) { const float* in_I_ADAW = karg_in(I_ADAW); const float* in_I_C = karg_in(I_C); const float* in_I_CCTX = karg_in(I_CCTX); const float* in_I_CTX = karg_in(I_CTX); const float* in_I_FDN = karg_in(I_FDN); const float* in_I_FUP = karg_in(I_FUP); const float* in_I_WIN = karg_in(I_WIN); const float* in_I_WOUT = karg_in(I_WOUT); const float* in_I_X = karg_in(I_X); launder_ws(f);
    LAS float* scr = (LAS float*)(f.lds + f.wave * 16384);
    const int gw = f.vcu * NWAVES + f.wave, NGW = f.G * NWAVES;
    constexpr int I_IN = (DM / 64) * (INC / 32), I_OUT = (DM / 64) * (DM / 32), I_UP = (DM / 64) * (UPN / 32), I_DN = (DFF / 64) * (DM / 32), I_L = I_IN + I_OUT + I_UP + I_DN;
    for (int it = gw; it < DEPTH * I_L; it += NGW) {
        const int l = it / I_L; int r = it % I_L;
        if (r < I_IN) { transpose_item(in_I_WIN + (size_t)l * DM * INC, DM, INC, WSP(bf16, WS_WIN) + (size_t)l * INP * DM, scr, r, f.lane); continue; } r -= I_IN;
        if (r < I_OUT) { transpose_item(in_I_WOUT + (size_t)l * DM * DM, DM, DM, WSP(bf16, WS_WOUT) + (size_t)l * DM * DM, scr, r, f.lane); continue; } r -= I_OUT;
        if (r < I_UP) {
            const int nb = r % (UPN / 32), n0 = 32 * nb, ch = n0 >= DFF ? n0 - DFF : n0, drow = (ch >> 7) * 256 + (n0 >= DFF ? 128 : 0) + (ch & 127);
            transpose_item(in_I_FUP + (size_t)l * DM * UPN, DM, UPN, WSP(bf16, WS_WUP) + (size_t)l * UPN * DM + (size_t)(drow - n0) * DM, scr, r, f.lane); continue; } r -= I_UP;
        transpose_item(in_I_FDN + (size_t)l * DFF * DM, DFF, DM, WSP(bf16, WS_WDN) + (size_t)l * DM * DFF, scr, r, f.lane);
    }
    for (int it = gw; it < DEPTH * (INP - INC); it += NGW) {
        const int l = it / (INP - INC), r = INC + it % (INP - INC);
        v4u* p = (v4u*)(WSP(bf16, WS_WIN) + ((size_t)l * INP + r) * DM) + f.lane;
#pragma unroll
        for (int j = 0; j < 4; ++j) p[64 * j] = (v4u){0u, 0u, 0u, 0u};
    }
    for (int it = gw; it < DEPTH * 48 * 16; it += NGW) {
        const int l = it / 768, rem = it % 768, cg = rem / 16, ks = rem % 16;
#pragma unroll
        for (int q = 0; q < 2; ++q) { const int kk = f.lane + 64 * q, k = ks * 128 + kk;
            const float c0 = in_I_C[k], c1 = in_I_C[DM + k], c2 = in_I_CCTX[k];
            scr[kk] = c0 * sigmoidf_(c0); scr[128 + kk] = c1 * sigmoidf_(c1); scr[256 + kk] = c2 * sigmoidf_(c2); }
        LDS_WAIT(); asm volatile("" ::: "memory");
        const f32x4* Wp = (const f32x4*)(in_I_ADAW + ((size_t)l * DM + ks * 128) * MODW + cg * 256) + f.lane;
        f32x4 a0 = {0.f, 0.f, 0.f, 0.f}, a1 = a0, a2 = a0;
#pragma unroll 8
        for (int kk = 0; kk < 128; ++kk) { const f32x4 w = Wp[(size_t)kk * (MODW / 4)]; a0 += w * scr[kk]; a1 += w * scr[128 + kk]; a2 += w * scr[256 + kk]; }
        float* o = WSP(float, WS_MODP) + ((size_t)(ks * DEPTH + l) * 3) * MODW + cg * 256 + f.lane * 4;
        *(f32x4*)(o) = a0; *(f32x4*)(o + MODW) = a1; *(f32x4*)(o + 2 * MODW) = a2;
        LDS_WAIT(); asm volatile("" ::: "memory");
    }
}
__device__ __forceinline__ void ph_modsum(Frame& f) { const float* in_I_ADAB = karg_in(I_ADAB); launder_ws(f);
    const int gt = f.vcu * 512 + f.tid, GT = f.G * 512;
    for (int i = gt; i < DEPTH * 3 * MODW; i += GT) {
        const int l = i / (3 * MODW), j = i % MODW;
        float s = in_I_ADAB[l * MODW + j];
#pragma unroll
        for (int ks = 0; ks < 16; ++ks) s += WSP(float, WS_MODP)[(size_t)ks * DEPTH * 3 * MODW + i];
        WSP(float, WS_MOD)[i] = s;
    }
}

__device__ __forceinline__ void ph_norm(Frame& f, int l, int which, int mrows) { const float* in_I_N1G = karg_in(I_N1G); const float* in_I_N2G = karg_in(I_N2G); launder_ws(f);
    const int gw = f.vcu * NWAVES + f.wave, NGW = f.G * NWAVES;
    const float* g = (which == 0 ? in_I_N1G : in_I_N2G) + l * DM;
    const int offsh = which == 0 ? 0 : 3 * DM, offsc = offsh + DM;
    for (int m = gw; m < mrows; m += NGW) {
        const int s = m < SEQ ? 0 : (m < MLAT ? 1 : 2);
        const float* mod = WSP(float, WS_MOD) + (size_t)(l * 3 + s) * MODW;
        const f32x4* xr = (const f32x4*)(WSP(float, WS_H) + (size_t)m * DM) + f.lane;
        f32x4 v[8]; float ss = 0.f;
#pragma unroll
        for (int j = 0; j < 8; ++j) { v[j] = xr[64 * j]; ss += (v[j].x * v[j].x + v[j].y * v[j].y) + (v[j].z * v[j].z + v[j].w * v[j].w); }
        const float rs = 1.0f / sqrtf(wave_sum(ss) * (1.f / DM) + 1e-6f);
        v2u* o = (v2u*)(WSP(bf16, WS_XN) + (size_t)m * DM) + f.lane;
#pragma unroll
        for (int j = 0; j < 8; ++j) { const int col = f.lane * 4 + 256 * j;
            const f32x4 g4 = *(const f32x4*)(g + col), sc = *(const f32x4*)(mod + offsc + col), sh = *(const f32x4*)(mod + offsh + col);
            const f32x4 r = (v[j] * rs) * g4 * (sc + 1.0f) + sh;
            v2u w; w.x = pk2(r.x, r.y); w.y = pk2(r.z, r.w); o[64 * j] = w; }
    }
}

__device__ __forceinline__ void ph_prep(Frame& f, int l) { const float* in_I_KG = karg_in(I_KG); const float* in_I_QG = karg_in(I_QG); launder_ws(f);
    const int gw = f.vcu * NWAVES + f.wave, NGW = f.G * NWAVES, lane = f.lane;
    const float qg = in_I_QG[l * HD + lane], kg = in_I_KG[l * HD + lane];
    const int ri = lane & 15, ra = lane >> 5, rp = (lane >> 4) & 1;
    const float inv_freq = powf(10000.0f, -(float)ri / 16.0f);
    for (int m = gw; m < MALL; m += NGW) {
        const RowInfo R = row_info(m);
        const bf16* y = WSP(bf16, WS_Y1) + (size_t)m * INP;
        float sn = 0.f, cs = 1.f;
        if (!R.isctx) { const int pos = ra == 0 ? (R.t / GRIDW) : (R.t % GRIDW); const float ang = (float)pos * inv_freq; sincosf(ang, &sn, &cs); }
        const int kvpos = R.isctx ? R.t : CTXL + R.t;
        const size_t kvrow = ((size_t)R.b * SKV + kvpos) * 128;
#pragma unroll
        for (int hh = 0; hh < 10; ++hh) {
            const int col = hh < 8 ? C_QB + hh * 64 + lane : C_KB + (hh - 8) * 64 + lane;
            const float x = bf2f(y[col]);
            const float ss = wave_sum(x * x);
            float xn = x * (1.0f / sqrtf(ss * (1.f / HD) + 1e-6f)) * (hh < 8 ? qg : kg);
            const float xp = __shfl_xor(xn, 16);
            if (!R.isctx) xn = rp == 0 ? (xn * cs - xp * sn) : (xp * sn + xn * cs);
            if (hh < 8) WSP(bf16, WS_QBP)[(size_t)m * 512 + hh * 64 + lane] = (bf16)f2bf(xn * QSCALE);
            else WSP(bf16, WS_KBP)[kvrow + (hh - 8) * 64 + lane] = (bf16)f2bf(xn);
        }
#pragma unroll
        for (int hv = 0; hv < 2; ++hv) WSP(bf16, WS_VBP)[kvrow + hv * 64 + lane] = y[C_VB + hv * 64 + lane];
    }
}

template <int KR> __device__ __forceinline__ void lora_mm(const LAS float* X, const float* W, int c0, float (&acc)[32][2]) {
#pragma unroll
    for (int t = 0; t < 32; ++t) { acc[t][0] = 0.f; acc[t][1] = 0.f; }
    for (int r4 = 0; r4 < KR / 4; ++r4) {
        float wa[4], wb[4];
#pragma unroll
        for (int i = 0; i < 4; ++i) { wa[i] = W[(size_t)(4 * r4 + i) * CW + c0]; wb[i] = W[(size_t)(4 * r4 + i) * CW + c0 + 512]; }
#pragma unroll
        for (int t = 0; t < 32; ++t) { const f32x4 x = *(const LAS f32x4*)(X + t * KR + 4 * r4);
            acc[t][0] += x.x * wa[0] + x.y * wa[1] + x.z * wa[2] + x.w * wa[3];
            acc[t][1] += x.x * wb[0] + x.y * wb[1] + x.z * wb[2] + x.w * wb[3]; }
    }
}
__device__ __forceinline__ void ph_lora(Frame& f, int l) { const float* in_I_A0 = karg_in(I_A0); const float* in_I_A2 = karg_in(I_A2); const float* in_I_G2 = karg_in(I_G2); const float* in_I_MUA = karg_in(I_MUA); const float* in_I_MUG = karg_in(I_MUG); const float* in_I_MUW = karg_in(I_MUW); const float* in_I_W0 = karg_in(I_W0); const float* in_I_W2 = karg_in(I_W2); launder_ws(f);
    LAS float* tw = (LAS float*)f.lds;
    LAS float* ta = tw + 4096;
    LAS float* sg = ta + 4096;
    const bf16* Y1 = WSP(bf16, WS_Y1);
    const int c0 = f.tid;
    __syncthreads();
    for (int tile = f.vcu; tile < MALL / 32; tile += f.G) {
        const int m0 = tile * 32;
        for (int idx = f.tid; idx < 32 * 416; idx += 512) {
            const int tok = idx / 416, col = idx % 416, m = m0 + tok;
            const RowInfo R = row_info(m);
            const float cur = bf2f(Y1[(size_t)m * INP + C_WD + col]);
            const float prev = R.t > 0 ? bf2f(Y1[(size_t)(m - 1) * INP + C_WD + col]) : 0.f;
            const float next = R.t < R.T - 1 ? bf2f(Y1[(size_t)(m + 1) * INP + C_WD + col]) : 0.f;
            if (col < 128) { const int d = col >> 6, r = col & 63; const float nb = d ? next : prev;
                tw[(d * 32 + tok) * 64 + r] = tanhf(cur + in_I_MUW[l * 128 + col] * (nb - cur)); }
            else if (col < 256) { const int c2 = col - 128, d = c2 >> 6, r = c2 & 63; const float nb = d ? next : prev;
                ta[(d * 32 + tok) * 64 + r] = cur + in_I_MUA[l * 128 + c2] * (nb - cur); }
            else { const int r = col - 256;
                sg[tok * 160 + r] = sigmoidf_(cur + in_I_MUG[l * 320 + r] * (prev - cur) + in_I_MUG[l * 320 + 160 + r] * (next - cur)); }
        }
        __syncthreads();
        float acc[32][2];
#pragma unroll 1
        for (int d = 0; d < 2; ++d) {
            lora_mm<64>(tw + d * 2048, in_I_W2 + ((size_t)(l * 2 + d) * 64) * CW, c0, acc);
            { float* o = WSP(float, WS_WDEC) + ((size_t)d * MALL + m0) * CW + c0;
              const float b0 = in_I_W0[(l * 2 + d) * CW + c0], b1 = in_I_W0[(l * 2 + d) * CW + c0 + 512];
#pragma unroll
              for (int t = 0; t < 32; ++t) {
#pragma unroll
                  for (int q = 0; q < 2; ++q) { const float z = (q ? b1 : b0) + acc[t][q];
                      const float nz = -z, sp = fmaxf(nz, 0.f) + log1pf(expf(-fabsf(nz)));
                      const float wlog = -sp - 0.5f;
                      o[(size_t)t * CW + 512 * q] = expf(-expf(wlog)); } } }
            lora_mm<64>(ta + d * 2048, in_I_A2 + ((size_t)(l * 2 + d) * 64) * CW, c0, acc);
            { float* o = WSP(float, WS_AIC) + ((size_t)d * MALL + m0) * CW + c0;
              const float b0 = in_I_A0[(l * 2 + d) * CW + c0], b1 = in_I_A0[(l * 2 + d) * CW + c0 + 512];
#pragma unroll
              for (int t = 0; t < 32; ++t) { o[(size_t)t * CW] = sigmoidf_(b0 + acc[t][0]); o[(size_t)t * CW + 512] = sigmoidf_(b1 + acc[t][1]); } }
        }
        lora_mm<160>(sg, in_I_G2 + (size_t)l * 160 * CW, c0, acc);
        { float* o = WSP(float, WS_G) + (size_t)m0 * CW + c0;
#pragma unroll
          for (int t = 0; t < 32; ++t) { o[(size_t)t * CW] = acc[t][0]; o[(size_t)t * CW + 512] = acc[t][1]; } }
        __syncthreads();
    }
}
struct AttState { float mx, ls; float o[64]; };
__device__ __forceinline__ void att_init(AttState& S) { S.mx = -1e30f; S.ls = 0.f;
#pragma unroll
    for (int d = 0; d < 64; ++d) S.o[d] = 0.f; }
__device__ __forceinline__ void load_row64(float (&q)[64], const bf16* p, float scale) {
#pragma unroll
    for (int c = 0; c < 8; ++c) { const v4u w = ((const v4u*)p)[c];
        q[8 * c + 0] = bflo(w.x) * scale; q[8 * c + 1] = bfhi(w.x) * scale; q[8 * c + 2] = bflo(w.y) * scale; q[8 * c + 3] = bfhi(w.y) * scale;
        q[8 * c + 4] = bflo(w.z) * scale; q[8 * c + 5] = bfhi(w.z) * scale; q[8 * c + 6] = bflo(w.w) * scale; q[8 * c + 7] = bfhi(w.w) * scale; }
}
__device__ __forceinline__ void att_key(AttState& S, const float (&q)[64], const bf16* kp, const bf16* vp, float bias) {
    float s0 = 0.f, s1 = 0.f, s2 = 0.f, s3 = 0.f;
#pragma unroll
    for (int c = 0; c < 8; ++c) { const v4u w = ((const v4u*)kp)[c];
        s0 += q[8 * c + 0] * bflo(w.x) + q[8 * c + 1] * bfhi(w.x); s1 += q[8 * c + 2] * bflo(w.y) + q[8 * c + 3] * bfhi(w.y);
        s2 += q[8 * c + 4] * bflo(w.z) + q[8 * c + 5] * bfhi(w.z); s3 += q[8 * c + 6] * bflo(w.w) + q[8 * c + 7] * bfhi(w.w); }
    const float s = (s0 + s1) + (s2 + s3) + bias;
    const float mn = fmaxf(S.mx, s), fo = exp2f(S.mx - mn), p = exp2f(s - mn);
    S.mx = mn; S.ls = S.ls * fo + p;
#pragma unroll
    for (int c = 0; c < 8; ++c) { const v4u w = ((const v4u*)vp)[c];
        S.o[8 * c + 0] = S.o[8 * c + 0] * fo + p * bflo(w.x); S.o[8 * c + 1] = S.o[8 * c + 1] * fo + p * bfhi(w.x);
        S.o[8 * c + 2] = S.o[8 * c + 2] * fo + p * bflo(w.y); S.o[8 * c + 3] = S.o[8 * c + 3] * fo + p * bfhi(w.y);
        S.o[8 * c + 4] = S.o[8 * c + 4] * fo + p * bflo(w.z); S.o[8 * c + 5] = S.o[8 * c + 5] * fo + p * bfhi(w.z);
        S.o[8 * c + 6] = S.o[8 * c + 6] * fo + p * bflo(w.w); S.o[8 * c + 7] = S.o[8 * c + 7] * fo + p * bfhi(w.w); }
}
__device__ __forceinline__ void att_finish(AttState& S, bf16* op, int sub) {
    float M = S.mx;
    M = fmaxf(M, __shfl_xor(M, 1)); M = fmaxf(M, __shfl_xor(M, 2)); M = fmaxf(M, __shfl_xor(M, 4));
    const float fo = exp2f(S.mx - M);
    float L = S.ls * fo; L += __shfl_xor(L, 1); L += __shfl_xor(L, 2); L += __shfl_xor(L, 4);
    const float inv = 1.0f / L;
    float r[8];
#pragma unroll
    for (int i = 0; i < 8; ++i) r[i] = 0.f;
#pragma unroll
    for (int d = 0; d < 64; ++d) { float v = S.o[d] * fo; v += __shfl_xor(v, 1); v += __shfl_xor(v, 2); v += __shfl_xor(v, 4);
        if ((d >> 3) == sub) r[d & 7] = v * inv; }
    v4u w; w.x = pk2(r[0], r[1]); w.y = pk2(r[2], r[3]); w.z = pk2(r[4], r[5]); w.w = pk2(r[6], r[7]);
    *(v4u*)(op + 8 * sub) = w;
}
__device__ __forceinline__ void ph_attn_naive(Frame& f, int l, int item_lo, int item_hi, bool do_ctx) { const float* in_I_RPB = karg_in(I_RPB); launder_ws(f);
    const bf16* Y1 = WSP(bf16, WS_Y1);
    const int qx = f.tid >> 3, sub = f.tid & 7;
    for (int it = item_lo + f.vcu; it < item_hi; it += f.G) {
        float q[64]; AttState S; att_init(S);
        if (it < 2048) {
            const int b = it >> 10, h = (it >> 7) & 7, i = it & 127;
            const int m = b * SEQ + i * GRIDW + qx;
            load_row64(q, Y1 + (size_t)m * INP + C_QA + h * 64, QSCALE);
            int rs = i - 4; rs = rs < 0 ? 0 : (rs > 120 ? 120 : rs);
            int cst = qx - 8; cst = cst < 0 ? 0 : (cst > 48 ? 48 : cst);
            const int jr = rs + sub;
            const float* rpb = in_I_RPB + ((size_t)(l * 8 + h) * 15 + (jr - i + 7)) * 31;
            for (int yy = 0; yy < 16; ++yy) { const int y = cst + yy, mk = b * SEQ + jr * GRIDW + y;
                int co = y - qx; co = co < -15 ? -15 : (co > 15 ? 15 : co);
                att_key(S, q, Y1 + (size_t)mk * INP + C_KA + h * 64, Y1 + (size_t)mk * INP + C_VA + h * 64, rpb[co + 15] * LOG2E); }
            for (int n = 0; n < 32; ++n) { const int mk = MLAT + b * CTXL + sub + 8 * n;
                att_key(S, q, Y1 + (size_t)mk * INP + C_KA + h * 64, Y1 + (size_t)mk * INP + C_VA + h * 64, 0.f); }
            att_finish(S, WSP(bf16, WS_OA) + (size_t)m * 512 + h * 64, sub);
        } else if (it < 2112) {
            if (!do_ctx) continue;
            const int r = it - 2048, b = r >> 5, h = (r >> 2) & 7, qt = r & 3;
            const int m = MLAT + b * CTXL + qt * 64 + qx;
            load_row64(q, Y1 + (size_t)m * INP + C_QA + h * 64, QSCALE);
            for (int n = 0; n < 32; ++n) { const int mk = MLAT + b * CTXL + sub + 8 * n;
                att_key(S, q, Y1 + (size_t)mk * INP + C_KA + h * 64, Y1 + (size_t)mk * INP + C_VA + h * 64, 0.f); }
            att_finish(S, WSP(bf16, WS_OA) + (size_t)m * 512 + h * 64, sub);
        } else if (it < 2176) {
            if (!do_ctx) continue;
            const int r = it - 2112, b = r >> 5, h = (r >> 2) & 7, qt = r & 3;
            const int m = MLAT + b * CTXL + qt * 64 + qx;
            load_row64(q, WSP(bf16, WS_QBP) + (size_t)m * 512 + h * 64, 1.0f);
            const bf16* kb = WSP(bf16, WS_KBP) + (size_t)b * SKV * 128 + (h >> 2) * 64; const bf16* vb = WSP(bf16, WS_VBP) + (size_t)b * SKV * 128 + (h >> 2) * 64;
            for (int n = 0; n < 32; ++n) { const int kp = sub + 8 * n; att_key(S, q, kb + (size_t)kp * 128, vb + (size_t)kp * 128, 0.f); }
            att_finish(S, WSP(bf16, WS_OB) + (size_t)m * 512 + h * 64, sub);
        } else {
            const int r = it - 2176, b = r >> 10, h = (r >> 7) & 7, qt = r & 127;
            const int m = b * SEQ + qt * 64 + qx;
            load_row64(q, WSP(bf16, WS_QBP) + (size_t)m * 512 + h * 64, 1.0f);
            const bf16* kb = WSP(bf16, WS_KBP) + (size_t)b * SKV * 128 + (h >> 2) * 64; const bf16* vb = WSP(bf16, WS_VBP) + (size_t)b * SKV * 128 + (h >> 2) * 64;
            for (int n = 0; n < SKV / 8; ++n) { const int kp = sub + 8 * n; att_key(S, q, kb + (size_t)kp * 128, vb + (size_t)kp * 128, 0.f); }
            att_finish(S, WSP(bf16, WS_OB) + (size_t)m * 512 + h * 64, sub);
        }
    }
}

__device__ __forceinline__ void ph_scan(Frame& f, int l) { const float* in_I_KA = karg_in(I_KA); const float* in_I_KK = karg_in(I_KK); const float* in_I_MURKV = karg_in(I_MURKV); launder_ws(f);
    LAS float* F = (LAS float*)f.lds;
    LAS float* YT = F + 32 * 6 * 64;
    const bf16* Y1 = WSP(bf16, WS_Y1);
    const int lane = f.lane, rg = lane >> 4, j = lane & 15;
    for (int it = f.vcu; it < 128; it += f.G) {
        const int half = it & 1, chain = it >> 1, b = chain >> 5, d = (chain >> 4) & 1, h = chain & 15;
        const int col = h * 64 + lane;
        const float mur = in_I_MURKV[(l * 2 + d) * 3072 + col], muk = in_I_MURKV[(l * 2 + d) * 3072 + 1024 + col], muv = in_I_MURKV[(l * 2 + d) * 3072 + 2048 + col];
        const float k_k = in_I_KK[l * CW + col], k_a = in_I_KA[l * CW + col];
        float s0 = 0.f, s1 = 0.f, s2 = 0.f, s3 = 0.f;
        const int myrow = half * 32 + f.wave * 4 + rg;
        for (int ch = 0; ch < SKV / 32; ++ch) {
#pragma unroll
            for (int q = 0; q < 4; ++q) {
                const int sl = f.wave * 4 + q, st = ch * 32 + sl;
                int m, t, T;
                if (st < CTXL) { t = d ? (CTXL - 1 - st) : st; T = CTXL; m = MLAT + b * CTXL + t; }
                else { const int u = st - CTXL; t = d ? (SEQ - 1 - u) : u; T = SEQ; m = b * SEQ + t; }
                const bool hasn = d ? (t < T - 1) : (t > 0); const int mn = d ? m + 1 : m - 1;
                const bf16* y = Y1 + (size_t)m * INP; const bf16* yn = Y1 + (size_t)mn * INP;
                const float r0 = bf2f(y[C_R + col]), k0 = bf2f(y[C_K + col]), v0 = bf2f(y[C_V + col]);
                const float rn = hasn ? bf2f(yn[C_R + col]) : 0.f, kn = hasn ? bf2f(yn[C_K + col]) : 0.f, vn = hasn ? bf2f(yn[C_V + col]) : 0.f;
                const float r = r0 + mur * (rn - r0), k = k0 + muk * (kn - k0), v = v0 + muv * (vn - v0);
                const float a = WSP(float, WS_AIC)[((size_t)d * MALL + m) * CW + col], w = WSP(float, WS_WDEC)[((size_t)d * MALL + m) * CW + col];
                float kk = k * k_k; const float nrm = sqrtf(wave_sum(kk * kk)); kk = kk / fmaxf(nrm, 1e-12f);
                const float km = k * (1.0f + (a - 1.0f) * k_a);
                LAS float* Fs = F + sl * 384;
                Fs[lane] = r; Fs[64 + lane] = w; Fs[128 + lane] = km; Fs[192 + lane] = -kk; Fs[256 + lane] = kk * a; Fs[320 + lane] = v;
            }
            __syncthreads();
#pragma unroll 4
            for (int sl = 0; sl < 32; ++sl) {
                const LAS float* Fs = F + sl * 384;
                const f32x4 r4 = *(const LAS f32x4*)(Fs + 4 * j), w4 = *(const LAS f32x4*)(Fs + 64 + 4 * j), k4 = *(const LAS f32x4*)(Fs + 128 + 4 * j);
                const f32x4 a4 = *(const LAS f32x4*)(Fs + 192 + 4 * j), b4 = *(const LAS f32x4*)(Fs + 256 + 4 * j);
                const float vv = Fs[320 + myrow];
                float sa = (s0 * a4.x + s1 * a4.y) + (s2 * a4.z + s3 * a4.w);
                sa += __shfl_xor(sa, 1); sa += __shfl_xor(sa, 2); sa += __shfl_xor(sa, 4); sa += __shfl_xor(sa, 8);
                s0 = s0 * w4.x + sa * b4.x + vv * k4.x; s1 = s1 * w4.y + sa * b4.y + vv * k4.y;
                s2 = s2 * w4.z + sa * b4.z + vv * k4.z; s3 = s3 * w4.w + sa * b4.w + vv * k4.w;
                float yv = (s0 * r4.x + s1 * r4.y) + (s2 * r4.z + s3 * r4.w);
                yv += __shfl_xor(yv, 1); yv += __shfl_xor(yv, 2); yv += __shfl_xor(yv, 4); yv += __shfl_xor(yv, 8);
                if (j == 0) YT[sl * 32 + f.wave * 4 + rg] = yv;
            }
            __syncthreads();
#pragma unroll
            for (int q = 0; q < 2; ++q) { const int idx = f.tid + 512 * q, sl = idx >> 5, rr = idx & 31, st = ch * 32 + sl;
                int m; if (st < CTXL) m = MLAT + b * CTXL + (d ? (CTXL - 1 - st) : st); else { const int u = st - CTXL; m = b * SEQ + (d ? (SEQ - 1 - u) : u); }
                WSP(float, WS_YS)[((size_t)d * MALL + m) * CW + h * 64 + half * 32 + rr] = YT[idx]; }
        }
        __syncthreads();
    }
}

__device__ __forceinline__ f32x4 bf4(v2u w) { return (f32x4){bflo(w.x), bfhi(w.x), bflo(w.y), bfhi(w.y)}; }
__device__ __forceinline__ float hsum4(f32x4 v) { return (v.x + v.y) + (v.z + v.w); }
__device__ __forceinline__ void ph_mix(Frame& f, int l, int mrows) { const float* in_I_GRPG = karg_in(I_GRPG); const float* in_I_KA = karg_in(I_KA); const float* in_I_LNXB = karg_in(I_LNXB); const float* in_I_LNXG = karg_in(I_LNXG); const float* in_I_MURKV = karg_in(I_MURKV); const float* in_I_RK = karg_in(I_RK); launder_ws(f);
    const int gw = f.vcu * NWAVES + f.wave, NGW = f.G * NWAVES, lane = f.lane, hq = lane >> 4, j = lane & 15;
    const bf16* Y1 = WSP(bf16, WS_Y1);
    LAS float* T_LG = (LAS float*)f.lds; LAS float* T_LB = T_LG + 1024; LAS float* T_RK = T_LG + 2048; LAS float* T_KA = T_LG + 3072; LAS float* T_MU = T_LG + 4096; LAS float* gg = T_LG + 10240;
    __syncthreads();
    for (int i = f.tid; i < 256; i += NWAVES * 64) { ((LAS f32x4*)T_LG)[i] = ((const f32x4*)(in_I_LNXG + l * CW))[i]; ((LAS f32x4*)T_LB)[i] = ((const f32x4*)(in_I_LNXB + l * CW))[i];
        ((LAS f32x4*)T_RK)[i] = ((const f32x4*)(in_I_RK + l * CW))[i]; ((LAS f32x4*)T_KA)[i] = ((const f32x4*)(in_I_KA + l * CW))[i]; }
    for (int i = f.tid; i < 1536; i += NWAVES * 64) ((LAS f32x4*)T_MU)[i] = ((const f32x4*)(in_I_MURKV + (size_t)l * 6144))[i];
    for (int i = f.tid; i < 512; i += NWAVES * 64) ((LAS f32x4*)gg)[i] = ((const f32x4*)(in_I_GRPG + l * DM))[i];
    __syncthreads();
    const float* YS0 = WSP(float, WS_YS); const float* YS1 = YS0 + (size_t)MALL * CW;
    const bf16* AIC0 = WSP(bf16, WS_AIC); const bf16* AIC1 = AIC0 + (size_t)MALL * CW;
    for (int m = gw; m < mrows; m += NGW) {
        const RowInfo R = row_info(m);
        const bool hasp = R.t > 0, hasn = R.t < R.T - 1;
        const bf16* y = Y1 + (size_t)m * INP; const bf16* yp = hasp ? y - INP : y; const bf16* yn = hasn ? y + INP : y;
        const bf16* gbuf = WSP(bf16, WS_G) + (size_t)m * CW; LAS float* obuf = (LAS float*)(f.lds + 65536 + f.wave * 4096);
        float ssc = 0.f;
#pragma unroll
        for (int it4 = 0; it4 < 4; ++it4) {
            const int c = (it4 * 4 + hq) * 64 + 4 * j;
            const f32x4 yv = __builtin_nontemporal_load((const f32x4*)(YS0 + (size_t)m * CW + c)) + __builtin_nontemporal_load((const f32x4*)(YS1 + (size_t)m * CW + c));
            const float mean = sum16(hsum4(yv)) * (1.f / 64.f); const f32x4 dv = yv - mean; const float var = sum16(hsum4(dv * dv)) * (1.f / 64.f);
            f32x4 o = dv * __builtin_amdgcn_rsqf(var + 64e-5f) * *(const LAS f32x4*)(T_LG + c) + *(const LAS f32x4*)(T_LB + c);
            const f32x4 r0 = bf4(*(const v2u*)(y + C_R + c)), k0 = bf4(*(const v2u*)(y + C_K + c)), v0 = bf4(*(const v2u*)(y + C_V + c));
            const f32x4 rkw = *(const LAS f32x4*)(T_RK + c), k_a = *(const LAS f32x4*)(T_KA + c);
#pragma unroll
            for (int d = 0; d < 2; ++d) {
                const bf16* yb = d ? yn : yp; const bool has = d ? hasn : hasp;
                f32x4 rn = bf4(*(const v2u*)(yb + C_R + c)), kn = bf4(*(const v2u*)(yb + C_K + c)), vn = bf4(*(const v2u*)(yb + C_V + c));
                if (!has) { rn = (f32x4){0.f, 0.f, 0.f, 0.f}; kn = rn; vn = rn; }
                const LAS float* mu = T_MU + d * 3072 + c;
                const f32x4 r = r0 + *(const LAS f32x4*)(mu) * (rn - r0), k = k0 + *(const LAS f32x4*)(mu + 1024) * (kn - k0), v = v0 + *(const LAS f32x4*)(mu + 2048) * (vn - v0);
                const f32x4 a = bf4(__builtin_nontemporal_load((const v2u*)((d ? AIC1 : AIC0) + (size_t)m * CW + c)));
                const f32x4 km = k * ((a - 1.0f) * k_a + 1.0f);
                o += v * sum16(hsum4(r * km * rkw));
            }
            o *= bf4(*(const v2u*)(gbuf + c));
            *(LAS f32x4*)(obuf + c) = o; ssc += hsum4(o * o);
            if (it4 == 1) asm volatile("" ::: "memory");
        }
        const float rc = __builtin_amdgcn_rsqf(sum64(ssc) * (1.f / 1024.f) + 1e-6f);
        const v4u wa = *(const v4u*)(WSP(bf16, WS_OA) + (size_t)m * 512 + lane * 8), wb = *(const v4u*)(WSP(bf16, WS_OB) + (size_t)m * 512 + lane * 8);
        const f32x4 a0 = bf4((v2u){wa.x, wa.y}), a1 = bf4((v2u){wa.z, wa.w}), b0 = bf4((v2u){wb.x, wb.y}), b1 = bf4((v2u){wb.z, wb.w});
        const float ra = __builtin_amdgcn_rsqf(sum64(hsum4(a0 * a0) + hsum4(a1 * a1)) * (1.f / 512.f) + 1e-6f), rb = __builtin_amdgcn_rsqf(sum64(hsum4(b0 * b0) + hsum4(b1 * b1)) * (1.f / 512.f) + 1e-6f);
        bf16* o = WSP(bf16, WS_MIX) + (size_t)m * DM;
        { const LAS float* ga = gg + lane * 8; const f32x4 x0 = a0 * ra * *(const LAS f32x4*)(ga), x1 = a1 * ra * *(const LAS f32x4*)(ga + 4);
          *(v4u*)(o + lane * 8) = (v4u){pk2(x0.x, x0.y), pk2(x0.z, x0.w), pk2(x1.x, x1.y), pk2(x1.z, x1.w)}; }
        { const LAS float* gb = gg + 512 + lane * 8; const f32x4 x0 = b0 * rb * *(const LAS f32x4*)(gb), x1 = b1 * rb * *(const LAS f32x4*)(gb + 4);
          *(v4u*)(o + 512 + lane * 8) = (v4u){pk2(x0.x, x0.y), pk2(x0.z, x0.w), pk2(x1.x, x1.y), pk2(x1.z, x1.w)}; }
#pragma unroll
        for (int q = 0; q < 4; ++q) { const int c = q * 256 + lane * 4; const f32x4 x = *(const LAS f32x4*)(obuf + c) * rc * *(const LAS f32x4*)(gg + 1024 + c);
            *(v2u*)(o + 1024 + c) = (v2u){pk2(x.x, x.y), pk2(x.z, x.w)}; }
    }
}

__device__ __forceinline__ void ph_convglu(Frame& f, int l, int mrows) { const float* in_I_CONVB = karg_in(I_CONVB); const float* in_I_CONVW = karg_in(I_CONVW); launder_ws(f);
    const int gt = f.vcu * 512 + f.tid, GT = f.G * 512;
    const bf16* U = WSP(bf16, WS_U); bf16* HB = WSP(bf16, WS_HB);
    const float* cw = in_I_CONVW + (size_t)l * 3 * DFF; const float* cb = in_I_CONVB + (size_t)l * DFF;
    constexpr int C8 = DFF / 8;
    for (int idx = gt; idx < mrows * C8; idx += GT) {
        const int m = idx / C8, c = (idx % C8) * 8;
        const RowInfo R = row_info(m);
        const v4u z = {0u, 0u, 0u, 0u};
        const v4u uc = *(const v4u*)(U + (size_t)m * UPN + c), vl = *(const v4u*)(U + (size_t)m * UPN + DFF + c);
        const v4u up = R.t > 0 ? *(const v4u*)(U + (size_t)(m - 1) * UPN + c) : z, un = R.t < R.T - 1 ? *(const v4u*)(U + (size_t)(m + 1) * UPN + c) : z;
        float r[8], gv[8];
#pragma unroll
        for (int i = 0; i < 8; ++i) {
            const unsigned wc_ = i < 2 ? uc.x : i < 4 ? uc.y : i < 6 ? uc.z : uc.w, wp_ = i < 2 ? up.x : i < 4 ? up.y : i < 6 ? up.z : up.w;
            const unsigned wn_ = i < 2 ? un.x : i < 4 ? un.y : i < 6 ? un.z : un.w, wv_ = i < 2 ? vl.x : i < 4 ? vl.y : i < 6 ? vl.z : vl.w;
            const float fc = (i & 1) ? bfhi(wc_) : bflo(wc_), fp = (i & 1) ? bfhi(wp_) : bflo(wp_), fn = (i & 1) ? bfhi(wn_) : bflo(wn_), fv = (i & 1) ? bfhi(wv_) : bflo(wv_);
            const float u = fp * cw[c + i] + fc * cw[DFF + c + i] + fn * cw[2 * DFF + c + i] + cb[c + i];
            r[i] = u; gv[i] = fv;
        }
#pragma unroll
        for (int i = 0; i < 8; i += 2) { const f32x2 g2 = pg8::gelu_pk((f32x2){r[i], r[i + 1]}); r[i] = g2.x * gv[i]; r[i + 1] = g2.y * gv[i + 1]; }
        v4u w; w.x = pk2(r[0], r[1]); w.y = pk2(r[2], r[3]); w.z = pk2(r[4], r[5]); w.w = pk2(r[6], r[7]);
        *(v4u*)(HB + (size_t)m * DFF + c) = w;
    }
}

__device__ __forceinline__ void ph_final(Frame& f) { const float* in_I_FING = karg_in(I_FING); float* out_p = (float*)karg_in(33); launder_ws(f);
    const int gw = f.vcu * NWAVES + f.wave, NGW = f.G * NWAVES;
    const float* g = in_I_FING;
    for (int m = gw; m < MLAT; m += NGW) {
        const f32x4* xr = (const f32x4*)(WSP(float, WS_H) + (size_t)m * DM) + f.lane;
        f32x4 v[8]; float ss = 0.f;
#pragma unroll
        for (int j = 0; j < 8; ++j) { v[j] = xr[64 * j]; ss += (v[j].x * v[j].x + v[j].y * v[j].y) + (v[j].z * v[j].z + v[j].w * v[j].w); }
        const float rs = 1.0f / sqrtf(wave_sum(ss) * (1.f / DM) + 1e-6f);
        f32x4* o = (f32x4*)(out_p + (size_t)m * DM) + f.lane;
#pragma unroll
        for (int j = 0; j < 8; ++j) { const f32x4 g4 = *(const f32x4*)(g + f.lane * 4 + 256 * j); o[64 * j] = (v[j] * rs) * g4; }
    }
}

struct EpiResGate {
    static constexpr bool PERM = true, AFTER_DRAIN = false;
    float* H; const float* mod;
    __device__ __forceinline__ void operator()(const pg8::f32x4 (&acc)[2][2][4][2], const pg8::Unit& u, int wr, int wc, int fr, int fq) const {
        const int row0 = u.pm * 256 + wr * 64 + fr, col0 = u.pn * 256 + wc * 32 + 8 * fq;
        const int s = u.pm < 32 ? 0 : (u.pm < 64 ? 1 : 2);
        const float* gp = mod + (size_t)s * MODW + col0;
        pg8::f32x4 gv[2][2];
#pragma unroll
        for (int bj = 0; bj < 2; ++bj)
#pragma unroll
            for (int n = 0; n < 2; ++n) gv[bj][n] = *(const pg8::f32x4*)(gp + bj * 128 + 4 * n);
#pragma unroll
        for (int ai = 0; ai < 2; ++ai)
#pragma unroll
            for (int m = 0; m < 4; ++m) { float* rowp = H + (size_t)(row0 + ai * 128 + m * 16) * DM + col0;
#pragma unroll
                for (int bj = 0; bj < 2; ++bj)
#pragma unroll
                    for (int n = 0; n < 2; ++n) { pg8::f32x4* p = (pg8::f32x4*)(rowp + bj * 128 + 4 * n); *p = *p + gv[bj][n] * acc[ai][bj][m][n]; } }
    }
};
struct ScanRaw { float r0, k0, v0, rn, kn, vn, a, w; };
struct ScanFeat { f32x4 r, w, k, a, b; float v; };
constexpr int SC_T = 16, SC_NCH = SKV / SC_T;
__device__ __forceinline__ int scan_row_of_step(int st, int b, int d) {
    if (st < CTXL) return MLAT + b * CTXL + (d ? (CTXL - 1 - st) : st);
    const int u = st - CTXL; return b * SEQ + (d ? (SEQ - 1 - u) : u);
}
__device__ __forceinline__ void scan_load_raw(ScanRaw& R, const bf16* Y1, const float* aic, const float* wdec, int st, int b, int d, int col) {
    int t, T, m;
    if (st < CTXL) { t = d ? (CTXL - 1 - st) : st; T = CTXL; m = MLAT + b * CTXL + t; } else { const int u = st - CTXL; t = d ? (SEQ - 1 - u) : u; T = SEQ; m = b * SEQ + t; }
    const bool hasn = d ? (t < T - 1) : (t > 0); const int mn = hasn ? (d ? m + 1 : m - 1) : m;
    const bf16* y = Y1 + (size_t)m * INP + col; const bf16* yn = Y1 + (size_t)mn * INP + col;
    R.r0 = bf2f(y[C_R]); R.k0 = bf2f(y[C_K]); R.v0 = bf2f(y[C_V]);
    const float rn = bf2f(yn[C_R]), kn = bf2f(yn[C_K]), vn = bf2f(yn[C_V]);
    R.rn = hasn ? rn : 0.f; R.kn = hasn ? kn : 0.f; R.vn = hasn ? vn : 0.f;
    R.a = aic[(size_t)m * CW + col]; R.w = wdec[(size_t)m * CW + col];
}
__device__ __forceinline__ void scan_emit(LAS float* Fs, const ScanRaw& R, float mur, float muk, float muv, float k_k, float k_a, int lane) {
    const float r = R.r0 + mur * (R.rn - R.r0), k = R.k0 + muk * (R.kn - R.k0), v = R.v0 + muv * (R.vn - R.v0);
    float kk = k * k_k; kk = kk * __builtin_amdgcn_rsqf(fmaxf(sum64(kk * kk), 1e-24f));
    const float km = k * (1.0f + (R.a - 1.0f) * k_a);
    Fs[lane] = r; Fs[64 + lane] = R.w; Fs[128 + lane] = km; Fs[192 + lane] = -kk; Fs[256 + lane] = kk * R.a; Fs[320 + lane] = v;
}
__device__ __forceinline__ void scan_ld_feat(ScanFeat& F, const LAS float* Fs, int j, int row) {
    F.r = *(const LAS f32x4*)(Fs + 4 * j); F.w = *(const LAS f32x4*)(Fs + 64 + 4 * j); F.k = *(const LAS f32x4*)(Fs + 128 + 4 * j);
    F.a = *(const LAS f32x4*)(Fs + 192 + 4 * j); F.b = *(const LAS f32x4*)(Fs + 256 + 4 * j); F.v = Fs[320 + row];
}
__device__ __forceinline__ void ph_scan2(Frame& f, int l) { const float* in_I_KA = karg_in(I_KA); const float* in_I_KK = karg_in(I_KK); const float* in_I_MURKV = karg_in(I_MURKV); launder_ws(f);
    LAS float* FB = (LAS float*)f.lds;
    LAS float* YP = FB + 2 * SC_T * 384;
    const bf16* Y1 = WSP(bf16, WS_Y1);
    const int lane = f.lane;
    for (int it = f.vcu; it < 256; it += f.G) {
        const int quarter = it & 3, chain = it >> 2, b = chain >> 5, d = (chain >> 4) & 1, h = chain & 15;
        if (f.wave >= 4) {
            const int pw = f.wave - 4, sq = lane >> 4, j = lane & 15, col = h * 64 + 4 * j;
            const float* murkv = in_I_MURKV + (l * 2 + d) * 3072 + col;
            const f32x4 mur = *(const f32x4*)(murkv), muk = *(const f32x4*)(murkv + 1024), muv = *(const f32x4*)(murkv + 2048);
            const f32x4 k_k = *(const f32x4*)(in_I_KK + l * CW + col), k_a = *(const f32x4*)(in_I_KA + l * CW + col);
            const bf16* aic = WSP(bf16, WS_AIC) + (size_t)d * MALL * CW + col; const bf16* wdec = WSP(bf16, WS_WDEC) + (size_t)d * MALL * CW + col;
            const bf16* y1c = Y1 + col;
            float* ys = WSP(float, WS_YS) + (size_t)d * MALL * CW + h * 64 + quarter * 16;
            const int pt = f.tid - 256, osl = pt >> 4, orr = pt & 15;
            struct PRaw { v2u r0, k0, v0, rn, kn, vn, a, w; bool has; };
            PRaw S0, S1, S2;
#define SC_LOAD(X, c) do { const int st_ = (c) * SC_T + pw * 4 + sq; int t_, T_, m_; \
        if (st_ < CTXL) { t_ = d ? (CTXL - 1 - st_) : st_; T_ = CTXL; m_ = MLAT + b * CTXL + t_; } else { const int u_ = st_ - CTXL; t_ = d ? (SEQ - 1 - u_) : u_; T_ = SEQ; m_ = b * SEQ + t_; } \
        X.has = d ? (t_ < T_ - 1) : (t_ > 0); const int mn_ = X.has ? (d ? m_ + 1 : m_ - 1) : m_; \
        const bf16* y_ = y1c + (size_t)m_ * INP; const bf16* yn_ = y1c + (size_t)mn_ * INP; \
        X.r0 = *(const v2u*)(y_ + C_R); X.k0 = *(const v2u*)(y_ + C_K); X.v0 = *(const v2u*)(y_ + C_V); X.rn = *(const v2u*)(yn_ + C_R); X.kn = *(const v2u*)(yn_ + C_K); X.vn = *(const v2u*)(yn_ + C_V); \
        X.a = *(const v2u*)(aic + (size_t)m_ * CW); X.w = *(const v2u*)(wdec + (size_t)m_ * CW); } while (0)
#define SC_EMIT(X, slot) do { const f32x4 z_ = {0.f, 0.f, 0.f, 0.f}; \
        const f32x4 r0_ = bf4(X.r0), k0_ = bf4(X.k0), v0_ = bf4(X.v0), rn_ = X.has ? bf4(X.rn) : z_, kn_ = X.has ? bf4(X.kn) : z_, vn_ = X.has ? bf4(X.vn) : z_; \
        const f32x4 r_ = r0_ + mur * (rn_ - r0_), k_ = k0_ + muk * (kn_ - k0_), v_ = v0_ + muv * (vn_ - v0_); \
        f32x4 kk_ = k_ * k_k; kk_ = kk_ * __builtin_amdgcn_rsqf(fmaxf(sum16(hsum4(kk_ * kk_)), 1e-24f)); \
        const f32x4 a_ = bf4(X.a), q_ = bf4(X.w); const f32x4 w_ = {__expf(-q_.x), __expf(-q_.y), __expf(-q_.z), __expf(-q_.w)}; \
        const f32x4 km_ = k_ * ((a_ - 1.0f) * k_a + 1.0f); \
        LAS float* Fs_ = FB + ((slot) * SC_T + pw * 4 + sq) * 384 + 4 * j; \
        *(LAS f32x4*)(Fs_) = r_; *(LAS f32x4*)(Fs_ + 64) = w_; *(LAS f32x4*)(Fs_ + 128) = km_; *(LAS f32x4*)(Fs_ + 192) = -kk_; *(LAS f32x4*)(Fs_ + 256) = kk_ * a_; *(LAS f32x4*)(Fs_ + 320) = v_; } while (0)
#define SC_YRED(c, slot) do { const LAS f32x4* yp = (const LAS f32x4*)(YP + (((slot) * SC_T + osl) * 16 + orr) * 16); const f32x4 y0 = yp[0], y1 = yp[1], y2 = yp[2], y3 = yp[3]; \
        const f32x4 ysum = (y0 + y1) + (y2 + y3); ys[(size_t)scan_row_of_step((c) * SC_T + osl, b, d) * CW + orr] = (ysum.x + ysum.y) + (ysum.z + ysum.w); } while (0)
#define SC_IVAL(c, XL, XE) do { if ((c) + 3 < SC_NCH) SC_LOAD(XL, (c) + 3); if ((c) >= 1) SC_YRED((c) - 1, ((c) - 1) & 1); if ((c) + 1 < SC_NCH) SC_EMIT(XE, ((c) + 1) & 1); \
        LDS_WAIT(); __builtin_amdgcn_s_barrier(); } while (0)
            SC_LOAD(S0, 0); SC_EMIT(S0, 0); SC_LOAD(S1, 1); SC_LOAD(S2, 2);
            LDS_WAIT(); __builtin_amdgcn_s_barrier();
            static_assert(SC_NCH % 6 == 0, "producer loop is unrolled by 6 intervals (3 register sets x 2 LDS slots)");
            for (int c = 0; c < SC_NCH; c += 6) {
                SC_IVAL(c, S0, S1); SC_IVAL(c + 1, S1, S2); SC_IVAL(c + 2, S2, S0); SC_IVAL(c + 3, S0, S1); SC_IVAL(c + 4, S1, S2); SC_IVAL(c + 5, S2, S0);
            }
            SC_YRED(SC_NCH - 1, (SC_NCH - 1) & 1);
#undef SC_LOAD
#undef SC_EMIT
#undef SC_YRED
#undef SC_IVAL
        } else {
            const int rg = lane >> 4, j = lane & 15, lrow = f.wave * 4 + rg, row = quarter * 16 + lrow;
            f32x2 s01 = {0.f, 0.f}, s23 = {0.f, 0.f};
            __builtin_amdgcn_s_setprio(3);
            const unsigned fb0 = (unsigned)(uintptr_t)FB, yp0 = (unsigned)(uintptr_t)YP;
            LDS_WAIT(); __builtin_amdgcn_s_barrier();
#define SC_LDF(Fv, sl) do { \
    asm volatile("ds_read_b128 %0, %1 offset:%2" : "=&v"(Fv.r) : "v"(adr), "n"((sl) * 1536)); \
    asm volatile("ds_read_b128 %0, %1 offset:%2" : "=&v"(Fv.w) : "v"(adr), "n"((sl) * 1536 + 256)); \
    asm volatile("ds_read_b128 %0, %1 offset:%2" : "=&v"(Fv.k) : "v"(adr), "n"((sl) * 1536 + 512)); \
    asm volatile("ds_read_b128 %0, %1 offset:%2" : "=&v"(Fv.a) : "v"(adr), "n"((sl) * 1536 + 768)); \
    asm volatile("ds_read_b128 %0, %1 offset:%2" : "=&v"(Fv.b) : "v"(adr), "n"((sl) * 1536 + 1024)); \
    asm volatile("ds_read_b32 %0, %1 offset:%2" : "=&v"(Fv.v) : "v"(adv), "n"((sl) * 1536 + 1280)); } while (0)
#define SC_WAITF(Fv, N) asm volatile("s_waitcnt lgkmcnt(" #N ")" : "+v"(Fv.r), "+v"(Fv.w), "+v"(Fv.k), "+v"(Fv.a), "+v"(Fv.b), "+v"(Fv.v))
#define SC_YOUT(sl) do { f32x2 y_ = s01 * (f32x2){rp.x, rp.y}; y_ = s23 * (f32x2){rp.z, rp.w} + y_; const float ys_ = y_.x + y_.y; \
    asm volatile("ds_write_b32 %0, %1 offset:%2" :: "v"(ady), "v"(ys_), "n"((sl) * 1024)); } while (0)
#define SC_STEP(X, Z, sl, N, HASLD, HASY) do { \
    if (HASLD) SC_LDF(Z, (sl) + 2); \
    SC_WAITF(X, N); \
    f32x2 p_ = s01 * (f32x2){X.a.x, X.a.y}; p_ = s23 * (f32x2){X.a.z, X.a.w} + p_; \
    const float sa_ = sum16(p_.x + p_.y); \
    if (HASY) SC_YOUT((sl) - 1); \
    const f32x2 sa2_ = {sa_, sa_}, vv2_ = {X.v, X.v}; \
    f32x2 t01_ = s01 * (f32x2){X.w.x, X.w.y}; t01_ = vv2_ * (f32x2){X.k.x, X.k.y} + t01_; \
    f32x2 t23_ = s23 * (f32x2){X.w.z, X.w.w}; t23_ = vv2_ * (f32x2){X.k.z, X.k.w} + t23_; \
    s01 = sa2_ * (f32x2){X.b.x, X.b.y} + t01_; s23 = sa2_ * (f32x2){X.b.z, X.b.w} + t23_; \
    rp = X.r; } while (0)
            for (int c = 0; c < SC_NCH; ++c) {
                const unsigned adr = fb0 + (unsigned)((c & 1) * SC_T * 1536 + 16 * j), adv = fb0 + (unsigned)((c & 1) * SC_T * 1536 + 4 * row);
                const unsigned ady = yp0 + (unsigned)((((c & 1) * SC_T) * 16 + lrow) * 64 + 4 * j);
                ScanFeat FA, FBv, FC; f32x4 rp = {0.f, 0.f, 0.f, 0.f};
                SC_LDF(FA, 0); SC_LDF(FBv, 1);
                SC_STEP(FA, FC, 0, 12, true, false);   SC_STEP(FBv, FA, 1, 12, true, true);   SC_STEP(FC, FBv, 2, 13, true, true);
                SC_STEP(FA, FC, 3, 14, true, true);    SC_STEP(FBv, FA, 4, 14, true, true);   SC_STEP(FC, FBv, 5, 14, true, true);
                SC_STEP(FA, FC, 6, 14, true, true);    SC_STEP(FBv, FA, 7, 14, true, true);   SC_STEP(FC, FBv, 8, 14, true, true);
                SC_STEP(FA, FC, 9, 14, true, true);    SC_STEP(FBv, FA, 10, 14, true, true);  SC_STEP(FC, FBv, 11, 14, true, true);
                SC_STEP(FA, FC, 12, 14, true, true);   SC_STEP(FBv, FA, 13, 14, true, true);  SC_STEP(FC, FBv, 14, 8, false, true);
                SC_STEP(FA, FC, 15, 2, false, true);
                SC_YOUT(15);
                LDS_WAIT(); __builtin_amdgcn_s_barrier();
            }
            __builtin_amdgcn_s_setprio(0);
#undef SC_LDF
#undef SC_WAITF
#undef SC_YOUT
#undef SC_STEP
        }
        __syncthreads();
    }
}
typedef short bf16x8_t __attribute__((ext_vector_type(8)));
__device__ __forceinline__ unsigned cvtpk(float lo, float hi) { typedef float f2 __attribute__((ext_vector_type(2))); typedef __bf16 b2 __attribute__((ext_vector_type(2))); f2 v = {lo, hi}; b2 b = __builtin_convertvector(v, b2); return __builtin_bit_cast(unsigned, b); }
__device__ __forceinline__ void ph_na(Frame& f, int l, int slot0, int nslot) { const float* in_I_RPB = karg_in(I_RPB); launder_ws(f);
    const bf16* Y1 = WSP(bf16, WS_Y1); const bf16* VAT = WSP(bf16, WS_VAT);
    LAS float* btab = (LAS float*)(f.lds + 106496 + f.wave * 1024);
    const int lane = f.lane, g = lane >> 4, qi = lane & 15;
    for (int sl = 0; sl < nslot; ++sl) { const int it = (slot0 + sl) * NWAVES + f.wave;
        const int qb = it & 3, unit = it >> 2, b = unit >> 10, h = (unit >> 7) & 7, i = unit & 127;
        const int x = qb * 16 + qi, m = b * SEQ + i * GRIDW + x;
        int rs = i - 4; rs = rs < 0 ? 0 : (rs > 120 ? 120 : rs);
        int cs = x - 8; cs = cs < 0 ? 0 : (cs > 48 ? 48 : cs);
        const int cb = qb == 0 ? 0 : (qb == 1 ? 8 : (qb == 2 ? 24 : 32));
#pragma unroll
        for (int q = 0; q < 4; ++q) { const int idx = lane + 64 * q; if (idx < 248) { const int jrl = idx / 31, dxi = idx % 31;
            btab[jrl * 32 + dxi] = in_I_RPB[((size_t)(l * 8 + h) * 15 + (rs + jrl - i + 7)) * 31 + dxi] * LOG2E; } }
        bf16x8_t qf[2];
#pragma unroll
        for (int ks = 0; ks < 2; ++ks) qf[ks] = *(const bf16x8_t*)(Y1 + (size_t)m * INP + C_QA + h * 64 + 32 * ks + 8 * g);
        float sc[16][8];
#pragma unroll
        for (int blk = 0; blk < 16; ++blk) {
            const int mk0 = blk < 8 ? (b * SEQ + (rs + blk) * GRIDW + cb) : (MLAT + b * CTXL + (blk - 8) * 32);
#pragma unroll
            for (int T = 0; T < 2; ++T) {
                const int kidx = 8 * (qi >> 2) + 4 * T + (qi & 3);
                const bf16* kp = Y1 + (size_t)(mk0 + kidx) * INP + C_KA + h * 64 + 8 * g;
                f32x4 acc = {0.f, 0.f, 0.f, 0.f};
                acc = __builtin_amdgcn_mfma_f32_16x16x32_bf16(*(const bf16x8_t*)kp, qf[0], acc, 0, 0, 0);
                acc = __builtin_amdgcn_mfma_f32_16x16x32_bf16(*(const bf16x8_t*)(kp + 32), qf[1], acc, 0, 0, 0);
                sc[blk][4 * T + 0] = acc.x; sc[blk][4 * T + 1] = acc.y; sc[blk][4 * T + 2] = acc.z; sc[blk][4 * T + 3] = acc.w;
            }
        }
        LDS_WAIT(); asm volatile("" ::: "memory");
        float mx = -1e30f;
#pragma unroll
        for (int blk = 0; blk < 16; ++blk)
#pragma unroll
            for (int j = 0; j < 8; ++j) {
                float s = sc[blk][j] * QSCALE;
                if (blk < 8) { const int y = cb + 8 * g + j; const bool valid = (unsigned)(y - cs) < 16u; int bi = y - x + 15; bi = bi < 0 ? 0 : (bi > 30 ? 30 : bi);
                    s = valid ? s + btab[blk * 32 + bi] : -1e30f; }
                sc[blk][j] = s; mx = fmaxf(mx, s);
            }
        mx = fmaxf(mx, __shfl_xor(mx, 16)); mx = fmaxf(mx, __shfl_xor(mx, 32));
        float sum = 0.f;
        bf16x8_t pf[16];
#pragma unroll
        for (int blk = 0; blk < 16; ++blk) {
#pragma unroll
            for (int j = 0; j < 8; ++j) { const float p = __builtin_amdgcn_exp2f(sc[blk][j] - mx); sc[blk][j] = p; sum += p; }
            const v4u w = {cvtpk(sc[blk][0], sc[blk][1]), cvtpk(sc[blk][2], sc[blk][3]), cvtpk(sc[blk][4], sc[blk][5]), cvtpk(sc[blk][6], sc[blk][7])};
            pf[blk] = __builtin_bit_cast(bf16x8_t, w);
        }
        sum += __shfl_xor(sum, 16); sum += __shfl_xor(sum, 32);
        f32x4 o[4];
#pragma unroll
        for (int dt = 0; dt < 4; ++dt) o[dt] = (f32x4){0.f, 0.f, 0.f, 0.f};
        const bf16* vbase = VAT + ((size_t)(b * 8 + h) * 64 + qi) * SKV + 8 * g;
#pragma unroll
        for (int blk = 0; blk < 16; ++blk) {
            const int pos0 = blk < 8 ? (CTXL + (rs + blk) * GRIDW + cb) : (blk - 8) * 32;
#pragma unroll
            for (int dt = 0; dt < 4; ++dt) o[dt] = __builtin_amdgcn_mfma_f32_16x16x32_bf16(*(const bf16x8_t*)(vbase + (size_t)dt * 16 * SKV + pos0), pf[blk], o[dt], 0, 0, 0);
        }
        const float inv = 1.0f / sum;
        bf16* op = WSP(bf16, WS_OA) + (size_t)m * 512 + h * 64 + 4 * g;
#pragma unroll
        for (int dt = 0; dt < 4; ++dt) { const f32x4 r = o[dt] * inv; *(v2u*)(op + dt * 16) = (v2u){cvtpk(r.x, r.y), cvtpk(r.z, r.w)}; }
        LDS_WAIT(); asm volatile("" ::: "memory");
    }
}
__device__ __forceinline__ void ph_vat(Frame& f) { launder_ws(f);
    const bf16* Y1 = WSP(bf16, WS_Y1); bf16* VAT = WSP(bf16, WS_VAT);
    LAS bf16* tile = (LAS bf16*)(f.lds + f.wave * 16384);
    const int lane = f.lane, gw = f.vcu * NWAVES + f.wave, NGW = f.G * NWAVES;
    constexpr int NA_ITEMS = 2 * 8 * (SKV / 64);
    for (int it = gw; it < NA_ITEMS + 16; it += NGW) {
        const bool grpb = it >= NA_ITEMS;
        const int itb = it - NA_ITEMS;
        const int pt = grpb ? (itb & 3) : it % (SKV / 64), bh = grpb ? (itb >> 2) : it / (SKV / 64), b = grpb ? (bh >> 1) : (bh >> 3), h = grpb ? (bh & 1) : (bh & 7);
        const int pos = pt * 64 + lane, m = pos < CTXL ? (MLAT + b * CTXL + pos) : (b * SEQ + pos - CTXL);
        const bf16* vp = Y1 + (size_t)m * INP + (grpb ? C_VB : C_VA) + h * 64;
#pragma unroll
        for (int c = 0; c < 8; ++c) { const v4u w = ((const v4u*)vp)[c];
            tile[(8 * c + 0) * 72 + lane] = (bf16)(w.x & 0xffffu); tile[(8 * c + 1) * 72 + lane] = (bf16)(w.x >> 16); tile[(8 * c + 2) * 72 + lane] = (bf16)(w.y & 0xffffu); tile[(8 * c + 3) * 72 + lane] = (bf16)(w.y >> 16);
            tile[(8 * c + 4) * 72 + lane] = (bf16)(w.z & 0xffffu); tile[(8 * c + 5) * 72 + lane] = (bf16)(w.z >> 16); tile[(8 * c + 6) * 72 + lane] = (bf16)(w.w & 0xffffu); tile[(8 * c + 7) * 72 + lane] = (bf16)(w.w >> 16); }
        LDS_WAIT(); asm volatile("" ::: "memory");
        bf16* op = grpb ? WSP(bf16, WS_VBT) + ((size_t)bh * 64 + lane) * CTXL + pt * 64 : VAT + ((size_t)bh * 64 + lane) * SKV + pt * 64;
#pragma unroll
        for (int c = 0; c < 8; ++c) *(v4u*)(op + 8 * c) = *(const LAS v4u*)(tile + lane * 72 + 8 * c);
        LDS_WAIT(); asm volatile("" ::: "memory");
    }
}
__device__ __forceinline__ void ph_ctxattn(Frame& f, int vrot) { launder_ws(f);
    const bf16* Y1 = WSP(bf16, WS_Y1);
    const int lane = f.lane, g = lane >> 4, qi = lane & 15;
    const int gw = ((f.vcu + vrot) % f.G) * NWAVES + f.wave, NGW = f.G * NWAVES;
    for (int it = gw; it < 512; it += NGW) {
        const int kind = it >> 8, r = it & 255, b = r >> 7, h = (r >> 4) & 7, qb = r & 15;
        const int m = MLAT + b * CTXL + qb * 16 + qi;
        const bf16* qp = kind ? WSP(bf16, WS_QBP) + (size_t)m * 512 + h * 64 : Y1 + (size_t)m * INP + C_QA + h * 64;
        const bf16* kbase = kind ? WSP(bf16, WS_KBP) + (size_t)b * SKV * 128 + (h >> 2) * 64 : Y1 + (size_t)(MLAT + b * CTXL) * INP + C_KA + h * 64;
        const int kpitch = kind ? 128 : INP;
        const bf16* vbase = kind ? WSP(bf16, WS_VBT) + (size_t)((b * 2 + (h >> 2)) * 64) * CTXL : WSP(bf16, WS_VAT) + (size_t)((b * 8 + h) * 64) * SKV;
        const int vpitch = kind ? CTXL : SKV;
        const float scale = kind ? 1.0f : QSCALE;
        bf16x8_t qf[2];
#pragma unroll
        for (int ks = 0; ks < 2; ++ks) qf[ks] = *(const bf16x8_t*)(qp + 32 * ks + 8 * g);
        float sc[8][8];
#pragma unroll
        for (int blk = 0; blk < 8; ++blk)
#pragma unroll
            for (int T = 0; T < 2; ++T) {
                const int kidx = 8 * (qi >> 2) + 4 * T + (qi & 3);
                const bf16* kp = kbase + (size_t)(blk * 32 + kidx) * kpitch + 8 * g;
                f32x4 acc = {0.f, 0.f, 0.f, 0.f};
                acc = __builtin_amdgcn_mfma_f32_16x16x32_bf16(*(const bf16x8_t*)kp, qf[0], acc, 0, 0, 0);
                acc = __builtin_amdgcn_mfma_f32_16x16x32_bf16(*(const bf16x8_t*)(kp + 32), qf[1], acc, 0, 0, 0);
                sc[blk][4 * T + 0] = acc.x * scale; sc[blk][4 * T + 1] = acc.y * scale; sc[blk][4 * T + 2] = acc.z * scale; sc[blk][4 * T + 3] = acc.w * scale;
            }
        float mx = -1e30f;
#pragma unroll
        for (int blk = 0; blk < 8; ++blk)
#pragma unroll
            for (int j = 0; j < 8; ++j) mx = fmaxf(mx, sc[blk][j]);
        mx = fmaxf(mx, __shfl_xor(mx, 16)); mx = fmaxf(mx, __shfl_xor(mx, 32));
        float sum = 0.f;
        bf16x8_t pf[8];
#pragma unroll
        for (int blk = 0; blk < 8; ++blk) {
#pragma unroll
            for (int j = 0; j < 8; ++j) { const float p = __builtin_amdgcn_exp2f(sc[blk][j] - mx); sc[blk][j] = p; sum += p; }
            const v4u w = {cvtpk(sc[blk][0], sc[blk][1]), cvtpk(sc[blk][2], sc[blk][3]), cvtpk(sc[blk][4], sc[blk][5]), cvtpk(sc[blk][6], sc[blk][7])};
            pf[blk] = __builtin_bit_cast(bf16x8_t, w);
        }
        sum += __shfl_xor(sum, 16); sum += __shfl_xor(sum, 32);
        f32x4 o[4];
#pragma unroll
        for (int dt = 0; dt < 4; ++dt) o[dt] = (f32x4){0.f, 0.f, 0.f, 0.f};
#pragma unroll
        for (int blk = 0; blk < 8; ++blk)
#pragma unroll
            for (int dt = 0; dt < 4; ++dt) o[dt] = __builtin_amdgcn_mfma_f32_16x16x32_bf16(*(const bf16x8_t*)(vbase + (size_t)(dt * 16 + qi) * vpitch + blk * 32 + 8 * g), pf[blk], o[dt], 0, 0, 0);
        const float inv = 1.0f / sum;
        bf16* op = (kind ? WSP(bf16, WS_OB) : WSP(bf16, WS_OA)) + (size_t)m * 512 + h * 64 + 4 * g;
#pragma unroll
        for (int dt = 0; dt < 4; ++dt) { const f32x4 rr = o[dt] * inv; *(v2u*)(op + dt * 16) = (v2u){cvtpk(rr.x, rr.y), cvtpk(rr.z, rr.w)}; }
    }
}
struct F8 { f32x4 lo, hi; };
__device__ __forceinline__ F8 unpack8(v4u w) { F8 r; r.lo = (f32x4){bflo(w.x), bfhi(w.x), bflo(w.y), bfhi(w.y)}; r.hi = (f32x4){bflo(w.z), bfhi(w.z), bflo(w.w), bfhi(w.w)}; return r; }
__device__ __forceinline__ bf16x8_t pack8(f32x4 lo, f32x4 hi) { const v4u w = {cvtpk(lo.x, lo.y), cvtpk(lo.z, lo.w), cvtpk(hi.x, hi.y), cvtpk(hi.z, hi.w)}; return __builtin_bit_cast(bf16x8_t, w); }
__device__ __forceinline__ float fast_tanh(float x) { const float e = __expf(2.0f * x); return 1.0f - 2.0f / (1.0f + e); }
__device__ __forceinline__ f32x4 tanh4(f32x4 v) { return (f32x4){fast_tanh(v.x), fast_tanh(v.y), fast_tanh(v.z), fast_tanh(v.w)}; }
__device__ __forceinline__ f32x4 sigm4(f32x4 v) { return (f32x4){sigmoidf_(v.x), sigmoidf_(v.y), sigmoidf_(v.z), sigmoidf_(v.w)}; }
__device__ __forceinline__ v4u sel4(bool c, v4u v) { return c ? v : (v4u){0u, 0u, 0u, 0u}; }
__device__ __forceinline__ void ph_lora2(Frame& f, int l) { const float* in_I_A0 = karg_in(I_A0); const float* in_I_MUA = karg_in(I_MUA); const float* in_I_MUG = karg_in(I_MUG); const float* in_I_MUW = karg_in(I_MUW); const float* in_I_W0 = karg_in(I_W0); launder_ws(f);
    const bf16* Y1 = WSP(bf16, WS_Y1);
    const bf16* W2T = WSP(bf16, WS_LW) + (size_t)l * 2 * CW * 64; const bf16* A2T = WSP(bf16, WS_LW + 1 * MiB) + (size_t)l * 2 * CW * 64; const bf16* G2T = WSP(bf16, WS_LW + 2 * MiB) + (size_t)l * CW * 160;
    const int lane = f.lane, g = lane >> 4, qi = lane & 15, gw = f.vcu * NWAVES + f.wave, NGW = f.G * NWAVES;
    const v4u zero4 = {0u, 0u, 0u, 0u};
    const int NFULL = (f.G * NWAVES < (MALL / 16) * 2) ? f.G * NWAVES : (MALL / 16) * 2, NREST = (MALL / 16) * 2 - NFULL;
    for (int it0 = gw; it0 < NFULL + NREST * 8; it0 += NGW) {
        const int it = it0 < NFULL ? it0 : NFULL + (it0 - NFULL) / 8, ct_lo = it0 < NFULL ? 0 : (it0 - NFULL) % 8, ct_hi = it0 < NFULL ? 8 : ct_lo + 1;
        const int half = it & 1, m = (it >> 1) * 16 + qi;
        const RowInfo R = row_info(m);
        const bool hasp = R.t > 0, hasn = R.t < R.T - 1;
        const bf16* y = Y1 + (size_t)m * INP; const bf16* yp = hasp ? y - INP : y; const bf16* yn = hasn ? y + INP : y;
        bf16x8_t xw[2][2], xa[2][2], xg[5];
#pragma unroll
        for (int d = 0; d < 2; ++d)
#pragma unroll
            for (int ks = 0; ks < 2; ++ks) {
                const int col = d * 64 + 32 * ks + 8 * g; const bf16* yb = d ? yn : yp; const bool has = d ? hasn : hasp;
                { const F8 cur = unpack8(*(const v4u*)(y + C_WD + col)), nb = unpack8(sel4(has, *(const v4u*)(yb + C_WD + col)));
                  const f32x4 m0 = *(const f32x4*)(in_I_MUW + l * 128 + col), m1 = *(const f32x4*)(in_I_MUW + l * 128 + col + 4);
                  xw[d][ks] = pack8(tanh4(cur.lo + m0 * (nb.lo - cur.lo)), tanh4(cur.hi + m1 * (nb.hi - cur.hi))); }
                asm volatile("" : "+v"(xw[d][ks]) :: "memory");
                { const F8 cur = unpack8(*(const v4u*)(y + C_AD + col)), nb = unpack8(sel4(has, *(const v4u*)(yb + C_AD + col)));
                  const f32x4 m0 = *(const f32x4*)(in_I_MUA + l * 128 + col), m1 = *(const f32x4*)(in_I_MUA + l * 128 + col + 4);
                  xa[d][ks] = pack8(cur.lo + m0 * (nb.lo - cur.lo), cur.hi + m1 * (nb.hi - cur.hi)); }
                asm volatile("" : "+v"(xa[d][ks]) :: "memory");
            }
#pragma unroll
        for (int ks = 0; ks < 5; ++ks) {
            const int col = 32 * ks + 8 * g;
            const F8 cur = unpack8(*(const v4u*)(y + C_GD + col)), pv = unpack8(sel4(hasp, *(const v4u*)(yp + C_GD + col))), nx = unpack8(sel4(hasn, *(const v4u*)(yn + C_GD + col)));
            const f32x4 p0 = *(const f32x4*)(in_I_MUG + l * 320 + col), p1 = *(const f32x4*)(in_I_MUG + l * 320 + col + 4), n0 = *(const f32x4*)(in_I_MUG + l * 320 + 160 + col), n1 = *(const f32x4*)(in_I_MUG + l * 320 + 160 + col + 4);
            xg[ks] = pack8(sigm4(cur.lo + p0 * (pv.lo - cur.lo) + n0 * (nx.lo - cur.lo)), sigm4(cur.hi + p1 * (pv.hi - cur.hi) + n1 * (nx.hi - cur.hi)));
            asm volatile("" : "+v"(xg[ks]) :: "memory");
        }
        bf16* wq = WSP(bf16, WS_WDEC); bf16* ai = WSP(bf16, WS_AIC); bf16* gq = WSP(bf16, WS_G);
        struct LwSet { bf16x8_t w[4][2]; f32x4 bias[4]; };
#define LW_LOAD(S_, base_, bias_, d_, c0_) do { const int cr_ = (c0_) + 16 * (qi >> 2) + (qi & 3), cc_ = (c0_) + 16 * g; _Pragma("unroll") for (int T = 0; T < 4; ++T) { \
            const bf16* wp_ = (base_) + ((size_t)(d_) * CW + cr_ + 4 * T) * 64 + 8 * g; S_.w[T][0] = *(const bf16x8_t*)wp_; S_.w[T][1] = *(const bf16x8_t*)(wp_ + 32); \
            S_.bias[T] = *(const f32x4*)((bias_) + (l * 2 + (d_)) * CW + cc_ + 4 * T); } } while (0)
#define LW_MMA(acc_, S_, x_) do { _Pragma("unroll") for (int T = 0; T < 4; ++T) { acc_[T] = (f32x4){0.f, 0.f, 0.f, 0.f}; \
            acc_[T] = __builtin_amdgcn_mfma_f32_16x16x32_bf16(S_.w[T][0], x_[0], acc_[T], 0, 0, 0); acc_[T] = __builtin_amdgcn_mfma_f32_16x16x32_bf16(S_.w[T][1], x_[1], acc_[T], 0, 0, 0); } } while (0)
#define LW_ST16(op_, o_) do { *(v4u*)(op_) = (v4u){cvtpk(o_[0].x, o_[0].y), cvtpk(o_[0].z, o_[0].w), cvtpk(o_[1].x, o_[1].y), cvtpk(o_[1].z, o_[1].w)}; \
            *(v4u*)((op_) + 8) = (v4u){cvtpk(o_[2].x, o_[2].y), cvtpk(o_[2].z, o_[2].w), cvtpk(o_[3].x, o_[3].y), cvtpk(o_[3].z, o_[3].w)}; } while (0)
#define LW_EPI(acc_, S_, dstb_, d_, c0_, scale_) do { f32x4 o_[4]; _Pragma("unroll") for (int T = 0; T < 4; ++T) { const f32x4 z_ = acc_[T] + S_.bias[T]; \
            _Pragma("unroll") for (int q = 0; q < 4; ++q) o_[T][q] = (scale_) * __builtin_amdgcn_rcpf(1.0f + __expf(-z_[q])); } \
            bf16* op_ = (dstb_) + ((size_t)(d_) * MALL + m) * CW + (c0_) + 16 * g; LW_ST16(op_, o_); } while (0)
#define LW_FENCE() asm volatile("" ::: "memory")
        LwSet SA, SB; bf16x8_t GW[4][5];
        { const int c0 = half * 512 + ct_lo * 64; LW_LOAD(SA, W2T, in_I_W0, 0, c0); }
        LW_FENCE();
#pragma unroll 1
        for (int ct = ct_lo; ct < ct_hi; ++ct) {
            const int c0 = half * 512 + ct * 64, cr = c0 + 16 * (qi >> 2) + (qi & 3), cc = c0 + 16 * g;
            const int c0n = half * 512 + (ct + 1 < ct_hi ? ct + 1 : ct) * 64;
            f32x4 acc[4];
            LW_MMA(acc, SA, xw[0]); LW_LOAD(SB, A2T, in_I_A0, 0, c0); LW_FENCE(); LW_EPI(acc, SA, wq, 0, c0, 0.60653065971f); LW_FENCE();
            LW_MMA(acc, SB, xa[0]); LW_LOAD(SA, W2T, in_I_W0, 1, c0); LW_FENCE(); LW_EPI(acc, SB, ai, 0, c0, 1.0f); LW_FENCE();
            LW_MMA(acc, SA, xw[1]); LW_LOAD(SB, A2T, in_I_A0, 1, c0); LW_FENCE(); LW_EPI(acc, SA, wq, 1, c0, 0.60653065971f); LW_FENCE();
            LW_MMA(acc, SB, xa[1]);
#pragma unroll
            for (int T = 0; T < 4; ++T) { const bf16* gp = G2T + (size_t)(cr + 4 * T) * 160 + 8 * g;
#pragma unroll
                for (int ks = 0; ks < 5; ++ks) GW[T][ks] = *(const bf16x8_t*)(gp + 32 * ks); }
            LW_FENCE(); LW_EPI(acc, SB, ai, 1, c0, 1.0f); LW_FENCE();
#pragma unroll
            for (int T = 0; T < 4; ++T) { acc[T] = (f32x4){0.f, 0.f, 0.f, 0.f};
#pragma unroll
                for (int ks = 0; ks < 5; ++ks) acc[T] = __builtin_amdgcn_mfma_f32_16x16x32_bf16(GW[T][ks], xg[ks], acc[T], 0, 0, 0); }
            LW_LOAD(SA, W2T, in_I_W0, 0, c0n); LW_FENCE();
            { bf16* op = gq + (size_t)m * CW + cc; LW_ST16(op, acc); }
            LW_FENCE();
        }
#undef LW_LOAD
#undef LW_MMA
#undef LW_ST16
#undef LW_EPI
#undef LW_FENCE
    }
}
__device__ __forceinline__ void ph_lora_weights(Frame& f) { const float* in_I_A2 = karg_in(I_A2); const float* in_I_G2 = karg_in(I_G2); const float* in_I_W2 = karg_in(I_W2); launder_ws(f);
    const int gt = f.vcu * 512 + f.tid, GT = f.G * 512;
    for (int i = gt; i < DEPTH * 2 * CW * 64; i += GT) { const int r = i & 63, c = (i >> 6) & (CW - 1), ld = i >> 16;
        WSP(bf16, WS_LW)[i] = (bf16)f2bf(in_I_W2[((size_t)ld * 64 + r) * CW + c]); WSP(bf16, WS_LW + 1 * MiB)[i] = (bf16)f2bf(in_I_A2[((size_t)ld * 64 + r) * CW + c]); }
    for (int i = gt; i < DEPTH * CW * 160; i += GT) { const int r = i % 160, c = (i / 160) % CW, l = i / (160 * CW);
        WSP(bf16, WS_LW + 2 * MiB)[i] = (bf16)f2bf(in_I_G2[((size_t)l * 160 + r) * CW + c]); }
}
__device__ __forceinline__ void ph_setup2(Frame& f) { const float* in_I_CTX = karg_in(I_CTX); const float* in_I_N1G = karg_in(I_N1G); const float* in_I_N2G = karg_in(I_N2G); const float* in_I_X = karg_in(I_X); launder_ws(f);
    const int gt = f.vcu * 512 + f.tid, GT = f.G * 512, gw = f.vcu * NWAVES + f.wave, NGW = f.G * NWAVES, lane = f.lane;
    const float* MOD = WSP(float, WS_MOD);
    for (int i = gt; i < DEPTH * 2 * 3 * DM; i += GT) { const int k = i & (DM - 1), s = (i >> 11) % 3, w = (i / (3 * DM)) & 1, l = i / (6 * DM);
        WSP(float, WS_GK)[i] = (w ? in_I_N2G : in_I_N1G)[l * DM + k] * (1.0f + MOD[(size_t)(l * 3 + s) * MODW + (w ? 4 : 1) * DM + k]); }
    for (int it = gw; it < DEPTH * (INP + UPN); it += NGW) {
        const int l = it / (INP + UPN), r = it % (INP + UPN); const bool up = r >= INP; const int n = up ? r - INP : r;
        const bf16* wrow = up ? WSP(bf16, WS_WUP) + ((size_t)l * UPN + n) * DM : WSP(bf16, WS_WIN) + ((size_t)l * INP + n) * DM;
        const float* sh = MOD + (size_t)l * 3 * MODW + (up ? 3 * DM : 0);
        float a0 = 0.f, a1 = 0.f, a2 = 0.f;
#pragma unroll
        for (int c = 0; c < 4; ++c) { const int k = c * 512 + lane * 8; const v4u w = *(const v4u*)(wrow + k);
            const f32x4 wl = bf4((v2u){w.x, w.y}), wh = bf4((v2u){w.z, w.w});
            a0 += hsum4(wl * *(const f32x4*)(sh + k)) + hsum4(wh * *(const f32x4*)(sh + k + 4));
            a1 += hsum4(wl * *(const f32x4*)(sh + MODW + k)) + hsum4(wh * *(const f32x4*)(sh + MODW + k + 4));
            a2 += hsum4(wl * *(const f32x4*)(sh + 2 * MODW + k)) + hsum4(wh * *(const f32x4*)(sh + 2 * MODW + k + 4)); }
        a0 = sum64(a0); a1 = sum64(a1); a2 = sum64(a2);
        if (lane == 0) { float* o = up ? WSP(float, WS_BIAS3) + (size_t)l * 3 * UPN + n : WSP(float, WS_BIAS1) + (size_t)l * 3 * INP + n; const int ld = up ? UPN : INP; o[0] = a0; o[ld] = a1; o[2 * ld] = a2; }
    }
    for (int m = gw; m < MALL; m += NGW) {
        const int s = m < SEQ ? 0 : (m < MLAT ? 1 : 2);
        const f32x4* xr = (const f32x4*)(m < MLAT ? in_I_X + (size_t)m * DM : in_I_CTX + (size_t)(m - MLAT) * DM) + lane;
        f32x4* hr = (f32x4*)(WSP(float, WS_H) + (size_t)m * DM) + lane; v2u* o = (v2u*)(WSP(bf16, WS_XN) + (size_t)m * DM) + lane;
        const float* sc = MOD + (size_t)s * MODW + DM;
        float ss = 0.f;
#pragma unroll
        for (int j = 0; j < 8; ++j) { const int col = lane * 4 + 256 * j; const f32x4 v = xr[64 * j]; hr[64 * j] = v; ss += hsum4(v * v);
            const f32x4 r = v * *(const f32x4*)(in_I_N1G + col) * (*(const f32x4*)(sc + col) + 1.0f);
            o[64 * j] = (v2u){pk2(r.x, r.y), pk2(r.z, r.w)}; }
        ss = sum64(ss);
        if (lane == 0) WSP(float, WS_RS)[m] = __builtin_amdgcn_rsqf(ss * (1.f / DM) + 1e-6f);
    }
}
struct EpiScaleBias {
    static constexpr bool PERM = true, AFTER_DRAIN = false;
    bf16* O; int ldc; const float* ss; const float* bias; int bias_ld;
    __device__ __forceinline__ void operator()(const pg8::f32x4 (&acc)[2][2][4][2], const pg8::Unit& u, int wr, int wc, int fr, int fq) const {
        const int row0 = u.pm * 256 + wr * 64 + fr, col0 = u.pn * 256 + wc * 32 + 8 * fq;
        const int s = u.pm < 32 ? 0 : (u.pm < 64 ? 1 : 2);
        const float* bp = bias + (size_t)s * bias_ld + col0;
        pg8::f32x4 bv[2][2];
#pragma unroll
        for (int bj = 0; bj < 2; ++bj)
#pragma unroll
            for (int n = 0; n < 2; ++n) bv[bj][n] = *(const pg8::f32x4*)(bp + bj * 128 + 4 * n);
#pragma unroll
        for (int ai = 0; ai < 2; ++ai)
#pragma unroll
            for (int m = 0; m < 4; ++m) { const int row = row0 + ai * 128 + m * 16; const float rs = ss[row];
                bf16* rowp = O + (size_t)row * ldc + col0;
#pragma unroll
                for (int bj = 0; bj < 2; ++bj) { const pg8::f32x4 v0 = acc[ai][bj][m][0] * rs + bv[bj][0], v1 = acc[ai][bj][m][1] * rs + bv[bj][1];
                    *(v4u*)(rowp + bj * 128) = (v4u){pg8::cvt_pk_bf16(v0[0], v0[1]), pg8::cvt_pk_bf16(v0[2], v0[3]), pg8::cvt_pk_bf16(v1[0], v1[1]), pg8::cvt_pk_bf16(v1[2], v1[3])}; } }
    }
};
struct EpiResGateNorm {
    static constexpr bool PERM = true, AFTER_DRAIN = false;
    float* H; const float* mod; const float* gk; bf16* AH; float* ss;
    __device__ __forceinline__ void operator()(const pg8::f32x4 (&acc)[2][2][4][2], const pg8::Unit& u, int wr, int wc, int fr, int fq) const {
        const int row0 = u.pm * 256 + wr * 64 + fr, col0 = u.pn * 256 + wc * 32 + 8 * fq;
        const int s = u.pm < 32 ? 0 : (u.pm < 64 ? 1 : 2);
        const float* gp = mod + (size_t)s * MODW + col0; const float* kp = gk + (size_t)s * DM + col0;
        pg8::f32x4 gv[2][2], kv[2][2];
#pragma unroll
        for (int bj = 0; bj < 2; ++bj)
#pragma unroll
            for (int n = 0; n < 2; ++n) { gv[bj][n] = *(const pg8::f32x4*)(gp + bj * 128 + 4 * n); kv[bj][n] = gk ? *(const pg8::f32x4*)(kp + bj * 128 + 4 * n) : (pg8::f32x4){0.f, 0.f, 0.f, 0.f}; }
#pragma unroll
        for (int ai = 0; ai < 2; ++ai)
#pragma unroll
            for (int m = 0; m < 4; ++m) { const int row = row0 + ai * 128 + m * 16; float* rowp = H + (size_t)row * DM + col0; float sq = 0.f;
#pragma unroll
                for (int bj = 0; bj < 2; ++bj) { pg8::f32x4* p0 = (pg8::f32x4*)(rowp + bj * 128); pg8::f32x4* p1 = p0 + 1;
                    const pg8::f32x4 h0 = *p0 + gv[bj][0] * acc[ai][bj][m][0], h1 = *p1 + gv[bj][1] * acc[ai][bj][m][1];
                    *p0 = h0; *p1 = h1;
                    if (gk) { sq += (h0[0] * h0[0] + h0[1] * h0[1]) + (h0[2] * h0[2] + h0[3] * h0[3]) + (h1[0] * h1[0] + h1[1] * h1[1]) + (h1[2] * h1[2] + h1[3] * h1[3]);
                        const pg8::f32x4 a0 = h0 * kv[bj][0], a1 = h1 * kv[bj][1];
                        *(v4u*)(AH + (size_t)row * DM + col0 + bj * 128) = (v4u){pg8::cvt_pk_bf16(a0[0], a0[1]), pg8::cvt_pk_bf16(a0[2], a0[3]), pg8::cvt_pk_bf16(a1[0], a1[1]), pg8::cvt_pk_bf16(a1[2], a1[3])}; } }
                if (gk) { sq += __shfl_xor(sq, 16); sq += __shfl_xor(sq, 32); if (fq == 0) ss[(size_t)row * 32 + u.pn * 4 + wc] = sq; } }
    }
};

struct CtxSplitOrder {
    int G, c, KS, ksub;
    __device__ __forceinline__ bool next(int i, pg8::Unit& u) const { const int L = i * G + c; if (L >= 16 * KS) return false; const int r = L & 15; u.kb = (L >> 4) * ksub; u.pm = 64 + (r & 1); u.pn = r >> 1; return true; }
    __device__ __forceinline__ void a_ready(const pg8::Unit&) const {}
    __device__ __forceinline__ void done(const pg8::Unit&) const {}
};
struct EpiPartial {
    static constexpr bool PERM = true, AFTER_DRAIN = false;
    float* P; int ksub;
    __device__ __forceinline__ void operator()(const pg8::f32x4 (&acc)[2][2][4][2], const pg8::Unit& u, int wr, int wc, int fr, int fq) const {
        const int row0 = (u.pm - 64) * 256 + wr * 64 + fr, col0 = u.pn * 256 + wc * 32 + 8 * fq, ks = u.kb / ksub;
#pragma unroll
        for (int ai = 0; ai < 2; ++ai)
#pragma unroll
            for (int m = 0; m < 4; ++m) { float* rowp = P + ((size_t)ks * MCTX + row0 + ai * 128 + m * 16) * DM + col0;
#pragma unroll
                for (int bj = 0; bj < 2; ++bj) { *(pg8::f32x4*)(rowp + bj * 128) = acc[ai][bj][m][0]; *(pg8::f32x4*)(rowp + bj * 128 + 4) = acc[ai][bj][m][1]; } }
    }
};
template <int KS> __device__ __forceinline__ void ph_rs(Frame& f, int which, const float* gate, const float* gk) { launder_ws(f);
    const int gt = f.vcu * 512 + f.tid, GT = f.G * 512;
    for (int m = gt; m < MLAT; m += GT) { const f32x4* p = (const f32x4*)(WSP(float, WS_SSP) + ((size_t)which * MALL + m) * 32);
        f32x4 a = p[0];
#pragma unroll
        for (int j = 1; j < 8; ++j) a += p[j];
        WSP(float, WS_RS)[(size_t)which * MALL + m] = __builtin_amdgcn_rsqf(hsum4(a) * (1.f / DM) + 1e-6f); }
    if (KS > 0) {
        LAS float* red = (LAS float*)f.lds;
        const int lane = f.lane;
        for (int rb = f.vcu; rb < MCTX / 2; rb += f.G) { const int r = rb * 2 + (f.wave >> 2), jq = f.wave & 3, m = MLAT + r;
            f32x4* hr = (f32x4*)(WSP(float, WS_H) + (size_t)m * DM) + lane; v2u* o = (v2u*)(WSP(bf16, WS_XN) + (size_t)m * DM) + lane;
            const f32x4* pp = (const f32x4*)(WSP(float, WS_PART) + (size_t)r * DM) + lane;
            float ss = 0.f;
#pragma unroll
            for (int jj = 0; jj < 2; ++jj) { const int j = jq * 2 + jj, col = lane * 4 + 256 * j;
                f32x4 pv[KS > 0 ? KS : 1];
#pragma unroll
                for (int ks = 0; ks < KS; ++ks) pv[ks] = pp[(size_t)ks * MCTX * DM / 4 + 64 * j];
                f32x4 acc = pv[0];
#pragma unroll
                for (int ks = 1; ks < KS; ++ks) acc += pv[ks];
                const f32x4 h = hr[64 * j] + *(const f32x4*)(gate + col) * acc;
                hr[64 * j] = h; ss += hsum4(h * h);
                const f32x4 a = h * *(const f32x4*)(gk + col);
                o[64 * j] = (v2u){pk2(a.x, a.y), pk2(a.z, a.w)}; }
            ss = sum64(ss);
            __syncthreads();
            if (lane == 0) red[f.wave] = ss;
            __syncthreads();
            if (jq == 0 && lane == 0) WSP(float, WS_RS)[(size_t)which * MALL + m] = __builtin_amdgcn_rsqf(((red[f.wave] + red[f.wave + 1]) + (red[f.wave + 2] + red[f.wave + 3])) * (1.f / DM) + 1e-6f);
        }
    }
}
template <int CTRL> __device__ __forceinline__ float dpp_mov(float v) { return __builtin_bit_cast(float, __builtin_amdgcn_update_dpp(0, __builtin_bit_cast(int, v), CTRL, 0xF, 0xF, true)); }
template <int CTRL> __device__ __forceinline__ float dpp_keep(float old, float v) { return __builtin_bit_cast(float, __builtin_amdgcn_update_dpp(__builtin_bit_cast(int, old), __builtin_bit_cast(int, v), CTRL, 0xF, 0xF, false)); }
struct EpiConvGlu {
    static constexpr bool PERM = true, AFTER_DRAIN = false;
    bf16* HB; bf16* U; const float* rsv; const float* bias; const float* cw; const float* cb;
    __device__ __forceinline__ void operator()(const pg8::f32x4 (&acc)[2][2][4][2], const pg8::Unit& u, int wr, int wc, int fr, int fq) const {
        const int row0 = u.pm * 256 + wr * 64 + fr, col0 = u.pn * 256 + wc * 32 + 8 * fq, ch0 = u.pn * 128 + wc * 32 + 8 * fq;
        const int s = u.pm < 32 ? 0 : (u.pm < 64 ? 1 : 2);
        const float* bp = bias + (size_t)s * UPN + col0;
        pg8::f32x4 bu[2], bv[2], w0[2], w1[2], w2[2], cbv[2];
#pragma unroll
        for (int n = 0; n < 2; ++n) { bu[n] = *(const pg8::f32x4*)(bp + 4 * n); bv[n] = *(const pg8::f32x4*)(bp + 128 + 4 * n);
            w0[n] = *(const pg8::f32x4*)(cw + ch0 + 4 * n); w1[n] = *(const pg8::f32x4*)(cw + DFF + ch0 + 4 * n); w2[n] = *(const pg8::f32x4*)(cw + 2 * DFF + ch0 + 4 * n); cbv[n] = *(const pg8::f32x4*)(cb + ch0 + 4 * n); }
#pragma unroll
        for (int ai = 0; ai < 2; ++ai) {
            pg8::f32x4 uu[4][2];
            float rs[4];
#pragma unroll
            for (int m = 0; m < 4; ++m) { rs[m] = rsv[row0 + ai * 128 + m * 16];
#pragma unroll
                for (int n = 0; n < 2; ++n) uu[m][n] = acc[ai][0][m][n] * rs[m] + bu[n]; }
#pragma unroll
            for (int m = 0; m < 4; ++m) {
                const int row = row0 + ai * 128 + m * 16;
                const bool edge = (m == 0 && fr == 0) || (m == 3 && fr == 15);
                unsigned hw[4];
#pragma unroll
                for (int n = 0; n < 2; ++n) {
                    pg8::f32x4 g;
#pragma unroll
                    for (int i = 0; i < 4; ++i) {
                        const float pold = m > 0 ? dpp_mov<0x121>(uu[m - 1][n][i]) : 0.f, nold = m < 3 ? dpp_mov<0x12F>(uu[m + 1][n][i]) : 0.f;
                        const float up = dpp_keep<0x111>(pold, uu[m][n][i]), un = dpp_keep<0x101>(nold, uu[m][n][i]);
                        g[i] = up * w0[n][i] + uu[m][n][i] * w1[n][i] + un * w2[n][i] + cbv[n][i];
                    }
                    const pg8::f32x2 g0 = pg8::gelu_pk((pg8::f32x2){g[0], g[1]}), g1 = pg8::gelu_pk((pg8::f32x2){g[2], g[3]});
                    const pg8::f32x4 vv = acc[ai][1][m][n] * rs[m] + bv[n];
                    hw[2 * n] = pg8::cvt_pk_bf16(g0.x * vv[0], g0.y * vv[1]); hw[2 * n + 1] = pg8::cvt_pk_bf16(g1.x * vv[2], g1.y * vv[3]);
                }
                if (!edge) *(v4u*)(HB + (size_t)row * DFF + ch0) = (v4u){hw[0], hw[1], hw[2], hw[3]};
                if ((m == 0 && fr < 2) || (m == 3 && fr >= 14)) {
                    const pg8::f32x4 v0 = acc[ai][1][m][0] * rs[m] + bv[0], v1 = acc[ai][1][m][1] * rs[m] + bv[1];
                    bf16* up_ = U + (size_t)row * UPN + col0;
                    *(v4u*)(up_) = (v4u){pg8::cvt_pk_bf16(uu[m][0][0], uu[m][0][1]), pg8::cvt_pk_bf16(uu[m][0][2], uu[m][0][3]), pg8::cvt_pk_bf16(uu[m][1][0], uu[m][1][1]), pg8::cvt_pk_bf16(uu[m][1][2], uu[m][1][3])};
                    *(v4u*)(up_ + 128) = (v4u){pg8::cvt_pk_bf16(v0[0], v0[1]), pg8::cvt_pk_bf16(v0[2], v0[3]), pg8::cvt_pk_bf16(v1[0], v1[1]), pg8::cvt_pk_bf16(v1[2], v1[3])};
                }
            }
        }
    }
};
__device__ __forceinline__ void ph_convfix(Frame& f, int l, int mrows) { const float* in_I_CONVB = karg_in(I_CONVB); const float* in_I_CONVW = karg_in(I_CONVW); launder_ws(f);
    const int gt = f.vcu * 512 + f.tid, GT = f.G * 512;
    const bf16* U = WSP(bf16, WS_U); bf16* HB = WSP(bf16, WS_HB);
    const float* cw = in_I_CONVW + (size_t)l * 3 * DFF; const float* cb = in_I_CONVB + (size_t)l * DFF;
    constexpr int C8 = DFF / 8;
    for (int idx = gt; idx < (mrows / 32) * C8; idx += GT) {
        const int ri = idx / C8, c = (idx % C8) * 8, m = (ri >> 1) * 64 + ((ri & 1) ? 63 : 0), nc = (c >> 7) * 256 + (c & 127);
        const RowInfo R = row_info(m);
        const v4u z = {0u, 0u, 0u, 0u};
        const v4u uc = *(const v4u*)(U + (size_t)m * UPN + nc), vl = *(const v4u*)(U + (size_t)m * UPN + nc + 128);
        const v4u up = R.t > 0 ? *(const v4u*)(U + (size_t)(m - 1) * UPN + nc) : z, un = R.t < R.T - 1 ? *(const v4u*)(U + (size_t)(m + 1) * UPN + nc) : z;
        float r[8], gv[8];
#pragma unroll
        for (int i = 0; i < 8; ++i) {
            const unsigned wc_ = i < 2 ? uc.x : i < 4 ? uc.y : i < 6 ? uc.z : uc.w, wp_ = i < 2 ? up.x : i < 4 ? up.y : i < 6 ? up.z : up.w;
            const unsigned wn_ = i < 2 ? un.x : i < 4 ? un.y : i < 6 ? un.z : un.w, wv_ = i < 2 ? vl.x : i < 4 ? vl.y : i < 6 ? vl.z : vl.w;
            const float fc = (i & 1) ? bfhi(wc_) : bflo(wc_), fp = (i & 1) ? bfhi(wp_) : bflo(wp_), fn = (i & 1) ? bfhi(wn_) : bflo(wn_), fv = (i & 1) ? bfhi(wv_) : bflo(wv_);
            r[i] = fp * cw[c + i] + fc * cw[DFF + c + i] + fn * cw[2 * DFF + c + i] + cb[c + i]; gv[i] = fv;
        }
#pragma unroll
        for (int i = 0; i < 8; i += 2) { const f32x2 g2 = pg8::gelu_pk((f32x2){r[i], r[i + 1]}); r[i] = g2.x * gv[i]; r[i + 1] = g2.y * gv[i + 1]; }
        *(v4u*)(HB + (size_t)m * DFF + c) = (v4u){pk2(r[0], r[1]), pk2(r[2], r[3]), pk2(r[4], r[5]), pk2(r[6], r[7])};
    }
}
typedef float f32x16 __attribute__((ext_vector_type(16)));
#ifndef CHUNK_CHECK_C0
#define CHUNK_CHECK_C0 0
#define CHUNK_CHECK_C1 100000
#endif
#ifndef CK_SELFTEST_E
#define CK_SELFTEST_E 0
#endif
#ifndef CHUNK_CHECK_T1
#define CHUNK_CHECK_T1 32
#endif
constexpr int CK_C = 32, CK_NCH = SKV / CK_C;
constexpr size_t CK_REC = 24 * 1024;
__device__ __forceinline__ int ck_rho(int i, int h) { return (i & 3) + 8 * (i >> 2) + 4 * h; }
__device__ __forceinline__ bf16x8_t ck_frag(const f32x16& a, int s) {
    const v4u w = {cvtpk(a[8 * s + 0], a[8 * s + 1]), cvtpk(a[8 * s + 2], a[8 * s + 3]), cvtpk(a[8 * s + 4], a[8 * s + 5]), cvtpk(a[8 * s + 6], a[8 * s + 7])};
    return __builtin_bit_cast(bf16x8_t, w);
}
__device__ __forceinline__ f32x16 ck_mm(bf16x8_t a, bf16x8_t b, f32x16 c) { return __builtin_amdgcn_mfma_f32_32x32x16_bf16(a, b, c, 0, 0, 0); }
__device__ __forceinline__ void ck_swap32(float v, float& lo, float& hi) {
    const auto rr = __builtin_amdgcn_permlane32_swap(__float_as_uint(v), __float_as_uint(v), false, false); const unsigned r0 = rr[0], r1 = rr[1]; lo = __uint_as_float(r0); hi = __uint_as_float(r1); }
__device__ __forceinline__ float ck_sum2(float v) { float lo, hi; ck_swap32(v, lo, hi); return lo + hi; }
template <int CTRL, int RMASK> __device__ __forceinline__ float dpp_add0(float v) { return v + __builtin_bit_cast(float, __builtin_amdgcn_update_dpp(0, __builtin_bit_cast(int, v), CTRL, RMASK, 0xF, false)); }
__device__ __forceinline__ float ck_prefix32(float v) {
    v = dpp_add0<0x111, 0xF>(v); v = dpp_add0<0x112, 0xF>(v); v = dpp_add0<0x114, 0xF>(v); v = dpp_add0<0x118, 0xF>(v); v = dpp_add0<0x142, 0xA>(v);
    return v; }
__device__ __forceinline__ f32x4 exp4(f32x4 v) { return (f32x4){__expf(v.x), __expf(v.y), __expf(v.z), __expf(v.w)}; }

__device__ __forceinline__ f32x16 ck_unpack(v4u lo, v4u hi) { f32x16 r;
    r[0] = bflo(lo.x); r[1] = bfhi(lo.x); r[2] = bflo(lo.y); r[3] = bfhi(lo.y); r[4] = bflo(lo.z); r[5] = bfhi(lo.z); r[6] = bflo(lo.w); r[7] = bfhi(lo.w);
    r[8] = bflo(hi.x); r[9] = bfhi(hi.x); r[10] = bflo(hi.y); r[11] = bfhi(hi.y); r[12] = bflo(hi.z); r[13] = bfhi(hi.z); r[14] = bflo(hi.w); r[15] = bfhi(hi.w); return r; }
__device__ __forceinline__ bf16x8_t ck_ident(int s, int t, int h) {
    unsigned w[4];
#pragma unroll
    for (int p = 0; p < 4; ++p) { const int e0 = 2 * p, e1 = 2 * p + 1; const int r0 = 16 * s + 8 * (e0 >> 2) + 4 * h + (e0 & 3), r1 = 16 * s + 8 * (e1 >> 2) + 4 * h + (e1 & 3);
        w[p] = (r0 == t ? 0x3F80u : 0u) | (r1 == t ? 0x3F800000u : 0u); }
    return __builtin_bit_cast(bf16x8_t, (v4u){w[0], w[1], w[2], w[3]});
}
#if defined(CK_SELFTEST)
__device__ __forceinline__ void ck_report(Frame& f, float v) {
    unsigned u = __builtin_bit_cast(unsigned, v);
#pragma unroll
    for (int n = 1; n < 64; n <<= 1) { const unsigned o = (unsigned)__shfl_xor((int)u, n, 64); u = o > u ? o : u; }
    if (f.lane == 0) __hip_atomic_fetch_max((unsigned*)(f.ws + WS_CTL) + 8194, u, __ATOMIC_RELAXED, __HIP_MEMORY_SCOPE_AGENT);
}
#endif
  template <int MODE> __device__ __forceinline__ void ph_scanA(Frame& f, int l) { const float* in_I_KA = karg_in(I_KA); const float* in_I_KK = karg_in(I_KK); const float* in_I_MURKV = karg_in(I_MURKV); launder_ws(f);
    const bf16* Y1 = WSP(bf16, WS_Y1);
    LAS float* Lt = (LAS float*)(f.lds + f.wave * 12800);
    LAS float* QC = Lt + 1024;
    LAS v4u* PKL = (LAS v4u*)(Lt + 1024 + 64);
    LAS float* RV = Lt + 1024 + 64 + 2048;
    LAS float* PT = (LAS float*)(f.lds + 102400);
    LAS float* PA = (LAS float*)(f.lds + 133120);
    __syncthreads();
    for (int i = f.tid; i < 1536; i += NWAVES * 64) ((LAS f32x4*)PT)[i] = ((const f32x4*)(in_I_MURKV + (size_t)l * 6144))[i];
    for (int i = f.tid; i < 256; i += NWAVES * 64) { ((LAS f32x4*)(PT + 6144))[i] = ((const f32x4*)(in_I_KK + (size_t)l * CW))[i]; ((LAS f32x4*)PA)[i] = ((const f32x4*)(in_I_KA + (size_t)l * CW))[i]; }
    __syncthreads();
    const int gw = f.vcu * NWAVES + f.wave, NGW = f.G * NWAVES;
#if defined(CK_STAGGER)
    for (int k_ = (f.wave * 8 + (f.vcu & 7)) * CK_STAGGER; k_ > 0; --k_) __builtin_amdgcn_s_sleep(16);
#endif
    struct CkRaw { v4u q[2], k0[2], kn[2], ic[2], r0[2], rn[2], v0[2], vn[2]; };
    struct CkAddr { unsigned oy, oyn, o2, oc; int has, d; };
#define CK_ADDR(A_, it_, t_, h_) do { const int chain_ = (it_) / CK_NCH, c_ = (it_) % CK_NCH, b_ = chain_ >> 5, d_ = (chain_ >> 4) & 1, hd_ = chain_ & 15; \
        const int st_ = c_ * CK_C + (t_); int tt_, TT_, m_; \
        if (st_ < CTXL) { tt_ = d_ ? (CTXL - 1 - st_) : st_; TT_ = CTXL; m_ = MLAT + b_ * CTXL + tt_; } else { const int u_ = st_ - CTXL; tt_ = d_ ? (SEQ - 1 - u_) : u_; TT_ = SEQ; m_ = b_ * SEQ + tt_; } \
        const bool has_ = d_ ? (tt_ < TT_ - 1) : (tt_ > 0); const int mn_ = has_ ? (d_ ? m_ + 1 : m_ - 1) : m_; \
        A_.oy = ((unsigned)m_ * INP + hd_ * 64 + 16 * (h_)) * 2u; A_.oyn = ((unsigned)mn_ * INP + hd_ * 64 + 16 * (h_)) * 2u; A_.o2 = (((unsigned)d_ * MALL + m_) * CW + hd_ * 64 + 16 * (h_)) * 2u; \
        A_.oc = (unsigned)(hd_ * 64 + 16 * (h_)) * 4u; A_.has = has_ ? 1 : 0; A_.d = d_; } while (0)
#define CK_GLD(dst_, off_, base_, imm_) asm volatile("global_load_dwordx4 %0, %1, %2 offset:%3" : "=&v"(dst_) : "v"(off_), "s"(base_), "n"(imm_))
#define CK_LD(X, T_, A_) do { const char* wqb_ = (const char*)WSP(bf16, WS_WDEC); const char* aib_ = (const char*)WSP(bf16, WS_AIC); \
        const char* ykb_ = (const char*)Y1 + C_K * 2; const char* yrb_ = (const char*)Y1 + C_R * 2; const char* yvb_ = (const char*)Y1 + C_V * 2; \
        _Pragma("unroll") for (int j_ = 0; j_ < 2; ++j_) { \
            CK_GLD(X.q[j_], A_.o2, wqb_, 64 * (T_) + 16 * j_); CK_GLD(X.k0[j_], A_.oy, ykb_, 64 * (T_) + 16 * j_); CK_GLD(X.kn[j_], A_.oyn, ykb_, 64 * (T_) + 16 * j_); CK_GLD(X.ic[j_], A_.o2, aib_, 64 * (T_) + 16 * j_); \
            CK_GLD(X.r0[j_], A_.oy, yrb_, 64 * (T_) + 16 * j_); CK_GLD(X.rn[j_], A_.oyn, yrb_, 64 * (T_) + 16 * j_); CK_GLD(X.v0[j_], A_.oy, yvb_, 64 * (T_) + 16 * j_); CK_GLD(X.vn[j_], A_.oyn, yvb_, 64 * (T_) + 16 * j_); } } while (0)
#define CK_LDWAIT(X, N_) do { asm volatile("s_waitcnt vmcnt(" #N_ ")" : "+v"(X.q[0]), "+v"(X.q[1]), "+v"(X.k0[0]), "+v"(X.k0[1]), "+v"(X.kn[0]), "+v"(X.kn[1]), "+v"(X.ic[0]), "+v"(X.ic[1]), \
            "+v"(X.r0[0]), "+v"(X.r0[1]), "+v"(X.rn[0]), "+v"(X.rn[1]), "+v"(X.v0[0]), "+v"(X.v0[1]), "+v"(X.vn[0]), "+v"(X.vn[1])); } while (0)
#define CK_PREF2 CK_LD(RB, 1, AD);
    CkRaw RA, RB; CkAddr AD;
    { const int it0 = gw < 64 * CK_NCH ? gw : 0; CK_ADDR(AD, it0, f.lane & 31, f.lane >> 5); CK_LD(RA, 0, AD); CK_PREF2 }
    CK_LDWAIT(RA, 0); CK_LDWAIT(RB, 0);
    for (int it = gw; it < 64 * CK_NCH; it += NGW) {
        int lane_ = f.lane; asm volatile("" : "+v"(lane_));
        launder_ws(f);
        const int lane = lane_, t = lane & 31, h = lane >> 5;
        LAS float* LtW = Lt + 4 * h * 32 + t;
        const bool has = AD.has != 0;
        const LAS float* pmu = PT + AD.d * 3072 + (AD.oc >> 2); const LAS float* pkk = PT + 6144 + (AD.oc >> 2); const LAS float* pka = PA + (AD.oc >> 2);
        const f32x4 z4 = {0.f, 0.f, 0.f, 0.f};
#define CK_PC(A_, g_) (((g_) & 1) ? (v2u){A_[(g_) >> 1].z, A_[(g_) >> 1].w} : (v2u){A_[(g_) >> 1].x, A_[(g_) >> 1].y})
#define CK_FEAT(X, T_, g_, u_) do { const f32x4 qv = bf4(CK_PC(X.q, g_)); const int pf_ = 32 * (T_) + 4 * (g_); \
            f32x4 Qi; Qi.x = ck_prefix32(qv.x); Qi.y = ck_prefix32(qv.y); Qi.z = ck_prefix32(qv.z); Qi.w = ck_prefix32(qv.w);         \
            if (t == 31) *(LAS f32x4*)(QC + 32 * (T_) + 8 * (g_) + 4 * h) = Qi; \
            const f32x4 k0 = bf4(CK_PC(X.k0, g_)), kn = has ? bf4(CK_PC(X.kn, g_)) : z4, kx = k0 + *(const LAS f32x4*)(pmu + (1024 + pf_)) * (kn - k0), ic = bf4(CK_PC(X.ic, g_)), kk = kx * *(const LAS f32x4*)(pkk + pf_); \
            ss += hsum4(kk * kk); \
            const f32x4 ep = exp4(Qi), em = exp4(-Qi), emx = exp4(qv - Qi); \
            const f32x4 r0 = bf4(CK_PC(X.r0, g_)), rn = has ? bf4(CK_PC(X.rn, g_)) : z4, r = r0 + *(const LAS f32x4*)(pmu + pf_) * (rn - r0); \
            const f32x4 v0 = bf4(CK_PC(X.v0, g_)), vn = has ? bf4(CK_PC(X.vn, g_)) : z4; \
            vv[u_] = v0 + *(const LAS f32x4*)(pmu + (2048 + pf_)) * (vn - v0); \
            av[u_] = -kk * emx; rv[u_] = r * em; bv[u_] = kk * ic * ep; kv2[u_] = kx * ((ic - 1.0f) * *(const LAS f32x4*)(pka + pf_) + 1.0f) * ep; \
            asm volatile("" : "+v"(av[u_]), "+v"(rv[u_]), "+v"(bv[u_]), "+v"(kv2[u_]), "+v"(vv[u_]) :: "memory"); } while (0)
        float ss = 0.f;
        bf16x8_t Ac[2][2], Rc[2][2], Bc[2][2], Kc[2][2], Vc[2][2];
#define CK_TILE(X, T_) do { _Pragma("unroll") for (int s = 0; s < 2; ++s) { f32x4 av[2], rv[2], bv[2], kv2[2], vv[2]; \
                CK_FEAT(X, T_, 2 * s, 0); CK_FEAT(X, T_, 2 * s + 1, 1); \
                Ac[T_][s] = pack8(av[0], av[1]); Rc[T_][s] = pack8(rv[0], rv[1]); Bc[T_][s] = pack8(bv[0], bv[1]); Kc[T_][s] = pack8(kv2[0], kv2[1]); Vc[T_][s] = pack8(vv[0], vv[1]); \
                asm volatile("" : "+v"(Ac[T_][s]), "+v"(Rc[T_][s]), "+v"(Bc[T_][s]), "+v"(Kc[T_][s]), "+v"(Vc[T_][s]) :: "memory"); } } while (0)
        CK_TILE(RA, 0); CK_TILE(RB, 1);
#undef CK_TILE
#undef CK_PC
#undef CK_FEAT
        ss = ck_sum2(ss);
        const float rinv = __builtin_amdgcn_rsqf(fmaxf(ss, 1e-24f));
        if (h == 0) RV[t] = rinv;
        LDS_WAIT(); asm volatile("" ::: "memory");
#define CK_RROW(i_) (RV[8 * ((i_) >> 2) + 4 * h + ((i_) & 3)])
        const f32x16 zero16 = {0.f, 0.f, 0.f, 0.f, 0.f, 0.f, 0.f, 0.f, 0.f, 0.f, 0.f, 0.f, 0.f, 0.f, 0.f, 0.f};
        bf16x8_t Vs[2][2];
#pragma unroll
        for (int T = 0; T < 2; ++T) { f32x16 x = ck_mm(Vc[T][0], ck_ident(0, t, h), zero16); x = ck_mm(Vc[T][1], ck_ident(1, t, h), x); Vs[T][0] = ck_frag(x, 0); Vs[T][1] = ck_frag(x, 1); asm volatile("" : "+v"(Vs[T][0]), "+v"(Vs[T][1])); }
        f32x16 XW[2], XU[2];
#pragma unroll
        for (int T = 0; T < 2; ++T) { XW[T] = ck_mm(Ac[T][0], ck_ident(0, t, h), zero16); XW[T] = ck_mm(Ac[T][1], ck_ident(1, t, h), XW[T]);
#pragma unroll
            for (int i = 0; i < 16; ++i) XW[T][i] *= CK_RROW(i); }
        bf16x8_t G2f[2], G3f[2], G4f[2];
        { f32x16 g = zero16;
#pragma unroll
          for (int T = 0; T < 2; ++T)
#pragma unroll
              for (int s = 0; s < 2; ++s) g = ck_mm(Bc[T][s], Ac[T][s], g);
#pragma unroll
          for (int i = 0; i < 16; ++i) LtW[((i & 3) + 8 * (i >> 2)) * 32] = ck_rho(i, h) < t ? g[i] * (CK_RROW(i) * RV[t]) : 0.f; }
        __builtin_amdgcn_sched_barrier(0);
        { f32x16 g = zero16;
#pragma unroll
          for (int T = 0; T < 2; ++T)
#pragma unroll
              for (int s = 0; s < 2; ++s) g = ck_mm(Kc[T][s], Ac[T][s], g);
#pragma unroll
          for (int i = 0; i < 16; ++i) g[i] = ck_rho(i, h) < t ? g[i] * RV[t] : 0.f;
          G2f[0] = ck_frag(g, 0); G2f[1] = ck_frag(g, 1); asm volatile("" : "+v"(G2f[0]), "+v"(G2f[1])); }
        __builtin_amdgcn_sched_barrier(0);
        { f32x16 g = zero16;
#pragma unroll
          for (int T = 0; T < 2; ++T)
#pragma unroll
              for (int s = 0; s < 2; ++s) g = ck_mm(Bc[T][s], Rc[T][s], g);
#pragma unroll
          for (int i = 0; i < 16; ++i) g[i] = ck_rho(i, h) <= t ? g[i] * CK_RROW(i) : 0.f;
          G3f[0] = ck_frag(g, 0); G3f[1] = ck_frag(g, 1); asm volatile("" : "+v"(G3f[0]), "+v"(G3f[1])); }
        __builtin_amdgcn_sched_barrier(0);
        { f32x16 g = zero16;
#pragma unroll
          for (int T = 0; T < 2; ++T)
#pragma unroll
              for (int s = 0; s < 2; ++s) g = ck_mm(Kc[T][s], Rc[T][s], g);
#pragma unroll
          for (int i = 0; i < 16; ++i) g[i] = ck_rho(i, h) <= t ? g[i] : 0.f;
#if defined(CK_SELFTEST)
          { float rd = 0.f;
#define CK_RD(x) do { const float r_ = (x); rd = (r_ == r_) ? fmaxf(rd, r_) : 1e30f; } while (0)
            if (CK_SELFTEST & 3) { float dref = 0.f, sref = 0.f, daref = 0.f, saref = 0.f;
#pragma unroll
              for (int T = 0; T < 2; ++T)
#pragma unroll
                for (int s2 = 0; s2 < 2; ++s2) { const v4u kw = __builtin_bit_cast(v4u, Kc[T][s2]), rw = __builtin_bit_cast(v4u, Rc[T][s2]);
                    const unsigned kk_[4] = {kw.x, kw.y, kw.z, kw.w}, rr_[4] = {rw.x, rw.y, rw.z, rw.w};
#pragma unroll
                    for (int q = 0; q < 4; ++q) { const float k0_ = bflo(kk_[q]), k1_ = bfhi(kk_[q]), r0_ = bflo(rr_[q]), r1_ = bfhi(rr_[q]);
                        dref += k0_ * r0_ + k1_ * r1_; daref += fabsf(k0_ * r0_) + fabsf(k1_ * r1_);
                        saref += fabsf(__shfl_up(k0_, 1, 32) * r0_) + fabsf(__shfl_up(k1_, 1, 32) * r1_);
                        sref += __shfl_up(k0_, 1, 32) * r0_ + __shfl_up(k1_, 1, 32) * r1_; } }
              dref = ck_sum2(dref);
              sref = ck_sum2(sref);
              daref = ck_sum2(daref);
              saref = ck_sum2(saref);
              float dm = 0.f, sm = 0.f;
#pragma unroll
              for (int i = 0; i < 16; ++i) { if (ck_rho(i, h) == t) dm = g[i]; if (ck_rho(i, h) == t - 1) sm = g[i]; }
              dm = ck_sum2(dm);
              sm = ck_sum2(sm);
              if (CK_SELFTEST & 1) CK_RD(fabsf(dm - dref) / (daref + 1e-30f));
              if ((CK_SELFTEST & 2) && t >= 1) CK_RD(fabsf(sm - sref) / (saref + 1e-30f)); }
            if (CK_SELFTEST & 128) {
                const unsigned av_ = pk2((float)(t + 1), (float)(t + 1)); const v4u aw = {av_, av_, av_, av_}; const v4u one4 = {0x3F803F80u, 0x3F803F80u, 0x3F803F80u, 0x3F803F80u};
                const f32x16 dd = ck_mm(__builtin_bit_cast(bf16x8_t, aw), __builtin_bit_cast(bf16x8_t, one4), zero16);
#pragma unroll
                for (int i = 0; i < 16; ++i) CK_RD(fabsf(dd[i] - 16.0f * (ck_rho(i, h) + 1)) / (16.0f * (ck_rho(i, h) + 1))); }
            if (CK_SELFTEST & 256) {
                const unsigned bv_ = pk2((float)(t + 1), (float)(t + 1)); const v4u bw = {bv_, bv_, bv_, bv_}; const v4u one4 = {0x3F803F80u, 0x3F803F80u, 0x3F803F80u, 0x3F803F80u};
                const f32x16 dd = ck_mm(__builtin_bit_cast(bf16x8_t, one4), __builtin_bit_cast(bf16x8_t, bw), zero16);
#pragma unroll
                for (int i = 0; i < 16; ++i) CK_RD(fabsf(dd[i] - 16.0f * (t + 1)) / (16.0f * (t + 1))); }
            if (CK_SELFTEST & 32) {
                const f32x16 dd = ck_mm(Kc[0][0], Rc[0][0], zero16);
                const v4u kw = __builtin_bit_cast(v4u, Kc[0][0]), rw = __builtin_bit_cast(v4u, Rc[0][0]);
                float d1 = bflo(kw.x) * bflo(rw.x) + bfhi(kw.x) * bfhi(rw.x) + bflo(kw.y) * bflo(rw.y) + bfhi(kw.y) * bfhi(rw.y) + bflo(kw.z) * bflo(rw.z) + bfhi(kw.z) * bfhi(rw.z) + bflo(kw.w) * bflo(rw.w) + bfhi(kw.w) * bfhi(rw.w);
                float a1 = fabsf(bflo(kw.x) * bflo(rw.x)) + fabsf(bfhi(kw.x) * bfhi(rw.x)) + fabsf(bflo(kw.y) * bflo(rw.y)) + fabsf(bfhi(kw.y) * bfhi(rw.y)) + fabsf(bflo(kw.z) * bflo(rw.z)) + fabsf(bfhi(kw.z) * bfhi(rw.z)) + fabsf(bflo(kw.w) * bflo(rw.w)) + fabsf(bfhi(kw.w) * bfhi(rw.w));
                d1 = ck_sum2(d1);
                a1 = ck_sum2(a1);
                float m1 = 0.f;
#pragma unroll
                for (int i = 0; i < 16; ++i) if (ck_rho(i, h) == t) m1 = dd[i];
                m1 = ck_sum2(m1);
                CK_RD(fabsf(m1 - d1) / (a1 + 1e-30f)); }
            if (CK_SELFTEST & (4096 | 65536)) CK_RD(rdq);
            ck_report(f, rd); }
#endif
          G4f[0] = ck_frag(g, 0); G4f[1] = ck_frag(g, 1); asm volatile("" : "+v"(G4f[0]), "+v"(G4f[1])); }
        __builtin_amdgcn_sched_barrier(0);
        bf16x8_t Bs[2][2], Ks[2][2];
        LDS_WAIT(); asm volatile("" ::: "memory");
#pragma unroll
        for (int T = 0; T < 2; ++T) { const float gc = __expf(-QC[32 * T + t]);
            f32x16 x = ck_mm(Bc[T][0], ck_ident(0, t, h), zero16); x = ck_mm(Bc[T][1], ck_ident(1, t, h), x);
#pragma unroll
            for (int i = 0; i < 16; ++i) x[i] *= gc * CK_RROW(i);
            Bs[T][0] = ck_frag(x, 0); Bs[T][1] = ck_frag(x, 1);
            x = ck_mm(Kc[T][0], ck_ident(0, t, h), zero16); x = ck_mm(Kc[T][1], ck_ident(1, t, h), x); x = x * gc; Ks[T][0] = ck_frag(x, 0); Ks[T][1] = ck_frag(x, 1);
            asm volatile("" : "+v"(Bs[T][0]), "+v"(Bs[T][1]), "+v"(Ks[T][0]), "+v"(Ks[T][1])); }
#pragma unroll
        for (int T = 0; T < 2; ++T)
#pragma unroll
            for (int s2 = 0; s2 < 2; ++s2) PKL[(T * 2 + s2) * 64 + lane] = __builtin_bit_cast(v4u, Rc[T][s2]);
        PKL[4 * 64 + lane] = __builtin_bit_cast(v4u, G3f[0]); PKL[5 * 64 + lane] = __builtin_bit_cast(v4u, G3f[1]); PKL[6 * 64 + lane] = __builtin_bit_cast(v4u, G4f[0]); PKL[7 * 64 + lane] = __builtin_bit_cast(v4u, G4f[1]);
        LDS_WAIT(); asm volatile("" ::: "memory");
#define CK_SOLVE2(X0, X1) do { _Pragma("unroll") for (int p = 0; p < 31; ++p) { \
            const int ip = (p & 3) + 4 * (p >> 3), hp = (p >> 2) & 1;               \
            float xp0, xp1; \
            { const float xv_ = X0[ip]; float lo_, hi_; ck_swap32(xv_, lo_, hi_); xp0 = hp ? hi_ : lo_; } \
            { const float xv_ = X1[ip]; float lo_, hi_; ck_swap32(xv_, lo_, hi_); xp1 = hp ? hi_ : lo_; } \
            _Pragma("unroll") for (int g4 = 0; g4 < 4; ++g4) { if (8 * g4 + 4 + 3 <= p) continue;       \
                const f32x4 cf = *(const LAS f32x4*)(Lt + p * 32 + 8 * g4 + 4 * h);       \
                _Pragma("unroll") for (int e = 0; e < 4; ++e) { const int i = 4 * g4 + e; X0[i] += cf[e] * xp0; X1[i] += cf[e] * xp1; } } \
            asm volatile("" ::: "memory"); } } while (0)
        CK_SOLVE2(XW[0], XW[1]);
        bf16x8_t Uf[2][2];
        int lane_q = lane; asm volatile("" : "+v"(lane_q));
        const int tq = lane_q & 31, hq = lane_q >> 5;
        v4u* rec = (v4u*)(f.ws + WS_CK + (size_t)it * CK_REC) + lane_q;
#define CK_ST(r_, x_) do { const v4u sv_ = (x_); if (MODE == 0) __builtin_nontemporal_store(sv_, &rec[64 * (r_)]); else asm volatile("" :: "v"(sv_)); } while (0)
        { bf16x8_t Wf[2][2];
#pragma unroll
          for (int T = 0; T < 2; ++T) { Wf[T][0] = ck_frag(XW[T], 0); Wf[T][1] = ck_frag(XW[T], 1); }
          asm volatile("" : "+v"(Wf[0][0]), "+v"(Wf[0][1]), "+v"(Wf[1][0]), "+v"(Wf[1][1]));
#pragma unroll
          for (int Ti = 0; Ti < 2; ++Ti)
#pragma unroll
              for (int To = 0; To < 2; ++To) { f32x16 mt = ck_mm(Wf[Ti][0], Bs[To][0], zero16); mt = ck_mm(Wf[Ti][1], Bs[To][1], mt);
                  if (Ti == To) { const float gc = __expf(-QC[32 * To + tq]);
#pragma unroll
                      for (int i = 0; i < 16; ++i) mt[i] += (ck_rho(i, hq) == tq) ? gc : 0.f; }
                  CK_ST(((Ti * 2 + To) * 2 + 0), __builtin_bit_cast(v4u, ck_frag(mt, 0))); CK_ST(((Ti * 2 + To) * 2 + 1), __builtin_bit_cast(v4u, ck_frag(mt, 1))); asm volatile("" ::: "memory"); }
          { const bf16x8_t g30 = __builtin_bit_cast(bf16x8_t, PKL[4 * 64 + lane_q]), g31 = __builtin_bit_cast(bf16x8_t, PKL[5 * 64 + lane_q]);
#pragma unroll
            for (int Tc = 0; Tc < 2; ++Tc) { f32x16 p1 = ck_unpack(PKL[(Tc * 2 + 0) * 64 + lane_q], PKL[(Tc * 2 + 1) * 64 + lane_q]);
                p1 = ck_mm(Wf[Tc][0], g30, p1); p1 = ck_mm(Wf[Tc][1], g31, p1);
                CK_ST((16 + Tc * 2 + 0), __builtin_bit_cast(v4u, ck_frag(p1, 0))); CK_ST((16 + Tc * 2 + 1), __builtin_bit_cast(v4u, ck_frag(p1, 1))); asm volatile("" ::: "memory"); } } }
#pragma unroll
        for (int T = 0; T < 2; ++T) { XU[T] = ck_mm(G2f[0], Vs[T][0], zero16); XU[T] = ck_mm(G2f[1], Vs[T][1], XU[T]); }
        CK_SOLVE2(XU[0], XU[1]);
#if defined(PROBE_SOLVE)
        { f32x16 D0 = XU[0], D1 = XU[1]; CK_SOLVE2(D0, D1); asm volatile("" :: "v"(D0), "v"(D1)); }
        { f32x16 D0 = XU[1], D1 = XU[0]; CK_SOLVE2(D0, D1); asm volatile("" :: "v"(D0), "v"(D1)); }
#endif
#undef CK_SOLVE2
#pragma unroll
        for (int T = 0; T < 2; ++T) { Uf[T][0] = ck_frag(XU[T], 0); Uf[T][1] = ck_frag(XU[T], 1); }
        { const int itn = (it + NGW < 64 * CK_NCH) ? it + NGW : it; CK_ADDR(AD, itn, tq, hq); CK_LD(RA, 0, AD); CK_PREF2 }
        asm volatile("" ::: "memory");
#pragma unroll
        for (int To = 0; To < 2; ++To)
#pragma unroll
            for (int Tn = 0; Tn < 2; ++Tn) { f32x16 nn = ck_mm(Bs[To][0], Uf[Tn][0], zero16); nn = ck_mm(Bs[To][1], Uf[Tn][1], nn); nn = ck_mm(Ks[To][0], Vs[Tn][0], nn); nn = ck_mm(Ks[To][1], Vs[Tn][1], nn);
                CK_ST((8 + (Tn * 2 + To) * 2 + 0), __builtin_bit_cast(v4u, ck_frag(nn, 0))); CK_ST((8 + (Tn * 2 + To) * 2 + 1), __builtin_bit_cast(v4u, ck_frag(nn, 1))); asm volatile("" ::: "memory"); }
        G3f[0] = __builtin_bit_cast(bf16x8_t, PKL[4 * 64 + lane_q]); G3f[1] = __builtin_bit_cast(bf16x8_t, PKL[5 * 64 + lane_q]);
        G4f[0] = __builtin_bit_cast(bf16x8_t, PKL[6 * 64 + lane_q]); G4f[1] = __builtin_bit_cast(bf16x8_t, PKL[7 * 64 + lane_q]);
#pragma unroll
        for (int Tn = 0; Tn < 2; ++Tn) { f32x16 y0 = ck_mm(G3f[0], Uf[Tn][0], zero16); y0 = ck_mm(G3f[1], Uf[Tn][1], y0); y0 = ck_mm(G4f[0], Vs[Tn][0], y0); y0 = ck_mm(G4f[1], Vs[Tn][1], y0);
            CK_ST((20 + Tn * 2 + 0), __builtin_bit_cast(v4u, ck_frag(y0, 0))); CK_ST((20 + Tn * 2 + 1), __builtin_bit_cast(v4u, ck_frag(y0, 1))); asm volatile("" ::: "memory"); }
        LDS_WAIT(); asm volatile("" ::: "memory");
        if (MODE == 0) { CK_LDWAIT(RA, 12); CK_LDWAIT(RB, 12); } else { CK_LDWAIT(RA, 0); CK_LDWAIT(RB, 0); }
    }
#undef CK_ADDR
#undef CK_LD
#undef CK_ST
#undef CK_PREF2
#undef CK_GLD
#undef CK_LDWAIT
}
template <int CHECK> __device__ __forceinline__ void ph_scanB(Frame& f, int l, int item_lo, int item_step) { launder_ws(f);
    LAS v4u* SL = (LAS v4u*)f.lds;
    LAS v4u* SFB = SL + 3 * 24 * 64;
    const int lane = f.lane;
    for (int it = item_lo + f.vcu; it < 64; it += item_step) {
        const int chain = it, b = chain >> 5, d = (chain >> 4) & 1, hd = chain & 15;
        if (f.wave >= 4) {
            const int w = f.wave - 4;
            const v4u* rec0 = (const v4u*)(f.ws + WS_CK + (size_t)chain * CK_NCH * CK_REC) + lane + 64 * w;
            struct LSet { v4u v0, v1, v2, v3, v4, v5; };
            LSet L0, L1, L2, L3, L4, L5, L6, L7;
#define CKB_LOAD(X, c) do { const v4u* rp_ = rec0 + (size_t)(c) * (CK_REC / 16); X.v0 = __builtin_nontemporal_load(rp_); X.v1 = __builtin_nontemporal_load(rp_ + 64 * 4); X.v2 = __builtin_nontemporal_load(rp_ + 64 * 8); X.v3 = __builtin_nontemporal_load(rp_ + 64 * 12); X.v4 = __builtin_nontemporal_load(rp_ + 64 * 16); X.v5 = __builtin_nontemporal_load(rp_ + 64 * 20); } while (0)
#define CKB_PUT(X, sb_) do { (sb_)[64 * w] = X.v0; (sb_)[64 * (4 + w)] = X.v1; (sb_)[64 * (8 + w)] = X.v2; (sb_)[64 * (12 + w)] = X.v3; (sb_)[64 * (16 + w)] = X.v4; (sb_)[64 * (20 + w)] = X.v5; } while (0)
            int sl = 1;
#define CKB_IVAL(c, XP, XL) do { CKB_PUT(XP, SL + sl * 24 * 64 + lane); sl = sl == 2 ? 0 : sl + 1; { const int cl_ = (c) + 8 < CK_NCH ? (c) + 8 : CK_NCH - 1; CKB_LOAD(XL, cl_); } LDS_WAIT(); __builtin_amdgcn_s_barrier(); } while (0)
            CKB_LOAD(L0, 0); CKB_LOAD(L1, 1); CKB_LOAD(L2, 2); CKB_LOAD(L3, 3); CKB_LOAD(L4, 4); CKB_LOAD(L5, 5); CKB_LOAD(L6, 6); CKB_LOAD(L7, 7);
            CKB_PUT(L0, SL + lane);
            LDS_WAIT(); __builtin_amdgcn_s_barrier();
            static_assert(CK_NCH % 8 == 0, "loader loop unrolled by eight register sets");
            for (int c = 0; c < CK_NCH; c += 8) {
                CKB_IVAL(c, L1, L0); CKB_IVAL(c + 1, L2, L1); CKB_IVAL(c + 2, L3, L2); CKB_IVAL(c + 3, L4, L3); CKB_IVAL(c + 4, L5, L4); CKB_IVAL(c + 5, L6, L5); CKB_IVAL(c + 6, L7, L6); CKB_IVAL(c + 7, L0, L7);
            }
            LDS_WAIT(); __builtin_amdgcn_s_barrier();
#undef CKB_LOAD
#undef CKB_PUT
#undef CKB_IVAL
        } else if (f.wave < 2) {
            const int Tn = f.wave;
            const f32x16 zero16 = {0.f, 0.f, 0.f, 0.f, 0.f, 0.f, 0.f, 0.f, 0.f, 0.f, 0.f, 0.f, 0.f, 0.f, 0.f, 0.f};
            f32x16 ST[2] = {zero16, zero16};
            __builtin_amdgcn_s_setprio(3);
            LDS_WAIT(); __builtin_amdgcn_s_barrier();
            int sl = 0;
            for (int c = 0; c < CK_NCH; ++c) {
                const LAS v4u* sp = SL + sl * 24 * 64 + lane; sl = sl == 2 ? 0 : sl + 1;
                LAS v4u* sf = SFB + ((c & 1) * 2 + Tn) * 4 * 64 + lane;
                v4u rm[8], rn[4];
#pragma unroll
                for (int k = 0; k < 8; ++k) rm[k] = sp[64 * k];
#pragma unroll
                for (int k = 0; k < 4; ++k) rn[k] = sp[64 * (8 + 4 * Tn + k)];
                bf16x8_t Sf[2][2];
#pragma unroll
                for (int Ti = 0; Ti < 2; ++Ti) { Sf[Ti][0] = ck_frag(ST[Ti], 0); Sf[Ti][1] = ck_frag(ST[Ti], 1); }
#pragma unroll
                for (int Ti = 0; Ti < 2; ++Ti) { sf[64 * (Ti * 2 + 0)] = __builtin_bit_cast(v4u, Sf[Ti][0]); sf[64 * (Ti * 2 + 1)] = __builtin_bit_cast(v4u, Sf[Ti][1]); }
                asm volatile("s_waitcnt lgkmcnt(0)" : "+v"(rm[0]), "+v"(rm[1]), "+v"(rm[2]), "+v"(rm[3]), "+v"(rm[4]), "+v"(rm[5]), "+v"(rm[6]), "+v"(rm[7]) :: "memory");
                asm volatile("" : "+v"(rn[0]), "+v"(rn[1]), "+v"(rn[2]), "+v"(rn[3]));
#pragma unroll
                for (int To = 0; To < 2; ++To) { f32x16 sn = ck_unpack(rn[To * 2], rn[To * 2 + 1]);
#pragma unroll
                    for (int Ti = 0; Ti < 2; ++Ti)
#pragma unroll
                        for (int s = 0; s < 2; ++s) sn = ck_mm(__builtin_bit_cast(bf16x8_t, rm[(Ti * 2 + To) * 2 + s]), Sf[Ti][s], sn);
                    ST[To] = sn; }
                LDS_WAIT(); __builtin_amdgcn_s_barrier();
            }
            __builtin_amdgcn_s_setprio(0);
            LDS_WAIT(); __builtin_amdgcn_s_barrier();
        } else {
            const int Tn = f.wave - 2, t = lane & 31, h = lane >> 5;
            const unsigned voff = (unsigned)(32 * Tn + 16 * ((t >> 2) & 1) + 4 * (t >> 3) + (t & 3)) + (unsigned)(4 * CW) * (unsigned)(d ? 1 - h : h);
            const float* ysu = WSP(float, WS_YS) + (size_t)d * MALL * CW + hd * 64;
            LDS_WAIT(); __builtin_amdgcn_s_barrier();
            LDS_WAIT(); __builtin_amdgcn_s_barrier();
            int sl = 0;
            for (int c = 0; c < CK_NCH; ++c) {
                const LAS v4u* sp = SL + sl * 24 * 64 + lane; sl = sl == 2 ? 0 : sl + 1;
                const LAS v4u* sf = SFB + ((c & 1) * 2 + Tn) * 4 * 64 + lane;
                v4u rs[4], rp[4], ry[2];
#pragma unroll
                for (int k = 0; k < 4; ++k) rs[k] = sf[64 * k];
#pragma unroll
                for (int k = 0; k < 4; ++k) rp[k] = sp[64 * (16 + k)];
                ry[0] = sp[64 * (20 + 2 * Tn)]; ry[1] = sp[64 * (21 + 2 * Tn)];
                asm volatile("s_waitcnt lgkmcnt(0)" : "+v"(rs[0]), "+v"(rs[1]), "+v"(rs[2]), "+v"(rs[3]), "+v"(rp[0]), "+v"(rp[1]), "+v"(rp[2]), "+v"(rp[3]), "+v"(ry[0]), "+v"(ry[1]) :: "memory");
                f32x16 yv = ck_unpack(ry[0], ry[1]);
#pragma unroll
                for (int k = 0; k < 4; ++k) yv = ck_mm(__builtin_bit_cast(bf16x8_t, rp[k]), __builtin_bit_cast(bf16x8_t, rs[k]), yv);
                { const int st0 = c * CK_C; int seg, pos0;
                  if (st0 < CTXL) { seg = MLAT + b * CTXL; pos0 = d ? (CTXL - 1 - st0) : st0; } else { seg = b * SEQ; pos0 = d ? (SEQ - 1 - (st0 - CTXL)) : (st0 - CTXL); }
                  const int mb = seg + pos0 - (d ? 4 : 0);
#pragma unroll
                  for (int i = 0; i < 16; ++i) { const int ci = (i & 3) + 8 * (i >> 2); const int mi = d ? mb - ci : mb + ci;
                    if (CHECK == 0) ((float*)ysu + (size_t)mi * CW)[voff] = yv[i]; else asm volatile("" :: "v"(yv[i])); } }
                LDS_WAIT(); __builtin_amdgcn_s_barrier();
            }
        }
        __syncthreads();
    }
}
#ifndef NA_BSLOTS
#define NA_BSLOTS 0
#endif
constexpr int GP_LAYER0 = 3, GP_PER_LAYER = 12, GP_FINAL = GP_LAYER0 + GP_PER_LAYER * DEPTH, GP_COUNT = GP_FINAL + 1;
#ifndef MK_ONE_LAUNCH
#define MK_ONE_LAUNCH 1
#endif
__global__ void __launch_bounds__(NWAVES * 64, 2) fwd(Args A) {
    extern __shared__ __attribute__((aligned(16))) unsigned char lds_raw[];
    Frame f;
    f.lds = (LAS unsigned char*)lds_raw;
    f.tid = threadIdx.x; f.lane = f.tid & 63; f.wave = __builtin_amdgcn_readfirstlane(f.tid >> 6);
    f.G = gridDim.x; { const int bx = blockIdx.x; f.vcu = (f.G % 8 == 0) ? (bx % 8) * (f.G / 8) + bx / 8 : bx; }
    f.ws = (GAS unsigned char*)A.ws;
    volatile LAS unsigned* MISC = (volatile LAS unsigned*)(f.lds + MISC_OFF);
    for (int u = f.tid; u < (LDS_BYTES - LDSCTL_OFF) / 4; u += NWAVES * 64) ((LAS unsigned*)(f.lds + LDSCTL_OFF))[u] = 0u;
    __syncthreads();
    unsigned* ctl = (unsigned*)WSP(unsigned, WS_CTL);
    XcdBarrier bar; bar.bar = ctl + CW_BAR; bar.x = 0; bar.st = MISC + 8; bar.wv = f.wave;
    if (A.use_bar) bar = xcd_barrier_post(ctl + CW_BAR, MISC + 8, f.wave);
    const int lo = A.gp_lo, hi = A.gp_hi;
#define IN(k) (lo <= (k) && (k) < hi)
#define BAR_AFTER(k) do { if (IN(k) && hi > (k) + 1) xcd_barrier(bar); } while (0)

    if (IN(0)) { ph_convert(f); ph_lora_weights(f); }
    BAR_AFTER(0);
    if (IN(1)) ph_modsum(f);
    BAR_AFTER(1);
    if (IN(2)) ph_setup2(f);
    BAR_AFTER(2);
    for (int l = 0; l < DEPTH; ++l) {
        const int g0 = GP_LAYER0 + GP_PER_LAYER * l;
        const bool lastl = (l == DEPTH - 1);
        const int mrows = lastl ? MLAT : MALL;
        if (IN(g0 + 0) && l > 0) ph_rs<11>(f, 0, WSP(float, WS_MOD) + (size_t)((l - 1) * 3 + 2) * MODW + 5 * DM, WSP(float, WS_GK) + (size_t)((l * 2 + 0) * 3 + 2) * DM);
        if (l > 0) BAR_AFTER(g0 + 0);
        if (IN(g0 + 1)) {
            launder_ws(f); pg8::Gemm g{WSP(bf16, WS_XN), WSP(bf16, WS_WIN) + (size_t)l * INP * DM, MALL, INP, DM}; pg8::StaticOrder S; S.init(MALL, INP, f.G, (int)blockIdx.x);
            EpiScaleBias E{WSP(bf16, WS_Y1), INP, WSP(float, WS_RS), WSP(float, WS_BIAS1) + (size_t)l * 3 * INP, INP};
            pg8::gemm_phase<EpiScaleBias, pg8::StaticOrder, true, true>(f.lds, g, S, E, f.wave);
        }
        BAR_AFTER(g0 + 1);
        if (IN(g0 + 2)) { ph_prep(f, l); ph_vat(f); ph_lora2(f, l); }
        BAR_AFTER(g0 + 2);
#if defined(SEQ_SCAN)
        if (IN(g0 + 3)) { for (int s_ = f.vcu; s_ < 1024; s_ += f.G) ph_na(f, l, s_, 1); if (!lastl) ph_ctxattn(f, 0); }
        if (IN(g0 + 4)) { launder_ws(f);
            const attn_body::AttnTensors AT{(const attn_body::bf16*)WSP(bf16, WS_QBP), (const attn_body::bf16*)WSP(bf16, WS_KBP), (const attn_body::bf16*)WSP(bf16, WS_VBP), (attn_body::bf16*)WSP(bf16, WS_OB)};
            attn_body::attn_phase<8>((char*)lds_raw, AT, f.vcu, f.G, f.wave);
        }
        if (IN(g0 + 5)) ph_scan2(f, l);
#if defined(CHUNK_CHECK)
        if (IN(g0 + 5)) { xcd_barrier(bar); ph_scanA<0>(f, l); xcd_barrier(bar); ph_scanB<1>(f, l, 0, f.G); }
#endif
#else
        if (IN(g0 + 3)) { ph_scanA<0>(f, l);
#if defined(PROBE_A2)
            ph_scanA<PROBE_A2 - 1>(f, l);
#endif
        }
        BAR_AFTER(g0 + 3);
        if (IN(g0 + 4)) {
            if (f.G == 256) {
                if (f.vcu < 64) { ph_scanB<0>(f, l, 0, f.G);
#if defined(PROBE_B2)
                    ph_scanB<PROBE_B2 - 1>(f, l, 0, f.G);
#endif
                    ph_na(f, l, 960 + f.vcu, NA_BSLOTS);
                } else if (NA_BSLOTS) ph_na(f, l, 5 * (f.vcu - 64), 5); else if (f.vcu < 128) ph_na(f, l, 6 * (f.vcu - 64), 6); else ph_na(f, l, 384 + 5 * (f.vcu - 128), 5); }
            else { ph_scanB<0>(f, l, 0, f.G); for (int s_ = f.vcu; s_ < 1024; s_ += f.G) ph_na(f, l, s_, 1); }
            if (!lastl) ph_ctxattn(f, 128);
        }
        if (IN(g0 + 5)) { __syncthreads(); launder_ws(f);
            const attn_body::AttnTensors AT{(const attn_body::bf16*)WSP(bf16, WS_QBP), (const attn_body::bf16*)WSP(bf16, WS_KBP), (const attn_body::bf16*)WSP(bf16, WS_VBP), (attn_body::bf16*)WSP(bf16, WS_OB)};
            attn_body::attn_phase<8>((char*)lds_raw, AT, f.vcu, f.G, f.wave);
        }
#endif
        BAR_AFTER(g0 + 5);
        if (IN(g0 + 6)) ph_mix(f, l, mrows);
        BAR_AFTER(g0 + 6);
        if (IN(g0 + 7)) {
            launder_ws(f); pg8::Gemm g{WSP(bf16, WS_MIX), WSP(bf16, WS_WOUT) + (size_t)l * DM * DM, MLAT, DM, DM}; pg8::StaticOrder S; S.init(MLAT, DM, f.G, (int)blockIdx.x);
            EpiResGateNorm E{WSP(float, WS_H), WSP(float, WS_MOD) + (size_t)l * 3 * MODW + 2 * DM, WSP(float, WS_GK) + (size_t)(l * 2 + 1) * 3 * DM, WSP(bf16, WS_XN), WSP(float, WS_SSP) + (size_t)MALL * 32};
            pg8::gemm_phase<EpiResGateNorm, pg8::StaticOrder, true, true>(f.lds, g, S, E, f.wave);
            if (!lastl) { pg8::Gemm g2{WSP(bf16, WS_MIX), WSP(bf16, WS_WOUT) + (size_t)l * DM * DM, MALL, DM, 256, DM}; CtxSplitOrder S2{f.G, (int)blockIdx.x, 8, 256}; EpiPartial E2{WSP(float, WS_PART), 256};
                pg8::gemm_phase<EpiPartial, CtxSplitOrder, true, true>(f.lds, g2, S2, E2, f.wave); }
        }
        BAR_AFTER(g0 + 7);
        if (IN(g0 + 8)) { const float* gate_ = WSP(float, WS_MOD) + (size_t)(l * 3 + 2) * MODW + 2 * DM; const float* gk_ = WSP(float, WS_GK) + (size_t)((l * 2 + 1) * 3 + 2) * DM;
            if (lastl) ph_rs<0>(f, 1, gate_, gk_); else ph_rs<8>(f, 1, gate_, gk_); }
        BAR_AFTER(g0 + 8);
        if (IN(g0 + 9)) {
            launder_ws(f); pg8::Gemm g{WSP(bf16, WS_XN), WSP(bf16, WS_WUP) + (size_t)l * UPN * DM, mrows, UPN, DM}; pg8::StaticOrder S; S.init(mrows, UPN, f.G, (int)blockIdx.x);
            const float* cw_ = karg_in(I_CONVW) + (size_t)l * 3 * DFF; const float* cb_ = karg_in(I_CONVB) + (size_t)l * DFF;
            EpiConvGlu E{WSP(bf16, WS_HB), WSP(bf16, WS_U), WSP(float, WS_RS) + MALL, WSP(float, WS_BIAS3) + (size_t)l * 3 * UPN, cw_, cb_};
            pg8::gemm_phase<EpiConvGlu, pg8::StaticOrder, true, true>(f.lds, g, S, E, f.wave);
        }
        BAR_AFTER(g0 + 9);
        if (IN(g0 + 10)) ph_convfix(f, l, mrows);
        BAR_AFTER(g0 + 10);
        if (IN(g0 + 11)) {
            launder_ws(f); pg8::Gemm g{WSP(bf16, WS_HB), WSP(bf16, WS_WDN) + (size_t)l * DM * DFF, MLAT, DM, DFF}; pg8::StaticOrder S; S.init(MLAT, DM, f.G, (int)blockIdx.x);
            EpiResGateNorm E{WSP(float, WS_H), WSP(float, WS_MOD) + (size_t)l * 3 * MODW + 5 * DM, lastl ? (const float*)nullptr : (const float*)(WSP(float, WS_GK) + (size_t)((l + 1) * 2 + 0) * 3 * DM), WSP(bf16, WS_XN), WSP(float, WS_SSP)};
            pg8::gemm_phase<EpiResGateNorm, pg8::StaticOrder, true, true>(f.lds, g, S, E, f.wave);
            if (!lastl) { pg8::Gemm g2{WSP(bf16, WS_HB), WSP(bf16, WS_WDN) + (size_t)l * DM * DFF, MALL, DM, 512, DFF}; CtxSplitOrder S2{f.G, (int)blockIdx.x, 11, 512}; EpiPartial E2{WSP(float, WS_PART), 512};
                pg8::gemm_phase<EpiPartial, CtxSplitOrder, true, true>(f.lds, g2, S2, E2, f.wave); }
        }
        BAR_AFTER(g0 + 11);
    }
    if (IN(GP_FINAL)) ph_final(f);
#if defined(CK_READOUT)
    if (IN(GP_FINAL)) { xcd_barrier(bar);
        if (blockIdx.x == 0 && f.tid == 0) { const float* cw_ = (const float*)(f.ws + WS_CTL) + 8192; const float e_ = __hip_atomic_load(cw_, __ATOMIC_RELAXED, __HIP_MEMORY_SCOPE_AGENT), r_ = __hip_atomic_load(cw_ + 1, __ATOMIC_RELAXED, __HIP_MEMORY_SCOPE_AGENT);
            const float m_ = __builtin_bit_cast(float, __hip_atomic_load((const unsigned*)cw_ + 2, __ATOMIC_RELAXED, __HIP_MEMORY_SCOPE_AGENT));
            float v_ = (CK_READOUT == 1) ? sqrtf(e_ / r_) : m_;
            if (CK_READOUT == 1 && v_ == v_ && v_ > 0.f) v_ = exp2f(rintf(log2f(v_) * 8.0f) * 0.125f);
            float* o_ = (float*)karg_in(33); o_[0] = (v_ == v_) ? fminf(v_ * 1.0e6f, 1.0e9f) : 4.0e9f; } }
#elif defined(CHUNK_CHECK)
    if (IN(GP_FINAL)) { const float* cw_ = (const float*)(f.ws + WS_CTL) + 8192; const float e_ = __hip_atomic_load(cw_, __ATOMIC_RELAXED, __HIP_MEMORY_SCOPE_AGENT), r_ = __hip_atomic_load(cw_ + 1, __ATOMIC_RELAXED, __HIP_MEMORY_SCOPE_AGENT);
        if (!(e_ <= CHUNK_CHECK * r_)) { __syncthreads(); float* o_ = (float*)karg_in(33); for (int i = f.vcu * 512 + f.tid; i < MLAT * DM; i += f.G * 512) o_[i] = __builtin_nanf(""); } }
#endif
#undef IN
#undef BAR_AFTER
}

extern "C" void kernel_launch(void* const* d_in, const int* in_sizes, int n_in, void* d_out, int out_size, void* d_ws, size_t ws_size, hipStream_t stream) {
    static int grid = 0;
    if (grid == 0) {
        if (n_in != 33 || in_sizes[0] != MLAT * DM || out_size != MLAT * DM || ws_size < WS_END) {
            fprintf(stderr, "kernel_launch: unexpected shapes (n_in %d, in0 %d, out %d, ws %zu); nothing launched\n", n_in, n_in > 0 ? in_sizes[0] : -1, out_size, ws_size); grid = -1; return; }
        int dev = 0, cus = 0;
        if (hipGetDevice(&dev) != hipSuccess || hipDeviceGetAttribute(&cus, hipDeviceAttributeMultiprocessorCount, dev) != hipSuccess) { grid = -1; return; }
        if (hipFuncSetAttribute((const void*)fwd, hipFuncAttributeMaxDynamicSharedMemorySize, LDS_BYTES) != hipSuccess) { fprintf(stderr, "kernel_launch: hipFuncSetAttribute failed\n"); grid = -1; return; }
        (void)hipGetLastError();
        grid = cus;
    }
    if (grid < 0) return;
    if (hipMemsetAsync((char*)d_ws + WS_CTL, 0, CTL_ZERO_BYTES, stream) != hipSuccess) return;
    Args a{};
    for (int i = 0; i < 33; ++i) a.in[i] = (const float*)d_in[i];
    a.out = (float*)d_out; a.ws = (unsigned char*)d_ws; a.pad = 0;
#if MK_ONE_LAUNCH
    a.gp_lo = 0; a.gp_hi = GP_COUNT; a.use_bar = 1;
    hipLaunchKernelGGL(fwd, dim3(grid), dim3(NWAVES * 64), LDS_BYTES, stream, a);
#else
    for (int gp = 0; gp < GP_COUNT; ++gp) {
        a.gp_lo = gp; a.gp_hi = gp + 1; a.use_bar = 0;
        hipLaunchKernelGGL(fwd, dim3(grid), dim3(NWAVES * 64), LDS_BYTES, stream, a);
    }
#endif
}
```

```cpp
#include <hip/hip_runtime.h>
#include <hip/hip_bf16.h>
#include <cstdio>
#include <cstdint>
#include <cmath>
namespace pg8 {
#define PG8_LAS __attribute__((address_space(3)))
typedef unsigned short bf16_t;
typedef short bf16x8 __attribute__((ext_vector_type(8)));
typedef float f32x4 __attribute__((ext_vector_type(4)));
typedef unsigned u32x4 __attribute__((ext_vector_type(4)));
constexpr int BM = 256, BK = 64, HALF = 128, HTB = HALF * BK * 2  , STAGE_BYTES = 8 * HTB, NXCD = 8, WGM = 8;

__host__ __device__ __forceinline__ int lds_byte(int r, int c) { const int st = (r >> 4) * 2 + (c >> 5), rr = r & 15, cc = c & 31, ob = rr * 64 + cc * 2; return st * 1024 + (ob ^ (((ob >> 9) & 1) << 5)); }
__host__ __device__ __forceinline__ void stage_rc(int b, int& R, int& C) { const int st = b / 1024, sb = b % 1024, swz = sb ^ (((sb >> 9) & 1) << 5); R = (st >> 1) * 16 + swz / 64; C = (st & 1) * 32 + (swz % 64) / 2; }
__host__ __device__ __forceinline__ int perm32(int rho) { const int n = rho >> 4, i = rho & 15; return 8 * (i >> 2) + 4 * n + (i & 3); }

struct Unit { int pm, pn, kb; };
struct Gemm { const bf16_t* A; const bf16_t* Bt; int M, N, K; int ld = 0; };

struct StaticOrder {
    int nM, nN, nwg, G, c;
    __host__ __device__ void init(int M, int N, int G_, int c_) { nM = M / BM; nN = N / BM; nwg = nM * nN; G = G_; c = c_; }
    __host__ __device__ bool next(int i, Unit& u) const {
        const long L = (long)i * G + c; if (L >= nwg) return false;
        int wgid = (int)L; { const int q = nwg / NXCD, r = nwg % NXCD, xcd = wgid % NXCD, off = wgid / NXCD; wgid = (xcd < r ? xcd * (q + 1) : r * (q + 1) + (xcd - r) * q) + off; }
        const int nig = WGM * nN, gid = wgid / nig, fm = gid * WGM, gsz = (nM - fm) < WGM ? (nM - fm) : WGM;
        u.pm = fm + ((wgid % nig) % gsz); u.pn = (wgid % nig) / gsz; u.kb = 0; return true;
    }
    __device__ __forceinline__ void a_ready(const Unit&) const {}
    __device__ __forceinline__ void done(const Unit&) const {}
};

__device__ __forceinline__ unsigned cvt_pk_bf16(float lo, float hi) { unsigned r; asm volatile("v_cvt_pk_bf16_f32 %0, %1, %2" : "=v"(r) : "v"(lo), "v"(hi)); return r; }
typedef float f32x2 __attribute__((ext_vector_type(2)));
__device__ __forceinline__ f32x2 gelu_pk(f32x2 v) {
    const f32x2 av = __builtin_elementwise_abs(v), d = av * 0.2316418882f + 1.0f;
    f32x2 t; t.x = __builtin_amdgcn_rcpf(d.x); t.y = __builtin_amdgcn_rcpf(d.y);
    f32x2 q = t * 0.5307027145f + (-0.7265760135f); q = q * t + 0.7107068705f; q = q * t + (-0.142248368f); q = q * t + 0.127414796f; q = q * t;
    const f32x2 s = (v * v) * (-0.72134752044f);
    f32x2 e; e.x = __builtin_amdgcn_exp2f(s.x); e.y = __builtin_amdgcn_exp2f(s.y);
    const f32x2 m = v * (q * e), r = v - m;
    f32x2 o; o.x = v.x < 0.f ? m.x : r.x; o.y = v.y < 0.f ? m.y : r.y; return o;
}

template <int ACT  > struct EpiBf16 {
    static constexpr bool PERM = true, AFTER_DRAIN = false; static_assert(ACT == 0 || ACT == 1, "EpiBf16: ACT is 0 (none) or 1 (gelu_pk)");
    bf16_t* O; int ldc; const float* bias; int split_cols; size_t split_stride; float scale0;
    __device__ __forceinline__ void operator()(const f32x4 (&acc)[2][2][4][2], const Unit& u, int wr, int wc, int fr, int fq) const {
        const int row0 = u.pm * BM + wr * 64 + fr; int colt = u.pn * BM; bf16_t* base = O;
        float sc = 1.f; if (split_cols) { const int t = colt / split_cols; base += (size_t)t * split_stride; colt -= t * split_cols; if (t == 0) sc = scale0; }
        const int col0 = colt + wc * 32 + 8 * fq, bcol0 = u.pn * BM + wc * 32 + 8 * fq;
        f32x4 bv[2][2];
#pragma unroll
        for (int bj = 0; bj < 2; ++bj)
#pragma unroll
            for (int n = 0; n < 2; ++n) bv[bj][n] = bias ? *(const f32x4*)(bias + bcol0 + bj * HALF + 4 * n) : (f32x4){0.f, 0.f, 0.f, 0.f};
#pragma unroll
        for (int ai = 0; ai < 2; ++ai)
#pragma unroll
            for (int m = 0; m < 4; ++m) { bf16_t* rowp = base + (size_t)(row0 + ai * HALF + m * 16) * ldc + col0;
#pragma unroll
                for (int bj = 0; bj < 2; ++bj) { f32x4 v0 = acc[ai][bj][m][0] + bv[bj][0], v1 = acc[ai][bj][m][1] + bv[bj][1];
                    if (ACT == 1) { f32x2 a = gelu_pk((f32x2){v0[0], v0[1]}), b = gelu_pk((f32x2){v0[2], v0[3]}), c = gelu_pk((f32x2){v1[0], v1[1]}), d = gelu_pk((f32x2){v1[2], v1[3]});
                        v0 = (f32x4){a.x, a.y, b.x, b.y}; v1 = (f32x4){c.x, c.y, d.x, d.y}; }
                    v0 = v0 * sc; v1 = v1 * sc; u32x4 w; w.x = cvt_pk_bf16(v0[0], v0[1]); w.y = cvt_pk_bf16(v0[2], v0[3]); w.z = cvt_pk_bf16(v1[0], v1[1]); w.w = cvt_pk_bf16(v1[2], v1[3]);
                    *(u32x4*)(rowp + bj * HALF) = w; } }
    }
};
template <class Epi, class Sched, bool ALIGN_EPI = false, bool SP2 = false>
__device__ __forceinline__ void gemm_phase(PG8_LAS unsigned char* lds, const Gemm g, const Sched& S, const Epi& E, int wave_in) {
    int ln_; asm volatile("v_mbcnt_lo_u32_b32 %0, -1, 0\n\tv_mbcnt_hi_u32_b32 %0, -1, %0" : "=v"(ln_)); asm volatile("" : "+s"(wave_in)); int tid_ = wave_in * 64 + ln_;
    const int tid = tid_, wid = __builtin_amdgcn_readfirstlane(tid >> 6), lane = tid & 63, wr = wid >> 2, wc = wid & 3, fr = lane & 15, fq = lane >> 4;
    const int K = g.ld ? g.ld : g.K, nt = g.K / BK;
    unsigned voffA[2], voffB[2];
#pragma unroll
    for (int i = 0; i < 2; ++i) { int R, C; stage_rc(tid * 16 + i * 8192, R, C); const int Rb = Epi::PERM ? ((R & ~31) + perm32(R & 31)) : R;
        voffA[i] = (unsigned)(R * K + C) * 2u; voffB[i] = (unsigned)(Rb * K + C) * 2u; }
    const size_t kstep = (size_t)(BK * 2);
    const size_t hstep = (size_t)HALF * K * 2;
    const size_t tstep = 2 * hstep;
    const unsigned ldsw = (unsigned)wid * 1024u;
    const int aoff = lds_byte(wr * 64 + fr, fq * 8), boff = lds_byte(wc * 32 + fr, fq * 8);
#define PG8_SA(b, h) (((b) * 2 + (h)) * HTB)
#define PG8_SB(b, h) ((4 + (b) * 2 + (h)) * HTB)
#define PG8_STAGE(bufoff, gbase, voff) do { _Pragma("unroll") for (int _i = 0; _i < 2; ++_i) \
        __builtin_amdgcn_global_load_lds((const unsigned*)((const char*)(gbase) + (voff)[_i]), (PG8_LAS unsigned*)(lds + (bufoff) + ldsw + _i * 8192), 16, 0, 0); } while (0)
#define PG8_LDA(dst, b, h) do { _Pragma("unroll") for (int m = 0; m < 4; ++m) _Pragma("unroll") for (int k = 0; k < 2; ++k) dst[m][k] = *(const PG8_LAS bf16x8*)(lds + PG8_SA(b, h) + aoff + m * 2048 + k * 1024); } while (0)
#define PG8_LDB(dst, b, h) do { _Pragma("unroll") for (int n = 0; n < 2; ++n) _Pragma("unroll") for (int k = 0; k < 2; ++k) dst[n][k] = *(const PG8_LAS bf16x8*)(lds + PG8_SB(b, h) + boff + n * 2048 + k * 1024); } while (0)
#define PG8_MMA(ai, bj, At, Bt) do { __builtin_amdgcn_s_setprio(1); _Pragma("unroll") for (int m = 0; m < 4; ++m) _Pragma("unroll") for (int n = 0; n < 2; ++n) _Pragma("unroll") for (int k = 0; k < 2; ++k) \
        acc[ai][bj][m][n] = __builtin_amdgcn_mfma_f32_16x16x32_bf16(Bt[n][k], At[m][k], acc[ai][bj][m][n], 0, 0, 0); __builtin_amdgcn_s_setprio(0); } while (0)
#define PG8_WAIT_V(n) asm volatile("s_waitcnt vmcnt(" #n ")" ::: "memory")
#define PG8_WAIT_L(n) asm volatile("s_waitcnt lgkmcnt(" #n ")" ::: "memory")
#define PG8_BAR __builtin_amdgcn_s_barrier()
#define PG8_SCHED __builtin_amdgcn_sched_barrier(0)
    Unit cur, nxt; int ui = 0;
    if (!S.next(0, cur)) return;
    f32x4 acc[2][2][4][2];
#pragma unroll
    for (int a = 0; a < 2; ++a)
#pragma unroll
        for (int b = 0; b < 2; ++b)
#pragma unroll
            for (int m = 0; m < 4; ++m)
#pragma unroll
                for (int n = 0; n < 2; ++n) acc[a][b][m][n] = (f32x4){0.f, 0.f, 0.f, 0.f};
    bf16x8 At[4][2], B0[2][2], B1[2][2];
    const char* cA = (const char*)g.A + (size_t)cur.pm * tstep + (size_t)cur.kb * 2; const char* cB = (const char*)g.Bt + (size_t)cur.pn * tstep + (size_t)cur.kb * 2;
    S.a_ready(cur);
    if constexpr (SP2) {
        PG8_STAGE(PG8_SB(0, 0), cB, voffB); PG8_STAGE(PG8_SB(0, 1), cB + hstep, voffB); PG8_STAGE(PG8_SA(0, 0), cA, voffA); PG8_STAGE(PG8_SA(0, 1), cA + hstep, voffA);
        if (wr == 1) PG8_BAR;
        PG8_WAIT_V(2); PG8_BAR;
        PG8_STAGE(PG8_SB(1, 0), cB + kstep, voffB); PG8_STAGE(PG8_SA(1, 0), cA + kstep, voffA); PG8_STAGE(PG8_SB(1, 1), cB + hstep + kstep, voffB);
        PG8_WAIT_V(6); PG8_BAR;
    } else {
        PG8_STAGE(PG8_SB(0, 0), cB, voffB); PG8_STAGE(PG8_SA(0, 0), cA, voffA); PG8_STAGE(PG8_SB(0, 1), cB + hstep, voffB); PG8_STAGE(PG8_SA(0, 1), cA + hstep, voffA);
        if (wr == 1) PG8_BAR;
        PG8_WAIT_V(4); PG8_BAR;
        PG8_STAGE(PG8_SB(1, 0), cB + kstep, voffB); PG8_STAGE(PG8_SA(1, 0), cA + kstep, voffA); PG8_STAGE(PG8_SB(1, 1), cB + hstep + kstep, voffB);
        PG8_WAIT_V(6); PG8_BAR;
    }
    for (;;) {
        const bool has_next = S.next(ui + 1, nxt);
        const char* nA = has_next ? (const char*)g.A + (size_t)nxt.pm * tstep + (size_t)nxt.kb * 2 : cA; const char* nB = has_next ? (const char*)g.Bt + (size_t)nxt.pn * tstep + (size_t)nxt.kb * 2 : cB;
        for (int t = 0; t < nt; t += 2) {
            const bool last = (t == nt - 2);
            const char* a1 = cA + (size_t)(t + 1) * kstep;
            const char* a2 = last ? nA : cA + (size_t)(t + 2) * kstep; const char* b2 = last ? nB : cB + (size_t)(t + 2) * kstep;
            const char* a3 = a2 + kstep; const char* b3 = b2 + kstep;
            if (last && has_next) S.a_ready(nxt);
            if constexpr (SP2) {
            PG8_LDB(B0, 0, 0); PG8_LDB(B1, 0, 1); PG8_SCHED; PG8_LDA(At, 0, 0); PG8_STAGE(PG8_SA(1, 1), a1 + hstep, voffA);
            PG8_WAIT_V(8); PG8_WAIT_L(0); PG8_BAR; PG8_MMA(0, 0, At, B0); PG8_MMA(0, 1, At, B1); PG8_BAR; PG8_SCHED;
            PG8_LDA(At, 0, 1); PG8_STAGE(PG8_SB(0, 0), b2, voffB); PG8_STAGE(PG8_SB(0, 1), b2 + hstep, voffB); PG8_STAGE(PG8_SA(0, 0), a2, voffA);
            PG8_WAIT_V(8); PG8_WAIT_L(0); PG8_BAR; PG8_MMA(1, 0, At, B0); PG8_MMA(1, 1, At, B1); PG8_BAR; PG8_SCHED;
            PG8_LDB(B0, 1, 0); PG8_LDB(B1, 1, 1); PG8_SCHED; PG8_LDA(At, 1, 0); PG8_STAGE(PG8_SA(0, 1), a2 + hstep, voffA);
            PG8_WAIT_V(8); PG8_WAIT_L(0); PG8_BAR; PG8_MMA(0, 0, At, B0); PG8_MMA(0, 1, At, B1); PG8_BAR; PG8_SCHED;
            PG8_LDA(At, 1, 1); PG8_STAGE(PG8_SB(1, 0), b3, voffB); PG8_STAGE(PG8_SB(1, 1), b3 + hstep, voffB); PG8_STAGE(PG8_SA(1, 0), a3, voffA);
            PG8_WAIT_V(8); PG8_WAIT_L(0); PG8_BAR; PG8_MMA(1, 0, At, B0); PG8_MMA(1, 1, At, B1); PG8_BAR; PG8_SCHED;
            } else {
            PG8_LDB(B0, 0, 0); PG8_SCHED; PG8_LDA(At, 0, 0); PG8_STAGE(PG8_SA(1, 1), a1 + hstep, voffA);
            PG8_WAIT_L(8); PG8_BAR; PG8_WAIT_L(0); PG8_MMA(0, 0, At, B0); PG8_BAR; PG8_SCHED;
            PG8_LDB(B1, 0, 1); PG8_STAGE(PG8_SB(0, 0), b2, voffB);
            PG8_BAR; PG8_WAIT_L(0); PG8_MMA(0, 1, At, B1); PG8_BAR;
            PG8_LDA(At, 0, 1); PG8_STAGE(PG8_SA(0, 0), a2, voffA);
            PG8_BAR; PG8_WAIT_L(0); PG8_MMA(1, 0, At, B0); PG8_BAR; PG8_SCHED;
            PG8_STAGE(PG8_SB(0, 1), b2 + hstep, voffB);
            PG8_WAIT_V(6); PG8_BAR; PG8_MMA(1, 1, At, B1); PG8_BAR;
            PG8_LDB(B0, 1, 0); PG8_SCHED; PG8_LDA(At, 1, 0); PG8_STAGE(PG8_SA(0, 1), a2 + hstep, voffA);
            PG8_WAIT_L(8); PG8_BAR; PG8_WAIT_L(0); PG8_MMA(0, 0, At, B0); PG8_BAR; PG8_SCHED;
            PG8_LDB(B1, 1, 1); PG8_STAGE(PG8_SB(1, 0), b3, voffB);
            PG8_BAR; PG8_WAIT_L(0); PG8_MMA(0, 1, At, B1); PG8_BAR;
            PG8_LDA(At, 1, 1); PG8_STAGE(PG8_SA(1, 0), a3, voffA);
            PG8_BAR; PG8_WAIT_L(0); PG8_MMA(1, 0, At, B0); PG8_BAR; PG8_SCHED;
            PG8_STAGE(PG8_SB(1, 1), b3 + hstep, voffB);
            PG8_WAIT_V(6); PG8_BAR; PG8_MMA(1, 1, At, B1); PG8_BAR;
            }
        }
        if constexpr (ALIGN_EPI) { if (wr == 0) PG8_BAR; }
        if constexpr (!Epi::AFTER_DRAIN) { E(acc, cur, wr, wc, fr, fq); S.done(cur); }
        if (!has_next) break;
#pragma unroll
        for (int a = 0; a < 2; ++a)
#pragma unroll
            for (int b = 0; b < 2; ++b)
#pragma unroll
                for (int m = 0; m < 4; ++m)
#pragma unroll
                    for (int n = 0; n < 2; ++n) acc[a][b][m][n] = (f32x4){0.f, 0.f, 0.f, 0.f};
        cur = nxt; cA = nA; cB = nB; ++ui;
        if constexpr (ALIGN_EPI) { if (wr == 1) PG8_BAR; }
    }
    PG8_WAIT_V(0);
    if constexpr (!ALIGN_EPI) { if (wr == 0) PG8_BAR; }
    PG8_BAR;
    if constexpr (Epi::AFTER_DRAIN) { E.fused(acc, cur, wr, wc, fr, fq, lds, wid, lane); S.done(cur); }
#undef PG8_SA
#undef PG8_SB
#undef PG8_STAGE
#undef PG8_LDA
#undef PG8_LDB
#undef PG8_MMA
#undef PG8_WAIT_V
#undef PG8_WAIT_L
#undef PG8_BAR
#undef PG8_SCHED
}
}

constexpr int NWAVES = 8;
constexpr int DM = 2048, NB = 2, SEQ = 8192, DEPTH = 4, GRIDW = 64, CTXL = 256, HD = 64;
constexpr int MLAT = NB * SEQ, MCTX = NB * CTXL, MALL = MLAT + MCTX;
constexpr int INC = 5792, INP = 5888;
constexpr int C_QA = 0, C_KA = 512, C_VA = 1024, C_QB = 1536, C_KB = 2048, C_VB = 2176, C_R = 2304, C_K = 3328, C_V = 4352, C_WD = 5376, C_AD = 5504, C_GD = 5632;
constexpr int CW = 1024;
constexpr int DFF = 5632, UPN = 2 * DFF;
constexpr int SKV = CTXL + SEQ;
constexpr int MODW = 6 * DM;
constexpr float LOG2E = 1.4426950408889634f;
constexpr float QSCALE = 0.125f * LOG2E;

constexpr size_t MiB = 1u << 20;
constexpr size_t WS_CTL = 0, CTL_ZERO_BYTES = 1 * MiB;
constexpr size_t WS_MOD = 1 * MiB;
constexpr size_t WS_MODP = 2 * MiB;
constexpr size_t WS_WIN = 12 * MiB;
constexpr size_t WS_WOUT = 104 * MiB;
constexpr size_t WS_WUP = 136 * MiB;
constexpr size_t WS_WDN = 312 * MiB;
constexpr size_t WS_H = 400 * MiB;
constexpr size_t WS_XN = 1111 * MiB;
constexpr size_t WS_Y1 = 532 * MiB;
constexpr size_t WS_QBP = 722 * MiB;
constexpr size_t WS_KBP = 739 * MiB;
constexpr size_t WS_VBP = 744 * MiB;
constexpr size_t WS_OA = 749 * MiB;
constexpr size_t WS_OB = 766 * MiB;
constexpr size_t WS_WDEC = 783 * MiB;
constexpr size_t WS_AIC = 849 * MiB;
constexpr size_t WS_G = 915 * MiB;
constexpr size_t WS_YS = 948 * MiB;
constexpr size_t WS_MIX = 1177 * MiB;
constexpr size_t WS_U = 532 * MiB;
constexpr size_t WS_HB = 895 * MiB;
constexpr size_t WS_VAT = 1080 * MiB;
constexpr size_t WS_LW = 1097 * MiB;
constexpr size_t WS_OC = 1243 * MiB;
constexpr size_t WS_GK = 1101 * MiB;
constexpr size_t WS_BIAS1 = 1102 * MiB;
constexpr size_t WS_BIAS3 = 1103 * MiB;
constexpr size_t WS_SS = 256 * 1024;
constexpr size_t WS_SSP = 1104 * MiB;
constexpr size_t WS_RS = 1109 * MiB;
constexpr size_t WS_PART = 1309 * MiB;
constexpr size_t WS_VBT = 1110 * MiB;
constexpr size_t WS_CK = 1111 * MiB;
constexpr size_t WS_CKS = 1498 * MiB;
constexpr size_t WS_END = 1530 * MiB;
static_assert(WS_U + (size_t)MALL * UPN * 2 <= WS_HB && WS_HB + (size_t)MALL * DFF * 2 <= WS_VAT, "overlay map");
constexpr int CW_BAR = 4096;
static_assert(WS_SS + (size_t)DEPTH * 2 * MALL * 4 <= CTL_ZERO_BYTES && (size_t)(CW_BAR + 3456) * 4 <= WS_SS, "control-region map");

constexpr int RING_BYTES = 131072;
constexpr int LDSCTL_OFF = RING_BYTES, MISC_OFF = LDSCTL_OFF + 320;
constexpr int LDS_BYTES = 147456;

#define GAS __attribute__((address_space(1)))
#define LAS __attribute__((address_space(3)))
typedef unsigned short bf16;
typedef unsigned v4u __attribute__((ext_vector_type(4)));
typedef unsigned v2u __attribute__((ext_vector_type(2)));
typedef float f32x4 __attribute__((ext_vector_type(4)));
typedef GAS unsigned gu32;
#define RLX_AGENT __ATOMIC_RELAXED, __HIP_MEMORY_SCOPE_AGENT
#define LDS_WAIT() asm volatile("s_waitcnt lgkmcnt(0)" ::: "memory")
#define VM_WAIT() asm volatile("s_waitcnt vmcnt(0)" ::: "memory")
__device__ __forceinline__ unsigned f2bf(float f) { unsigned u = __builtin_bit_cast(unsigned, f); return (u + 0x7fffu + ((u >> 16) & 1u)) >> 16; }
__device__ __forceinline__ unsigned pk2(float lo, float hi) { return f2bf(lo) | (f2bf(hi) << 16); }
__device__ __forceinline__ float bf2f(bf16 u) { return __uint_as_float((unsigned)u << 16); }
__device__ __forceinline__ float bflo(unsigned w) { return __uint_as_float(w << 16); }
__device__ __forceinline__ float bfhi(unsigned w) { return __uint_as_float(w & 0xffff0000u); }
template <int CTRL> __device__ __forceinline__ float dpp_f(float v) { return __builtin_bit_cast(float, __builtin_amdgcn_update_dpp(0, __builtin_bit_cast(int, v), CTRL, 0xF, 0xF, true)); }
__device__ __forceinline__ float sum16(float v) { v += dpp_f<0xB1>(v); v += dpp_f<0x4E>(v); v += dpp_f<0x141>(v); v += dpp_f<0x140>(v); return v; }
__device__ __forceinline__ float sum64(float v) { v = sum16(v); const int b = __builtin_bit_cast(int, v);
    return (__builtin_bit_cast(float, __builtin_amdgcn_readlane(b, 0)) + __builtin_bit_cast(float, __builtin_amdgcn_readlane(b, 16))) + (__builtin_bit_cast(float, __builtin_amdgcn_readlane(b, 32)) + __builtin_bit_cast(float, __builtin_amdgcn_readlane(b, 48))); }
__device__ __forceinline__ float wave_sum(float v) { return sum64(v); }
typedef float f32x2 __attribute__((ext_vector_type(2)));
__device__ __forceinline__ float sigmoidf_(float x) { return 1.f / (1.f + __expf(-x)); }

namespace attn_body {
using bf16=__hip_bfloat16;
using bf16x8=__attribute__((ext_vector_type(8)))short;
using s16x4=__attribute__((ext_vector_type(4)))short;
using f32x16=__attribute__((ext_vector_type(16)))float;
using u32x4=__attribute__((ext_vector_type(4)))unsigned;
constexpr int D=64,QP=512,KP=128,OP=512,SEQQ=8192,SEQK=8448;
constexpr int NW=8,QBLK=32,QB=QBLK*NW,KVBLK=64,NQB=SEQQ/QB;
constexpr int ATTN_UNIT_ROWS=QB;
__device__ __forceinline__ int crow(int r,int hi){return (r&3)+8*(r>>2)+4*hi;}
#define SBAR() __builtin_amdgcn_sched_barrier(0)
__device__ __forceinline__ void cmask(f32x16&p0,f32x16&p1,int jb,int qrel,int hi){
  const float NEG=-INFINITY; int kb=64*jb+4*hi;
  #pragma unroll
  for(int r=0;r<16;++r){int kv=kb+(r&3)+8*(r>>2); if(kv>qrel)p0[r]=NEG; if(kv+32>qrel)p1[r]=NEG;}
}

constexpr int NSLOT=3, SLOTB=8192;
constexpr int LDS_K=0, LDS_V=NSLOT*SLOTB, LDS_WS=2*NSLOT*SLOTB, LDS_OST=LDS_WS+NW*64*4, LDS_BYTES=LDS_OST+NW*4096;
constexpr float C2=0.125f*1.4426950408889634f;
__device__ __forceinline__ void glds16(const void*gsrc,unsigned lds_dst){unsigned keep;
  asm volatile("s_mov_b32 %0, m0\n\ts_mov_b32 m0, %2\n\ts_nop 0\n\tglobal_load_lds_dwordx4 %1, off\n\ts_mov_b32 m0, %0":"=&s"(keep):"v"(gsrc),"s"(lds_dst):"memory");}
__device__ __forceinline__ float max3f(float a,float b,float c){float r;asm("v_max3_f32 %0, %1, %2, %3":"=v"(r):"v"(a),"v"(b),"v"(c));return r;}
__device__ __forceinline__ float max2f(float a,float b){float r;asm("v_max_f32_e32 %0, %1, %2":"=v"(r):"v"(a),"v"(b));return r;}
__device__ __forceinline__ float fadd_s(float a,float b){float r;asm("v_add_f32_e32 %0, %1, %2":"=v"(r):"v"(a),"v"(b));return r;}
__device__ __forceinline__ float fsub_s(float a,float b){float r;asm("v_sub_f32_e32 %0, %1, %2":"=v"(r):"v"(a),"v"(b));return r;}
typedef float f32x2_t __attribute__((ext_vector_type(2))); typedef __bf16 bf16x2_t __attribute__((ext_vector_type(2)));
__device__ __forceinline__ unsigned cvtpk_s(float lo,float hi){f32x2_t v={lo,hi};bf16x2_t b=__builtin_convertvector(v,bf16x2_t);return __builtin_bit_cast(unsigned,b);}
#define WAIT_BAR(N) asm volatile("s_waitcnt vmcnt(" #N ") lgkmcnt(0)\n\ts_barrier":::"memory")

__device__ __forceinline__ void qkt(f32x16&p0,f32x16&p1,const char*Kslot,const bf16x8*qr,const f32x16&negm,int r32,int hi){
  const char*kb=Kslot+hi*1024+r32*16;
  #pragma unroll
  for(int d0=0;d0<4;++d0){
    const bf16x8 b0=*reinterpret_cast<const bf16x8*>(kb+d0*2048);
    const bf16x8 b1=*reinterpret_cast<const bf16x8*>(kb+d0*2048+512);
    if(d0==0){p0=__builtin_amdgcn_mfma_f32_32x32x16_bf16(b0,qr[0],negm,0,0,0);p1=__builtin_amdgcn_mfma_f32_32x32x16_bf16(b1,qr[0],negm,0,0,0);}
    else{p0=__builtin_amdgcn_mfma_f32_32x32x16_bf16(b0,qr[d0],p0,0,0,0);p1=__builtin_amdgcn_mfma_f32_32x32x16_bf16(b1,qr[d0],p1,0,0,0);}}
}
typedef __attribute__((address_space(3))) const char* lds_cptr;
typedef short v4i16_t __attribute__((ext_vector_type(4)));
__device__ __forceinline__ void kload8(bf16x8*kf,lds_cptr kp){
  kf[0]=*(const __attribute__((address_space(3))) bf16x8*)(kp);      kf[1]=*(const __attribute__((address_space(3))) bf16x8*)(kp+512);
  kf[2]=*(const __attribute__((address_space(3))) bf16x8*)(kp+2048); kf[3]=*(const __attribute__((address_space(3))) bf16x8*)(kp+2560);
  kf[4]=*(const __attribute__((address_space(3))) bf16x8*)(kp+4096); kf[5]=*(const __attribute__((address_space(3))) bf16x8*)(kp+4608);
  kf[6]=*(const __attribute__((address_space(3))) bf16x8*)(kp+6144); kf[7]=*(const __attribute__((address_space(3))) bf16x8*)(kp+6656);
}
__device__ __forceinline__ void kload2(bf16x8*kf,lds_cptr kp,int j){ kf[2*j]=*(const __attribute__((address_space(3))) bf16x8*)(kp+j*2048); kf[2*j+1]=*(const __attribute__((address_space(3))) bf16x8*)(kp+j*2048+512); }
__device__ __forceinline__ s16x4 vtr(lds_cptr p){ return __builtin_bit_cast(s16x4,__builtin_amdgcn_ds_read_tr16_b64_v4i16((__attribute__((address_space(3))) v4i16_t*)p)); }
__device__ __forceinline__ float rowmax(const f32x16&p0,const f32x16&p1){
  float a=max3f(p0[0],p0[1],p1[0]),b=max3f(p0[2],p0[3],p1[1]);a=max3f(a,p1[2],p1[3]);
  #pragma unroll
  for(int r=4;r<16;r+=4){a=max3f(a,p0[r],p0[r+1]);b=max3f(b,p0[r+2],p0[r+3]);a=max3f(a,p1[r],p1[r+1]);b=max3f(b,p1[r+2],p1[r+3]);}
  const float m=max2f(a,b);
  auto rr=__builtin_amdgcn_permlane32_swap(__float_as_uint(m),__float_as_uint(m),false,false);
  return max2f(__uint_as_float(rr[0]),__uint_as_float(rr[1]));
}
__device__ __forceinline__ void pv(f32x16*o,int vb,bf16x8 pa0,bf16x8 pa1,bf16x8 pa2,bf16x8 pa3){
  #pragma unroll
  for(int d0=0;d0<2;++d0){s16x4 lo[4],hi[4];
    #pragma unroll
    for(int ks=0;ks<4;++ks){
      asm volatile("ds_read_b64_tr_b16 %0,%1 offset:%c2":"=&v"(lo[ks]):"v"(vb),"i"(d0*4096+ks*1024):"memory");
      asm volatile("ds_read_b64_tr_b16 %0,%1 offset:%c2":"=&v"(hi[ks]):"v"(vb),"i"(d0*4096+ks*1024+512):"memory");}
    asm volatile("s_waitcnt lgkmcnt(0)":::"memory");SBAR();
    #define PK(k) (bf16x8){lo[k][0],lo[k][1],lo[k][2],lo[k][3],hi[k][0],hi[k][1],hi[k][2],hi[k][3]}
    o[d0]=__builtin_amdgcn_mfma_f32_32x32x16_bf16(pa0,PK(0),o[d0],0,0,0);
    o[d0]=__builtin_amdgcn_mfma_f32_32x32x16_bf16(pa1,PK(1),o[d0],0,0,0);
    o[d0]=__builtin_amdgcn_mfma_f32_32x32x16_bf16(pa2,PK(2),o[d0],0,0,0);
    o[d0]=__builtin_amdgcn_mfma_f32_32x32x16_bf16(pa3,PK(3),o[d0],0,0,0);
    #undef PK
  }
}

#ifndef ATTN_STORE16
#define ATTN_STORE16(p,v) (*(u32x4*)(p)=(v))
#endif
template<int THRL> __device__ __forceinline__ void attn_unit(int b,int h,int qb,const bf16*Q,const bf16*__restrict__ K,const bf16*__restrict__ V,bf16*O,char*shm,int wave_in){
  int ln_; asm volatile("v_mbcnt_lo_u32_b32 %0, -1, 0\n\tv_mbcnt_hi_u32_b32 %0, -1, %0" : "=v"(ln_)); asm volatile("" : "+s"(wave_in)); int tid_=wave_in*64+ln_; const int tid=tid_,lane=tid&63,r32=lane&31,hi=lane>>5; const int wid=__builtin_amdgcn_readfirstlane(tid>>6);
  const long rowq=(long)b*SEQQ, rowk=(long)b*SEQK; const int q0=qb*QB;
  const bf16*Qw=Q+(rowq+q0+wid*QBLK)*QP+h*D;
  const bf16*Kh=K+rowk*KP+(h>>2)*D,*Vh=V+rowk*KP+(h>>2)*D;
  const unsigned lds0=(unsigned)(uintptr_t)shm;
  float*wsf=(float*)(shm+LDS_WS)+wid*64;
  const bf16*ksrc=Kh+(long)lane*KP+wid*8;
  const bf16*vsrc=Vh+(long)(16*(wid&3)+(lane>>2))*KP+(wid>>2)*32+(lane&3)*8;
  const unsigned kdst=lds0+LDS_K+wid*1024, vdst=lds0+LDS_V+wid*1024;
  #define DMA_K(t,slot) glds16(ksrc+(long)(t)*KVBLK*KP,(unsigned)__builtin_amdgcn_readfirstlane(kdst+(slot)))
  #define DMA_V(t,slot) glds16(vsrc+(long)(t)*KVBLK*KP,(unsigned)__builtin_amdgcn_readfirstlane(vdst+(slot)))
  const int vb0=(int)(lds0+LDS_V)+((lane>>4)&1)*32+(lane&3)*8+(4*hi+((lane&15)>>2))*64;
  const char*Kbase=shm+LDS_K; bf16x8 kf[8];
  const lds_cptr shm3=(lds_cptr)shm; const lds_cptr kp0=shm3+LDS_K+hi*1024+r32*16; const lds_cptr vp0=shm3+LDS_V+((lane>>4)&1)*32+(lane&3)*8+(4*hi+((lane&15)>>2))*64;
  constexpr int NT=SEQK/KVBLK;
  DMA_K(0,0);DMA_V(0,0);DMA_K(1,SLOTB);
  bf16x8 qr[4];
  #pragma unroll
  for(int d0=0;d0<4;++d0)qr[d0]=*reinterpret_cast<const bf16x8*>(&Qw[(long)r32*QP+d0*16+hi*8]);
  float mhat=0.f,l_reg=0.f;f32x16 o[2];o[0]=f32x16{};o[1]=f32x16{};f32x16 negm=f32x16{};asm volatile("":"+v"(negm));

  #define CMASK(P0,P1,t) do{}while(0)
  bool resc=false;
  #define START(P0,P1) do{ const float rm=rowmax(P0,P1); resc=false; \
    { const float dl=rm; mhat=fadd_s(mhat,dl); \
      _Pragma("unroll") for(int r=0;r<16;++r){P0[r]=fsub_s(P0[r],dl);P1[r]=fsub_s(P1[r],dl);} \
      _Pragma("unroll") for(int r=0;r<16;++r)negm[r]=-mhat; asm volatile("":"+v"(negm)); } \
    _Pragma("unroll") for(int r=0;r<16;++r)P0[r]=__builtin_amdgcn_exp2f(P0[r]); }while(0)
  #define RESC() do{ if(resc){ asm volatile("s_waitcnt lgkmcnt(0)":::"memory"); \
      _Pragma("unroll") for(int d_=0;d_<2;++d_) _Pragma("unroll") for(int r=0;r<16;++r)o[d_][r]*=wsf[crow(r,hi)]; } }while(0)
  f32x16 pA0,pA1,pB0,pB1;
  int sl_prev=0,sl_cur=0,sl_next=SLOTB;
  #define ROT() do{sl_prev=sl_cur;sl_cur=sl_next;sl_next=(sl_next==(NSLOT-1)*SLOTB)?0:sl_next+SLOTB;}while(0)
  DMA_K(2,2*SLOTB);
  WAIT_BAR(3);
  qkt(pA0,pA1,Kbase,qr,negm,r32,hi);asm volatile("s_nop 15\n\ts_nop 7":"+v"(pA0),"+v"(pA1));CMASK(pA0,pA1,0);
  START(pA0,pA1);
  _Pragma("unroll") for(int r=0;r<16;++r)pA1[r]=__builtin_amdgcn_exp2f(pA1[r]);
  WAIT_BAR(0);
  DMA_K(3,0);DMA_V(1,SLOTB);
  ROT();
  kload8(kf,kp0+sl_cur);
  WAIT_BAR(2);
  s16x4 vlo[8],vhi[8]; u32x4 pw0,pw1,pw2,pw3;
  #define PKW(P,B) cvtpk_s(P[B],P[B+1])
  #define PAF(k) __builtin_bit_cast(bf16x8,pw##k)
  #define VFR(i) (bf16x8){vlo[i][0],vlo[i][1],vlo[i][2],vlo[i][3],vhi[i][0],vhi[i][1],vhi[i][2],vhi[i][3]}
  #define PIN(x) asm volatile("":"+v"(x))
  #define MX3(a,b,c) __builtin_fmaxf(__builtin_fmaxf((a),(b)),(c))
  #define GAPA(MF,A0,A1,A2,A3,W0,W1,PW) do{ MF; sacc+=A0; sacc+=A1; sacc+=A2; sacc+=A3; PIN(sacc); W0; W1; PIN(PW); SBAR(); }while(0)
  #define EX(v) __builtin_amdgcn_exp2f(v)
  #define GAPB(MF,X,B) do{ MF; X[B]=EX(X[B]); X[B+1]=EX(X[B+1]); X[B+2]=EX(X[B+2]); X[B+3]=EX(X[B+3]); PIN(X); SBAR(); }while(0)
  #define VRD(i) do{ vlo[i]=vtr(vp_+(((i)>>2)*4096+((i)&3)*1024)); vhi[i]=vtr(vp_+(((i)>>2)*4096+((i)&3)*1024+512)); }while(0)
  #define KRD(G,j) do{ if(G){ kload2(kf,kp0+sl_next,j); SBAR(); } }while(0)
  #define STEP(C0,C1,P0,P1,t,GK,GV,GL) do{ SBAR(); \
    const lds_cptr vp_=vp0+sl_prev; \
    VRD(0); SBAR(); float sacc=(P0[0]+P0[1]); \
    GAPA(C0=__builtin_amdgcn_mfma_f32_32x32x16_bf16(kf[0],qr[0],negm,0,0,0), P0[2],P0[3],P0[4],P0[5],     pw0[0]=PKW(P0,0), pw0[1]=PKW(P0,2), pw0); \
    VRD(4); SBAR(); GAPA(C1=__builtin_amdgcn_mfma_f32_32x32x16_bf16(kf[1],qr[0],negm,0,0,0), P0[6],P0[7],P0[8],P0[9],     pw0[2]=PKW(P0,4), pw0[3]=PKW(P0,6), pw0); \
    VRD(1); SBAR(); GAPA(C0=__builtin_amdgcn_mfma_f32_32x32x16_bf16(kf[2],qr[1],C0,0,0,0),   P0[10],P0[11],P0[12],P0[13], pw1[0]=PKW(P0,8), pw1[1]=PKW(P0,10), pw1); \
    VRD(5); SBAR(); GAPA(C1=__builtin_amdgcn_mfma_f32_32x32x16_bf16(kf[3],qr[1],C1,0,0,0),   P0[14],P0[15],P1[0],P1[1],   pw1[2]=PKW(P0,12),pw1[3]=PKW(P0,14), pw1); \
    VRD(2); SBAR(); GAPA(C0=__builtin_amdgcn_mfma_f32_32x32x16_bf16(kf[4],qr[2],C0,0,0,0),   P1[2],P1[3],P1[4],P1[5],     pw2[0]=PKW(P1,0), pw2[1]=PKW(P1,2), pw2); \
    VRD(6); SBAR(); GAPA(C1=__builtin_amdgcn_mfma_f32_32x32x16_bf16(kf[5],qr[2],C1,0,0,0),   P1[6],P1[7],P1[8],P1[9],     pw2[2]=PKW(P1,4), pw2[3]=PKW(P1,6), pw2); \
    VRD(3); SBAR(); GAPA(C0=__builtin_amdgcn_mfma_f32_32x32x16_bf16(kf[6],qr[3],C0,0,0,0),   P1[10],P1[11],P1[12],P1[13], pw3[0]=PKW(P1,8), pw3[1]=PKW(P1,10), pw3); \
    VRD(7); SBAR(); GAPA(C1=__builtin_amdgcn_mfma_f32_32x32x16_bf16(kf[7],qr[3],C1,0,0,0),   P1[14],P1[15],0.f,0.f,       pw3[2]=PKW(P1,12),pw3[3]=PKW(P1,14), pw3); \
    l_reg+=sacc; \
    if(GK){DMA_K((t)+3,sl_cur);} if(GV){DMA_V((t)+1,sl_next);} \
    CMASK(C0,C1,t); \
    { float a=MX3(C0[0],C0[1],C1[0]),b=MX3(C0[2],C0[3],C1[1]); a=MX3(a,C1[2],C1[3]); \
      _Pragma("unroll") for(int r=4;r<16;r+=4){a=MX3(a,C0[r],C0[r+1]);b=MX3(b,C0[r+2],C0[r+3]);a=MX3(a,C1[r],C1[r+1]);b=MX3(b,C1[r+2],C1[r+3]);} \
      float rm=__builtin_fmaxf(a,b); { auto rr=__builtin_amdgcn_permlane32_swap(__float_as_uint(rm),__float_as_uint(rm),false,false); rm=__builtin_fmaxf(__uint_as_float(rr[0]),__uint_as_float(rr[1])); } \
      resc=false; \
      if(__builtin_expect(__any(rm>(float)THRL),0)){ const float dl=__builtin_fmaxf(rm,0.f); mhat+=dl; \
        _Pragma("unroll") for(int r=0;r<16;++r){C0[r]-=dl;C1[r]-=dl;} \
        _Pragma("unroll") for(int r=0;r<16;++r)negm[r]=-mhat; asm volatile("":"+v"(negm)); \
        const float f=__builtin_amdgcn_exp2f(-dl); l_reg*=f; if(hi==0)wsf[r32]=f; resc=true; } } \
    SBAR(); \
    GAPB(o[0]=__builtin_amdgcn_mfma_f32_32x32x16_bf16(PAF(0),VFR(0),o[0],0,0,0), C0,0); \
    GAPB(o[1]=__builtin_amdgcn_mfma_f32_32x32x16_bf16(PAF(0),VFR(4),o[1],0,0,0), C0,4); \
    KRD(GL,0); GAPB(o[0]=__builtin_amdgcn_mfma_f32_32x32x16_bf16(PAF(1),VFR(1),o[0],0,0,0), C0,8); \
    KRD(GL,1); GAPB(o[1]=__builtin_amdgcn_mfma_f32_32x32x16_bf16(PAF(1),VFR(5),o[1],0,0,0), C0,12); \
    KRD(GL,2); GAPB(o[0]=__builtin_amdgcn_mfma_f32_32x32x16_bf16(PAF(2),VFR(2),o[0],0,0,0), C1,0); \
    KRD(GL,3); GAPB(o[1]=__builtin_amdgcn_mfma_f32_32x32x16_bf16(PAF(2),VFR(6),o[1],0,0,0), C1,4); \
    GAPB(o[0]=__builtin_amdgcn_mfma_f32_32x32x16_bf16(PAF(3),VFR(3),o[0],0,0,0), C1,8); \
    GAPB(o[1]=__builtin_amdgcn_mfma_f32_32x32x16_bf16(PAF(3),VFR(7),o[1],0,0,0), C1,12); \
    }while(0)
  int t=1;
  #undef CMASK
  #define CMASK(P0,P1,t) do{}while(0)
  for(;t+5<NT;t+=2){
    STEP(pB0,pB1,pA0,pA1,t,true,true,true);     WAIT_BAR(2); RESC(); ROT();
    STEP(pA0,pA1,pB0,pB1,t+1,true,true,true);   WAIT_BAR(2); RESC(); ROT();
  }
  #undef CMASK
  #define CMASK(P0,P1,t) do{}while(0)
  #define ENDW(tt) do{ if((tt)+3<NT){WAIT_BAR(2);} else if((tt)+2<NT){WAIT_BAR(1);} else {WAIT_BAR(0);} }while(0)
  for(;t+1<NT;t+=2){
    STEP(pB0,pB1,pA0,pA1,t,(t+3<NT),(t+1<NT),(t+1<NT));       ENDW(t);   RESC(); ROT();
    STEP(pA0,pA1,pB0,pB1,t+1,(t+4<NT),(t+2<NT),(t+2<NT));     ENDW(t+1); RESC(); ROT();
  }
  STEP(pB0,pB1,pA0,pA1,NT-1,false,false,false); RESC();
  { float sacc=pB0[0]+pB0[1]; _Pragma("unroll") for(int r=2;r<16;++r)sacc+=pB0[r]; _Pragma("unroll") for(int r=0;r<16;++r)sacc+=pB1[r]; l_reg+=sacc;
    pw0=(u32x4){PKW(pB0,0),PKW(pB0,2),PKW(pB0,4),PKW(pB0,6)};pw1=(u32x4){PKW(pB0,8),PKW(pB0,10),PKW(pB0,12),PKW(pB0,14)};pw2=(u32x4){PKW(pB1,0),PKW(pB1,2),PKW(pB1,4),PKW(pB1,6)};pw3=(u32x4){PKW(pB1,8),PKW(pB1,10),PKW(pB1,12),PKW(pB1,14)};
    SBAR(); pv(o,vb0+sl_cur,PAF(0),PAF(1),PAF(2),PAF(3)); }
  #undef PKW
  #undef PAF
  #undef VFR
  #undef PIN
  #undef MX3
  #undef GAPA
  #undef GAPB
  #undef EX
  #undef VRD
  #undef KRD
  #undef STEP
  #undef ENDW
  {auto rr=__builtin_amdgcn_permlane32_swap(__float_as_uint(l_reg),__float_as_uint(l_reg),false,false);l_reg=__uint_as_float(rr[0])+__uint_as_float(rr[1]);}
  if(hi==0)wsf[32+r32]=l_reg;asm volatile("s_waitcnt lgkmcnt(0)":::"memory");
  float rli[16];
  #pragma unroll
  for(int r=0;r<16;++r)rli[r]=__builtin_amdgcn_rcpf(wsf[32+crow(r,hi)]);
  bf16*Ow=O+(rowq+q0+wid*QBLK)*OP+h*D;
  { bf16*stg=(bf16*)(shm+LDS_OST)+wid*2048;
    #pragma unroll
    for(int r=0;r<16;++r){const int orow=crow(r,hi);
      #pragma unroll
      for(int d0=0;d0<2;++d0)stg[orow*64+d0*32+r32]=__float2bfloat16(o[d0][r]*rli[r]);}
    asm volatile("s_waitcnt lgkmcnt(0)":::"memory");
    #pragma unroll
    for(int i=0;i<4;++i){const int row=i*8+(lane>>3),ch=lane&7; const u32x4 v=*(const u32x4*)(stg+row*64+ch*8); ATTN_STORE16(Ow+(long)row*OP+ch*8,v);} }
  asm volatile("s_waitcnt lgkmcnt(0)\n\ts_barrier":::"memory");
  #undef DMA_K
  #undef DMA_V
  #undef CMASK
  #undef START
  #undef RESC
  #undef ROT
}
constexpr int ATTN_LDS_BYTES=LDS_BYTES;
struct AttnTensors { const bf16* Q; const bf16* K; const bf16* V; bf16* O; };
template<int THRL=8> __device__ __forceinline__ void attn_phase(char*lds,const AttnTensors&T,int vcu,int G,int wave_in){
  for(int u=vcu;u<2*8*NQB;u+=G){ attn_unit<THRL>(u>>8,(u>>5)&7,u&31,T.Q,T.K,T.V,T.O,lds,wave_in); }
}
#undef SBAR
#undef WAIT_BAR
}
#define XB_TMO      128
#define XB_XCNT(j)  (256  + 64 * (j))
#define XB_XSUB(j)  (1280 + 64 * (j))
#define XB_XGEN(j)  (2304 + 64 * (j))
#define XB_TOP      3328
#define XB_TOPGEN   3392
#define XCD_BAR_WORDS 3456
#define XB_SPIN_CAP (1u << 18)

__device__ __forceinline__ unsigned xb_ld(unsigned* p)              { return __hip_atomic_load(p, __ATOMIC_RELAXED, __HIP_MEMORY_SCOPE_AGENT); }
__device__ __forceinline__ unsigned xb_add(unsigned* p, unsigned v) { return __hip_atomic_fetch_add(p, v, __ATOMIC_RELAXED, __HIP_MEMORY_SCOPE_AGENT); }
__device__ __forceinline__ unsigned xb_xcc_id() { return (unsigned)__builtin_amdgcn_s_getreg((3 << 11) | 20) & 0xFu; }
#define XB_SPIN(cond, bar) do { unsigned _sp = 0; while (cond) { __builtin_amdgcn_s_sleep(1); \
    if ((++_sp & 255u) == 0u) { if (xb_ld(&(bar)[XB_TMO])) break; if (_sp > XB_SPIN_CAP) { atomicAdd(&(bar)[XB_TMO], 1u); break; } } } } while (0)

struct XcdBarrier {
    unsigned* bar; unsigned x;
    int wv;
    volatile LAS unsigned* st;
};

__device__ __forceinline__ bool xb_thread0(int wv) { int ln_; asm volatile("v_mbcnt_lo_u32_b32 %0, -1, 0\n\tv_mbcnt_hi_u32_b32 %0, -1, %0" : "=v"(ln_)); return wv == 0 && ln_ == 0; }
__device__ __forceinline__ XcdBarrier xcd_barrier_post(unsigned* bar, volatile LAS unsigned* st, int wv) {
    XcdBarrier b; b.bar = bar; b.x = xb_xcc_id(); b.st = st; b.wv = wv;
    if (xb_thread0(wv)) (void)xb_add(&bar[XB_XCNT(b.x)], 1u);
    return b;
}
__device__ __forceinline__ void xcd_barrier_complete(unsigned* bar, unsigned x, unsigned& nloc, unsigned& nx) {
    const unsigned G = gridDim.x * gridDim.y * gridDim.z;
    unsigned sum, cnt, mine, sp = 0u;
    for (;;) {
        sum = 0u; cnt = 0u; mine = 0u;
#pragma unroll
        for (unsigned j = 0; j < 16; ++j) { const unsigned c = xb_ld(&bar[XB_XCNT(j)]); sum += c; cnt += (c > 0u) ? 1u : 0u; mine = (j == x) ? c : mine; }
        if (sum == G) break;
        __builtin_amdgcn_s_sleep(1);
        if ((++sp & 255u) == 0u) { if (xb_ld(&bar[XB_TMO])) break; if (sp > XB_SPIN_CAP) { atomicAdd(&bar[XB_TMO], 1u); break; } }
    }
    nloc = mine > 0u ? mine : 1u; nx = cnt > 0u ? cnt : 1u;
}

__device__ __forceinline__ void xcd_barrier(const XcdBarrier& b) {
    asm volatile("s_waitcnt vmcnt(0)" ::: "memory");
    __syncthreads();
    if (xb_thread0(b.wv)) {
        unsigned* bar = b.bar;
        __builtin_amdgcn_s_waitcnt(0);
        unsigned nloc = b.st[0], nx = b.st[1];
        if (nloc == 0u) { xcd_barrier_complete(bar, b.x, nloc, nx); b.st[0] = nloc; b.st[1] = nx; }
        const unsigned old = xb_add(&bar[XB_XSUB(b.x)], 1u);
        const unsigned gen = old / nloc;
        if (old + 1u == (gen + 1u) * nloc) {
            __builtin_amdgcn_fence(__ATOMIC_RELEASE, "agent");
            asm volatile("s_waitcnt vmcnt(0)" ::: "memory");
            const unsigned og = xb_add(&bar[XB_TOP], 1u);
            const unsigned tg = og / nx;
            if (og + 1u == (tg + 1u) * nx) xb_add(&bar[XB_TOPGEN], 1u);
            else XB_SPIN(xb_ld(&bar[XB_TOPGEN]) == tg, bar);
            __builtin_amdgcn_fence(__ATOMIC_ACQUIRE, "agent");
            xb_add(&bar[XB_XGEN(b.x)], 1u);
            asm volatile("s_waitcnt vmcnt(0)" ::: "memory");
        } else {
            XB_SPIN(xb_ld(&bar[XB_XGEN(b.x)]) == gen, bar);
            __builtin_amdgcn_fence(__ATOMIC_ACQUIRE, "agent");
            asm volatile("s_waitcnt vmcnt(0)" ::: "memory");
        }
    }
    __syncthreads();
}

struct Args { const float* in[33]; float* out; unsigned char* ws; int gp_lo, gp_hi, use_bar, pad; };
enum { I_X = 0, I_C, I_CTX, I_CCTX, I_ADAW, I_ADAB, I_N1G, I_N2G, I_WIN, I_RPB, I_QG, I_KG, I_MURKV, I_MUW, I_MUA, I_MUG, I_W0, I_W2, I_A0, I_A2, I_G2,
       I_KK, I_KA, I_RK, I_LNXG, I_LNXB, I_GRPG, I_WOUT, I_FUP, I_CONVW, I_CONVB, I_FDN, I_FING };
struct Frame {
    LAS unsigned char* lds;
    int tid, lane, wave, vcu, G;
    GAS unsigned char* ws;
};
#define WSP(T, off) ((T*)(GAS T*)(f.ws + (off)))
__device__ __forceinline__ const float* karg_in(int idx) {
    const GAS float* p; const void* ka = (const void*)__builtin_amdgcn_kernarg_segment_ptr();
    asm volatile("s_load_dwordx2 %0, %1, %2\n\ts_waitcnt lgkmcnt(0)" : "=s"(p) : "s"(ka), "i"(idx * 8) : "memory");
    return (const float*)p;
}
__device__ __forceinline__ void launder_ws(Frame& f) {
    GAS unsigned char* w = f.ws; int wv = f.wave, v = f.vcu, g = f.G, ln;
    asm volatile("" : "+s"(w), "+s"(wv), "+s"(v), "+s"(g));
    asm volatile("v_mbcnt_lo_u32_b32 %0, -1, 0\n\tv_mbcnt_hi_u32_b32 %0, -1, %0" : "=v"(ln));
    f.ws = w; f.wave = wv; f.lane = ln; f.tid = wv * 64 + ln; f.vcu = v; f.G = g;
}

struct RowInfo { int t, T, b, isctx; };
__device__ __forceinline__ RowInfo row_info(int m) {
    RowInfo r;
    if (m < MLAT) { r.b = m >> 13; r.t = m & (SEQ - 1); r.T = SEQ; r.isctx = 0; }
    else { const int mm = m - MLAT; r.b = mm >> 8; r.t = mm & (CTXL - 1); r.T = CTXL; r.isctx = 1; }
    return r;
}

__device__ __forceinline__ void transpose_item(const float* W, int K, int N, bf16* WT, LAS float* scr, int item, int lane) {
    const int nblk = N / 32, kb = item / nblk, nb = item % nblk, k0 = 64 * kb, n0 = 32 * nb;
    float tv[32];
#pragma unroll
    for (int i = 0; i < 32; ++i) { const int kk = 2 * i + (lane >> 5); tv[i] = W[(size_t)(k0 + kk) * N + n0 + (lane & 31)]; }
#pragma unroll
    for (int i = 0; i < 32; ++i) { const int kk = 2 * i + (lane >> 5); scr[kk * 33 + (lane & 31)] = tv[i]; }
    LDS_WAIT(); asm volatile("" ::: "memory");
    const int c = lane & 7;
#pragma unroll
    for (int j = 0; j < 4; ++j) { const int n = (lane >> 3) + 8 * j; const LAS float* s = scr + (8 * c) * 33 + n;
        v4u o; o.x = pk2(s[0 * 33], s[1 * 33]); o.y = pk2(s[2 * 33], s[3 * 33]); o.z = pk2(s[4 * 33], s[5 * 33]); o.w = pk2(s[6 * 33], s[7 * 33]);
        *(v4u*)(WT + (size_t)(n0 + n) * K + k0 + 8 * c) = o; }
    LDS_WAIT(); asm volatile("" ::: "memory");
}
__device__ __forceinline__ void ph_convert(Frame& f) { const float* in_I_ADAW = karg_in(I_ADAW); const float* in_I_C = karg_in(I_C); const float* in_I_CCTX = karg_in(I_CCTX); const float* in_I_CTX = karg_in(I_CTX); const float* in_I_FDN = karg_in(I_FDN); const float* in_I_FUP = karg_in(I_FUP); const float* in_I_WIN = karg_in(I_WIN); const float* in_I_WOUT = karg_in(I_WOUT); const float* in_I_X = karg_in(I_X); launder_ws(f);
    LAS float* scr = (LAS float*)(f.lds + f.wave * 16384);
    const int gw = f.vcu * NWAVES + f.wave, NGW = f.G * NWAVES;
    constexpr int I_IN = (DM / 64) * (INC / 32), I_OUT = (DM / 64) * (DM / 32), I_UP = (DM / 64) * (UPN / 32), I_DN = (DFF / 64) * (DM / 32), I_L = I_IN + I_OUT + I_UP + I_DN;
    for (int it = gw; it < DEPTH * I_L; it += NGW) {
        const int l = it / I_L; int r = it % I_L;
        if (r < I_IN) { transpose_item(in_I_WIN + (size_t)l * DM * INC, DM, INC, WSP(bf16, WS_WIN) + (size_t)l * INP * DM, scr, r, f.lane); continue; } r -= I_IN;
        if (r < I_OUT) { transpose_item(in_I_WOUT + (size_t)l * DM * DM, DM, DM, WSP(bf16, WS_WOUT) + (size_t)l * DM * DM, scr, r, f.lane); continue; } r -= I_OUT;
        if (r < I_UP) {
            const int nb = r % (UPN / 32), n0 = 32 * nb, ch = n0 >= DFF ? n0 - DFF : n0, drow = (ch >> 7) * 256 + (n0 >= DFF ? 128 : 0) + (ch & 127);
            transpose_item(in_I_FUP + (size_t)l * DM * UPN, DM, UPN, WSP(bf16, WS_WUP) + (size_t)l * UPN * DM + (size_t)(drow - n0) * DM, scr, r, f.lane); continue; } r -= I_UP;
        transpose_item(in_I_FDN + (size_t)l * DFF * DM, DFF, DM, WSP(bf16, WS_WDN) + (size_t)l * DM * DFF, scr, r, f.lane);
    }
    for (int it = gw; it < DEPTH * (INP - INC); it += NGW) {
        const int l = it / (INP - INC), r = INC + it % (INP - INC);
        v4u* p = (v4u*)(WSP(bf16, WS_WIN) + ((size_t)l * INP + r) * DM) + f.lane;
#pragma unroll
        for (int j = 0; j < 4; ++j) p[64 * j] = (v4u){0u, 0u, 0u, 0u};
    }
    for (int it = gw; it < DEPTH * 48 * 16; it += NGW) {
        const int l = it / 768, rem = it % 768, cg = rem / 16, ks = rem % 16;
#pragma unroll
        for (int q = 0; q < 2; ++q) { const int kk = f.lane + 64 * q, k = ks * 128 + kk;
            const float c0 = in_I_C[k], c1 = in_I_C[DM + k], c2 = in_I_CCTX[k];
            scr[kk] = c0 * sigmoidf_(c0); scr[128 + kk] = c1 * sigmoidf_(c1); scr[256 + kk] = c2 * sigmoidf_(c2); }
        LDS_WAIT(); asm volatile("" ::: "memory");
        const f32x4* Wp = (const f32x4*)(in_I_ADAW + ((size_t)l * DM + ks * 128) * MODW + cg * 256) + f.lane;
        f32x4 a0 = {0.f, 0.f, 0.f, 0.f}, a1 = a0, a2 = a0;
#pragma unroll 8
        for (int kk = 0; kk < 128; ++kk) { const f32x4 w = Wp[(size_t)kk * (MODW / 4)]; a0 += w * scr[kk]; a1 += w * scr[128 + kk]; a2 += w * scr[256 + kk]; }
        float* o = WSP(float, WS_MODP) + ((size_t)(ks * DEPTH + l) * 3) * MODW + cg * 256 + f.lane * 4;
        *(f32x4*)(o) = a0; *(f32x4*)(o + MODW) = a1; *(f32x4*)(o + 2 * MODW) = a2;
        LDS_WAIT(); asm volatile("" ::: "memory");
    }
}
__device__ __forceinline__ void ph_modsum(Frame& f) { const float* in_I_ADAB = karg_in(I_ADAB); launder_ws(f);
    const int gt = f.vcu * 512 + f.tid, GT = f.G * 512;
    for (int i = gt; i < DEPTH * 3 * MODW; i += GT) {
        const int l = i / (3 * MODW), j = i % MODW;
        float s = in_I_ADAB[l * MODW + j];
#pragma unroll
        for (int ks = 0; ks < 16; ++ks) s += WSP(float, WS_MODP)[(size_t)ks * DEPTH * 3 * MODW + i];
        WSP(float, WS_MOD)[i] = s;
    }
}

__device__ __forceinline__ void ph_norm(Frame& f, int l, int which, int mrows) { const float* in_I_N1G = karg_in(I_N1G); const float* in_I_N2G = karg_in(I_N2G); launder_ws(f);
    const int gw = f.vcu * NWAVES + f.wave, NGW = f.G * NWAVES;
    const float* g = (which == 0 ? in_I_N1G : in_I_N2G) + l * DM;
    const int offsh = which == 0 ? 0 : 3 * DM, offsc = offsh + DM;
    for (int m = gw; m < mrows; m += NGW) {
        const int s = m < SEQ ? 0 : (m < MLAT ? 1 : 2);
        const float* mod = WSP(float, WS_MOD) + (size_t)(l * 3 + s) * MODW;
        const f32x4* xr = (const f32x4*)(WSP(float, WS_H) + (size_t)m * DM) + f.lane;
        f32x4 v[8]; float ss = 0.f;
#pragma unroll
        for (int j = 0; j < 8; ++j) { v[j] = xr[64 * j]; ss += (v[j].x * v[j].x + v[j].y * v[j].y) + (v[j].z * v[j].z + v[j].w * v[j].w); }
        const float rs = 1.0f / sqrtf(wave_sum(ss) * (1.f / DM) + 1e-6f);
        v2u* o = (v2u*)(WSP(bf16, WS_XN) + (size_t)m * DM) + f.lane;
#pragma unroll
        for (int j = 0; j < 8; ++j) { const int col = f.lane * 4 + 256 * j;
            const f32x4 g4 = *(const f32x4*)(g + col), sc = *(const f32x4*)(mod + offsc + col), sh = *(const f32x4*)(mod + offsh + col);
            const f32x4 r = (v[j] * rs) * g4 * (sc + 1.0f) + sh;
            v2u w; w.x = pk2(r.x, r.y); w.y = pk2(r.z, r.w); o[64 * j] = w; }
    }
}

__device__ __forceinline__ void ph_prep(Frame& f, int l) { const float* in_I_KG = karg_in(I_KG); const float* in_I_QG = karg_in(I_QG); launder_ws(f);
    const int gw = f.vcu * NWAVES + f.wave, NGW = f.G * NWAVES, lane = f.lane;
    const float qg = in_I_QG[l * HD + lane], kg = in_I_KG[l * HD + lane];
    const int ri = lane & 15, ra = lane >> 5, rp = (lane >> 4) & 1;
    const float inv_freq = powf(10000.0f, -(float)ri / 16.0f);
    for (int m = gw; m < MALL; m += NGW) {
        const RowInfo R = row_info(m);
        const bf16* y = WSP(bf16, WS_Y1) + (size_t)m * INP;
        float sn = 0.f, cs = 1.f;
        if (!R.isctx) { const int pos = ra == 0 ? (R.t / GRIDW) : (R.t % GRIDW); const float ang = (float)pos * inv_freq; sincosf(ang, &sn, &cs); }
        const int kvpos = R.isctx ? R.t : CTXL + R.t;
        const size_t kvrow = ((size_t)R.b * SKV + kvpos) * 128;
#pragma unroll
        for (int hh = 0; hh < 10; ++hh) {
            const int col = hh < 8 ? C_QB + hh * 64 + lane : C_KB + (hh - 8) * 64 + lane;
            const float x = bf2f(y[col]);
            const float ss = wave_sum(x * x);
            float xn = x * (1.0f / sqrtf(ss * (1.f / HD) + 1e-6f)) * (hh < 8 ? qg : kg);
            const float xp = __shfl_xor(xn, 16);
            if (!R.isctx) xn = rp == 0 ? (xn * cs - xp * sn) : (xp * sn + xn * cs);
            if (hh < 8) WSP(bf16, WS_QBP)[(size_t)m * 512 + hh * 64 + lane] = (bf16)f2bf(xn * QSCALE);
            else WSP(bf16, WS_KBP)[kvrow + (hh - 8) * 64 + lane] = (bf16)f2bf(xn);
        }
#pragma unroll
        for (int hv = 0; hv < 2; ++hv) WSP(bf16, WS_VBP)[kvrow + hv * 64 + lane] = y[C_VB + hv * 64 + lane];
    }
}

template <int KR> __device__ __forceinline__ void lora_mm(const LAS float* X, const float* W, int c0, float (&acc)[32][2]) {
#pragma unroll
    for (int t = 0; t < 32; ++t) { acc[t][0] = 0.f; acc[t][1] = 0.f; }
    for (int r4 = 0; r4 < KR / 4; ++r4) {
        float wa[4], wb[4];
#pragma unroll
        for (int i = 0; i < 4; ++i) { wa[i] = W[(size_t)(4 * r4 + i) * CW + c0]; wb[i] = W[(size_t)(4 * r4 + i) * CW + c0 + 512]; }
#pragma unroll
        for (int t = 0; t < 32; ++t) { const f32x4 x = *(const LAS f32x4*)(X + t * KR + 4 * r4);
            acc[t][0] += x.x * wa[0] + x.y * wa[1] + x.z * wa[2] + x.w * wa[3];
            acc[t][1] += x.x * wb[0] + x.y * wb[1] + x.z * wb[2] + x.w * wb[3]; }
    }
}
__device__ __forceinline__ void ph_lora(Frame& f, int l) { const float* in_I_A0 = karg_in(I_A0); const float* in_I_A2 = karg_in(I_A2); const float* in_I_G2 = karg_in(I_G2); const float* in_I_MUA = karg_in(I_MUA); const float* in_I_MUG = karg_in(I_MUG); const float* in_I_MUW = karg_in(I_MUW); const float* in_I_W0 = karg_in(I_W0); const float* in_I_W2 = karg_in(I_W2); launder_ws(f);
    LAS float* tw = (LAS float*)f.lds;
    LAS float* ta = tw + 4096;
    LAS float* sg = ta + 4096;
    const bf16* Y1 = WSP(bf16, WS_Y1);
    const int c0 = f.tid;
    __syncthreads();
    for (int tile = f.vcu; tile < MALL / 32; tile += f.G) {
        const int m0 = tile * 32;
        for (int idx = f.tid; idx < 32 * 416; idx += 512) {
            const int tok = idx / 416, col = idx % 416, m = m0 + tok;
            const RowInfo R = row_info(m);
            const float cur = bf2f(Y1[(size_t)m * INP + C_WD + col]);
            const float prev = R.t > 0 ? bf2f(Y1[(size_t)(m - 1) * INP + C_WD + col]) : 0.f;
            const float next = R.t < R.T - 1 ? bf2f(Y1[(size_t)(m + 1) * INP + C_WD + col]) : 0.f;
            if (col < 128) { const int d = col >> 6, r = col & 63; const float nb = d ? next : prev;
                tw[(d * 32 + tok) * 64 + r] = tanhf(cur + in_I_MUW[l * 128 + col] * (nb - cur)); }
            else if (col < 256) { const int c2 = col - 128, d = c2 >> 6, r = c2 & 63; const float nb = d ? next : prev;
                ta[(d * 32 + tok) * 64 + r] = cur + in_I_MUA[l * 128 + c2] * (nb - cur); }
            else { const int r = col - 256;
                sg[tok * 160 + r] = sigmoidf_(cur + in_I_MUG[l * 320 + r] * (prev - cur) + in_I_MUG[l * 320 + 160 + r] * (next - cur)); }
        }
        __syncthreads();
        float acc[32][2];
#pragma unroll 1
        for (int d = 0; d < 2; ++d) {
            lora_mm<64>(tw + d * 2048, in_I_W2 + ((size_t)(l * 2 + d) * 64) * CW, c0, acc);
            { float* o = WSP(float, WS_WDEC) + ((size_t)d * MALL + m0) * CW + c0;
              const float b0 = in_I_W0[(l * 2 + d) * CW + c0], b1 = in_I_W0[(l * 2 + d) * CW + c0 + 512];
#pragma unroll
              for (int t = 0; t < 32; ++t) {
#pragma unroll
                  for (int q = 0; q < 2; ++q) { const float z = (q ? b1 : b0) + acc[t][q];
                      const float nz = -z, sp = fmaxf(nz, 0.f) + log1pf(expf(-fabsf(nz)));
                      const float wlog = -sp - 0.5f;
                      o[(size_t)t * CW + 512 * q] = expf(-expf(wlog)); } } }
            lora_mm<64>(ta + d * 2048, in_I_A2 + ((size_t)(l * 2 + d) * 64) * CW, c0, acc);
            { float* o = WSP(float, WS_AIC) + ((size_t)d * MALL + m0) * CW + c0;
              const float b0 = in_I_A0[(l * 2 + d) * CW + c0], b1 = in_I_A0[(l * 2 + d) * CW + c0 + 512];
#pragma unroll
              for (int t = 0; t < 32; ++t) { o[(size_t)t * CW] = sigmoidf_(b0 + acc[t][0]); o[(size_t)t * CW + 512] = sigmoidf_(b1 + acc[t][1]); } }
        }
        lora_mm<160>(sg, in_I_G2 + (size_t)l * 160 * CW, c0, acc);
        { float* o = WSP(float, WS_G) + (size_t)m0 * CW + c0;
#pragma unroll
          for (int t = 0; t < 32; ++t) { o[(size_t)t * CW] = acc[t][0]; o[(size_t)t * CW + 512] = acc[t][1]; } }
        __syncthreads();
    }
}
struct AttState { float mx, ls; float o[64]; };
__device__ __forceinline__ void att_init(AttState& S) { S.mx = -1e30f; S.ls = 0.f;
#pragma unroll
    for (int d = 0; d < 64; ++d) S.o[d] = 0.f; }
__device__ __forceinline__ void load_row64(float (&q)[64], const bf16* p, float scale) {
#pragma unroll
    for (int c = 0; c < 8; ++c) { const v4u w = ((const v4u*)p)[c];
        q[8 * c + 0] = bflo(w.x) * scale; q[8 * c + 1] = bfhi(w.x) * scale; q[8 * c + 2] = bflo(w.y) * scale; q[8 * c + 3] = bfhi(w.y) * scale;
        q[8 * c + 4] = bflo(w.z) * scale; q[8 * c + 5] = bfhi(w.z) * scale; q[8 * c + 6] = bflo(w.w) * scale; q[8 * c + 7] = bfhi(w.w) * scale; }
}
__device__ __forceinline__ void att_key(AttState& S, const float (&q)[64], const bf16* kp, const bf16* vp, float bias) {
    float s0 = 0.f, s1 = 0.f, s2 = 0.f, s3 = 0.f;
#pragma unroll
    for (int c = 0; c < 8; ++c) { const v4u w = ((const v4u*)kp)[c];
        s0 += q[8 * c + 0] * bflo(w.x) + q[8 * c + 1] * bfhi(w.x); s1 += q[8 * c + 2] * bflo(w.y) + q[8 * c + 3] * bfhi(w.y);
        s2 += q[8 * c + 4] * bflo(w.z) + q[8 * c + 5] * bfhi(w.z); s3 += q[8 * c + 6] * bflo(w.w) + q[8 * c + 7] * bfhi(w.w); }
    const float s = (s0 + s1) + (s2 + s3) + bias;
    const float mn = fmaxf(S.mx, s), fo = exp2f(S.mx - mn), p = exp2f(s - mn);
    S.mx = mn; S.ls = S.ls * fo + p;
#pragma unroll
    for (int c = 0; c < 8; ++c) { const v4u w = ((const v4u*)vp)[c];
        S.o[8 * c + 0] = S.o[8 * c + 0] * fo + p * bflo(w.x); S.o[8 * c + 1] = S.o[8 * c + 1] * fo + p * bfhi(w.x);
        S.o[8 * c + 2] = S.o[8 * c + 2] * fo + p * bflo(w.y); S.o[8 * c + 3] = S.o[8 * c + 3] * fo + p * bfhi(w.y);
        S.o[8 * c + 4] = S.o[8 * c + 4] * fo + p * bflo(w.z); S.o[8 * c + 5] = S.o[8 * c + 5] * fo + p * bfhi(w.z);
        S.o[8 * c + 6] = S.o[8 * c + 6] * fo + p * bflo(w.w); S.o[8 * c + 7] = S.o[8 * c + 7] * fo + p * bfhi(w.w); }
}
__device__ __forceinline__ void att_finish(AttState& S, bf16* op, int sub) {
    float M = S.mx;
    M = fmaxf(M, __shfl_xor(M, 1)); M = fmaxf(M, __shfl_xor(M, 2)); M = fmaxf(M, __shfl_xor(M, 4));
    const float fo = exp2f(S.mx - M);
    float L = S.ls * fo; L += __shfl_xor(L, 1); L += __shfl_xor(L, 2); L += __shfl_xor(L, 4);
    const float inv = 1.0f / L;
    float r[8];
#pragma unroll
    for (int i = 0; i < 8; ++i) r[i] = 0.f;
#pragma unroll
    for (int d = 0; d < 64; ++d) { float v = S.o[d] * fo; v += __shfl_xor(v, 1); v += __shfl_xor(v, 2); v += __shfl_xor(v, 4);
        if ((d >> 3) == sub) r[d & 7] = v * inv; }
    v4u w; w.x = pk2(r[0], r[1]); w.y = pk2(r[2], r[3]); w.z = pk2(r[4], r[5]); w.w = pk2(r[6], r[7]);
    *(v4u*)(op + 8 * sub) = w;
}
__device__ __forceinline__ void ph_attn_naive(Frame& f, int l, int item_lo, int item_hi, bool do_ctx) { const float* in_I_RPB = karg_in(I_RPB); launder_ws(f);
    const bf16* Y1 = WSP(bf16, WS_Y1);
    const int qx = f.tid >> 3, sub = f.tid & 7;
    for (int it = item_lo + f.vcu; it < item_hi; it += f.G) {
        float q[64]; AttState S; att_init(S);
        if (it < 2048) {
            const int b = it >> 10, h = (it >> 7) & 7, i = it & 127;
            const int m = b * SEQ + i * GRIDW + qx;
            load_row64(q, Y1 + (size_t)m * INP + C_QA + h * 64, QSCALE);
            int rs = i - 4; rs = rs < 0 ? 0 : (rs > 120 ? 120 : rs);
            int cst = qx - 8; cst = cst < 0 ? 0 : (cst > 48 ? 48 : cst);
            const int jr = rs + sub;
            const float* rpb = in_I_RPB + ((size_t)(l * 8 + h) * 15 + (jr - i + 7)) * 31;
            for (int yy = 0; yy < 16; ++yy) { const int y = cst + yy, mk = b * SEQ + jr * GRIDW + y;
                int co = y - qx; co = co < -15 ? -15 : (co > 15 ? 15 : co);
                att_key(S, q, Y1 + (size_t)mk * INP + C_KA + h * 64, Y1 + (size_t)mk * INP + C_VA + h * 64, rpb[co + 15] * LOG2E); }
            for (int n = 0; n < 32; ++n) { const int mk = MLAT + b * CTXL + sub + 8 * n;
                att_key(S, q, Y1 + (size_t)mk * INP + C_KA + h * 64, Y1 + (size_t)mk * INP + C_VA + h * 64, 0.f); }
            att_finish(S, WSP(bf16, WS_OA) + (size_t)m * 512 + h * 64, sub);
        } else if (it < 2112) {
            if (!do_ctx) continue;
            const int r = it - 2048, b = r >> 5, h = (r >> 2) & 7, qt = r & 3;
            const int m = MLAT + b * CTXL + qt * 64 + qx;
            load_row64(q, Y1 + (size_t)m * INP + C_QA + h * 64, QSCALE);
            for (int n = 0; n < 32; ++n) { const int mk = MLAT + b * CTXL + sub + 8 * n;
                att_key(S, q, Y1 + (size_t)mk * INP + C_KA + h * 64, Y1 + (size_t)mk * INP + C_VA + h * 64, 0.f); }
            att_finish(S, WSP(bf16, WS_OA) + (size_t)m * 512 + h * 64, sub);
        } else if (it < 2176) {
            if (!do_ctx) continue;
            const int r = it - 2112, b = r >> 5, h = (r >> 2) & 7, qt = r & 3;
            const int m = MLAT + b * CTXL + qt * 64 + qx;
            load_row64(q, WSP(bf16, WS_QBP) + (size_t)m * 512 + h * 64, 1.0f);
            const bf16* kb = WSP(bf16, WS_KBP) + (size_t)b * SKV * 128 + (h >> 2) * 64; const bf16* vb = WSP(bf16, WS_VBP) + (size_t)b * SKV * 128 + (h >> 2) * 64;
            for (int n = 0; n < 32; ++n) { const int kp = sub + 8 * n; att_key(S, q, kb + (size_t)kp * 128, vb + (size_t)kp * 128, 0.f); }
            att_finish(S, WSP(bf16, WS_OB) + (size_t)m * 512 + h * 64, sub);
        } else {
            const int r = it - 2176, b = r >> 10, h = (r >> 7) & 7, qt = r & 127;
            const int m = b * SEQ + qt * 64 + qx;
            load_row64(q, WSP(bf16, WS_QBP) + (size_t)m * 512 + h * 64, 1.0f);
            const bf16* kb = WSP(bf16, WS_KBP) + (size_t)b * SKV * 128 + (h >> 2) * 64; const bf16* vb = WSP(bf16, WS_VBP) + (size_t)b * SKV * 128 + (h >> 2) * 64;
            for (int n = 0; n < SKV / 8; ++n) { const int kp = sub + 8 * n; att_key(S, q, kb + (size_t)kp * 128, vb + (size_t)kp * 128, 0.f); }
            att_finish(S, WSP(bf16, WS_OB) + (size_t)m * 512 + h * 64, sub);
        }
    }
}

__device__ __forceinline__ void ph_scan(Frame& f, int l) { const float* in_I_KA = karg_in(I_KA); const float* in_I_KK = karg_in(I_KK); const float* in_I_MURKV = karg_in(I_MURKV); launder_ws(f);
    LAS float* F = (LAS float*)f.lds;
    LAS float* YT = F + 32 * 6 * 64;
    const bf16* Y1 = WSP(bf16, WS_Y1);
    const int lane = f.lane, rg = lane >> 4, j = lane & 15;
    for (int it = f.vcu; it < 128; it += f.G) {
        const int half = it & 1, chain = it >> 1, b = chain >> 5, d = (chain >> 4) & 1, h = chain & 15;
        const int col = h * 64 + lane;
        const float mur = in_I_MURKV[(l * 2 + d) * 3072 + col], muk = in_I_MURKV[(l * 2 + d) * 3072 + 1024 + col], muv = in_I_MURKV[(l * 2 + d) * 3072 + 2048 + col];
        const float k_k = in_I_KK[l * CW + col], k_a = in_I_KA[l * CW + col];
        float s0 = 0.f, s1 = 0.f, s2 = 0.f, s3 = 0.f;
        const int myrow = half * 32 + f.wave * 4 + rg;
        for (int ch = 0; ch < SKV / 32; ++ch) {
#pragma unroll
            for (int q = 0; q < 4; ++q) {
                const int sl = f.wave * 4 + q, st = ch * 32 + sl;
                int m, t, T;
                if (st < CTXL) { t = d ? (CTXL - 1 - st) : st; T = CTXL; m = MLAT + b * CTXL + t; }
                else { const int u = st - CTXL; t = d ? (SEQ - 1 - u) : u; T = SEQ; m = b * SEQ + t; }
                const bool hasn = d ? (t < T - 1) : (t > 0); const int mn = d ? m + 1 : m - 1;
                const bf16* y = Y1 + (size_t)m * INP; const bf16* yn = Y1 + (size_t)mn * INP;
                const float r0 = bf2f(y[C_R + col]), k0 = bf2f(y[C_K + col]), v0 = bf2f(y[C_V + col]);
                const float rn = hasn ? bf2f(yn[C_R + col]) : 0.f, kn = hasn ? bf2f(yn[C_K + col]) : 0.f, vn = hasn ? bf2f(yn[C_V + col]) : 0.f;
                const float r = r0 + mur * (rn - r0), k = k0 + muk * (kn - k0), v = v0 + muv * (vn - v0);
                const float a = WSP(float, WS_AIC)[((size_t)d * MALL + m) * CW + col], w = WSP(float, WS_WDEC)[((size_t)d * MALL + m) * CW + col];
                float kk = k * k_k; const float nrm = sqrtf(wave_sum(kk * kk)); kk = kk / fmaxf(nrm, 1e-12f);
                const float km = k * (1.0f + (a - 1.0f) * k_a);
                LAS float* Fs = F + sl * 384;
                Fs[lane] = r; Fs[64 + lane] = w; Fs[128 + lane] = km; Fs[192 + lane] = -kk; Fs[256 + lane] = kk * a; Fs[320 + lane] = v;
            }
            __syncthreads();
#pragma unroll 4
            for (int sl = 0; sl < 32; ++sl) {
                const LAS float* Fs = F + sl * 384;
                const f32x4 r4 = *(const LAS f32x4*)(Fs + 4 * j), w4 = *(const LAS f32x4*)(Fs + 64 + 4 * j), k4 = *(const LAS f32x4*)(Fs + 128 + 4 * j);
                const f32x4 a4 = *(const LAS f32x4*)(Fs + 192 + 4 * j), b4 = *(const LAS f32x4*)(Fs + 256 + 4 * j);
                const float vv = Fs[320 + myrow];
                float sa = (s0 * a4.x + s1 * a4.y) + (s2 * a4.z + s3 * a4.w);
                sa += __shfl_xor(sa, 1); sa += __shfl_xor(sa, 2); sa += __shfl_xor(sa, 4); sa += __shfl_xor(sa, 8);
                s0 = s0 * w4.x + sa * b4.x + vv * k4.x; s1 = s1 * w4.y + sa * b4.y + vv * k4.y;
                s2 = s2 * w4.z + sa * b4.z + vv * k4.z; s3 = s3 * w4.w + sa * b4.w + vv * k4.w;
                float yv = (s0 * r4.x + s1 * r4.y) + (s2 * r4.z + s3 * r4.w);
                yv += __shfl_xor(yv, 1); yv += __shfl_xor(yv, 2); yv += __shfl_xor(yv, 4); yv += __shfl_xor(yv, 8);
                if (j == 0) YT[sl * 32 + f.wave * 4 + rg] = yv;
            }
            __syncthreads();
#pragma unroll
            for (int q = 0; q < 2; ++q) { const int idx = f.tid + 512 * q, sl = idx >> 5, rr = idx & 31, st = ch * 32 + sl;
                int m; if (st < CTXL) m = MLAT + b * CTXL + (d ? (CTXL - 1 - st) : st); else { const int u = st - CTXL; m = b * SEQ + (d ? (SEQ - 1 - u) : u); }
                WSP(float, WS_YS)[((size_t)d * MALL + m) * CW + h * 64 + half * 32 + rr] = YT[idx]; }
        }
        __syncthreads();
    }
}

__device__ __forceinline__ f32x4 bf4(v2u w) { return (f32x4){bflo(w.x), bfhi(w.x), bflo(w.y), bfhi(w.y)}; }
__device__ __forceinline__ float hsum4(f32x4 v) { return (v.x + v.y) + (v.z + v.w); }
__device__ __forceinline__ void ph_mix(Frame& f, int l, int mrows) { const float* in_I_GRPG = karg_in(I_GRPG); const float* in_I_KA = karg_in(I_KA); const float* in_I_LNXB = karg_in(I_LNXB); const float* in_I_LNXG = karg_in(I_LNXG); const float* in_I_MURKV = karg_in(I_MURKV); const float* in_I_RK = karg_in(I_RK); launder_ws(f);
    const int gw = f.vcu * NWAVES + f.wave, NGW = f.G * NWAVES, lane = f.lane, hq = lane >> 4, j = lane & 15;
    const bf16* Y1 = WSP(bf16, WS_Y1);
    LAS float* T_LG = (LAS float*)f.lds; LAS float* T_LB = T_LG + 1024; LAS float* T_RK = T_LG + 2048; LAS float* T_KA = T_LG + 3072; LAS float* T_MU = T_LG + 4096; LAS float* gg = T_LG + 10240;
    __syncthreads();
    for (int i = f.tid; i < 256; i += NWAVES * 64) { ((LAS f32x4*)T_LG)[i] = ((const f32x4*)(in_I_LNXG + l * CW))[i]; ((LAS f32x4*)T_LB)[i] = ((const f32x4*)(in_I_LNXB + l * CW))[i];
        ((LAS f32x4*)T_RK)[i] = ((const f32x4*)(in_I_RK + l * CW))[i]; ((LAS f32x4*)T_KA)[i] = ((const f32x4*)(in_I_KA + l * CW))[i]; }
    for (int i = f.tid; i < 1536; i += NWAVES * 64) ((LAS f32x4*)T_MU)[i] = ((const f32x4*)(in_I_MURKV + (size_t)l * 6144))[i];
    for (int i = f.tid; i < 512; i += NWAVES * 64) ((LAS f32x4*)gg)[i] = ((const f32x4*)(in_I_GRPG + l * DM))[i];
    __syncthreads();
    const float* YS0 = WSP(float, WS_YS); const float* YS1 = YS0 + (size_t)MALL * CW;
    const bf16* AIC0 = WSP(bf16, WS_AIC); const bf16* AIC1 = AIC0 + (size_t)MALL * CW;
    for (int m = gw; m < mrows; m += NGW) {
        const RowInfo R = row_info(m);
        const bool hasp = R.t > 0, hasn = R.t < R.T - 1;
        const bf16* y = Y1 + (size_t)m * INP; const bf16* yp = hasp ? y - INP : y; const bf16* yn = hasn ? y + INP : y;
        const bf16* gbuf = WSP(bf16, WS_G) + (size_t)m * CW; LAS float* obuf = (LAS float*)(f.lds + 65536 + f.wave * 4096);
        float ssc = 0.f;
#pragma unroll
        for (int it4 = 0; it4 < 4; ++it4) {
            const int c = (it4 * 4 + hq) * 64 + 4 * j;
            const f32x4 yv = *(const f32x4*)(YS0 + (size_t)m * CW + c) + *(const f32x4*)(YS1 + (size_t)m * CW + c);
            const float mean = sum16(hsum4(yv)) * (1.f / 64.f); const f32x4 dv = yv - mean; const float var = sum16(hsum4(dv * dv)) * (1.f / 64.f);
            f32x4 o = dv * __builtin_amdgcn_rsqf(var + 64e-5f) * *(const LAS f32x4*)(T_LG + c) + *(const LAS f32x4*)(T_LB + c);
            const f32x4 r0 = bf4(*(const v2u*)(y + C_R + c)), k0 = bf4(*(const v2u*)(y + C_K + c)), v0 = bf4(*(const v2u*)(y + C_V + c));
            const f32x4 rkw = *(const LAS f32x4*)(T_RK + c), k_a = *(const LAS f32x4*)(T_KA + c);
#pragma unroll
            for (int d = 0; d < 2; ++d) {
                const bf16* yb = d ? yn : yp; const bool has = d ? hasn : hasp;
                f32x4 rn = bf4(*(const v2u*)(yb + C_R + c)), kn = bf4(*(const v2u*)(yb + C_K + c)), vn = bf4(*(const v2u*)(yb + C_V + c));
                if (!has) { rn = (f32x4){0.f, 0.f, 0.f, 0.f}; kn = rn; vn = rn; }
                const LAS float* mu = T_MU + d * 3072 + c;
                const f32x4 r = r0 + *(const LAS f32x4*)(mu) * (rn - r0), k = k0 + *(const LAS f32x4*)(mu + 1024) * (kn - k0), v = v0 + *(const LAS f32x4*)(mu + 2048) * (vn - v0);
                const f32x4 a = bf4(*(const v2u*)((d ? AIC1 : AIC0) + (size_t)m * CW + c));
                const f32x4 km = k * ((a - 1.0f) * k_a + 1.0f);
                o += v * sum16(hsum4(r * km * rkw));
            }
            o *= bf4(*(const v2u*)(gbuf + c));
            *(LAS f32x4*)(obuf + c) = o; ssc += hsum4(o * o);
            if (it4 == 1) asm volatile("" ::: "memory");
        }
        const float rc = __builtin_amdgcn_rsqf(sum64(ssc) * (1.f / 1024.f) + 1e-6f);
        const v4u wa = *(const v4u*)(WSP(bf16, WS_OA) + (size_t)m * 512 + lane * 8), wb = *(const v4u*)(WSP(bf16, WS_OB) + (size_t)m * 512 + lane * 8);
        const f32x4 a0 = bf4((v2u){wa.x, wa.y}), a1 = bf4((v2u){wa.z, wa.w}), b0 = bf4((v2u){wb.x, wb.y}), b1 = bf4((v2u){wb.z, wb.w});
        const float ra = __builtin_amdgcn_rsqf(sum64(hsum4(a0 * a0) + hsum4(a1 * a1)) * (1.f / 512.f) + 1e-6f), rb = __builtin_amdgcn_rsqf(sum64(hsum4(b0 * b0) + hsum4(b1 * b1)) * (1.f / 512.f) + 1e-6f);
        bf16* o = WSP(bf16, WS_MIX) + (size_t)m * DM;
        { const LAS float* ga = gg + lane * 8; const f32x4 x0 = a0 * ra * *(const LAS f32x4*)(ga), x1 = a1 * ra * *(const LAS f32x4*)(ga + 4);
          *(v4u*)(o + lane * 8) = (v4u){pk2(x0.x, x0.y), pk2(x0.z, x0.w), pk2(x1.x, x1.y), pk2(x1.z, x1.w)}; }
        { const LAS float* gb = gg + 512 + lane * 8; const f32x4 x0 = b0 * rb * *(const LAS f32x4*)(gb), x1 = b1 * rb * *(const LAS f32x4*)(gb + 4);
          *(v4u*)(o + 512 + lane * 8) = (v4u){pk2(x0.x, x0.y), pk2(x0.z, x0.w), pk2(x1.x, x1.y), pk2(x1.z, x1.w)}; }
#pragma unroll
        for (int q = 0; q < 4; ++q) { const int c = q * 256 + lane * 4; const f32x4 x = *(const LAS f32x4*)(obuf + c) * rc * *(const LAS f32x4*)(gg + 1024 + c);
            *(v2u*)(o + 1024 + c) = (v2u){pk2(x.x, x.y), pk2(x.z, x.w)}; }
    }
}

__device__ __forceinline__ void ph_convglu(Frame& f, int l, int mrows) { const float* in_I_CONVB = karg_in(I_CONVB); const float* in_I_CONVW = karg_in(I_CONVW); launder_ws(f);
    const int gt = f.vcu * 512 + f.tid, GT = f.G * 512;
    const bf16* U = WSP(bf16, WS_U); bf16* HB = WSP(bf16, WS_HB);
    const float* cw = in_I_CONVW + (size_t)l * 3 * DFF; const float* cb = in_I_CONVB + (size_t)l * DFF;
    constexpr int C8 = DFF / 8;
    for (int idx = gt; idx < mrows * C8; idx += GT) {
        const int m = idx / C8, c = (idx % C8) * 8;
        const RowInfo R = row_info(m);
        const v4u z = {0u, 0u, 0u, 0u};
        const v4u uc = *(const v4u*)(U + (size_t)m * UPN + c), vl = *(const v4u*)(U + (size_t)m * UPN + DFF + c);
        const v4u up = R.t > 0 ? *(const v4u*)(U + (size_t)(m - 1) * UPN + c) : z, un = R.t < R.T - 1 ? *(const v4u*)(U + (size_t)(m + 1) * UPN + c) : z;
        float r[8], gv[8];
#pragma unroll
        for (int i = 0; i < 8; ++i) {
            const unsigned wc_ = i < 2 ? uc.x : i < 4 ? uc.y : i < 6 ? uc.z : uc.w, wp_ = i < 2 ? up.x : i < 4 ? up.y : i < 6 ? up.z : up.w;
            const unsigned wn_ = i < 2 ? un.x : i < 4 ? un.y : i < 6 ? un.z : un.w, wv_ = i < 2 ? vl.x : i < 4 ? vl.y : i < 6 ? vl.z : vl.w;
            const float fc = (i & 1) ? bfhi(wc_) : bflo(wc_), fp = (i & 1) ? bfhi(wp_) : bflo(wp_), fn = (i & 1) ? bfhi(wn_) : bflo(wn_), fv = (i & 1) ? bfhi(wv_) : bflo(wv_);
            const float u = fp * cw[c + i] + fc * cw[DFF + c + i] + fn * cw[2 * DFF + c + i] + cb[c + i];
            r[i] = u; gv[i] = fv;
        }
#pragma unroll
        for (int i = 0; i < 8; i += 2) { const f32x2 g2 = pg8::gelu_pk((f32x2){r[i], r[i + 1]}); r[i] = g2.x * gv[i]; r[i + 1] = g2.y * gv[i + 1]; }
        v4u w; w.x = pk2(r[0], r[1]); w.y = pk2(r[2], r[3]); w.z = pk2(r[4], r[5]); w.w = pk2(r[6], r[7]);
        *(v4u*)(HB + (size_t)m * DFF + c) = w;
    }
}

__device__ __forceinline__ void ph_final(Frame& f) { const float* in_I_FING = karg_in(I_FING); float* out_p = (float*)karg_in(33); launder_ws(f);
    const int gw = f.vcu * NWAVES + f.wave, NGW = f.G * NWAVES;
    const float* g = in_I_FING;
    for (int m = gw; m < MLAT; m += NGW) {
        const f32x4* xr = (const f32x4*)(WSP(float, WS_H) + (size_t)m * DM) + f.lane;
        f32x4 v[8]; float ss = 0.f;
#pragma unroll
        for (int j = 0; j < 8; ++j) { v[j] = xr[64 * j]; ss += (v[j].x * v[j].x + v[j].y * v[j].y) + (v[j].z * v[j].z + v[j].w * v[j].w); }
        const float rs = 1.0f / sqrtf(wave_sum(ss) * (1.f / DM) + 1e-6f);
        f32x4* o = (f32x4*)(out_p + (size_t)m * DM) + f.lane;
#pragma unroll
        for (int j = 0; j < 8; ++j) { const f32x4 g4 = *(const f32x4*)(g + f.lane * 4 + 256 * j); o[64 * j] = (v[j] * rs) * g4; }
    }
}

struct EpiResGate {
    static constexpr bool PERM = true, AFTER_DRAIN = false;
    float* H; const float* mod;
    __device__ __forceinline__ void operator()(const pg8::f32x4 (&acc)[2][2][4][2], const pg8::Unit& u, int wr, int wc, int fr, int fq) const {
        const int row0 = u.pm * 256 + wr * 64 + fr, col0 = u.pn * 256 + wc * 32 + 8 * fq;
        const int s = u.pm < 32 ? 0 : (u.pm < 64 ? 1 : 2);
        const float* gp = mod + (size_t)s * MODW + col0;
        pg8::f32x4 gv[2][2];
#pragma unroll
        for (int bj = 0; bj < 2; ++bj)
#pragma unroll
            for (int n = 0; n < 2; ++n) gv[bj][n] = *(const pg8::f32x4*)(gp + bj * 128 + 4 * n);
#pragma unroll
        for (int ai = 0; ai < 2; ++ai)
#pragma unroll
            for (int m = 0; m < 4; ++m) { float* rowp = H + (size_t)(row0 + ai * 128 + m * 16) * DM + col0;
#pragma unroll
                for (int bj = 0; bj < 2; ++bj)
#pragma unroll
                    for (int n = 0; n < 2; ++n) { pg8::f32x4* p = (pg8::f32x4*)(rowp + bj * 128 + 4 * n); *p = *p + gv[bj][n] * acc[ai][bj][m][n]; } }
    }
};
struct ScanRaw { float r0, k0, v0, rn, kn, vn, a, w; };
struct ScanFeat { f32x4 r, w, k, a, b; float v; };
constexpr int SC_T = 16, SC_NCH = SKV / SC_T;
__device__ __forceinline__ int scan_row_of_step(int st, int b, int d) {
    if (st < CTXL) return MLAT + b * CTXL + (d ? (CTXL - 1 - st) : st);
    const int u = st - CTXL; return b * SEQ + (d ? (SEQ - 1 - u) : u);
}
__device__ __forceinline__ void scan_load_raw(ScanRaw& R, const bf16* Y1, const float* aic, const float* wdec, int st, int b, int d, int col) {
    int t, T, m;
    if (st < CTXL) { t = d ? (CTXL - 1 - st) : st; T = CTXL; m = MLAT + b * CTXL + t; } else { const int u = st - CTXL; t = d ? (SEQ - 1 - u) : u; T = SEQ; m = b * SEQ + t; }
    const bool hasn = d ? (t < T - 1) : (t > 0); const int mn = hasn ? (d ? m + 1 : m - 1) : m;
    const bf16* y = Y1 + (size_t)m * INP + col; const bf16* yn = Y1 + (size_t)mn * INP + col;
    R.r0 = bf2f(y[C_R]); R.k0 = bf2f(y[C_K]); R.v0 = bf2f(y[C_V]);
    const float rn = bf2f(yn[C_R]), kn = bf2f(yn[C_K]), vn = bf2f(yn[C_V]);
    R.rn = hasn ? rn : 0.f; R.kn = hasn ? kn : 0.f; R.vn = hasn ? vn : 0.f;
    R.a = aic[(size_t)m * CW + col]; R.w = wdec[(size_t)m * CW + col];
}
__device__ __forceinline__ void scan_emit(LAS float* Fs, const ScanRaw& R, float mur, float muk, float muv, float k_k, float k_a, int lane) {
    const float r = R.r0 + mur * (R.rn - R.r0), k = R.k0 + muk * (R.kn - R.k0), v = R.v0 + muv * (R.vn - R.v0);
    float kk = k * k_k; kk = kk * __builtin_amdgcn_rsqf(fmaxf(sum64(kk * kk), 1e-24f));
    const float km = k * (1.0f + (R.a - 1.0f) * k_a);
    Fs[lane] = r; Fs[64 + lane] = R.w; Fs[128 + lane] = km; Fs[192 + lane] = -kk; Fs[256 + lane] = kk * R.a; Fs[320 + lane] = v;
}
__device__ __forceinline__ void scan_ld_feat(ScanFeat& F, const LAS float* Fs, int j, int row) {
    F.r = *(const LAS f32x4*)(Fs + 4 * j); F.w = *(const LAS f32x4*)(Fs + 64 + 4 * j); F.k = *(const LAS f32x4*)(Fs + 128 + 4 * j);
    F.a = *(const LAS f32x4*)(Fs + 192 + 4 * j); F.b = *(const LAS f32x4*)(Fs + 256 + 4 * j); F.v = Fs[320 + row];
}
__device__ __forceinline__ void ph_scan2(Frame& f, int l) { const float* in_I_KA = karg_in(I_KA); const float* in_I_KK = karg_in(I_KK); const float* in_I_MURKV = karg_in(I_MURKV); launder_ws(f);
    LAS float* FB = (LAS float*)f.lds;
    LAS float* YP = FB + 2 * SC_T * 384;
    const bf16* Y1 = WSP(bf16, WS_Y1);
    const int lane = f.lane;
    for (int it = f.vcu; it < 256; it += f.G) {
        const int quarter = it & 3, chain = it >> 2, b = chain >> 5, d = (chain >> 4) & 1, h = chain & 15;
        if (f.wave >= 4) {
            const int pw = f.wave - 4, sq = lane >> 4, j = lane & 15, col = h * 64 + 4 * j;
            const float* murkv = in_I_MURKV + (l * 2 + d) * 3072 + col;
            const f32x4 mur = *(const f32x4*)(murkv), muk = *(const f32x4*)(murkv + 1024), muv = *(const f32x4*)(murkv + 2048);
            const f32x4 k_k = *(const f32x4*)(in_I_KK + l * CW + col), k_a = *(const f32x4*)(in_I_KA + l * CW + col);
            const bf16* aic = WSP(bf16, WS_AIC) + (size_t)d * MALL * CW + col; const bf16* wdec = WSP(bf16, WS_WDEC) + (size_t)d * MALL * CW + col;
            const bf16* y1c = Y1 + col;
            float* ys = WSP(float, WS_YS) + (size_t)d * MALL * CW + h * 64 + quarter * 16;
            const int pt = f.tid - 256, osl = pt >> 4, orr = pt & 15;
            struct PRaw { v2u r0, k0, v0, rn, kn, vn, a, w; bool has; };
            PRaw S0, S1, S2;
#define SC_LOAD(X, c) do { const int st_ = (c) * SC_T + pw * 4 + sq; int t_, T_, m_; \
        if (st_ < CTXL) { t_ = d ? (CTXL - 1 - st_) : st_; T_ = CTXL; m_ = MLAT + b * CTXL + t_; } else { const int u_ = st_ - CTXL; t_ = d ? (SEQ - 1 - u_) : u_; T_ = SEQ; m_ = b * SEQ + t_; } \
        X.has = d ? (t_ < T_ - 1) : (t_ > 0); const int mn_ = X.has ? (d ? m_ + 1 : m_ - 1) : m_; \
        const bf16* y_ = y1c + (size_t)m_ * INP; const bf16* yn_ = y1c + (size_t)mn_ * INP; \
        X.r0 = *(const v2u*)(y_ + C_R); X.k0 = *(const v2u*)(y_ + C_K); X.v0 = *(const v2u*)(y_ + C_V); X.rn = *(const v2u*)(yn_ + C_R); X.kn = *(const v2u*)(yn_ + C_K); X.vn = *(const v2u*)(yn_ + C_V); \
        X.a = *(const v2u*)(aic + (size_t)m_ * CW); X.w = *(const v2u*)(wdec + (size_t)m_ * CW); } while (0)
#define SC_EMIT(X, slot) do { const f32x4 z_ = {0.f, 0.f, 0.f, 0.f}; \
        const f32x4 r0_ = bf4(X.r0), k0_ = bf4(X.k0), v0_ = bf4(X.v0), rn_ = X.has ? bf4(X.rn) : z_, kn_ = X.has ? bf4(X.kn) : z_, vn_ = X.has ? bf4(X.vn) : z_; \
        const f32x4 r_ = r0_ + mur * (rn_ - r0_), k_ = k0_ + muk * (kn_ - k0_), v_ = v0_ + muv * (vn_ - v0_); \
        f32x4 kk_ = k_ * k_k; kk_ = kk_ * __builtin_amdgcn_rsqf(fmaxf(sum16(hsum4(kk_ * kk_)), 1e-24f)); \
        const f32x4 a_ = bf4(X.a), q_ = bf4(X.w); const f32x4 w_ = {__expf(-q_.x), __expf(-q_.y), __expf(-q_.z), __expf(-q_.w)}; \
        const f32x4 km_ = k_ * ((a_ - 1.0f) * k_a + 1.0f); \
        LAS float* Fs_ = FB + ((slot) * SC_T + pw * 4 + sq) * 384 + 4 * j; \
        *(LAS f32x4*)(Fs_) = r_; *(LAS f32x4*)(Fs_ + 64) = w_; *(LAS f32x4*)(Fs_ + 128) = km_; *(LAS f32x4*)(Fs_ + 192) = -kk_; *(LAS f32x4*)(Fs_ + 256) = kk_ * a_; *(LAS f32x4*)(Fs_ + 320) = v_; } while (0)
#define SC_YRED(c, slot) do { const LAS f32x4* yp = (const LAS f32x4*)(YP + (((slot) * SC_T + osl) * 16 + orr) * 16); const f32x4 y0 = yp[0], y1 = yp[1], y2 = yp[2], y3 = yp[3]; \
        const f32x4 ysum = (y0 + y1) + (y2 + y3); ys[(size_t)scan_row_of_step((c) * SC_T + osl, b, d) * CW + orr] = (ysum.x + ysum.y) + (ysum.z + ysum.w); } while (0)
#define SC_IVAL(c, XL, XE) do { if ((c) + 3 < SC_NCH) SC_LOAD(XL, (c) + 3); if ((c) >= 1) SC_YRED((c) - 1, ((c) - 1) & 1); if ((c) + 1 < SC_NCH) SC_EMIT(XE, ((c) + 1) & 1); \
        LDS_WAIT(); __builtin_amdgcn_s_barrier(); } while (0)
            SC_LOAD(S0, 0); SC_EMIT(S0, 0); SC_LOAD(S1, 1); SC_LOAD(S2, 2);
            LDS_WAIT(); __builtin_amdgcn_s_barrier();
            static_assert(SC_NCH % 6 == 0, "producer loop is unrolled by 6 intervals (3 register sets x 2 LDS slots)");
            for (int c = 0; c < SC_NCH; c += 6) {
                SC_IVAL(c, S0, S1); SC_IVAL(c + 1, S1, S2); SC_IVAL(c + 2, S2, S0); SC_IVAL(c + 3, S0, S1); SC_IVAL(c + 4, S1, S2); SC_IVAL(c + 5, S2, S0);
            }
            SC_YRED(SC_NCH - 1, (SC_NCH - 1) & 1);
#undef SC_LOAD
#undef SC_EMIT
#undef SC_YRED
#undef SC_IVAL
        } else {
            const int rg = lane >> 4, j = lane & 15, lrow = f.wave * 4 + rg, row = quarter * 16 + lrow;
            f32x2 s01 = {0.f, 0.f}, s23 = {0.f, 0.f};
            __builtin_amdgcn_s_setprio(3);
            const unsigned fb0 = (unsigned)(uintptr_t)FB, yp0 = (unsigned)(uintptr_t)YP;
            LDS_WAIT(); __builtin_amdgcn_s_barrier();
#define SC_LDF(Fv, sl) do { \
    asm volatile("ds_read_b128 %0, %1 offset:%2" : "=&v"(Fv.r) : "v"(adr), "n"((sl) * 1536)); \
    asm volatile("ds_read_b128 %0, %1 offset:%2" : "=&v"(Fv.w) : "v"(adr), "n"((sl) * 1536 + 256)); \
    asm volatile("ds_read_b128 %0, %1 offset:%2" : "=&v"(Fv.k) : "v"(adr), "n"((sl) * 1536 + 512)); \
    asm volatile("ds_read_b128 %0, %1 offset:%2" : "=&v"(Fv.a) : "v"(adr), "n"((sl) * 1536 + 768)); \
    asm volatile("ds_read_b128 %0, %1 offset:%2" : "=&v"(Fv.b) : "v"(adr), "n"((sl) * 1536 + 1024)); \
    asm volatile("ds_read_b32 %0, %1 offset:%2" : "=&v"(Fv.v) : "v"(adv), "n"((sl) * 1536 + 1280)); } while (0)
#define SC_WAITF(Fv, N) asm volatile("s_waitcnt lgkmcnt(" #N ")" : "+v"(Fv.r), "+v"(Fv.w), "+v"(Fv.k), "+v"(Fv.a), "+v"(Fv.b), "+v"(Fv.v))
#define SC_YOUT(sl) do { f32x2 y_ = s01 * (f32x2){rp.x, rp.y}; y_ = s23 * (f32x2){rp.z, rp.w} + y_; const float ys_ = y_.x + y_.y; \
    asm volatile("ds_write_b32 %0, %1 offset:%2" :: "v"(ady), "v"(ys_), "n"((sl) * 1024)); } while (0)
#define SC_STEP(X, Z, sl, N, HASLD, HASY) do { \
    if (HASLD) SC_LDF(Z, (sl) + 2); \
    SC_WAITF(X, N); \
    f32x2 p_ = s01 * (f32x2){X.a.x, X.a.y}; p_ = s23 * (f32x2){X.a.z, X.a.w} + p_; \
    const float sa_ = sum16(p_.x + p_.y); \
    if (HASY) SC_YOUT((sl) - 1); \
    const f32x2 sa2_ = {sa_, sa_}, vv2_ = {X.v, X.v}; \
    f32x2 t01_ = s01 * (f32x2){X.w.x, X.w.y}; t01_ = vv2_ * (f32x2){X.k.x, X.k.y} + t01_; \
    f32x2 t23_ = s23 * (f32x2){X.w.z, X.w.w}; t23_ = vv2_ * (f32x2){X.k.z, X.k.w} + t23_; \
    s01 = sa2_ * (f32x2){X.b.x, X.b.y} + t01_; s23 = sa2_ * (f32x2){X.b.z, X.b.w} + t23_; \
    rp = X.r; } while (0)
            for (int c = 0; c < SC_NCH; ++c) {
                const unsigned adr = fb0 + (unsigned)((c & 1) * SC_T * 1536 + 16 * j), adv = fb0 + (unsigned)((c & 1) * SC_T * 1536 + 4 * row);
                const unsigned ady = yp0 + (unsigned)((((c & 1) * SC_T) * 16 + lrow) * 64 + 4 * j);
                ScanFeat FA, FBv, FC; f32x4 rp = {0.f, 0.f, 0.f, 0.f};
                SC_LDF(FA, 0); SC_LDF(FBv, 1);
                SC_STEP(FA, FC, 0, 12, true, false);   SC_STEP(FBv, FA, 1, 12, true, true);   SC_STEP(FC, FBv, 2, 13, true, true);
                SC_STEP(FA, FC, 3, 14, true, true);    SC_STEP(FBv, FA, 4, 14, true, true);   SC_STEP(FC, FBv, 5, 14, true, true);
                SC_STEP(FA, FC, 6, 14, true, true);    SC_STEP(FBv, FA, 7, 14, true, true);   SC_STEP(FC, FBv, 8, 14, true, true);
                SC_STEP(FA, FC, 9, 14, true, true);    SC_STEP(FBv, FA, 10, 14, true, true);  SC_STEP(FC, FBv, 11, 14, true, true);
                SC_STEP(FA, FC, 12, 14, true, true);   SC_STEP(FBv, FA, 13, 14, true, true);  SC_STEP(FC, FBv, 14, 8, false, true);
                SC_STEP(FA, FC, 15, 2, false, true);
                SC_YOUT(15);
                LDS_WAIT(); __builtin_amdgcn_s_barrier();
            }
            __builtin_amdgcn_s_setprio(0);
#undef SC_LDF
#undef SC_WAITF
#undef SC_YOUT
#undef SC_STEP
        }
        __syncthreads();
    }
}
typedef short bf16x8_t __attribute__((ext_vector_type(8)));
__device__ __forceinline__ unsigned cvtpk(float lo, float hi) { typedef float f2 __attribute__((ext_vector_type(2))); typedef __bf16 b2 __attribute__((ext_vector_type(2))); f2 v = {lo, hi}; b2 b = __builtin_convertvector(v, b2); return __builtin_bit_cast(unsigned, b); }
__device__ __forceinline__ void ph_na(Frame& f, int l, int slot0, int nslot) { const float* in_I_RPB = karg_in(I_RPB); launder_ws(f);
    const bf16* Y1 = WSP(bf16, WS_Y1); const bf16* VAT = WSP(bf16, WS_VAT);
    LAS float* btab = (LAS float*)(f.lds + 106496 + f.wave * 1024);
    const int lane = f.lane, g = lane >> 4, qi = lane & 15;
    for (int sl = 0; sl < nslot; ++sl) { const int it = (slot0 + sl) * NWAVES + f.wave;
        const int qb = it & 3, unit = it >> 2, b = unit >> 10, h = (unit >> 7) & 7, i = unit & 127;
        const int x = qb * 16 + qi, m = b * SEQ + i * GRIDW + x;
        int rs = i - 4; rs = rs < 0 ? 0 : (rs > 120 ? 120 : rs);
        int cs = x - 8; cs = cs < 0 ? 0 : (cs > 48 ? 48 : cs);
        const int cb = qb == 0 ? 0 : (qb == 1 ? 8 : (qb == 2 ? 24 : 32));
#pragma unroll
        for (int q = 0; q < 4; ++q) { const int idx = lane + 64 * q; if (idx < 248) { const int jrl = idx / 31, dxi = idx % 31;
            btab[jrl * 32 + dxi] = in_I_RPB[((size_t)(l * 8 + h) * 15 + (rs + jrl - i + 7)) * 31 + dxi] * LOG2E; } }
        bf16x8_t qf[2];
#pragma unroll
        for (int ks = 0; ks < 2; ++ks) qf[ks] = *(const bf16x8_t*)(Y1 + (size_t)m * INP + C_QA + h * 64 + 32 * ks + 8 * g);
        float sc[16][8];
#pragma unroll
        for (int blk = 0; blk < 16; ++blk) {
            const int mk0 = blk < 8 ? (b * SEQ + (rs + blk) * GRIDW + cb) : (MLAT + b * CTXL + (blk - 8) * 32);
#pragma unroll
            for (int T = 0; T < 2; ++T) {
                const int kidx = 8 * (qi >> 2) + 4 * T + (qi & 3);
                const bf16* kp = Y1 + (size_t)(mk0 + kidx) * INP + C_KA + h * 64 + 8 * g;
                f32x4 acc = {0.f, 0.f, 0.f, 0.f};
                acc = __builtin_amdgcn_mfma_f32_16x16x32_bf16(*(const bf16x8_t*)kp, qf[0], acc, 0, 0, 0);
                acc = __builtin_amdgcn_mfma_f32_16x16x32_bf16(*(const bf16x8_t*)(kp + 32), qf[1], acc, 0, 0, 0);
                sc[blk][4 * T + 0] = acc.x; sc[blk][4 * T + 1] = acc.y; sc[blk][4 * T + 2] = acc.z; sc[blk][4 * T + 3] = acc.w;
            }
        }
        LDS_WAIT(); asm volatile("" ::: "memory");
        float mx = -1e30f;
#pragma unroll
        for (int blk = 0; blk < 16; ++blk)
#pragma unroll
            for (int j = 0; j < 8; ++j) {
                float s = sc[blk][j] * QSCALE;
                if (blk < 8) { const int y = cb + 8 * g + j; const bool valid = (unsigned)(y - cs) < 16u; int bi = y - x + 15; bi = bi < 0 ? 0 : (bi > 30 ? 30 : bi);
                    s = valid ? s + btab[blk * 32 + bi] : -1e30f; }
                sc[blk][j] = s; mx = fmaxf(mx, s);
            }
        mx = fmaxf(mx, __shfl_xor(mx, 16)); mx = fmaxf(mx, __shfl_xor(mx, 32));
        float sum = 0.f;
        bf16x8_t pf[16];
#pragma unroll
        for (int blk = 0; blk < 16; ++blk) {
#pragma unroll
            for (int j = 0; j < 8; ++j) { const float p = __builtin_amdgcn_exp2f(sc[blk][j] - mx); sc[blk][j] = p; sum += p; }
            const v4u w = {cvtpk(sc[blk][0], sc[blk][1]), cvtpk(sc[blk][2], sc[blk][3]), cvtpk(sc[blk][4], sc[blk][5]), cvtpk(sc[blk][6], sc[blk][7])};
            pf[blk] = __builtin_bit_cast(bf16x8_t, w);
        }
        sum += __shfl_xor(sum, 16); sum += __shfl_xor(sum, 32);
        f32x4 o[4];
#pragma unroll
        for (int dt = 0; dt < 4; ++dt) o[dt] = (f32x4){0.f, 0.f, 0.f, 0.f};
        const bf16* vbase = VAT + ((size_t)(b * 8 + h) * 64 + qi) * SKV + 8 * g;
#pragma unroll
        for (int blk = 0; blk < 16; ++blk) {
            const int pos0 = blk < 8 ? (CTXL + (rs + blk) * GRIDW + cb) : (blk - 8) * 32;
#pragma unroll
            for (int dt = 0; dt < 4; ++dt) o[dt] = __builtin_amdgcn_mfma_f32_16x16x32_bf16(*(const bf16x8_t*)(vbase + (size_t)dt * 16 * SKV + pos0), pf[blk], o[dt], 0, 0, 0);
        }
        const float inv = 1.0f / sum;
        bf16* op = WSP(bf16, WS_OA) + (size_t)m * 512 + h * 64 + 4 * g;
#pragma unroll
        for (int dt = 0; dt < 4; ++dt) { const f32x4 r = o[dt] * inv; *(v2u*)(op + dt * 16) = (v2u){cvtpk(r.x, r.y), cvtpk(r.z, r.w)}; }
        LDS_WAIT(); asm volatile("" ::: "memory");
    }
}
__device__ __forceinline__ void ph_vat(Frame& f) { launder_ws(f);
    const bf16* Y1 = WSP(bf16, WS_Y1); bf16* VAT = WSP(bf16, WS_VAT);
    LAS bf16* tile = (LAS bf16*)(f.lds + f.wave * 16384);
    const int lane = f.lane, gw = f.vcu * NWAVES + f.wave, NGW = f.G * NWAVES;
    constexpr int NA_ITEMS = 2 * 8 * (SKV / 64);
    for (int it = gw; it < NA_ITEMS + 16; it += NGW) {
        const bool grpb = it >= NA_ITEMS;
        const int itb = it - NA_ITEMS;
        const int pt = grpb ? (itb & 3) : it % (SKV / 64), bh = grpb ? (itb >> 2) : it / (SKV / 64), b = grpb ? (bh >> 1) : (bh >> 3), h = grpb ? (bh & 1) : (bh & 7);
        const int pos = pt * 64 + lane, m = pos < CTXL ? (MLAT + b * CTXL + pos) : (b * SEQ + pos - CTXL);
        const bf16* vp = Y1 + (size_t)m * INP + (grpb ? C_VB : C_VA) + h * 64;
#pragma unroll
        for (int c = 0; c < 8; ++c) { const v4u w = ((const v4u*)vp)[c];
            tile[(8 * c + 0) * 72 + lane] = (bf16)(w.x & 0xffffu); tile[(8 * c + 1) * 72 + lane] = (bf16)(w.x >> 16); tile[(8 * c + 2) * 72 + lane] = (bf16)(w.y & 0xffffu); tile[(8 * c + 3) * 72 + lane] = (bf16)(w.y >> 16);
            tile[(8 * c + 4) * 72 + lane] = (bf16)(w.z & 0xffffu); tile[(8 * c + 5) * 72 + lane] = (bf16)(w.z >> 16); tile[(8 * c + 6) * 72 + lane] = (bf16)(w.w & 0xffffu); tile[(8 * c + 7) * 72 + lane] = (bf16)(w.w >> 16); }
        LDS_WAIT(); asm volatile("" ::: "memory");
        bf16* op = grpb ? WSP(bf16, WS_VBT) + ((size_t)bh * 64 + lane) * CTXL + pt * 64 : VAT + ((size_t)bh * 64 + lane) * SKV + pt * 64;
#pragma unroll
        for (int c = 0; c < 8; ++c) *(v4u*)(op + 8 * c) = *(const LAS v4u*)(tile + lane * 72 + 8 * c);
        LDS_WAIT(); asm volatile("" ::: "memory");
    }
}
__device__ __forceinline__ void ph_ctxattn(Frame& f, int vrot) { launder_ws(f);
    const bf16* Y1 = WSP(bf16, WS_Y1);
    const int lane = f.lane, g = lane >> 4, qi = lane & 15;
    const int gw = ((f.vcu + vrot) % f.G) * NWAVES + f.wave, NGW = f.G * NWAVES;
    for (int it = gw; it < 512; it += NGW) {
        const int kind = it >> 8, r = it & 255, b = r >> 7, h = (r >> 4) & 7, qb = r & 15;
        const int m = MLAT + b * CTXL + qb * 16 + qi;
        const bf16* qp = kind ? WSP(bf16, WS_QBP) + (size_t)m * 512 + h * 64 : Y1 + (size_t)m * INP + C_QA + h * 64;
        const bf16* kbase = kind ? WSP(bf16, WS_KBP) + (size_t)b * SKV * 128 + (h >> 2) * 64 : Y1 + (size_t)(MLAT + b * CTXL) * INP + C_KA + h * 64;
        const int kpitch = kind ? 128 : INP;
        const bf16* vbase = kind ? WSP(bf16, WS_VBT) + (size_t)((b * 2 + (h >> 2)) * 64) * CTXL : WSP(bf16, WS_VAT) + (size_t)((b * 8 + h) * 64) * SKV;
        const int vpitch = kind ? CTXL : SKV;
        const float scale = kind ? 1.0f : QSCALE;
        bf16x8_t qf[2];
#pragma unroll
        for (int ks = 0; ks < 2; ++ks) qf[ks] = *(const bf16x8_t*)(qp + 32 * ks + 8 * g);
        float sc[8][8];
#pragma unroll
        for (int blk = 0; blk < 8; ++blk)
#pragma unroll
            for (int T = 0; T < 2; ++T) {
                const int kidx = 8 * (qi >> 2) + 4 * T + (qi & 3);
                const bf16* kp = kbase + (size_t)(blk * 32 + kidx) * kpitch + 8 * g;
                f32x4 acc = {0.f, 0.f, 0.f, 0.f};
                acc = __builtin_amdgcn_mfma_f32_16x16x32_bf16(*(const bf16x8_t*)kp, qf[0], acc, 0, 0, 0);
                acc = __builtin_amdgcn_mfma_f32_16x16x32_bf16(*(const bf16x8_t*)(kp + 32), qf[1], acc, 0, 0, 0);
                sc[blk][4 * T + 0] = acc.x * scale; sc[blk][4 * T + 1] = acc.y * scale; sc[blk][4 * T + 2] = acc.z * scale; sc[blk][4 * T + 3] = acc.w * scale;
            }
        float mx = -1e30f;
#pragma unroll
        for (int blk = 0; blk < 8; ++blk)
#pragma unroll
            for (int j = 0; j < 8; ++j) mx = fmaxf(mx, sc[blk][j]);
        mx = fmaxf(mx, __shfl_xor(mx, 16)); mx = fmaxf(mx, __shfl_xor(mx, 32));
        float sum = 0.f;
        bf16x8_t pf[8];
#pragma unroll
        for (int blk = 0; blk < 8; ++blk) {
#pragma unroll
            for (int j = 0; j < 8; ++j) { const float p = __builtin_amdgcn_exp2f(sc[blk][j] - mx); sc[blk][j] = p; sum += p; }
            const v4u w = {cvtpk(sc[blk][0], sc[blk][1]), cvtpk(sc[blk][2], sc[blk][3]), cvtpk(sc[blk][4], sc[blk][5]), cvtpk(sc[blk][6], sc[blk][7])};
            pf[blk] = __builtin_bit_cast(bf16x8_t, w);
        }
        sum += __shfl_xor(sum, 16); sum += __shfl_xor(sum, 32);
        f32x4 o[4];
#pragma unroll
        for (int dt = 0; dt < 4; ++dt) o[dt] = (f32x4){0.f, 0.f, 0.f, 0.f};
#pragma unroll
        for (int blk = 0; blk < 8; ++blk)
#pragma unroll
            for (int dt = 0; dt < 4; ++dt) o[dt] = __builtin_amdgcn_mfma_f32_16x16x32_bf16(*(const bf16x8_t*)(vbase + (size_t)(dt * 16 + qi) * vpitch + blk * 32 + 8 * g), pf[blk], o[dt], 0, 0, 0);
        const float inv = 1.0f / sum;
        bf16* op = (kind ? WSP(bf16, WS_OB) : WSP(bf16, WS_OA)) + (size_t)m * 512 + h * 64 + 4 * g;
#pragma unroll
        for (int dt = 0; dt < 4; ++dt) { const f32x4 rr = o[dt] * inv; *(v2u*)(op + dt * 16) = (v2u){cvtpk(rr.x, rr.y), cvtpk(rr.z, rr.w)}; }
    }
}
struct F8 { f32x4 lo, hi; };
__device__ __forceinline__ F8 unpack8(v4u w) { F8 r; r.lo = (f32x4){bflo(w.x), bfhi(w.x), bflo(w.y), bfhi(w.y)}; r.hi = (f32x4){bflo(w.z), bfhi(w.z), bflo(w.w), bfhi(w.w)}; return r; }
__device__ __forceinline__ bf16x8_t pack8(f32x4 lo, f32x4 hi) { const v4u w = {cvtpk(lo.x, lo.y), cvtpk(lo.z, lo.w), cvtpk(hi.x, hi.y), cvtpk(hi.z, hi.w)}; return __builtin_bit_cast(bf16x8_t, w); }
__device__ __forceinline__ float fast_tanh(float x) { const float e = __expf(2.0f * x); return 1.0f - 2.0f / (1.0f + e); }
__device__ __forceinline__ f32x4 tanh4(f32x4 v) { return (f32x4){fast_tanh(v.x), fast_tanh(v.y), fast_tanh(v.z), fast_tanh(v.w)}; }
__device__ __forceinline__ f32x4 sigm4(f32x4 v) { return (f32x4){sigmoidf_(v.x), sigmoidf_(v.y), sigmoidf_(v.z), sigmoidf_(v.w)}; }
__device__ __forceinline__ v4u sel4(bool c, v4u v) { return c ? v : (v4u){0u, 0u, 0u, 0u}; }
__device__ __forceinline__ void ph_lora2(Frame& f, int l) { const float* in_I_A0 = karg_in(I_A0); const float* in_I_MUA = karg_in(I_MUA); const float* in_I_MUG = karg_in(I_MUG); const float* in_I_MUW = karg_in(I_MUW); const float* in_I_W0 = karg_in(I_W0); launder_ws(f);
    const bf16* Y1 = WSP(bf16, WS_Y1);
    const bf16* W2T = WSP(bf16, WS_LW) + (size_t)l * 2 * CW * 64; const bf16* A2T = WSP(bf16, WS_LW + 1 * MiB) + (size_t)l * 2 * CW * 64; const bf16* G2T = WSP(bf16, WS_LW + 2 * MiB) + (size_t)l * CW * 160;
    const int lane = f.lane, g = lane >> 4, qi = lane & 15, gw = f.vcu * NWAVES + f.wave, NGW = f.G * NWAVES;
    const v4u zero4 = {0u, 0u, 0u, 0u};
    const int NFULL = (f.G * NWAVES < (MALL / 16) * 2) ? f.G * NWAVES : (MALL / 16) * 2, NREST = (MALL / 16) * 2 - NFULL;
    for (int it0 = gw; it0 < NFULL + NREST * 8; it0 += NGW) {
        const int it = it0 < NFULL ? it0 : NFULL + (it0 - NFULL) / 8, ct_lo = it0 < NFULL ? 0 : (it0 - NFULL) % 8, ct_hi = it0 < NFULL ? 8 : ct_lo + 1;
        const int half = it & 1, m = (it >> 1) * 16 + qi;
        const RowInfo R = row_info(m);
        const bool hasp = R.t > 0, hasn = R.t < R.T - 1;
        const bf16* y = Y1 + (size_t)m * INP; const bf16* yp = hasp ? y - INP : y; const bf16* yn = hasn ? y + INP : y;
        bf16x8_t xw[2][2], xa[2][2], xg[5];
#pragma unroll
        for (int d = 0; d < 2; ++d)
#pragma unroll
            for (int ks = 0; ks < 2; ++ks) {
                const int col = d * 64 + 32 * ks + 8 * g; const bf16* yb = d ? yn : yp; const bool has = d ? hasn : hasp;
                { const F8 cur = unpack8(*(const v4u*)(y + C_WD + col)), nb = unpack8(sel4(has, *(const v4u*)(yb + C_WD + col)));
                  const f32x4 m0 = *(const f32x4*)(in_I_MUW + l * 128 + col), m1 = *(const f32x4*)(in_I_MUW + l * 128 + col + 4);
                  xw[d][ks] = pack8(tanh4(cur.lo + m0 * (nb.lo - cur.lo)), tanh4(cur.hi + m1 * (nb.hi - cur.hi))); }
                asm volatile("" : "+v"(xw[d][ks]) :: "memory");
                { const F8 cur = unpack8(*(const v4u*)(y + C_AD + col)), nb = unpack8(sel4(has, *(const v4u*)(yb + C_AD + col)));
                  const f32x4 m0 = *(const f32x4*)(in_I_MUA + l * 128 + col), m1 = *(const f32x4*)(in_I_MUA + l * 128 + col + 4);
                  xa[d][ks] = pack8(cur.lo + m0 * (nb.lo - cur.lo), cur.hi + m1 * (nb.hi - cur.hi)); }
                asm volatile("" : "+v"(xa[d][ks]) :: "memory");
            }
#pragma unroll
        for (int ks = 0; ks < 5; ++ks) {
            const int col = 32 * ks + 8 * g;
            const F8 cur = unpack8(*(const v4u*)(y + C_GD + col)), pv = unpack8(sel4(hasp, *(const v4u*)(yp + C_GD + col))), nx = unpack8(sel4(hasn, *(const v4u*)(yn + C_GD + col)));
            const f32x4 p0 = *(const f32x4*)(in_I_MUG + l * 320 + col), p1 = *(const f32x4*)(in_I_MUG + l * 320 + col + 4), n0 = *(const f32x4*)(in_I_MUG + l * 320 + 160 + col), n1 = *(const f32x4*)(in_I_MUG + l * 320 + 160 + col + 4);
            xg[ks] = pack8(sigm4(cur.lo + p0 * (pv.lo - cur.lo) + n0 * (nx.lo - cur.lo)), sigm4(cur.hi + p1 * (pv.hi - cur.hi) + n1 * (nx.hi - cur.hi)));
            asm volatile("" : "+v"(xg[ks]) :: "memory");
        }
        bf16* wq = WSP(bf16, WS_WDEC); bf16* ai = WSP(bf16, WS_AIC); bf16* gq = WSP(bf16, WS_G);
        struct LwSet { bf16x8_t w[4][2]; f32x4 bias[4]; };
#define LW_LOAD(S_, base_, bias_, d_, c0_) do { const int cr_ = (c0_) + 16 * (qi >> 2) + (qi & 3), cc_ = (c0_) + 16 * g; _Pragma("unroll") for (int T = 0; T < 4; ++T) { \
            const bf16* wp_ = (base_) + ((size_t)(d_) * CW + cr_ + 4 * T) * 64 + 8 * g; S_.w[T][0] = *(const bf16x8_t*)wp_; S_.w[T][1] = *(const bf16x8_t*)(wp_ + 32); \
            S_.bias[T] = *(const f32x4*)((bias_) + (l * 2 + (d_)) * CW + cc_ + 4 * T); } } while (0)
#define LW_MMA(acc_, S_, x_) do { _Pragma("unroll") for (int T = 0; T < 4; ++T) { acc_[T] = (f32x4){0.f, 0.f, 0.f, 0.f}; \
            acc_[T] = __builtin_amdgcn_mfma_f32_16x16x32_bf16(S_.w[T][0], x_[0], acc_[T], 0, 0, 0); acc_[T] = __builtin_amdgcn_mfma_f32_16x16x32_bf16(S_.w[T][1], x_[1], acc_[T], 0, 0, 0); } } while (0)
#define LW_ST16(op_, o_) do { *(v4u*)(op_) = (v4u){cvtpk(o_[0].x, o_[0].y), cvtpk(o_[0].z, o_[0].w), cvtpk(o_[1].x, o_[1].y), cvtpk(o_[1].z, o_[1].w)}; \
            *(v4u*)((op_) + 8) = (v4u){cvtpk(o_[2].x, o_[2].y), cvtpk(o_[2].z, o_[2].w), cvtpk(o_[3].x, o_[3].y), cvtpk(o_[3].z, o_[3].w)}; } while (0)
#define LW_EPI(acc_, S_, dstb_, d_, c0_, scale_) do { f32x4 o_[4]; _Pragma("unroll") for (int T = 0; T < 4; ++T) { const f32x4 z_ = acc_[T] + S_.bias[T]; \
            _Pragma("unroll") for (int q = 0; q < 4; ++q) o_[T][q] = (scale_) * __builtin_amdgcn_rcpf(1.0f + __expf(-z_[q])); } \
            bf16* op_ = (dstb_) + ((size_t)(d_) * MALL + m) * CW + (c0_) + 16 * g; LW_ST16(op_, o_); } while (0)
#define LW_FENCE() asm volatile("" ::: "memory")
        LwSet SA, SB; bf16x8_t GW[4][5];
        { const int c0 = half * 512 + ct_lo * 64; LW_LOAD(SA, W2T, in_I_W0, 0, c0); }
        LW_FENCE();
#pragma unroll 1
        for (int ct = ct_lo; ct < ct_hi; ++ct) {
            const int c0 = half * 512 + ct * 64, cr = c0 + 16 * (qi >> 2) + (qi & 3), cc = c0 + 16 * g;
            const int c0n = half * 512 + (ct + 1 < ct_hi ? ct + 1 : ct) * 64;
            f32x4 acc[4];
            LW_MMA(acc, SA, xw[0]); LW_LOAD(SB, A2T, in_I_A0, 0, c0); LW_FENCE(); LW_EPI(acc, SA, wq, 0, c0, 0.60653065971f); LW_FENCE();
            LW_MMA(acc, SB, xa[0]); LW_LOAD(SA, W2T, in_I_W0, 1, c0); LW_FENCE(); LW_EPI(acc, SB, ai, 0, c0, 1.0f); LW_FENCE();
            LW_MMA(acc, SA, xw[1]); LW_LOAD(SB, A2T, in_I_A0, 1, c0); LW_FENCE(); LW_EPI(acc, SA, wq, 1, c0, 0.60653065971f); LW_FENCE();
            LW_MMA(acc, SB, xa[1]);
#pragma unroll
            for (int T = 0; T < 4; ++T) { const bf16* gp = G2T + (size_t)(cr + 4 * T) * 160 + 8 * g;
#pragma unroll
                for (int ks = 0; ks < 5; ++ks) GW[T][ks] = *(const bf16x8_t*)(gp + 32 * ks); }
            LW_FENCE(); LW_EPI(acc, SB, ai, 1, c0, 1.0f); LW_FENCE();
#pragma unroll
            for (int T = 0; T < 4; ++T) { acc[T] = (f32x4){0.f, 0.f, 0.f, 0.f};
#pragma unroll
                for (int ks = 0; ks < 5; ++ks) acc[T] = __builtin_amdgcn_mfma_f32_16x16x32_bf16(GW[T][ks], xg[ks], acc[T], 0, 0, 0); }
            LW_LOAD(SA, W2T, in_I_W0, 0, c0n); LW_FENCE();
            { bf16* op = gq + (size_t)m * CW + cc; LW_ST16(op, acc); }
            LW_FENCE();
        }
#undef LW_LOAD
#undef LW_MMA
#undef LW_ST16
#undef LW_EPI
#undef LW_FENCE
    }
}
__device__ __forceinline__ void ph_lora_weights(Frame& f) { const float* in_I_A2 = karg_in(I_A2); const float* in_I_G2 = karg_in(I_G2); const float* in_I_W2 = karg_in(I_W2); launder_ws(f);
    const int gt = f.vcu * 512 + f.tid, GT = f.G * 512;
    for (int i = gt; i < DEPTH * 2 * CW * 64; i += GT) { const int r = i & 63, c = (i >> 6) & (CW - 1), ld = i >> 16;
        WSP(bf16, WS_LW)[i] = (bf16)f2bf(in_I_W2[((size_t)ld * 64 + r) * CW + c]); WSP(bf16, WS_LW + 1 * MiB)[i] = (bf16)f2bf(in_I_A2[((size_t)ld * 64 + r) * CW + c]); }
    for (int i = gt; i < DEPTH * CW * 160; i += GT) { const int r = i % 160, c = (i / 160) % CW, l = i / (160 * CW);
        WSP(bf16, WS_LW + 2 * MiB)[i] = (bf16)f2bf(in_I_G2[((size_t)l * 160 + r) * CW + c]); }
}
__device__ __forceinline__ void ph_setup2(Frame& f) { const float* in_I_CTX = karg_in(I_CTX); const float* in_I_N1G = karg_in(I_N1G); const float* in_I_N2G = karg_in(I_N2G); const float* in_I_X = karg_in(I_X); launder_ws(f);
    const int gt = f.vcu * 512 + f.tid, GT = f.G * 512, gw = f.vcu * NWAVES + f.wave, NGW = f.G * NWAVES, lane = f.lane;
    const float* MOD = WSP(float, WS_MOD);
    for (int i = gt; i < DEPTH * 2 * 3 * DM; i += GT) { const int k = i & (DM - 1), s = (i >> 11) % 3, w = (i / (3 * DM)) & 1, l = i / (6 * DM);
        WSP(float, WS_GK)[i] = (w ? in_I_N2G : in_I_N1G)[l * DM + k] * (1.0f + MOD[(size_t)(l * 3 + s) * MODW + (w ? 4 : 1) * DM + k]); }
    for (int it = gw; it < DEPTH * (INP + UPN); it += NGW) {
        const int l = it / (INP + UPN), r = it % (INP + UPN); const bool up = r >= INP; const int n = up ? r - INP : r;
        const bf16* wrow = up ? WSP(bf16, WS_WUP) + ((size_t)l * UPN + n) * DM : WSP(bf16, WS_WIN) + ((size_t)l * INP + n) * DM;
        const float* sh = MOD + (size_t)l * 3 * MODW + (up ? 3 * DM : 0);
        float a0 = 0.f, a1 = 0.f, a2 = 0.f;
#pragma unroll
        for (int c = 0; c < 4; ++c) { const int k = c * 512 + lane * 8; const v4u w = *(const v4u*)(wrow + k);
            const f32x4 wl = bf4((v2u){w.x, w.y}), wh = bf4((v2u){w.z, w.w});
            a0 += hsum4(wl * *(const f32x4*)(sh + k)) + hsum4(wh * *(const f32x4*)(sh + k + 4));
            a1 += hsum4(wl * *(const f32x4*)(sh + MODW + k)) + hsum4(wh * *(const f32x4*)(sh + MODW + k + 4));
            a2 += hsum4(wl * *(const f32x4*)(sh + 2 * MODW + k)) + hsum4(wh * *(const f32x4*)(sh + 2 * MODW + k + 4)); }
        a0 = sum64(a0); a1 = sum64(a1); a2 = sum64(a2);
        if (lane == 0) { float* o = up ? WSP(float, WS_BIAS3) + (size_t)l * 3 * UPN + n : WSP(float, WS_BIAS1) + (size_t)l * 3 * INP + n; const int ld = up ? UPN : INP; o[0] = a0; o[ld] = a1; o[2 * ld] = a2; }
    }
    for (int m = gw; m < MALL; m += NGW) {
        const int s = m < SEQ ? 0 : (m < MLAT ? 1 : 2);
        const f32x4* xr = (const f32x4*)(m < MLAT ? in_I_X + (size_t)m * DM : in_I_CTX + (size_t)(m - MLAT) * DM) + lane;
        f32x4* hr = (f32x4*)(WSP(float, WS_H) + (size_t)m * DM) + lane; v2u* o = (v2u*)(WSP(bf16, WS_XN) + (size_t)m * DM) + lane;
        const float* sc = MOD + (size_t)s * MODW + DM;
        float ss = 0.f;
#pragma unroll
        for (int j = 0; j < 8; ++j) { const int col = lane * 4 + 256 * j; const f32x4 v = xr[64 * j]; hr[64 * j] = v; ss += hsum4(v * v);
            const f32x4 r = v * *(const f32x4*)(in_I_N1G + col) * (*(const f32x4*)(sc + col) + 1.0f);
            o[64 * j] = (v2u){pk2(r.x, r.y), pk2(r.z, r.w)}; }
        ss = sum64(ss);
        if (lane == 0) WSP(float, WS_RS)[m] = __builtin_amdgcn_rsqf(ss * (1.f / DM) + 1e-6f);
    }
}
struct EpiScaleBias {
    static constexpr bool PERM = true, AFTER_DRAIN = false;
    bf16* O; int ldc; const float* ss; const float* bias; int bias_ld;
    __device__ __forceinline__ void operator()(const pg8::f32x4 (&acc)[2][2][4][2], const pg8::Unit& u, int wr, int wc, int fr, int fq) const {
        const int row0 = u.pm * 256 + wr * 64 + fr, col0 = u.pn * 256 + wc * 32 + 8 * fq;
        const int s = u.pm < 32 ? 0 : (u.pm < 64 ? 1 : 2);
        const float* bp = bias + (size_t)s * bias_ld + col0;
        pg8::f32x4 bv[2][2];
#pragma unroll
        for (int bj = 0; bj < 2; ++bj)
#pragma unroll
            for (int n = 0; n < 2; ++n) bv[bj][n] = *(const pg8::f32x4*)(bp + bj * 128 + 4 * n);
#pragma unroll
        for (int ai = 0; ai < 2; ++ai)
#pragma unroll
            for (int m = 0; m < 4; ++m) { const int row = row0 + ai * 128 + m * 16; const float rs = ss[row];
                bf16* rowp = O + (size_t)row * ldc + col0;
#pragma unroll
                for (int bj = 0; bj < 2; ++bj) { const pg8::f32x4 v0 = acc[ai][bj][m][0] * rs + bv[bj][0], v1 = acc[ai][bj][m][1] * rs + bv[bj][1];
                    *(v4u*)(rowp + bj * 128) = (v4u){pg8::cvt_pk_bf16(v0[0], v0[1]), pg8::cvt_pk_bf16(v0[2], v0[3]), pg8::cvt_pk_bf16(v1[0], v1[1]), pg8::cvt_pk_bf16(v1[2], v1[3])}; } }
    }
};
struct EpiResGateNorm {
    static constexpr bool PERM = true, AFTER_DRAIN = false;
    float* H; const float* mod; const float* gk; bf16* AH; float* ss;
    __device__ __forceinline__ void operator()(const pg8::f32x4 (&acc)[2][2][4][2], const pg8::Unit& u, int wr, int wc, int fr, int fq) const {
        const int row0 = u.pm * 256 + wr * 64 + fr, col0 = u.pn * 256 + wc * 32 + 8 * fq;
        const int s = u.pm < 32 ? 0 : (u.pm < 64 ? 1 : 2);
        const float* gp = mod + (size_t)s * MODW + col0; const float* kp = gk + (size_t)s * DM + col0;
        pg8::f32x4 gv[2][2], kv[2][2];
#pragma unroll
        for (int bj = 0; bj < 2; ++bj)
#pragma unroll
            for (int n = 0; n < 2; ++n) { gv[bj][n] = *(const pg8::f32x4*)(gp + bj * 128 + 4 * n); kv[bj][n] = gk ? *(const pg8::f32x4*)(kp + bj * 128 + 4 * n) : (pg8::f32x4){0.f, 0.f, 0.f, 0.f}; }
#pragma unroll
        for (int ai = 0; ai < 2; ++ai)
#pragma unroll
            for (int m = 0; m < 4; ++m) { const int row = row0 + ai * 128 + m * 16; float* rowp = H + (size_t)row * DM + col0; float sq = 0.f;
#pragma unroll
                for (int bj = 0; bj < 2; ++bj) { pg8::f32x4* p0 = (pg8::f32x4*)(rowp + bj * 128); pg8::f32x4* p1 = p0 + 1;
                    const pg8::f32x4 h0 = *p0 + gv[bj][0] * acc[ai][bj][m][0], h1 = *p1 + gv[bj][1] * acc[ai][bj][m][1];
                    *p0 = h0; *p1 = h1;
                    if (gk) { sq += (h0[0] * h0[0] + h0[1] * h0[1]) + (h0[2] * h0[2] + h0[3] * h0[3]) + (h1[0] * h1[0] + h1[1] * h1[1]) + (h1[2] * h1[2] + h1[3] * h1[3]);
                        const pg8::f32x4 a0 = h0 * kv[bj][0], a1 = h1 * kv[bj][1];
                        *(v4u*)(AH + (size_t)row * DM + col0 + bj * 128) = (v4u){pg8::cvt_pk_bf16(a0[0], a0[1]), pg8::cvt_pk_bf16(a0[2], a0[3]), pg8::cvt_pk_bf16(a1[0], a1[1]), pg8::cvt_pk_bf16(a1[2], a1[3])}; } }
                if (gk) { sq += __shfl_xor(sq, 16); sq += __shfl_xor(sq, 32); if (fq == 0) ss[(size_t)row * 32 + u.pn * 4 + wc] = sq; } }
    }
};

struct CtxSplitOrder {
    int G, c, KS, ksub;
    __device__ __forceinline__ bool next(int i, pg8::Unit& u) const { const int L = i * G + c; if (L >= 16 * KS) return false; const int r = L & 15; u.kb = (L >> 4) * ksub; u.pm = 64 + (r & 1); u.pn = r >> 1; return true; }
    __device__ __forceinline__ void a_ready(const pg8::Unit&) const {}
    __device__ __forceinline__ void done(const pg8::Unit&) const {}
};
struct EpiPartial {
    static constexpr bool PERM = true, AFTER_DRAIN = false;
    float* P; int ksub;
    __device__ __forceinline__ void operator()(const pg8::f32x4 (&acc)[2][2][4][2], const pg8::Unit& u, int wr, int wc, int fr, int fq) const {
        const int row0 = (u.pm - 64) * 256 + wr * 64 + fr, col0 = u.pn * 256 + wc * 32 + 8 * fq, ks = u.kb / ksub;
#pragma unroll
        for (int ai = 0; ai < 2; ++ai)
#pragma unroll
            for (int m = 0; m < 4; ++m) { float* rowp = P + ((size_t)ks * MCTX + row0 + ai * 128 + m * 16) * DM + col0;
#pragma unroll
                for (int bj = 0; bj < 2; ++bj) { *(pg8::f32x4*)(rowp + bj * 128) = acc[ai][bj][m][0]; *(pg8::f32x4*)(rowp + bj * 128 + 4) = acc[ai][bj][m][1]; } }
    }
};
template <int KS> __device__ __forceinline__ void ph_rs(Frame& f, int which, const float* gate, const float* gk) { launder_ws(f);
    const int gt = f.vcu * 512 + f.tid, GT = f.G * 512;
    for (int m = gt; m < MLAT; m += GT) { const f32x4* p = (const f32x4*)(WSP(float, WS_SSP) + ((size_t)which * MALL + m) * 32);
        f32x4 a = p[0];
#pragma unroll
        for (int j = 1; j < 8; ++j) a += p[j];
        WSP(float, WS_RS)[(size_t)which * MALL + m] = __builtin_amdgcn_rsqf(hsum4(a) * (1.f / DM) + 1e-6f); }
    if (KS > 0) {
        LAS float* red = (LAS float*)f.lds;
        const int lane = f.lane;
        for (int rb = f.vcu; rb < MCTX / 2; rb += f.G) { const int r = rb * 2 + (f.wave >> 2), jq = f.wave & 3, m = MLAT + r;
            f32x4* hr = (f32x4*)(WSP(float, WS_H) + (size_t)m * DM) + lane; v2u* o = (v2u*)(WSP(bf16, WS_XN) + (size_t)m * DM) + lane;
            const f32x4* pp = (const f32x4*)(WSP(float, WS_PART) + (size_t)r * DM) + lane;
            float ss = 0.f;
#pragma unroll
            for (int jj = 0; jj < 2; ++jj) { const int j = jq * 2 + jj, col = lane * 4 + 256 * j;
                f32x4 pv[KS > 0 ? KS : 1];
#pragma unroll
                for (int ks = 0; ks < KS; ++ks) pv[ks] = pp[(size_t)ks * MCTX * DM / 4 + 64 * j];
                f32x4 acc = pv[0];
#pragma unroll
                for (int ks = 1; ks < KS; ++ks) acc += pv[ks];
                const f32x4 h = hr[64 * j] + *(const f32x4*)(gate + col) * acc;
                hr[64 * j] = h; ss += hsum4(h * h);
                const f32x4 a = h * *(const f32x4*)(gk + col);
                o[64 * j] = (v2u){pk2(a.x, a.y), pk2(a.z, a.w)}; }
            ss = sum64(ss);
            __syncthreads();
            if (lane == 0) red[f.wave] = ss;
            __syncthreads();
            if (jq == 0 && lane == 0) WSP(float, WS_RS)[(size_t)which * MALL + m] = __builtin_amdgcn_rsqf(((red[f.wave] + red[f.wave + 1]) + (red[f.wave + 2] + red[f.wave + 3])) * (1.f / DM) + 1e-6f);
        }
    }
}
template <int CTRL> __device__ __forceinline__ float dpp_mov(float v) { return __builtin_bit_cast(float, __builtin_amdgcn_update_dpp(0, __builtin_bit_cast(int, v), CTRL, 0xF, 0xF, true)); }
template <int CTRL> __device__ __forceinline__ float dpp_keep(float old, float v) { return __builtin_bit_cast(float, __builtin_amdgcn_update_dpp(__builtin_bit_cast(int, old), __builtin_bit_cast(int, v), CTRL, 0xF, 0xF, false)); }
struct EpiConvGlu {
    static constexpr bool PERM = true, AFTER_DRAIN = false;
    bf16* HB; bf16* U; const float* rsv; const float* bias; const float* cw; const float* cb;
    __device__ __forceinline__ void operator()(const pg8::f32x4 (&acc)[2][2][4][2], const pg8::Unit& u, int wr, int wc, int fr, int fq) const {
        const int row0 = u.pm * 256 + wr * 64 + fr, col0 = u.pn * 256 + wc * 32 + 8 * fq, ch0 = u.pn * 128 + wc * 32 + 8 * fq;
        const int s = u.pm < 32 ? 0 : (u.pm < 64 ? 1 : 2);
        const float* bp = bias + (size_t)s * UPN + col0;
        pg8::f32x4 bu[2], bv[2], w0[2], w1[2], w2[2], cbv[2];
#pragma unroll
        for (int n = 0; n < 2; ++n) { bu[n] = *(const pg8::f32x4*)(bp + 4 * n); bv[n] = *(const pg8::f32x4*)(bp + 128 + 4 * n);
            w0[n] = *(const pg8::f32x4*)(cw + ch0 + 4 * n); w1[n] = *(const pg8::f32x4*)(cw + DFF + ch0 + 4 * n); w2[n] = *(const pg8::f32x4*)(cw + 2 * DFF + ch0 + 4 * n); cbv[n] = *(const pg8::f32x4*)(cb + ch0 + 4 * n); }
#pragma unroll
        for (int ai = 0; ai < 2; ++ai) {
            pg8::f32x4 uu[4][2];
            float rs[4];
#pragma unroll
            for (int m = 0; m < 4; ++m) { rs[m] = rsv[row0 + ai * 128 + m * 16];
#pragma unroll
                for (int n = 0; n < 2; ++n) uu[m][n] = acc[ai][0][m][n] * rs[m] + bu[n]; }
#pragma unroll
            for (int m = 0; m < 4; ++m) {
                const int row = row0 + ai * 128 + m * 16;
                const bool edge = (m == 0 && fr == 0) || (m == 3 && fr == 15);
                unsigned hw[4];
#pragma unroll
                for (int n = 0; n < 2; ++n) {
                    pg8::f32x4 g;
#pragma unroll
                    for (int i = 0; i < 4; ++i) {
                        const float pold = m > 0 ? dpp_mov<0x121>(uu[m - 1][n][i]) : 0.f, nold = m < 3 ? dpp_mov<0x12F>(uu[m + 1][n][i]) : 0.f;
                        const float up = dpp_keep<0x111>(pold, uu[m][n][i]), un = dpp_keep<0x101>(nold, uu[m][n][i]);
                        g[i] = up * w0[n][i] + uu[m][n][i] * w1[n][i] + un * w2[n][i] + cbv[n][i];
                    }
                    const pg8::f32x2 g0 = pg8::gelu_pk((pg8::f32x2){g[0], g[1]}), g1 = pg8::gelu_pk((pg8::f32x2){g[2], g[3]});
                    const pg8::f32x4 vv = acc[ai][1][m][n] * rs[m] + bv[n];
                    hw[2 * n] = pg8::cvt_pk_bf16(g0.x * vv[0], g0.y * vv[1]); hw[2 * n + 1] = pg8::cvt_pk_bf16(g1.x * vv[2], g1.y * vv[3]);
                }
                if (!edge) *(v4u*)(HB + (size_t)row * DFF + ch0) = (v4u){hw[0], hw[1], hw[2], hw[3]};
                if ((m == 0 && fr < 2) || (m == 3 && fr >= 14)) {
                    const pg8::f32x4 v0 = acc[ai][1][m][0] * rs[m] + bv[0], v1 = acc[ai][1][m][1] * rs[m] + bv[1];
                    bf16* up_ = U + (size_t)row * UPN + col0;
                    *(v4u*)(up_) = (v4u){pg8::cvt_pk_bf16(uu[m][0][0], uu[m][0][1]), pg8::cvt_pk_bf16(uu[m][0][2], uu[m][0][3]), pg8::cvt_pk_bf16(uu[m][1][0], uu[m][1][1]), pg8::cvt_pk_bf16(uu[m][1][2], uu[m][1][3])};
                    *(v4u*)(up_ + 128) = (v4u){pg8::cvt_pk_bf16(v0[0], v0[1]), pg8::cvt_pk_bf16(v0[2], v0[3]), pg8::cvt_pk_bf16(v1[0], v1[1]), pg8::cvt_pk_bf16(v1[2], v1[3])};
                }
            }
        }
    }
};
__device__ __forceinline__ void ph_convfix(Frame& f, int l, int mrows) { const float* in_I_CONVB = karg_in(I_CONVB); const float* in_I_CONVW = karg_in(I_CONVW); launder_ws(f);
    const int gt = f.vcu * 512 + f.tid, GT = f.G * 512;
    const bf16* U = WSP(bf16, WS_U); bf16* HB = WSP(bf16, WS_HB);
    const float* cw = in_I_CONVW + (size_t)l * 3 * DFF; const float* cb = in_I_CONVB + (size_t)l * DFF;
    constexpr int C8 = DFF / 8;
    for (int idx = gt; idx < (mrows / 32) * C8; idx += GT) {
        const int ri = idx / C8, c = (idx % C8) * 8, m = (ri >> 1) * 64 + ((ri & 1) ? 63 : 0), nc = (c >> 7) * 256 + (c & 127);
        const RowInfo R = row_info(m);
        const v4u z = {0u, 0u, 0u, 0u};
        const v4u uc = *(const v4u*)(U + (size_t)m * UPN + nc), vl = *(const v4u*)(U + (size_t)m * UPN + nc + 128);
        const v4u up = R.t > 0 ? *(const v4u*)(U + (size_t)(m - 1) * UPN + nc) : z, un = R.t < R.T - 1 ? *(const v4u*)(U + (size_t)(m + 1) * UPN + nc) : z;
        float r[8], gv[8];
#pragma unroll
        for (int i = 0; i < 8; ++i) {
            const unsigned wc_ = i < 2 ? uc.x : i < 4 ? uc.y : i < 6 ? uc.z : uc.w, wp_ = i < 2 ? up.x : i < 4 ? up.y : i < 6 ? up.z : up.w;
            const unsigned wn_ = i < 2 ? un.x : i < 4 ? un.y : i < 6 ? un.z : un.w, wv_ = i < 2 ? vl.x : i < 4 ? vl.y : i < 6 ? vl.z : vl.w;
            const float fc = (i & 1) ? bfhi(wc_) : bflo(wc_), fp = (i & 1) ? bfhi(wp_) : bflo(wp_), fn = (i & 1) ? bfhi(wn_) : bflo(wn_), fv = (i & 1) ? bfhi(wv_) : bflo(wv_);
            r[i] = fp * cw[c + i] + fc * cw[DFF + c + i] + fn * cw[2 * DFF + c + i] + cb[c + i]; gv[i] = fv;
        }
#pragma unroll
        for (int i = 0; i < 8; i += 2) { const f32x2 g2 = pg8::gelu_pk((f32x2){r[i], r[i + 1]}); r[i] = g2.x * gv[i]; r[i + 1] = g2.y * gv[i + 1]; }
        *(v4u*)(HB + (size_t)m * DFF + c) = (v4u){pk2(r[0], r[1]), pk2(r[2], r[3]), pk2(r[4], r[5]), pk2(r[6], r[7])};
    }
}
typedef float f32x16 __attribute__((ext_vector_type(16)));
#ifndef CHUNK_CHECK_C0
#define CHUNK_CHECK_C0 0
#define CHUNK_CHECK_C1 100000
#endif
#ifndef CK_SELFTEST_E
#define CK_SELFTEST_E 0
#endif
#ifndef CHUNK_CHECK_T1
#define CHUNK_CHECK_T1 32
#endif
constexpr int CK_C = 32, CK_NCH = SKV / CK_C;
constexpr size_t CK_REC = 24 * 1024;
__device__ __forceinline__ int ck_rho(int i, int h) { return (i & 3) + 8 * (i >> 2) + 4 * h; }
__device__ __forceinline__ bf16x8_t ck_frag(const f32x16& a, int s) {
    const v4u w = {cvtpk(a[8 * s + 0], a[8 * s + 1]), cvtpk(a[8 * s + 2], a[8 * s + 3]), cvtpk(a[8 * s + 4], a[8 * s + 5]), cvtpk(a[8 * s + 6], a[8 * s + 7])};
    return __builtin_bit_cast(bf16x8_t, w);
}
__device__ __forceinline__ f32x16 ck_mm(bf16x8_t a, bf16x8_t b, f32x16 c) { return __builtin_amdgcn_mfma_f32_32x32x16_bf16(a, b, c, 0, 0, 0); }
__device__ __forceinline__ void ck_swap32(float v, float& lo, float& hi) {
    const auto rr = __builtin_amdgcn_permlane32_swap(__float_as_uint(v), __float_as_uint(v), false, false); const unsigned r0 = rr[0], r1 = rr[1]; lo = __uint_as_float(r0); hi = __uint_as_float(r1); }
__device__ __forceinline__ float ck_sum2(float v) { float lo, hi; ck_swap32(v, lo, hi); return lo + hi; }
template <int CTRL, int RMASK> __device__ __forceinline__ float dpp_add0(float v) { return v + __builtin_bit_cast(float, __builtin_amdgcn_update_dpp(0, __builtin_bit_cast(int, v), CTRL, RMASK, 0xF, false)); }
__device__ __forceinline__ float ck_prefix32(float v) {
    v = dpp_add0<0x111, 0xF>(v); v = dpp_add0<0x112, 0xF>(v); v = dpp_add0<0x114, 0xF>(v); v = dpp_add0<0x118, 0xF>(v); v = dpp_add0<0x142, 0xA>(v);
    return v; }
__device__ __forceinline__ f32x4 exp4(f32x4 v) { return (f32x4){__expf(v.x), __expf(v.y), __expf(v.z), __expf(v.w)}; }

__device__ __forceinline__ f32x16 ck_unpack(v4u lo, v4u hi) { f32x16 r;
    r[0] = bflo(lo.x); r[1] = bfhi(lo.x); r[2] = bflo(lo.y); r[3] = bfhi(lo.y); r[4] = bflo(lo.z); r[5] = bfhi(lo.z); r[6] = bflo(lo.w); r[7] = bfhi(lo.w);
    r[8] = bflo(hi.x); r[9] = bfhi(hi.x); r[10] = bflo(hi.y); r[11] = bfhi(hi.y); r[12] = bflo(hi.z); r[13] = bfhi(hi.z); r[14] = bflo(hi.w); r[15] = bfhi(hi.w); return r; }
__device__ __forceinline__ bf16x8_t ck_ident(int s, int t, int h) {
    unsigned w[4];
#pragma unroll
    for (int p = 0; p < 4; ++p) { const int e0 = 2 * p, e1 = 2 * p + 1; const int r0 = 16 * s + 8 * (e0 >> 2) + 4 * h + (e0 & 3), r1 = 16 * s + 8 * (e1 >> 2) + 4 * h + (e1 & 3);
        w[p] = (r0 == t ? 0x3F80u : 0u) | (r1 == t ? 0x3F800000u : 0u); }
    return __builtin_bit_cast(bf16x8_t, (v4u){w[0], w[1], w[2], w[3]});
}
#if defined(CK_SELFTEST)
__device__ __forceinline__ void ck_report(Frame& f, float v) {
    unsigned u = __builtin_bit_cast(unsigned, v);
#pragma unroll
    for (int n = 1; n < 64; n <<= 1) { const unsigned o = (unsigned)__shfl_xor((int)u, n, 64); u = o > u ? o : u; }
    if (f.lane == 0) __hip_atomic_fetch_max((unsigned*)(f.ws + WS_CTL) + 8194, u, __ATOMIC_RELAXED, __HIP_MEMORY_SCOPE_AGENT);
}
#endif
  template <int MODE> __device__ __forceinline__ void ph_scanA(Frame& f, int l) { const float* in_I_KA = karg_in(I_KA); const float* in_I_KK = karg_in(I_KK); const float* in_I_MURKV = karg_in(I_MURKV); launder_ws(f);
    const bf16* Y1 = WSP(bf16, WS_Y1);
    LAS float* Lt = (LAS float*)(f.lds + f.wave * 12800);
    LAS float* QC = Lt + 1024;
    LAS v4u* PKL = (LAS v4u*)(Lt + 1024 + 64);
    LAS float* RV = Lt + 1024 + 64 + 2048;
    LAS float* PT = (LAS float*)(f.lds + 102400);
    LAS float* PA = (LAS float*)(f.lds + 133120);
    __syncthreads();
    for (int i = f.tid; i < 1536; i += NWAVES * 64) ((LAS f32x4*)PT)[i] = ((const f32x4*)(in_I_MURKV + (size_t)l * 6144))[i];
    for (int i = f.tid; i < 256; i += NWAVES * 64) { ((LAS f32x4*)(PT + 6144))[i] = ((const f32x4*)(in_I_KK + (size_t)l * CW))[i]; ((LAS f32x4*)PA)[i] = ((const f32x4*)(in_I_KA + (size_t)l * CW))[i]; }
    __syncthreads();
    const int gw = f.vcu * NWAVES + f.wave, NGW = f.G * NWAVES;
#if defined(CK_STAGGER)
    for (int k_ = (f.wave * 8 + (f.vcu & 7)) * CK_STAGGER; k_ > 0; --k_) __builtin_amdgcn_s_sleep(16);
#endif
    struct CkRaw { v4u q[2], k0[2], kn[2], ic[2], r0[2], rn[2], v0[2], vn[2]; };
    struct CkAddr { unsigned oy, oyn, o2, oc; int has, d; };
#define CK_ADDR(A_, it_, t_, h_) do { const int chain_ = (it_) / CK_NCH, c_ = (it_) % CK_NCH, b_ = chain_ >> 5, d_ = (chain_ >> 4) & 1, hd_ = chain_ & 15; \
        const int st_ = c_ * CK_C + (t_); int tt_, TT_, m_; \
        if (st_ < CTXL) { tt_ = d_ ? (CTXL - 1 - st_) : st_; TT_ = CTXL; m_ = MLAT + b_ * CTXL + tt_; } else { const int u_ = st_ - CTXL; tt_ = d_ ? (SEQ - 1 - u_) : u_; TT_ = SEQ; m_ = b_ * SEQ + tt_; } \
        const bool has_ = d_ ? (tt_ < TT_ - 1) : (tt_ > 0); const int mn_ = has_ ? (d_ ? m_ + 1 : m_ - 1) : m_; \
        A_.oy = ((unsigned)m_ * INP + hd_ * 64 + 16 * (h_)) * 2u; A_.oyn = ((unsigned)mn_ * INP + hd_ * 64 + 16 * (h_)) * 2u; A_.o2 = (((unsigned)d_ * MALL + m_) * CW + hd_ * 64 + 16 * (h_)) * 2u; \
        A_.oc = (unsigned)(hd_ * 64 + 16 * (h_)) * 4u; A_.has = has_ ? 1 : 0; A_.d = d_; } while (0)
#define CK_GLD(dst_, off_, base_, imm_) asm volatile("global_load_dwordx4 %0, %1, %2 offset:%3" : "=&v"(dst_) : "v"(off_), "s"(base_), "n"(imm_))
#define CK_LD(X, T_, A_) do { const char* wqb_ = (const char*)WSP(bf16, WS_WDEC); const char* aib_ = (const char*)WSP(bf16, WS_AIC); \
        const char* ykb_ = (const char*)Y1 + C_K * 2; const char* yrb_ = (const char*)Y1 + C_R * 2; const char* yvb_ = (const char*)Y1 + C_V * 2; \
        _Pragma("unroll") for (int j_ = 0; j_ < 2; ++j_) { \
            CK_GLD(X.q[j_], A_.o2, wqb_, 64 * (T_) + 16 * j_); CK_GLD(X.k0[j_], A_.oy, ykb_, 64 * (T_) + 16 * j_); CK_GLD(X.kn[j_], A_.oyn, ykb_, 64 * (T_) + 16 * j_); CK_GLD(X.ic[j_], A_.o2, aib_, 64 * (T_) + 16 * j_); \
            CK_GLD(X.r0[j_], A_.oy, yrb_, 64 * (T_) + 16 * j_); CK_GLD(X.rn[j_], A_.oyn, yrb_, 64 * (T_) + 16 * j_); CK_GLD(X.v0[j_], A_.oy, yvb_, 64 * (T_) + 16 * j_); CK_GLD(X.vn[j_], A_.oyn, yvb_, 64 * (T_) + 16 * j_); } } while (0)
#define CK_LDWAIT(X, N_) do { asm volatile("s_waitcnt vmcnt(" #N_ ")" : "+v"(X.q[0]), "+v"(X.q[1]), "+v"(X.k0[0]), "+v"(X.k0[1]), "+v"(X.kn[0]), "+v"(X.kn[1]), "+v"(X.ic[0]), "+v"(X.ic[1]), \
            "+v"(X.r0[0]), "+v"(X.r0[1]), "+v"(X.rn[0]), "+v"(X.rn[1]), "+v"(X.v0[0]), "+v"(X.v0[1]), "+v"(X.vn[0]), "+v"(X.vn[1])); } while (0)
#define CK_PREF2 CK_LD(RB, 1, AD);
    CkRaw RA, RB; CkAddr AD;
    { const int it0 = gw < 64 * CK_NCH ? gw : 0; CK_ADDR(AD, it0, f.lane & 31, f.lane >> 5); CK_LD(RA, 0, AD); CK_PREF2 }
    CK_LDWAIT(RA, 0); CK_LDWAIT(RB, 0);
    for (int it = gw; it < 64 * CK_NCH; it += NGW) {
        int lane_ = f.lane; asm volatile("" : "+v"(lane_));
        launder_ws(f);
        const int lane = lane_, t = lane & 31, h = lane >> 5;
        LAS float* LtW = Lt + 4 * h * 32 + t;
        const bool has = AD.has != 0;
        const LAS float* pmu = PT + AD.d * 3072 + (AD.oc >> 2); const LAS float* pkk = PT + 6144 + (AD.oc >> 2); const LAS float* pka = PA + (AD.oc >> 2);
        const f32x4 z4 = {0.f, 0.f, 0.f, 0.f};
#define CK_PC(A_, g_) (((g_) & 1) ? (v2u){A_[(g_) >> 1].z, A_[(g_) >> 1].w} : (v2u){A_[(g_) >> 1].x, A_[(g_) >> 1].y})
#define CK_FEAT(X, T_, g_, u_) do { const f32x4 qv = bf4(CK_PC(X.q, g_)); const int pf_ = 32 * (T_) + 4 * (g_); \
            f32x4 Qi; Qi.x = ck_prefix32(qv.x); Qi.y = ck_prefix32(qv.y); Qi.z = ck_prefix32(qv.z); Qi.w = ck_prefix32(qv.w);         \
            if (t == 31) *(LAS f32x4*)(QC + 32 * (T_) + 8 * (g_) + 4 * h) = Qi; \
            const f32x4 k0 = bf4(CK_PC(X.k0, g_)), kn = has ? bf4(CK_PC(X.kn, g_)) : z4, kx = k0 + *(const LAS f32x4*)(pmu + (1024 + pf_)) * (kn - k0), ic = bf4(CK_PC(X.ic, g_)), kk = kx * *(const LAS f32x4*)(pkk + pf_); \
            ss += hsum4(kk * kk); \
            const f32x4 ep = exp4(Qi), em = exp4(-Qi), emx = exp4(qv - Qi); \
            const f32x4 r0 = bf4(CK_PC(X.r0, g_)), rn = has ? bf4(CK_PC(X.rn, g_)) : z4, r = r0 + *(const LAS f32x4*)(pmu + pf_) * (rn - r0); \
            const f32x4 v0 = bf4(CK_PC(X.v0, g_)), vn = has ? bf4(CK_PC(X.vn, g_)) : z4; \
            vv[u_] = v0 + *(const LAS f32x4*)(pmu + (2048 + pf_)) * (vn - v0); \
            av[u_] = -kk * emx; rv[u_] = r * em; bv[u_] = kk * ic * ep; kv2[u_] = kx * ((ic - 1.0f) * *(const LAS f32x4*)(pka + pf_) + 1.0f) * ep; \
            asm volatile("" : "+v"(av[u_]), "+v"(rv[u_]), "+v"(bv[u_]), "+v"(kv2[u_]), "+v"(vv[u_]) :: "memory"); } while (0)
        float ss = 0.f;
        bf16x8_t Ac[2][2], Rc[2][2], Bc[2][2], Kc[2][2], Vc[2][2];
#define CK_TILE(X, T_) do { _Pragma("unroll") for (int s = 0; s < 2; ++s) { f32x4 av[2], rv[2], bv[2], kv2[2], vv[2]; \
                CK_FEAT(X, T_, 2 * s, 0); CK_FEAT(X, T_, 2 * s + 1, 1); \
                Ac[T_][s] = pack8(av[0], av[1]); Rc[T_][s] = pack8(rv[0], rv[1]); Bc[T_][s] = pack8(bv[0], bv[1]); Kc[T_][s] = pack8(kv2[0], kv2[1]); Vc[T_][s] = pack8(vv[0], vv[1]); \
                asm volatile("" : "+v"(Ac[T_][s]), "+v"(Rc[T_][s]), "+v"(Bc[T_][s]), "+v"(Kc[T_][s]), "+v"(Vc[T_][s]) :: "memory"); } } while (0)
        CK_TILE(RA, 0); CK_TILE(RB, 1);
#undef CK_TILE
#undef CK_PC
#undef CK_FEAT
        ss = ck_sum2(ss);
        const float rinv = __builtin_amdgcn_rsqf(fmaxf(ss, 1e-24f));
        if (h == 0) RV[t] = rinv;
        LDS_WAIT(); asm volatile("" ::: "memory");
#define CK_RROW(i_) (RV[8 * ((i_) >> 2) + 4 * h + ((i_) & 3)])
        const f32x16 zero16 = {0.f, 0.f, 0.f, 0.f, 0.f, 0.f, 0.f, 0.f, 0.f, 0.f, 0.f, 0.f, 0.f, 0.f, 0.f, 0.f};
        bf16x8_t Vs[2][2];
#pragma unroll
        for (int T = 0; T < 2; ++T) { f32x16 x = ck_mm(Vc[T][0], ck_ident(0, t, h), zero16); x = ck_mm(Vc[T][1], ck_ident(1, t, h), x); Vs[T][0] = ck_frag(x, 0); Vs[T][1] = ck_frag(x, 1); asm volatile("" : "+v"(Vs[T][0]), "+v"(Vs[T][1])); }
        f32x16 XW[2], XU[2];
#pragma unroll
        for (int T = 0; T < 2; ++T) { XW[T] = ck_mm(Ac[T][0], ck_ident(0, t, h), zero16); XW[T] = ck_mm(Ac[T][1], ck_ident(1, t, h), XW[T]);
#pragma unroll
            for (int i = 0; i < 16; ++i) XW[T][i] *= CK_RROW(i); }
        bf16x8_t G2f[2], G3f[2], G4f[2];
        { f32x16 g = zero16;
#pragma unroll
          for (int T = 0; T < 2; ++T)
#pragma unroll
              for (int s = 0; s < 2; ++s) g = ck_mm(Bc[T][s], Ac[T][s], g);
#pragma unroll
          for (int i = 0; i < 16; ++i) LtW[((i & 3) + 8 * (i >> 2)) * 32] = ck_rho(i, h) < t ? g[i] * (CK_RROW(i) * RV[t]) : 0.f; }
        __builtin_amdgcn_sched_barrier(0);
        { f32x16 g = zero16;
#pragma unroll
          for (int T = 0; T < 2; ++T)
#pragma unroll
              for (int s = 0; s < 2; ++s) g = ck_mm(Kc[T][s], Ac[T][s], g);
#pragma unroll
          for (int i = 0; i < 16; ++i) g[i] = ck_rho(i, h) < t ? g[i] * RV[t] : 0.f;
          G2f[0] = ck_frag(g, 0); G2f[1] = ck_frag(g, 1); asm volatile("" : "+v"(G2f[0]), "+v"(G2f[1])); }
        __builtin_amdgcn_sched_barrier(0);
        { f32x16 g = zero16;
#pragma unroll
          for (int T = 0; T < 2; ++T)
#pragma unroll
              for (int s = 0; s < 2; ++s) g = ck_mm(Bc[T][s], Rc[T][s], g);
#pragma unroll
          for (int i = 0; i < 16; ++i) g[i] = ck_rho(i, h) <= t ? g[i] * CK_RROW(i) : 0.f;
          G3f[0] = ck_frag(g, 0); G3f[1] = ck_frag(g, 1); asm volatile("" : "+v"(G3f[0]), "+v"(G3f[1])); }
        __builtin_amdgcn_sched_barrier(0);
        { f32x16 g = zero16;
#pragma unroll
          for (int T = 0; T < 2; ++T)
#pragma unroll
              for (int s = 0; s < 2; ++s) g = ck_mm(Kc[T][s], Rc[T][s], g);
#pragma unroll
          for (int i = 0; i < 16; ++i) g[i] = ck_rho(i, h) <= t ? g[i] : 0.f;
#if defined(CK_SELFTEST)
          { float rd = 0.f;
#define CK_RD(x) do { const float r_ = (x); rd = (r_ == r_) ? fmaxf(rd, r_) : 1e30f; } while (0)
            if (CK_SELFTEST & 3) { float dref = 0.f, sref = 0.f, daref = 0.f, saref = 0.f;
#pragma unroll
              for (int T = 0; T < 2; ++T)
#pragma unroll
                for (int s2 = 0; s2 < 2; ++s2) { const v4u kw = __builtin_bit_cast(v4u, Kc[T][s2]), rw = __builtin_bit_cast(v4u, Rc[T][s2]);
                    const unsigned kk_[4] = {kw.x, kw.y, kw.z, kw.w}, rr_[4] = {rw.x, rw.y, rw.z, rw.w};
#pragma unroll
                    for (int q = 0; q < 4; ++q) { const float k0_ = bflo(kk_[q]), k1_ = bfhi(kk_[q]), r0_ = bflo(rr_[q]), r1_ = bfhi(rr_[q]);
                        dref += k0_ * r0_ + k1_ * r1_; daref += fabsf(k0_ * r0_) + fabsf(k1_ * r1_);
                        saref += fabsf(__shfl_up(k0_, 1, 32) * r0_) + fabsf(__shfl_up(k1_, 1, 32) * r1_);
                        sref += __shfl_up(k0_, 1, 32) * r0_ + __shfl_up(k1_, 1, 32) * r1_; } }
              dref = ck_sum2(dref);
              sref = ck_sum2(sref);
              daref = ck_sum2(daref);
              saref = ck_sum2(saref);
              float dm = 0.f, sm = 0.f;
#pragma unroll
              for (int i = 0; i < 16; ++i) { if (ck_rho(i, h) == t) dm = g[i]; if (ck_rho(i, h) == t - 1) sm = g[i]; }
              dm = ck_sum2(dm);
              sm = ck_sum2(sm);
              if (CK_SELFTEST & 1) CK_RD(fabsf(dm - dref) / (daref + 1e-30f));
              if ((CK_SELFTEST & 2) && t >= 1) CK_RD(fabsf(sm - sref) / (saref + 1e-30f)); }
            if (CK_SELFTEST & 128) {
                const unsigned av_ = pk2((float)(t + 1), (float)(t + 1)); const v4u aw = {av_, av_, av_, av_}; const v4u one4 = {0x3F803F80u, 0x3F803F80u, 0x3F803F80u, 0x3F803F80u};
                const f32x16 dd = ck_mm(__builtin_bit_cast(bf16x8_t, aw), __builtin_bit_cast(bf16x8_t, one4), zero16);
#pragma unroll
                for (int i = 0; i < 16; ++i) CK_RD(fabsf(dd[i] - 16.0f * (ck_rho(i, h) + 1)) / (16.0f * (ck_rho(i, h) + 1))); }
            if (CK_SELFTEST & 256) {
                const unsigned bv_ = pk2((float)(t + 1), (float)(t + 1)); const v4u bw = {bv_, bv_, bv_, bv_}; const v4u one4 = {0x3F803F80u, 0x3F803F80u, 0x3F803F80u, 0x3F803F80u};
                const f32x16 dd = ck_mm(__builtin_bit_cast(bf16x8_t, one4), __builtin_bit_cast(bf16x8_t, bw), zero16);
#pragma unroll
                for (int i = 0; i < 16; ++i) CK_RD(fabsf(dd[i] - 16.0f * (t + 1)) / (16.0f * (t + 1))); }
            if (CK_SELFTEST & 32) {
                const f32x16 dd = ck_mm(Kc[0][0], Rc[0][0], zero16);
                const v4u kw = __builtin_bit_cast(v4u, Kc[0][0]), rw = __builtin_bit_cast(v4u, Rc[0][0]);
                float d1 = bflo(kw.x) * bflo(rw.x) + bfhi(kw.x) * bfhi(rw.x) + bflo(kw.y) * bflo(rw.y) + bfhi(kw.y) * bfhi(rw.y) + bflo(kw.z) * bflo(rw.z) + bfhi(kw.z) * bfhi(rw.z) + bflo(kw.w) * bflo(rw.w) + bfhi(kw.w) * bfhi(rw.w);
                float a1 = fabsf(bflo(kw.x) * bflo(rw.x)) + fabsf(bfhi(kw.x) * bfhi(rw.x)) + fabsf(bflo(kw.y) * bflo(rw.y)) + fabsf(bfhi(kw.y) * bfhi(rw.y)) + fabsf(bflo(kw.z) * bflo(rw.z)) + fabsf(bfhi(kw.z) * bfhi(rw.z)) + fabsf(bflo(kw.w) * bflo(rw.w)) + fabsf(bfhi(kw.w) * bfhi(rw.w));
                d1 = ck_sum2(d1);
                a1 = ck_sum2(a1);
                float m1 = 0.f;
#pragma unroll
                for (int i = 0; i < 16; ++i) if (ck_rho(i, h) == t) m1 = dd[i];
                m1 = ck_sum2(m1);
                CK_RD(fabsf(m1 - d1) / (a1 + 1e-30f)); }
            if (CK_SELFTEST & (4096 | 65536)) CK_RD(rdq);
            ck_report(f, rd); }
#endif
          G4f[0] = ck_frag(g, 0); G4f[1] = ck_frag(g, 1); asm volatile("" : "+v"(G4f[0]), "+v"(G4f[1])); }
        __builtin_amdgcn_sched_barrier(0);
        bf16x8_t Bs[2][2], Ks[2][2];
        LDS_WAIT(); asm volatile("" ::: "memory");
#pragma unroll
        for (int T = 0; T < 2; ++T) { const float gc = __expf(-QC[32 * T + t]);
            f32x16 x = ck_mm(Bc[T][0], ck_ident(0, t, h), zero16); x = ck_mm(Bc[T][1], ck_ident(1, t, h), x);
#pragma unroll
            for (int i = 0; i < 16; ++i) x[i] *= gc * CK_RROW(i);
            Bs[T][0] = ck_frag(x, 0); Bs[T][1] = ck_frag(x, 1);
            x = ck_mm(Kc[T][0], ck_ident(0, t, h), zero16); x = ck_mm(Kc[T][1], ck_ident(1, t, h), x); x = x * gc; Ks[T][0] = ck_frag(x, 0); Ks[T][1] = ck_frag(x, 1);
            asm volatile("" : "+v"(Bs[T][0]), "+v"(Bs[T][1]), "+v"(Ks[T][0]), "+v"(Ks[T][1])); }
#pragma unroll
        for (int T = 0; T < 2; ++T)
#pragma unroll
            for (int s2 = 0; s2 < 2; ++s2) PKL[(T * 2 + s2) * 64 + lane] = __builtin_bit_cast(v4u, Rc[T][s2]);
        PKL[4 * 64 + lane] = __builtin_bit_cast(v4u, G3f[0]); PKL[5 * 64 + lane] = __builtin_bit_cast(v4u, G3f[1]); PKL[6 * 64 + lane] = __builtin_bit_cast(v4u, G4f[0]); PKL[7 * 64 + lane] = __builtin_bit_cast(v4u, G4f[1]);
        LDS_WAIT(); asm volatile("" ::: "memory");
#define CK_CFLD(dst_, p_) do { _Pragma("unroll") for (int g4 = 0; g4 < 4; ++g4) if (8 * g4 + 4 + 3 > (p_)) dst_[g4] = *(const LAS f32x4*)(Lt + (p_) * 32 + 8 * g4 + 4 * h); } while (0)
#define CK_SOLVE2(X0, X1) do { f32x4 cfa_[4], cfb_[4]; CK_CFLD(cfa_, 0); \
        _Pragma("unroll") for (int p = 0; p < 31; ++p) { \
            const int ip = (p & 3) + 4 * (p >> 3), hp = (p >> 2) & 1;               \
            if (p + 1 < 31) { if (p & 1) CK_CFLD(cfa_, p + 1); else CK_CFLD(cfb_, p + 1); }         \
            float xp0, xp1; \
            { const float xv_ = X0[ip]; float lo_, hi_; ck_swap32(xv_, lo_, hi_); xp0 = hp ? hi_ : lo_; } \
            { const float xv_ = X1[ip]; float lo_, hi_; ck_swap32(xv_, lo_, hi_); xp1 = hp ? hi_ : lo_; } \
            _Pragma("unroll") for (int g4 = 0; g4 < 4; ++g4) { if (8 * g4 + 4 + 3 <= p) continue;       \
                const f32x4 cf = (p & 1) ? cfb_[g4] : cfa_[g4]; \
                _Pragma("unroll") for (int e = 0; e < 4; ++e) { const int i = 4 * g4 + e; X0[i] += cf[e] * xp0; X1[i] += cf[e] * xp1; } } \
            asm volatile("" ::: "memory"); } } while (0)
        CK_SOLVE2(XW[0], XW[1]);
        bf16x8_t Uf[2][2];
        int lane_q = lane; asm volatile("" : "+v"(lane_q));
        const int tq = lane_q & 31, hq = lane_q >> 5;
        v4u* rec = (v4u*)(f.ws + WS_CK + (size_t)it * CK_REC) + lane_q;
#define CK_ST(r_, x_) do { const v4u sv_ = (x_); if (MODE == 0) __builtin_nontemporal_store(sv_, &rec[64 * (r_)]); else asm volatile("" :: "v"(sv_)); } while (0)
        { bf16x8_t Wf[2][2];
#pragma unroll
          for (int T = 0; T < 2; ++T) { Wf[T][0] = ck_frag(XW[T], 0); Wf[T][1] = ck_frag(XW[T], 1); }
          asm volatile("" : "+v"(Wf[0][0]), "+v"(Wf[0][1]), "+v"(Wf[1][0]), "+v"(Wf[1][1]));
#pragma unroll
          for (int Ti = 0; Ti < 2; ++Ti)
#pragma unroll
              for (int To = 0; To < 2; ++To) { f32x16 mt = ck_mm(Wf[Ti][0], Bs[To][0], zero16); mt = ck_mm(Wf[Ti][1], Bs[To][1], mt);
                  if (Ti == To) { const float gc = __expf(-QC[32 * To + tq]);
#pragma unroll
                      for (int i = 0; i < 16; ++i) mt[i] += (ck_rho(i, hq) == tq) ? gc : 0.f; }
                  CK_ST(((Ti * 2 + To) * 2 + 0), __builtin_bit_cast(v4u, ck_frag(mt, 0))); CK_ST(((Ti * 2 + To) * 2 + 1), __builtin_bit_cast(v4u, ck_frag(mt, 1))); asm volatile("" ::: "memory"); }
          { const bf16x8_t g30 = __builtin_bit_cast(bf16x8_t, PKL[4 * 64 + lane_q]), g31 = __builtin_bit_cast(bf16x8_t, PKL[5 * 64 + lane_q]);
#pragma unroll
            for (int Tc = 0; Tc < 2; ++Tc) { f32x16 p1 = ck_unpack(PKL[(Tc * 2 + 0) * 64 + lane_q], PKL[(Tc * 2 + 1) * 64 + lane_q]);
                p1 = ck_mm(Wf[Tc][0], g30, p1); p1 = ck_mm(Wf[Tc][1], g31, p1);
                CK_ST((16 + Tc * 2 + 0), __builtin_bit_cast(v4u, ck_frag(p1, 0))); CK_ST((16 + Tc * 2 + 1), __builtin_bit_cast(v4u, ck_frag(p1, 1))); asm volatile("" ::: "memory"); } } }
#pragma unroll
        for (int T = 0; T < 2; ++T) { XU[T] = ck_mm(G2f[0], Vs[T][0], zero16); XU[T] = ck_mm(G2f[1], Vs[T][1], XU[T]); }
        CK_SOLVE2(XU[0], XU[1]);
#if defined(PROBE_SOLVE)
        { f32x16 D0 = XU[0], D1 = XU[1]; CK_SOLVE2(D0, D1); asm volatile("" :: "v"(D0), "v"(D1)); }
        { f32x16 D0 = XU[1], D1 = XU[0]; CK_SOLVE2(D0, D1); asm volatile("" :: "v"(D0), "v"(D1)); }
#endif
#undef CK_SOLVE2
#undef CK_CFLD
#pragma unroll
        for (int T = 0; T < 2; ++T) { Uf[T][0] = ck_frag(XU[T], 0); Uf[T][1] = ck_frag(XU[T], 1); }
        { const int itn = (it + NGW < 64 * CK_NCH) ? it + NGW : it; CK_ADDR(AD, itn, tq, hq); CK_LD(RA, 0, AD); CK_PREF2 }
        asm volatile("" ::: "memory");
#pragma unroll
        for (int To = 0; To < 2; ++To)
#pragma unroll
            for (int Tn = 0; Tn < 2; ++Tn) { f32x16 nn = ck_mm(Bs[To][0], Uf[Tn][0], zero16); nn = ck_mm(Bs[To][1], Uf[Tn][1], nn); nn = ck_mm(Ks[To][0], Vs[Tn][0], nn); nn = ck_mm(Ks[To][1], Vs[Tn][1], nn);
                CK_ST((8 + (Tn * 2 + To) * 2 + 0), __builtin_bit_cast(v4u, ck_frag(nn, 0))); CK_ST((8 + (Tn * 2 + To) * 2 + 1), __builtin_bit_cast(v4u, ck_frag(nn, 1))); asm volatile("" ::: "memory"); }
        G3f[0] = __builtin_bit_cast(bf16x8_t, PKL[4 * 64 + lane_q]); G3f[1] = __builtin_bit_cast(bf16x8_t, PKL[5 * 64 + lane_q]);
        G4f[0] = __builtin_bit_cast(bf16x8_t, PKL[6 * 64 + lane_q]); G4f[1] = __builtin_bit_cast(bf16x8_t, PKL[7 * 64 + lane_q]);
#pragma unroll
        for (int Tn = 0; Tn < 2; ++Tn) { f32x16 y0 = ck_mm(G3f[0], Uf[Tn][0], zero16); y0 = ck_mm(G3f[1], Uf[Tn][1], y0); y0 = ck_mm(G4f[0], Vs[Tn][0], y0); y0 = ck_mm(G4f[1], Vs[Tn][1], y0);
            CK_ST((20 + Tn * 2 + 0), __builtin_bit_cast(v4u, ck_frag(y0, 0))); CK_ST((20 + Tn * 2 + 1), __builtin_bit_cast(v4u, ck_frag(y0, 1))); asm volatile("" ::: "memory"); }
        LDS_WAIT(); asm volatile("" ::: "memory");
        if (MODE == 0) { CK_LDWAIT(RA, 12); CK_LDWAIT(RB, 12); } else { CK_LDWAIT(RA, 0); CK_LDWAIT(RB, 0); }
    }
#undef CK_ADDR
#undef CK_LD
#undef CK_ST
#undef CK_PREF2
#undef CK_GLD
#undef CK_LDWAIT
}
template <int CHECK> __device__ __forceinline__ void ph_scanB(Frame& f, int l, int item_lo, int item_step) { launder_ws(f);
    LAS v4u* SL = (LAS v4u*)f.lds;
    LAS v4u* SFB = SL + 3 * 24 * 64;
    const int lane = f.lane;
    for (int it = item_lo + f.vcu; it < 64; it += item_step) {
        const int chain = it, b = chain >> 5, d = (chain >> 4) & 1, hd = chain & 15;
        if (f.wave >= 4) {
            const int w = f.wave - 4;
            const v4u* rec0 = (const v4u*)(f.ws + WS_CK + (size_t)chain * CK_NCH * CK_REC) + lane + 64 * w;
            struct LSet { v4u v0, v1, v2, v3, v4, v5; };
            LSet L0, L1, L2, L3, L4, L5, L6, L7;
#define CKB_LOAD(X, c) do { const v4u* rp_ = rec0 + (size_t)(c) * (CK_REC / 16); X.v0 = __builtin_nontemporal_load(rp_); X.v1 = __builtin_nontemporal_load(rp_ + 64 * 4); X.v2 = __builtin_nontemporal_load(rp_ + 64 * 8); X.v3 = __builtin_nontemporal_load(rp_ + 64 * 12); X.v4 = __builtin_nontemporal_load(rp_ + 64 * 16); X.v5 = __builtin_nontemporal_load(rp_ + 64 * 20); } while (0)
#define CKB_PUT(X, sb_) do { (sb_)[64 * w] = X.v0; (sb_)[64 * (4 + w)] = X.v1; (sb_)[64 * (8 + w)] = X.v2; (sb_)[64 * (12 + w)] = X.v3; (sb_)[64 * (16 + w)] = X.v4; (sb_)[64 * (20 + w)] = X.v5; } while (0)
            int sl = 1;
#define CKB_IVAL(c, XP, XL) do { CKB_PUT(XP, SL + sl * 24 * 64 + lane); sl = sl == 2 ? 0 : sl + 1; { const int cl_ = (c) + 8 < CK_NCH ? (c) + 8 : CK_NCH - 1; CKB_LOAD(XL, cl_); } LDS_WAIT(); __builtin_amdgcn_s_barrier(); } while (0)
            CKB_LOAD(L0, 0); CKB_LOAD(L1, 1); CKB_LOAD(L2, 2); CKB_LOAD(L3, 3); CKB_LOAD(L4, 4); CKB_LOAD(L5, 5); CKB_LOAD(L6, 6); CKB_LOAD(L7, 7);
            CKB_PUT(L0, SL + lane);
            LDS_WAIT(); __builtin_amdgcn_s_barrier();
            static_assert(CK_NCH % 8 == 0, "loader loop unrolled by eight register sets");
            for (int c = 0; c < CK_NCH; c += 8) {
                CKB_IVAL(c, L1, L0); CKB_IVAL(c + 1, L2, L1); CKB_IVAL(c + 2, L3, L2); CKB_IVAL(c + 3, L4, L3); CKB_IVAL(c + 4, L5, L4); CKB_IVAL(c + 5, L6, L5); CKB_IVAL(c + 6, L7, L6); CKB_IVAL(c + 7, L0, L7);
            }
            LDS_WAIT(); __builtin_amdgcn_s_barrier();
#undef CKB_LOAD
#undef CKB_PUT
#undef CKB_IVAL
        } else if (f.wave < 2) {
            const int Tn = f.wave;
            const f32x16 zero16 = {0.f, 0.f, 0.f, 0.f, 0.f, 0.f, 0.f, 0.f, 0.f, 0.f, 0.f, 0.f, 0.f, 0.f, 0.f, 0.f};
            f32x16 ST[2] = {zero16, zero16};
            __builtin_amdgcn_s_setprio(3);
            LDS_WAIT(); __builtin_amdgcn_s_barrier();
            int sl = 0;
            for (int c = 0; c < CK_NCH; ++c) {
                const LAS v4u* sp = SL + sl * 24 * 64 + lane; sl = sl == 2 ? 0 : sl + 1;
                LAS v4u* sf = SFB + ((c & 1) * 2 + Tn) * 4 * 64 + lane;
                v4u rm[8], rn[4];
#pragma unroll
                for (int k = 0; k < 8; ++k) rm[k] = sp[64 * k];
#pragma unroll
                for (int k = 0; k < 4; ++k) rn[k] = sp[64 * (8 + 4 * Tn + k)];
                bf16x8_t Sf[2][2];
#pragma unroll
                for (int Ti = 0; Ti < 2; ++Ti) { Sf[Ti][0] = ck_frag(ST[Ti], 0); Sf[Ti][1] = ck_frag(ST[Ti], 1); }
#pragma unroll
                for (int Ti = 0; Ti < 2; ++Ti) { sf[64 * (Ti * 2 + 0)] = __builtin_bit_cast(v4u, Sf[Ti][0]); sf[64 * (Ti * 2 + 1)] = __builtin_bit_cast(v4u, Sf[Ti][1]); }
                asm volatile("s_waitcnt lgkmcnt(0)" : "+v"(rm[0]), "+v"(rm[1]), "+v"(rm[2]), "+v"(rm[3]), "+v"(rm[4]), "+v"(rm[5]), "+v"(rm[6]), "+v"(rm[7]) :: "memory");
                asm volatile("" : "+v"(rn[0]), "+v"(rn[1]), "+v"(rn[2]), "+v"(rn[3]));
#pragma unroll
                for (int To = 0; To < 2; ++To) { f32x16 sn = ck_unpack(rn[To * 2], rn[To * 2 + 1]);
#pragma unroll
                    for (int Ti = 0; Ti < 2; ++Ti)
#pragma unroll
                        for (int s = 0; s < 2; ++s) sn = ck_mm(__builtin_bit_cast(bf16x8_t, rm[(Ti * 2 + To) * 2 + s]), Sf[Ti][s], sn);
                    ST[To] = sn; }
                LDS_WAIT(); __builtin_amdgcn_s_barrier();
            }
            __builtin_amdgcn_s_setprio(0);
            LDS_WAIT(); __builtin_amdgcn_s_barrier();
        } else {
            const int Tn = f.wave - 2, t = lane & 31, h = lane >> 5;
            const unsigned voff = (unsigned)(32 * Tn + 16 * ((t >> 2) & 1) + 4 * (t >> 3) + (t & 3)) + (unsigned)(4 * CW) * (unsigned)(d ? 1 - h : h);
            const float* ysu = WSP(float, WS_YS) + (size_t)d * MALL * CW + hd * 64;
            LDS_WAIT(); __builtin_amdgcn_s_barrier();
            LDS_WAIT(); __builtin_amdgcn_s_barrier();
            int sl = 0;
            for (int c = 0; c < CK_NCH; ++c) {
                const LAS v4u* sp = SL + sl * 24 * 64 + lane; sl = sl == 2 ? 0 : sl + 1;
                const LAS v4u* sf = SFB + ((c & 1) * 2 + Tn) * 4 * 64 + lane;
                v4u rs[4], rp[4], ry[2];
#pragma unroll
                for (int k = 0; k < 4; ++k) rs[k] = sf[64 * k];
#pragma unroll
                for (int k = 0; k < 4; ++k) rp[k] = sp[64 * (16 + k)];
                ry[0] = sp[64 * (20 + 2 * Tn)]; ry[1] = sp[64 * (21 + 2 * Tn)];
                asm volatile("s_waitcnt lgkmcnt(0)" : "+v"(rs[0]), "+v"(rs[1]), "+v"(rs[2]), "+v"(rs[3]), "+v"(rp[0]), "+v"(rp[1]), "+v"(rp[2]), "+v"(rp[3]), "+v"(ry[0]), "+v"(ry[1]) :: "memory");
                f32x16 yv = ck_unpack(ry[0], ry[1]);
#pragma unroll
                for (int k = 0; k < 4; ++k) yv = ck_mm(__builtin_bit_cast(bf16x8_t, rp[k]), __builtin_bit_cast(bf16x8_t, rs[k]), yv);
                { const int st0 = c * CK_C; int seg, pos0;
                  if (st0 < CTXL) { seg = MLAT + b * CTXL; pos0 = d ? (CTXL - 1 - st0) : st0; } else { seg = b * SEQ; pos0 = d ? (SEQ - 1 - (st0 - CTXL)) : (st0 - CTXL); }
                  const int mb = seg + pos0 - (d ? 4 : 0);
#pragma unroll
                  for (int i = 0; i < 16; ++i) { const int ci = (i & 3) + 8 * (i >> 2); const int mi = d ? mb - ci : mb + ci;
                    if (CHECK == 0) ((float*)ysu + (size_t)mi * CW)[voff] = yv[i]; else asm volatile("" :: "v"(yv[i])); } }
                LDS_WAIT(); __builtin_amdgcn_s_barrier();
            }
        }
        __syncthreads();
    }
}
#ifndef NA_BSLOTS
#define NA_BSLOTS 0
#endif
constexpr int GP_LAYER0 = 3, GP_PER_LAYER = 12, GP_FINAL = GP_LAYER0 + GP_PER_LAYER * DEPTH, GP_COUNT = GP_FINAL + 1;
#ifndef MK_ONE_LAUNCH
#define MK_ONE_LAUNCH 1
#endif
__global__ void __launch_bounds__(NWAVES * 64, 2) fwd(Args A) {
    extern __shared__ __attribute__((aligned(16))) unsigned char lds_raw[];
    Frame f;
    f.lds = (LAS unsigned char*)lds_raw;
    f.tid = threadIdx.x; f.lane = f.tid & 63; f.wave = __builtin_amdgcn_readfirstlane(f.tid >> 6);
    f.G = gridDim.x; { const int bx = blockIdx.x; f.vcu = (f.G % 8 == 0) ? (bx % 8) * (f.G / 8) + bx / 8 : bx; }
    f.ws = (GAS unsigned char*)A.ws;
    volatile LAS unsigned* MISC = (volatile LAS unsigned*)(f.lds + MISC_OFF);
    for (int u = f.tid; u < (LDS_BYTES - LDSCTL_OFF) / 4; u += NWAVES * 64) ((LAS unsigned*)(f.lds + LDSCTL_OFF))[u] = 0u;
    __syncthreads();
    unsigned* ctl = (unsigned*)WSP(unsigned, WS_CTL);
    XcdBarrier bar; bar.bar = ctl + CW_BAR; bar.x = 0; bar.st = MISC + 8; bar.wv = f.wave;
    if (A.use_bar) bar = xcd_barrier_post(ctl + CW_BAR, MISC + 8, f.wave);
    const int lo = A.gp_lo, hi = A.gp_hi;
#define IN(k) (lo <= (k) && (k) < hi)
#define BAR_AFTER(k) do { if (IN(k) && hi > (k) + 1) xcd_barrier(bar); } while (0)

    if (IN(0)) { ph_convert(f); ph_lora_weights(f); }
    BAR_AFTER(0);
    if (IN(1)) ph_modsum(f);
    BAR_AFTER(1);
    if (IN(2)) ph_setup2(f);
    BAR_AFTER(2);
    for (int l = 0; l < DEPTH; ++l) {
        const int g0 = GP_LAYER0 + GP_PER_LAYER * l;
        const bool lastl = (l == DEPTH - 1);
        const int mrows = lastl ? MLAT : MALL;
        if (IN(g0 + 0) && l > 0) ph_rs<11>(f, 0, WSP(float, WS_MOD) + (size_t)((l - 1) * 3 + 2) * MODW + 5 * DM, WSP(float, WS_GK) + (size_t)((l * 2 + 0) * 3 + 2) * DM);
        if (l > 0) BAR_AFTER(g0 + 0);
        if (IN(g0 + 1)) {
            launder_ws(f); pg8::Gemm g{WSP(bf16, WS_XN), WSP(bf16, WS_WIN) + (size_t)l * INP * DM, MALL, INP, DM}; pg8::StaticOrder S; S.init(MALL, INP, f.G, (int)blockIdx.x);
            EpiScaleBias E{WSP(bf16, WS_Y1), INP, WSP(float, WS_RS), WSP(float, WS_BIAS1) + (size_t)l * 3 * INP, INP};
            pg8::gemm_phase<EpiScaleBias, pg8::StaticOrder, true, true>(f.lds, g, S, E, f.wave);
        }
        BAR_AFTER(g0 + 1);
        if (IN(g0 + 2)) { ph_prep(f, l); ph_vat(f); ph_lora2(f, l); }
        BAR_AFTER(g0 + 2);
#if defined(SEQ_SCAN)
        if (IN(g0 + 3)) { for (int s_ = f.vcu; s_ < 1024; s_ += f.G) ph_na(f, l, s_, 1); if (!lastl) ph_ctxattn(f, 0); }
        if (IN(g0 + 4)) { launder_ws(f);
            const attn_body::AttnTensors AT{(const attn_body::bf16*)WSP(bf16, WS_QBP), (const attn_body::bf16*)WSP(bf16, WS_KBP), (const attn_body::bf16*)WSP(bf16, WS_VBP), (attn_body::bf16*)WSP(bf16, WS_OB)};
            attn_body::attn_phase<8>((char*)lds_raw, AT, f.vcu, f.G, f.wave);
        }
        if (IN(g0 + 5)) ph_scan2(f, l);
#if defined(CHUNK_CHECK)
        if (IN(g0 + 5)) { xcd_barrier(bar); ph_scanA<0>(f, l); xcd_barrier(bar); ph_scanB<1>(f, l, 0, f.G); }
#endif
#else
        if (IN(g0 + 3)) { ph_scanA<0>(f, l);
#if defined(PROBE_A2)
            ph_scanA<PROBE_A2 - 1>(f, l);
#endif
        }
        BAR_AFTER(g0 + 3);
        if (IN(g0 + 4)) {
            if (f.G == 256) {
                if (f.vcu < 64) { ph_scanB<0>(f, l, 0, f.G);
#if defined(PROBE_B2)
                    ph_scanB<PROBE_B2 - 1>(f, l, 0, f.G);
#endif
                    ph_na(f, l, 960 + f.vcu, NA_BSLOTS);
                } else if (NA_BSLOTS) ph_na(f, l, 5 * (f.vcu - 64), 5); else if (f.vcu < 128) ph_na(f, l, 6 * (f.vcu - 64), 6); else ph_na(f, l, 384 + 5 * (f.vcu - 128), 5); }
            else { ph_scanB<0>(f, l, 0, f.G); for (int s_ = f.vcu; s_ < 1024; s_ += f.G) ph_na(f, l, s_, 1); }
            if (!lastl) ph_ctxattn(f, 128);
        }
        if (IN(g0 + 5)) { __syncthreads(); launder_ws(f);
            const attn_body::AttnTensors AT{(const attn_body::bf16*)WSP(bf16, WS_QBP), (const attn_body::bf16*)WSP(bf16, WS_KBP), (const attn_body::bf16*)WSP(bf16, WS_VBP), (attn_body::bf16*)WSP(bf16, WS_OB)};
            attn_body::attn_phase<8>((char*)lds_raw, AT, f.vcu, f.G, f.wave);
        }
#endif
        BAR_AFTER(g0 + 5);
        if (IN(g0 + 6)) ph_mix(f, l, mrows);
        BAR_AFTER(g0 + 6);
        if (IN(g0 + 7)) {
            launder_ws(f); pg8::Gemm g{WSP(bf16, WS_MIX), WSP(bf16, WS_WOUT) + (size_t)l * DM * DM, MLAT, DM, DM}; pg8::StaticOrder S; S.init(MLAT, DM, f.G, (int)blockIdx.x);
            EpiResGateNorm E{WSP(float, WS_H), WSP(float, WS_MOD) + (size_t)l * 3 * MODW + 2 * DM, WSP(float, WS_GK) + (size_t)(l * 2 + 1) * 3 * DM, WSP(bf16, WS_XN), WSP(float, WS_SSP) + (size_t)MALL * 32};
            pg8::gemm_phase<EpiResGateNorm, pg8::StaticOrder, true, true>(f.lds, g, S, E, f.wave);
            if (!lastl) { pg8::Gemm g2{WSP(bf16, WS_MIX), WSP(bf16, WS_WOUT) + (size_t)l * DM * DM, MALL, DM, 256, DM}; CtxSplitOrder S2{f.G, (int)blockIdx.x, 8, 256}; EpiPartial E2{WSP(float, WS_PART), 256};
                pg8::gemm_phase<EpiPartial, CtxSplitOrder, true, true>(f.lds, g2, S2, E2, f.wave); }
        }
        BAR_AFTER(g0 + 7);
        if (IN(g0 + 8)) { const float* gate_ = WSP(float, WS_MOD) + (size_t)(l * 3 + 2) * MODW + 2 * DM; const float* gk_ = WSP(float, WS_GK) + (size_t)((l * 2 + 1) * 3 + 2) * DM;
            if (lastl) ph_rs<0>(f, 1, gate_, gk_); else ph_rs<8>(f, 1, gate_, gk_); }
        BAR_AFTER(g0 + 8);
        if (IN(g0 + 9)) {
            launder_ws(f); pg8::Gemm g{WSP(bf16, WS_XN), WSP(bf16, WS_WUP) + (size_t)l * UPN * DM, mrows, UPN, DM}; pg8::StaticOrder S; S.init(mrows, UPN, f.G, (int)blockIdx.x);
            const float* cw_ = karg_in(I_CONVW) + (size_t)l * 3 * DFF; const float* cb_ = karg_in(I_CONVB) + (size_t)l * DFF;
            EpiConvGlu E{WSP(bf16, WS_HB), WSP(bf16, WS_U), WSP(float, WS_RS) + MALL, WSP(float, WS_BIAS3) + (size_t)l * 3 * UPN, cw_, cb_};
            pg8::gemm_phase<EpiConvGlu, pg8::StaticOrder, true, true>(f.lds, g, S, E, f.wave);
        }
        BAR_AFTER(g0 + 9);
        if (IN(g0 + 10)) ph_convfix(f, l, mrows);
        BAR_AFTER(g0 + 10);
        if (IN(g0 + 11)) {
            launder_ws(f); pg8::Gemm g{WSP(bf16, WS_HB), WSP(bf16, WS_WDN) + (size_t)l * DM * DFF, MLAT, DM, DFF}; pg8::StaticOrder S; S.init(MLAT, DM, f.G, (int)blockIdx.x);
            EpiResGateNorm E{WSP(float, WS_H), WSP(float, WS_MOD) + (size_t)l * 3 * MODW + 5 * DM, lastl ? (const float*)nullptr : (const float*)(WSP(float, WS_GK) + (size_t)((l + 1) * 2 + 0) * 3 * DM), WSP(bf16, WS_XN), WSP(float, WS_SSP)};
            pg8::gemm_phase<EpiResGateNorm, pg8::StaticOrder, true, true>(f.lds, g, S, E, f.wave);
            if (!lastl) { pg8::Gemm g2{WSP(bf16, WS_HB), WSP(bf16, WS_WDN) + (size_t)l * DM * DFF, MALL, DM, 512, DFF}; CtxSplitOrder S2{f.G, (int)blockIdx.x, 11, 512}; EpiPartial E2{WSP(float, WS_PART), 512};
                pg8::gemm_phase<EpiPartial, CtxSplitOrder, true, true>(f.lds, g2, S2, E2, f.wave); }
        }
        BAR_AFTER(g0 + 11);
    }
    if (IN(GP_FINAL)) ph_final(f);
#if defined(CK_READOUT)
    if (IN(GP_FINAL)) { xcd_barrier(bar);
        if (blockIdx.x == 0 && f.tid == 0) { const float* cw_ = (const float*)(f.ws + WS_CTL) + 8192; const float e_ = __hip_atomic_load(cw_, __ATOMIC_RELAXED, __HIP_MEMORY_SCOPE_AGENT), r_ = __hip_atomic_load(cw_ + 1, __ATOMIC_RELAXED, __HIP_MEMORY_SCOPE_AGENT);
            const float m_ = __builtin_bit_cast(float, __hip_atomic_load((const unsigned*)cw_ + 2, __ATOMIC_RELAXED, __HIP_MEMORY_SCOPE_AGENT));
            float v_ = (CK_READOUT == 1) ? sqrtf(e_ / r_) : m_;
            if (CK_READOUT == 1 && v_ == v_ && v_ > 0.f) v_ = exp2f(rintf(log2f(v_) * 8.0f) * 0.125f);
            float* o_ = (float*)karg_in(33); o_[0] = (v_ == v_) ? fminf(v_ * 1.0e6f, 1.0e9f) : 4.0e9f; } }
#elif defined(CHUNK_CHECK)
    if (IN(GP_FINAL)) { const float* cw_ = (const float*)(f.ws + WS_CTL) + 8192; const float e_ = __hip_atomic_load(cw_, __ATOMIC_RELAXED, __HIP_MEMORY_SCOPE_AGENT), r_ = __hip_atomic_load(cw_ + 1, __ATOMIC_RELAXED, __HIP_MEMORY_SCOPE_AGENT);
        if (!(e_ <= CHUNK_CHECK * r_)) { __syncthreads(); float* o_ = (float*)karg_in(33); for (int i = f.vcu * 512 + f.tid; i < MLAT * DM; i += f.G * 512) o_[i] = __builtin_nanf(""); } }
#endif
#undef IN
#undef BAR_AFTER
}

extern "C" void kernel_launch(void* const* d_in, const int* in_sizes, int n_in, void* d_out, int out_size, void* d_ws, size_t ws_size, hipStream_t stream) {
    static int grid = 0;
    if (grid == 0) {
        if (n_in != 33 || in_sizes[0] != MLAT * DM || out_size != MLAT * DM || ws_size < WS_END) {
            fprintf(stderr, "kernel_launch: unexpected shapes (n_in %d, in0 %d, out %d, ws %zu); nothing launched\n", n_in, n_in > 0 ? in_sizes[0] : -1, out_size, ws_size); grid = -1; return; }
        int dev = 0, cus = 0;
        if (hipGetDevice(&dev) != hipSuccess || hipDeviceGetAttribute(&cus, hipDeviceAttributeMultiprocessorCount, dev) != hipSuccess) { grid = -1; return; }
        if (hipFuncSetAttribute((const void*)fwd, hipFuncAttributeMaxDynamicSharedMemorySize, LDS_BYTES) != hipSuccess) { fprintf(stderr, "kernel_launch: hipFuncSetAttribute failed\n"); grid = -1; return; }
        (void)hipGetLastError();
        grid = cus;
    }
    if (grid < 0) return;
    if (hipMemsetAsync((char*)d_ws + WS_CTL, 0, CTL_ZERO_BYTES, stream) != hipSuccess) return;
    Args a{};
    for (int i = 0; i < 33; ++i) a.in[i] = (const float*)d_in[i];
    a.out = (float*)d_out; a.ws = (unsigned char*)d_ws; a.pad = 0;
#if MK_ONE_LAUNCH
    a.gp_lo = 0; a.gp_hi = GP_COUNT; a.use_bar = 1;
    hipLaunchKernelGGL(fwd, dim3(grid), dim3(NWAVES * 64), LDS_BYTES, stream, a);
#else
    for (int gp = 0; gp < GP_COUNT; ++gp) {
        a.gp_lo = gp; a.gp_hi = gp + 1; a.use_bar = 0;
        hipLaunchKernelGGL(fwd, dim3(grid), dim3(NWAVES * 64), LDS_BYTES, stream, a);
    }
#endif
}
```

```cpp
#include <hip/hip_runtime.h>
#include <hip/hip_bf16.h>
#include <cstdio>
#include <cstdint>
#include <cmath>
namespace pg8 {
#define PG8_LAS __attribute__((address_space(3)))
typedef unsigned short bf16_t;
typedef short bf16x8 __attribute__((ext_vector_type(8)));
typedef float f32x4 __attribute__((ext_vector_type(4)));
typedef unsigned u32x4 __attribute__((ext_vector_type(4)));
constexpr int BM = 256, BK = 64, HALF = 128, HTB = HALF * BK * 2  , STAGE_BYTES = 8 * HTB, NXCD = 8, WGM = 8;

__host__ __device__ __forceinline__ int lds_byte(int r, int c) { const int st = (r >> 4) * 2 + (c >> 5), rr = r & 15, cc = c & 31, ob = rr * 64 + cc * 2; return st * 1024 + (ob ^ (((ob >> 9) & 1) << 5)); }
__host__ __device__ __forceinline__ void stage_rc(int b, int& R, int& C) { const int st = b / 1024, sb = b % 1024, swz = sb ^ (((sb >> 9) & 1) << 5); R = (st >> 1) * 16 + swz / 64; C = (st & 1) * 32 + (swz % 64) / 2; }
__host__ __device__ __forceinline__ int perm32(int rho) { const int n = rho >> 4, i = rho & 15; return 8 * (i >> 2) + 4 * n + (i & 3); }

struct Unit { int pm, pn, kb; };
struct Gemm { const bf16_t* A; const bf16_t* Bt; int M, N, K; int ld = 0; };

struct StaticOrder {
    int nM, nN, nwg, G, c;
    __host__ __device__ void init(int M, int N, int G_, int c_) { nM = M / BM; nN = N / BM; nwg = nM * nN; G = G_; c = c_; }
    __host__ __device__ bool next(int i, Unit& u) const {
        const long L = (long)i * G + c; if (L >= nwg) return false;
        int wgid = (int)L; { const int q = nwg / NXCD, r = nwg % NXCD, xcd = wgid % NXCD, off = wgid / NXCD; wgid = (xcd < r ? xcd * (q + 1) : r * (q + 1) + (xcd - r) * q) + off; }
        const int nig = WGM * nN, gid = wgid / nig, fm = gid * WGM, gsz = (nM - fm) < WGM ? (nM - fm) : WGM;
        u.pm = fm + ((wgid % nig) % gsz); u.pn = (wgid % nig) / gsz; u.kb = 0; return true;
    }
    __device__ __forceinline__ void a_ready(const Unit&) const {}
    __device__ __forceinline__ void done(const Unit&) const {}
};

__device__ __forceinline__ unsigned cvt_pk_bf16(float lo, float hi) { unsigned r; asm volatile("v_cvt_pk_bf16_f32 %0, %1, %2" : "=v"(r) : "v"(lo), "v"(hi)); return r; }
typedef float f32x2 __attribute__((ext_vector_type(2)));
__device__ __forceinline__ f32x2 gelu_pk(f32x2 v) {
    const f32x2 av = __builtin_elementwise_abs(v), d = av * 0.2316418882f + 1.0f;
    f32x2 t; t.x = __builtin_amdgcn_rcpf(d.x); t.y = __builtin_amdgcn_rcpf(d.y);
    f32x2 q = t * 0.5307027145f + (-0.7265760135f); q = q * t + 0.7107068705f; q = q * t + (-0.142248368f); q = q * t + 0.127414796f; q = q * t;
    const f32x2 s = (v * v) * (-0.72134752044f);
    f32x2 e; e.x = __builtin_amdgcn_exp2f(s.x); e.y = __builtin_amdgcn_exp2f(s.y);
    const f32x2 m = v * (q * e), r = v - m;
    f32x2 o; o.x = v.x < 0.f ? m.x : r.x; o.y = v.y < 0.f ? m.y : r.y; return o;
}

template <int ACT  > struct EpiBf16 {
    static constexpr bool PERM = true, AFTER_DRAIN = false; static_assert(ACT == 0 || ACT == 1, "EpiBf16: ACT is 0 (none) or 1 (gelu_pk)");
    bf16_t* O; int ldc; const float* bias; int split_cols; size_t split_stride; float scale0;
    __device__ __forceinline__ void operator()(const f32x4 (&acc)[2][2][4][2], const Unit& u, int wr, int wc, int fr, int fq) const {
        const int row0 = u.pm * BM + wr * 64 + fr; int colt = u.pn * BM; bf16_t* base = O;
        float sc = 1.f; if (split_cols) { const int t = colt / split_cols; base += (size_t)t * split_stride; colt -= t * split_cols; if (t == 0) sc = scale0; }
        const int col0 = colt + wc * 32 + 8 * fq, bcol0 = u.pn * BM + wc * 32 + 8 * fq;
        f32x4 bv[2][2];
#pragma unroll
        for (int bj = 0; bj < 2; ++bj)
#pragma unroll
            for (int n = 0; n < 2; ++n) bv[bj][n] = bias ? *(const f32x4*)(bias + bcol0 + bj * HALF + 4 * n) : (f32x4){0.f, 0.f, 0.f, 0.f};
#pragma unroll
        for (int ai = 0; ai < 2; ++ai)
#pragma unroll
            for (int m = 0; m < 4; ++m) { bf16_t* rowp = base + (size_t)(row0 + ai * HALF + m * 16) * ldc + col0;
#pragma unroll
                for (int bj = 0; bj < 2; ++bj) { f32x4 v0 = acc[ai][bj][m][0] + bv[bj][0], v1 = acc[ai][bj][m][1] + bv[bj][1];
                    if (ACT == 1) { f32x2 a = gelu_pk((f32x2){v0[0], v0[1]}), b = gelu_pk((f32x2){v0[2], v0[3]}), c = gelu_pk((f32x2){v1[0], v1[1]}), d = gelu_pk((f32x2){v1[2], v1[3]});
                        v0 = (f32x4){a.x, a.y, b.x, b.y}; v1 = (f32x4){c.x, c.y, d.x, d.y}; }
                    v0 = v0 * sc; v1 = v1 * sc; u32x4 w; w.x = cvt_pk_bf16(v0[0], v0[1]); w.y = cvt_pk_bf16(v0[2], v0[3]); w.z = cvt_pk_bf16(v1[0], v1[1]); w.w = cvt_pk_bf16(v1[2], v1[3]);
                    *(u32x4*)(rowp + bj * HALF) = w; } }
    }
};
template <class Epi, class Sched, bool ALIGN_EPI = false, bool SP2 = false>
__device__ __forceinline__ void gemm_phase(PG8_LAS unsigned char* lds, const Gemm g, const Sched& S, const Epi& E, int wave_in) {
    int ln_; asm volatile("v_mbcnt_lo_u32_b32 %0, -1, 0\n\tv_mbcnt_hi_u32_b32 %0, -1, %0" : "=v"(ln_)); asm volatile("" : "+s"(wave_in)); int tid_ = wave_in * 64 + ln_;
    const int tid = tid_, wid = __builtin_amdgcn_readfirstlane(tid >> 6), lane = tid & 63, wr = wid >> 2, wc = wid & 3, fr = lane & 15, fq = lane >> 4;
    const int K = g.ld ? g.ld : g.K, nt = g.K / BK;
    unsigned voffA[2], voffB[2];
#pragma unroll
    for (int i = 0; i < 2; ++i) { int R, C; stage_rc(tid * 16 + i * 8192, R, C); const int Rb = Epi::PERM ? ((R & ~31) + perm32(R & 31)) : R;
        voffA[i] = (unsigned)(R * K + C) * 2u; voffB[i] = (unsigned)(Rb * K + C) * 2u; }
    const size_t kstep = (size_t)(BK * 2);
    const size_t hstep = (size_t)HALF * K * 2;
    const size_t tstep = 2 * hstep;
    const unsigned ldsw = (unsigned)wid * 1024u;
    const int aoff = lds_byte(wr * 64 + fr, fq * 8), boff = lds_byte(wc * 32 + fr, fq * 8);
#define PG8_SA(b, h) (((b) * 2 + (h)) * HTB)
#define PG8_SB(b, h) ((4 + (b) * 2 + (h)) * HTB)
#define PG8_STAGE(bufoff, gbase, voff) do { _Pragma("unroll") for (int _i = 0; _i < 2; ++_i) \
        __builtin_amdgcn_global_load_lds((const unsigned*)((const char*)(gbase) + (voff)[_i]), (PG8_LAS unsigned*)(lds + (bufoff) + ldsw + _i * 8192), 16, 0, 0); } while (0)
#define PG8_LDA(dst, b, h) do { _Pragma("unroll") for (int m = 0; m < 4; ++m) _Pragma("unroll") for (int k = 0; k < 2; ++k) dst[m][k] = *(const PG8_LAS bf16x8*)(lds + PG8_SA(b, h) + aoff + m * 2048 + k * 1024); } while (0)
#define PG8_LDB(dst, b, h) do { _Pragma("unroll") for (int n = 0; n < 2; ++n) _Pragma("unroll") for (int k = 0; k < 2; ++k) dst[n][k] = *(const PG8_LAS bf16x8*)(lds + PG8_SB(b, h) + boff + n * 2048 + k * 1024); } while (0)
#define PG8_MMA(ai, bj, At, Bt) do { __builtin_amdgcn_s_setprio(1); _Pragma("unroll") for (int m = 0; m < 4; ++m) _Pragma("unroll") for (int n = 0; n < 2; ++n) _Pragma("unroll") for (int k = 0; k < 2; ++k) \
        acc[ai][bj][m][n] = __builtin_amdgcn_mfma_f32_16x16x32_bf16(Bt[n][k], At[m][k], acc[ai][bj][m][n], 0, 0, 0); __builtin_amdgcn_s_setprio(0); } while (0)
#define PG8_WAIT_V(n) asm volatile("s_waitcnt vmcnt(" #n ")" ::: "memory")
#define PG8_WAIT_L(n) asm volatile("s_waitcnt lgkmcnt(" #n ")" ::: "memory")
#define PG8_BAR __builtin_amdgcn_s_barrier()
#define PG8_SCHED __builtin_amdgcn_sched_barrier(0)
    Unit cur, nxt; int ui = 0;
    if (!S.next(0, cur)) return;
    f32x4 acc[2][2][4][2];
#pragma unroll
    for (int a = 0; a < 2; ++a)
#pragma unroll
        for (int b = 0; b < 2; ++b)
#pragma unroll
            for (int m = 0; m < 4; ++m)
#pragma unroll
                for (int n = 0; n < 2; ++n) acc[a][b][m][n] = (f32x4){0.f, 0.f, 0.f, 0.f};
    bf16x8 At[4][2], B0[2][2], B1[2][2];
    const char* cA = (const char*)g.A + (size_t)cur.pm * tstep + (size_t)cur.kb * 2; const char* cB = (const char*)g.Bt + (size_t)cur.pn * tstep + (size_t)cur.kb * 2;
    S.a_ready(cur);
    if constexpr (SP2) {
        PG8_STAGE(PG8_SB(0, 0), cB, voffB); PG8_STAGE(PG8_SB(0, 1), cB + hstep, voffB); PG8_STAGE(PG8_SA(0, 0), cA, voffA); PG8_STAGE(PG8_SA(0, 1), cA + hstep, voffA);
        if (wr == 1) PG8_BAR;
        PG8_WAIT_V(2); PG8_BAR;
        PG8_STAGE(PG8_SB(1, 0), cB + kstep, voffB); PG8_STAGE(PG8_SA(1, 0), cA + kstep, voffA); PG8_STAGE(PG8_SB(1, 1), cB + hstep + kstep, voffB);
        PG8_WAIT_V(6); PG8_BAR;
    } else {
        PG8_STAGE(PG8_SB(0, 0), cB, voffB); PG8_STAGE(PG8_SA(0, 0), cA, voffA); PG8_STAGE(PG8_SB(0, 1), cB + hstep, voffB); PG8_STAGE(PG8_SA(0, 1), cA + hstep, voffA);
        if (wr == 1) PG8_BAR;
        PG8_WAIT_V(4); PG8_BAR;
        PG8_STAGE(PG8_SB(1, 0), cB + kstep, voffB); PG8_STAGE(PG8_SA(1, 0), cA + kstep, voffA); PG8_STAGE(PG8_SB(1, 1), cB + hstep + kstep, voffB);
        PG8_WAIT_V(6); PG8_BAR;
    }
    for (;;) {
        const bool has_next = S.next(ui + 1, nxt);
        const char* nA = has_next ? (const char*)g.A + (size_t)nxt.pm * tstep + (size_t)nxt.kb * 2 : cA; const char* nB = has_next ? (const char*)g.Bt + (size_t)nxt.pn * tstep + (size_t)nxt.kb * 2 : cB;
        for (int t = 0; t < nt; t += 2) {
            const bool last = (t == nt - 2);
            const char* a1 = cA + (size_t)(t + 1) * kstep;
            const char* a2 = last ? nA : cA + (size_t)(t + 2) * kstep; const char* b2 = last ? nB : cB + (size_t)(t + 2) * kstep;
            const char* a3 = a2 + kstep; const char* b3 = b2 + kstep;
            if (last && has_next) S.a_ready(nxt);
            if constexpr (SP2) {
            PG8_LDB(B0, 0, 0); PG8_LDB(B1, 0, 1); PG8_SCHED; PG8_LDA(At, 0, 0); PG8_STAGE(PG8_SA(1, 1), a1 + hstep, voffA);
            PG8_WAIT_V(8); PG8_WAIT_L(0); PG8_BAR; PG8_MMA(0, 0, At, B0); PG8_MMA(0, 1, At, B1); PG8_BAR; PG8_SCHED;
            PG8_LDA(At, 0, 1); PG8_STAGE(PG8_SB(0, 0), b2, voffB); PG8_STAGE(PG8_SB(0, 1), b2 + hstep, voffB); PG8_STAGE(PG8_SA(0, 0), a2, voffA);
            PG8_WAIT_V(8); PG8_WAIT_L(0); PG8_BAR; PG8_MMA(1, 0, At, B0); PG8_MMA(1, 1, At, B1); PG8_BAR; PG8_SCHED;
            PG8_LDB(B0, 1, 0); PG8_LDB(B1, 1, 1); PG8_SCHED; PG8_LDA(At, 1, 0); PG8_STAGE(PG8_SA(0, 1), a2 + hstep, voffA);
            PG8_WAIT_V(8); PG8_WAIT_L(0); PG8_BAR; PG8_MMA(0, 0, At, B0); PG8_MMA(0, 1, At, B1); PG8_BAR; PG8_SCHED;
            PG8_LDA(At, 1, 1); PG8_STAGE(PG8_SB(1, 0), b3, voffB); PG8_STAGE(PG8_SB(1, 1), b3 + hstep, voffB); PG8_STAGE(PG8_SA(1, 0), a3, voffA);
            PG8_WAIT_V(8); PG8_WAIT_L(0); PG8_BAR; PG8_MMA(1, 0, At, B0); PG8_MMA(1, 1, At, B1); PG8_BAR; PG8_SCHED;
            } else {
            PG8_LDB(B0, 0, 0); PG8_SCHED; PG8_LDA(At, 0, 0); PG8_STAGE(PG8_SA(1, 1), a1 + hstep, voffA);
            PG8_WAIT_L(8); PG8_BAR; PG8_WAIT_L(0); PG8_MMA(0, 0, At, B0); PG8_BAR; PG8_SCHED;
            PG8_LDB(B1, 0, 1); PG8_STAGE(PG8_SB(0, 0), b2, voffB);
            PG8_BAR; PG8_WAIT_L(0); PG8_MMA(0, 1, At, B1); PG8_BAR;
            PG8_LDA(At, 0, 1); PG8_STAGE(PG8_SA(0, 0), a2, voffA);
            PG8_BAR; PG8_WAIT_L(0); PG8_MMA(1, 0, At, B0); PG8_BAR; PG8_SCHED;
            PG8_STAGE(PG8_SB(0, 1), b2 + hstep, voffB);
            PG8_WAIT_V(6); PG8_BAR; PG8_MMA(1, 1, At, B1); PG8_BAR;
            PG8_LDB(B0, 1, 0); PG8_SCHED; PG8_LDA(At, 1, 0); PG8_STAGE(PG8_SA(0, 1), a2 + hstep, voffA);
            PG8_WAIT_L(8); PG8_BAR; PG8_WAIT_L(0); PG8_MMA(0, 0, At, B0); PG8_BAR; PG8_SCHED;
            PG8_LDB(B1, 1, 1); PG8_STAGE(PG8_SB(1, 0), b3, voffB);
            PG8_BAR; PG8_WAIT_L(0); PG8_MMA(0, 1, At, B1); PG8_BAR;
            PG8_LDA(At, 1, 1); PG8_STAGE(PG8_SA(1, 0), a3, voffA);
            PG8_BAR; PG8_WAIT_L(0); PG8_MMA(1, 0, At, B0); PG8_BAR; PG8_SCHED;
            PG8_STAGE(PG8_SB(1, 1), b3 + hstep, voffB);
            PG8_WAIT_V(6); PG8_BAR; PG8_MMA(1, 1, At, B1); PG8_BAR;
            }
        }
        if constexpr (ALIGN_EPI) { if (wr == 0) PG8_BAR; }
        if constexpr (!Epi::AFTER_DRAIN) { E(acc, cur, wr, wc, fr, fq); S.done(cur); }
        if (!has_next) break;
#pragma unroll
        for (int a = 0; a < 2; ++a)
#pragma unroll
            for (int b = 0; b < 2; ++b)
#pragma unroll
                for (int m = 0; m < 4; ++m)
#pragma unroll
                    for (int n = 0; n < 2; ++n) acc[a][b][m][n] = (f32x4){0.f, 0.f, 0.f, 0.f};
        cur = nxt; cA = nA; cB = nB; ++ui;
        if constexpr (ALIGN_EPI) { if (wr == 1) PG8_BAR; }
    }
    PG8_WAIT_V(0);
    if constexpr (!ALIGN_EPI) { if (wr == 0) PG8_BAR; }
    PG8_BAR;
    if constexpr (Epi::AFTER_DRAIN) { E.fused(acc, cur, wr, wc, fr, fq, lds, wid, lane); S.done(cur); }
#undef PG8_SA
#undef PG8_SB
#undef PG8_STAGE
#undef PG8_LDA
#undef PG8_LDB
#undef PG8_MMA
#undef PG8_WAIT_V
#undef PG8_WAIT_L
#undef PG8_BAR
#undef PG8_SCHED
}
}

constexpr int NWAVES = 8;
constexpr int DM = 2048, NB = 2, SEQ = 8192, DEPTH = 4, GRIDW = 64, CTXL = 256, HD = 64;
constexpr int MLAT = NB * SEQ, MCTX = NB * CTXL, MALL = MLAT + MCTX;
constexpr int INC = 5792, INP = 5888;
constexpr int C_QA = 0, C_KA = 512, C_VA = 1024, C_QB = 1536, C_KB = 2048, C_VB = 2176, C_R = 2304, C_K = 3328, C_V = 4352, C_WD = 5376, C_AD = 5504, C_GD = 5632;
constexpr int CW = 1024;
constexpr int DFF = 5632, UPN = 2 * DFF;
constexpr int SKV = CTXL + SEQ;
constexpr int MODW = 6 * DM;
constexpr float LOG2E = 1.4426950408889634f;
constexpr float QSCALE = 0.125f * LOG2E;

constexpr size_t MiB = 1u << 20;
constexpr size_t WS_CTL = 0, CTL_ZERO_BYTES = 1 * MiB;
constexpr size_t WS_MOD = 1 * MiB;
constexpr size_t WS_MODP = 2 * MiB;
constexpr size_t WS_WIN = 12 * MiB;
constexpr size_t WS_WOUT = 104 * MiB;
constexpr size_t WS_WUP = 136 * MiB;
constexpr size_t WS_WDN = 312 * MiB;
constexpr size_t WS_H = 400 * MiB;
constexpr size_t WS_XN = 1111 * MiB;
constexpr size_t WS_Y1 = 532 * MiB;
constexpr size_t WS_QBP = 722 * MiB;
constexpr size_t WS_KBP = 739 * MiB;
constexpr size_t WS_VBP = 744 * MiB;
constexpr size_t WS_OA = 749 * MiB;
constexpr size_t WS_OB = 766 * MiB;
constexpr size_t WS_WDEC = 783 * MiB;
constexpr size_t WS_AIC = 849 * MiB;
constexpr size_t WS_G = 915 * MiB;
constexpr size_t WS_YS = 948 * MiB;
constexpr size_t WS_MIX = 1177 * MiB;
constexpr size_t WS_U = 532 * MiB;
constexpr size_t WS_HB = 895 * MiB;
constexpr size_t WS_VAT = 1080 * MiB;
constexpr size_t WS_LW = 1097 * MiB;
constexpr size_t WS_OC = 1243 * MiB;
constexpr size_t WS_GK = 1101 * MiB;
constexpr size_t WS_BIAS1 = 1102 * MiB;
constexpr size_t WS_BIAS3 = 1103 * MiB;
constexpr size_t WS_SS = 256 * 1024;
constexpr size_t WS_SSP = 1104 * MiB;
constexpr size_t WS_RS = 1109 * MiB;
constexpr size_t WS_PART = 1309 * MiB;
constexpr size_t WS_VBT = 1110 * MiB;
constexpr size_t WS_CK = 1111 * MiB;
constexpr size_t WS_CKS = 1498 * MiB;
constexpr size_t WS_END = 1530 * MiB;
static_assert(WS_U + (size_t)MALL * UPN * 2 <= WS_HB && WS_HB + (size_t)MALL * DFF * 2 <= WS_VAT, "overlay map");
constexpr int CW_BAR = 4096;
static_assert(WS_SS + (size_t)DEPTH * 2 * MALL * 4 <= CTL_ZERO_BYTES && (size_t)(CW_BAR + 3456) * 4 <= WS_SS, "control-region map");

constexpr int RING_BYTES = 131072;
constexpr int LDSCTL_OFF = RING_BYTES, MISC_OFF = LDSCTL_OFF + 320;
constexpr int LDS_BYTES = 147456;

#define GAS __attribute__((address_space(1)))
#define LAS __attribute__((address_space(3)))
typedef unsigned short bf16;
typedef unsigned v4u __attribute__((ext_vector_type(4)));
typedef unsigned v2u __attribute__((ext_vector_type(2)));
typedef float f32x4 __attribute__((ext_vector_type(4)));
typedef GAS unsigned gu32;
#define RLX_AGENT __ATOMIC_RELAXED, __HIP_MEMORY_SCOPE_AGENT
#define LDS_WAIT() asm volatile("s_waitcnt lgkmcnt(0)" ::: "memory")
#define VM_WAIT() asm volatile("s_waitcnt vmcnt(0)" ::: "memory")
__device__ __forceinline__ unsigned f2bf(float f) { unsigned u = __builtin_bit_cast(unsigned, f); return (u + 0x7fffu + ((u >> 16) & 1u)) >> 16; }
__device__ __forceinline__ unsigned pk2(float lo, float hi) { return f2bf(lo) | (f2bf(hi) << 16); }
__device__ __forceinline__ float bf2f(bf16 u) { return __uint_as_float((unsigned)u << 16); }
__device__ __forceinline__ float bflo(unsigned w) { return __uint_as_float(w << 16); }
__device__ __forceinline__ float bfhi(unsigned w) { return __uint_as_float(w & 0xffff0000u); }
template <int CTRL> __device__ __forceinline__ float dpp_f(float v) { return __builtin_bit_cast(float, __builtin_amdgcn_update_dpp(0, __builtin_bit_cast(int, v), CTRL, 0xF, 0xF, true)); }
__device__ __forceinline__ float sum16(float v) { v += dpp_f<0xB1>(v); v += dpp_f<0x4E>(v); v += dpp_f<0x141>(v); v += dpp_f<0x140>(v); return v; }
__device__ __forceinline__ float sum64(float v) { v = sum16(v); const int b = __builtin_bit_cast(int, v);
    return (__builtin_bit_cast(float, __builtin_amdgcn_readlane(b, 0)) + __builtin_bit_cast(float, __builtin_amdgcn_readlane(b, 16))) + (__builtin_bit_cast(float, __builtin_amdgcn_readlane(b, 32)) + __builtin_bit_cast(float, __builtin_amdgcn_readlane(b, 48))); }
__device__ __forceinline__ float wave_sum(float v) { return sum64(v); }
typedef float f32x2 __attribute__((ext_vector_type(2)));
__device__ __forceinline__ float sigmoidf_(float x) { return 1.f / (1.f + __expf(-x)); }

namespace attn_body {
using bf16=__hip_bfloat16;
using bf16x8=__attribute__((ext_vector_type(8)))short;
using s16x4=__attribute__((ext_vector_type(4)))short;
using f32x16=__attribute__((ext_vector_type(16)))float;
using u32x4=__attribute__((ext_vector_type(4)))unsigned;
constexpr int D=64,QP=512,KP=128,OP=512,SEQQ=8192,SEQK=8448;
constexpr int NW=8,QBLK=32,QB=QBLK*NW,KVBLK=64,NQB=SEQQ/QB;
constexpr int ATTN_UNIT_ROWS=QB;
__device__ __forceinline__ int crow(int r,int hi){return (r&3)+8*(r>>2)+4*hi;}
#define SBAR() __builtin_amdgcn_sched_barrier(0)
__device__ __forceinline__ void cmask(f32x16&p0,f32x16&p1,int jb,int qrel,int hi){
  const float NEG=-INFINITY; int kb=64*jb+4*hi;
  #pragma unroll
  for(int r=0;r<16;++r){int kv=kb+(r&3)+8*(r>>2); if(kv>qrel)p0[r]=NEG; if(kv+32>qrel)p1[r]=NEG;}
}

constexpr int NSLOT=3, SLOTB=8192;
constexpr int LDS_K=0, LDS_V=NSLOT*SLOTB, LDS_WS=2*NSLOT*SLOTB, LDS_OST=LDS_WS+NW*64*4, LDS_BYTES=LDS_OST+NW*4096;
constexpr float C2=0.125f*1.4426950408889634f;
__device__ __forceinline__ void glds16(const void*gsrc,unsigned lds_dst){unsigned keep;
  asm volatile("s_mov_b32 %0, m0\n\ts_mov_b32 m0, %2\n\ts_nop 0\n\tglobal_load_lds_dwordx4 %1, off\n\ts_mov_b32 m0, %0":"=&s"(keep):"v"(gsrc),"s"(lds_dst):"memory");}
__device__ __forceinline__ float max3f(float a,float b,float c){float r;asm("v_max3_f32 %0, %1, %2, %3":"=v"(r):"v"(a),"v"(b),"v"(c));return r;}
__device__ __forceinline__ float max2f(float a,float b){float r;asm("v_max_f32_e32 %0, %1, %2":"=v"(r):"v"(a),"v"(b));return r;}
__device__ __forceinline__ float fadd_s(float a,float b){float r;asm("v_add_f32_e32 %0, %1, %2":"=v"(r):"v"(a),"v"(b));return r;}
__device__ __forceinline__ float fsub_s(float a,float b){float r;asm("v_sub_f32_e32 %0, %1, %2":"=v"(r):"v"(a),"v"(b));return r;}
typedef float f32x2_t __attribute__((ext_vector_type(2))); typedef __bf16 bf16x2_t __attribute__((ext_vector_type(2)));
__device__ __forceinline__ unsigned cvtpk_s(float lo,float hi){f32x2_t v={lo,hi};bf16x2_t b=__builtin_convertvector(v,bf16x2_t);return __builtin_bit_cast(unsigned,b);}
#define WAIT_BAR(N) asm volatile("s_waitcnt vmcnt(" #N ") lgkmcnt(0)\n\ts_barrier":::"memory")

__device__ __forceinline__ void qkt(f32x16&p0,f32x16&p1,const char*Kslot,const bf16x8*qr,const f32x16&negm,int r32,int hi){
  const char*kb=Kslot+hi*1024+r32*16;
  #pragma unroll
  for(int d0=0;d0<4;++d0){
    const bf16x8 b0=*reinterpret_cast<const bf16x8*>(kb+d0*2048);
    const bf16x8 b1=*reinterpret_cast<const bf16x8*>(kb+d0*2048+512);
    if(d0==0){p0=__builtin_amdgcn_mfma_f32_32x32x16_bf16(b0,qr[0],negm,0,0,0);p1=__builtin_amdgcn_mfma_f32_32x32x16_bf16(b1,qr[0],negm,0,0,0);}
    else{p0=__builtin_amdgcn_mfma_f32_32x32x16_bf16(b0,qr[d0],p0,0,0,0);p1=__builtin_amdgcn_mfma_f32_32x32x16_bf16(b1,qr[d0],p1,0,0,0);}}
}
typedef __attribute__((address_space(3))) const char* lds_cptr;
typedef short v4i16_t __attribute__((ext_vector_type(4)));
__device__ __forceinline__ void kload8(bf16x8*kf,lds_cptr kp){
  kf[0]=*(const __attribute__((address_space(3))) bf16x8*)(kp);      kf[1]=*(const __attribute__((address_space(3))) bf16x8*)(kp+512);
  kf[2]=*(const __attribute__((address_space(3))) bf16x8*)(kp+2048); kf[3]=*(const __attribute__((address_space(3))) bf16x8*)(kp+2560);
  kf[4]=*(const __attribute__((address_space(3))) bf16x8*)(kp+4096); kf[5]=*(const __attribute__((address_space(3))) bf16x8*)(kp+4608);
  kf[6]=*(const __attribute__((address_space(3))) bf16x8*)(kp+6144); kf[7]=*(const __attribute__((address_space(3))) bf16x8*)(kp+6656);
}
__device__ __forceinline__ void kload2(bf16x8*kf,lds_cptr kp,int j){ kf[2*j]=*(const __attribute__((address_space(3))) bf16x8*)(kp+j*2048); kf[2*j+1]=*(const __attribute__((address_space(3))) bf16x8*)(kp+j*2048+512); }
__device__ __forceinline__ s16x4 vtr(lds_cptr p){ return __builtin_bit_cast(s16x4,__builtin_amdgcn_ds_read_tr16_b64_v4i16((__attribute__((address_space(3))) v4i16_t*)p)); }
__device__ __forceinline__ float rowmax(const f32x16&p0,const f32x16&p1){
  float a=max3f(p0[0],p0[1],p1[0]),b=max3f(p0[2],p0[3],p1[1]);a=max3f(a,p1[2],p1[3]);
  #pragma unroll
  for(int r=4;r<16;r+=4){a=max3f(a,p0[r],p0[r+1]);b=max3f(b,p0[r+2],p0[r+3]);a=max3f(a,p1[r],p1[r+1]);b=max3f(b,p1[r+2],p1[r+3]);}
  const float m=max2f(a,b);
  auto rr=__builtin_amdgcn_permlane32_swap(__float_as_uint(m),__float_as_uint(m),false,false);
  return max2f(__uint_as_float(rr[0]),__uint_as_float(rr[1]));
}
__device__ __forceinline__ void pv(f32x16*o,int vb,bf16x8 pa0,bf16x8 pa1,bf16x8 pa2,bf16x8 pa3){
  #pragma unroll
  for(int d0=0;d0<2;++d0){s16x4 lo[4],hi[4];
    #pragma unroll
    for(int ks=0;ks<4;++ks){
      asm volatile("ds_read_b64_tr_b16 %0,%1 offset:%c2":"=&v"(lo[ks]):"v"(vb),"i"(d0*4096+ks*1024):"memory");
      asm volatile("ds_read_b64_tr_b16 %0,%1 offset:%c2":"=&v"(hi[ks]):"v"(vb),"i"(d0*4096+ks*1024+512):"memory");}
    asm volatile("s_waitcnt lgkmcnt(0)":::"memory");SBAR();
    #define PK(k) (bf16x8){lo[k][0],lo[k][1],lo[k][2],lo[k][3],hi[k][0],hi[k][1],hi[k][2],hi[k][3]}
    o[d0]=__builtin_amdgcn_mfma_f32_32x32x16_bf16(pa0,PK(0),o[d0],0,0,0);
    o[d0]=__builtin_amdgcn_mfma_f32_32x32x16_bf16(pa1,PK(1),o[d0],0,0,0);
    o[d0]=__builtin_amdgcn_mfma_f32_32x32x16_bf16(pa2,PK(2),o[d0],0,0,0);
    o[d0]=__builtin_amdgcn_mfma_f32_32x32x16_bf16(pa3,PK(3),o[d0],0,0,0);
    #undef PK
  }
}

#ifndef ATTN_STORE16
#define ATTN_STORE16(p,v) (*(u32x4*)(p)=(v))
#endif
template<int THRL> __device__ __forceinline__ void attn_unit(int b,int h,int qb,const bf16*Q,const bf16*__restrict__ K,const bf16*__restrict__ V,bf16*O,char*shm,int wave_in){
  int ln_; asm volatile("v_mbcnt_lo_u32_b32 %0, -1, 0\n\tv_mbcnt_hi_u32_b32 %0, -1, %0" : "=v"(ln_)); asm volatile("" : "+s"(wave_in)); int tid_=wave_in*64+ln_; const int tid=tid_,lane=tid&63,r32=lane&31,hi=lane>>5; const int wid=__builtin_amdgcn_readfirstlane(tid>>6);
  const long rowq=(long)b*SEQQ, rowk=(long)b*SEQK; const int q0=qb*QB;
  const bf16*Qw=Q+(rowq+q0+wid*QBLK)*QP+h*D;
  const bf16*Kh=K+rowk*KP+(h>>2)*D,*Vh=V+rowk*KP+(h>>2)*D;
  const unsigned lds0=(unsigned)(uintptr_t)shm;
  float*wsf=(float*)(shm+LDS_WS)+wid*64;
  const bf16*ksrc=Kh+(long)lane*KP+wid*8;
  const bf16*vsrc=Vh+(long)(16*(wid&3)+(lane>>2))*KP+(wid>>2)*32+(lane&3)*8;
  const unsigned kdst=lds0+LDS_K+wid*1024, vdst=lds0+LDS_V+wid*1024;
  #define DMA_K(t,slot) glds16(ksrc+(long)(t)*KVBLK*KP,(unsigned)__builtin_amdgcn_readfirstlane(kdst+(slot)))
  #define DMA_V(t,slot) glds16(vsrc+(long)(t)*KVBLK*KP,(unsigned)__builtin_amdgcn_readfirstlane(vdst+(slot)))
  const int vb0=(int)(lds0+LDS_V)+((lane>>4)&1)*32+(lane&3)*8+(4*hi+((lane&15)>>2))*64;
  const char*Kbase=shm+LDS_K; bf16x8 kf[8];
  const lds_cptr shm3=(lds_cptr)shm; const lds_cptr kp0=shm3+LDS_K+hi*1024+r32*16; const lds_cptr vp0=shm3+LDS_V+((lane>>4)&1)*32+(lane&3)*8+(4*hi+((lane&15)>>2))*64;
  constexpr int NT=SEQK/KVBLK;
  DMA_K(0,0);DMA_V(0,0);DMA_K(1,SLOTB);
  bf16x8 qr[4];
  #pragma unroll
  for(int d0=0;d0<4;++d0)qr[d0]=*reinterpret_cast<const bf16x8*>(&Qw[(long)r32*QP+d0*16+hi*8]);
  float mhat=0.f,l_reg=0.f;f32x16 o[2];o[0]=f32x16{};o[1]=f32x16{};f32x16 negm=f32x16{};asm volatile("":"+v"(negm));

  #define CMASK(P0,P1,t) do{}while(0)
  bool resc=false;
  #define START(P0,P1) do{ const float rm=rowmax(P0,P1); resc=false; \
    { const float dl=rm; mhat=fadd_s(mhat,dl); \
      _Pragma("unroll") for(int r=0;r<16;++r){P0[r]=fsub_s(P0[r],dl);P1[r]=fsub_s(P1[r],dl);} \
      _Pragma("unroll") for(int r=0;r<16;++r)negm[r]=-mhat; asm volatile("":"+v"(negm)); } \
    _Pragma("unroll") for(int r=0;r<16;++r)P0[r]=__builtin_amdgcn_exp2f(P0[r]); }while(0)
  #define RESC() do{ if(resc){ asm volatile("s_waitcnt lgkmcnt(0)":::"memory"); \
      _Pragma("unroll") for(int d_=0;d_<2;++d_) _Pragma("unroll") for(int r=0;r<16;++r)o[d_][r]*=wsf[crow(r,hi)]; } }while(0)
  f32x16 pA0,pA1,pB0,pB1;
  int sl_prev=0,sl_cur=0,sl_next=SLOTB;
  #define ROT() do{sl_prev=sl_cur;sl_cur=sl_next;sl_next=(sl_next==(NSLOT-1)*SLOTB)?0:sl_next+SLOTB;}while(0)
  DMA_K(2,2*SLOTB);
  WAIT_BAR(3);
  qkt(pA0,pA1,Kbase,qr,negm,r32,hi);asm volatile("s_nop 15\n\ts_nop 7":"+v"(pA0),"+v"(pA1));CMASK(pA0,pA1,0);
  START(pA0,pA1);
  _Pragma("unroll") for(int r=0;r<16;++r)pA1[r]=__builtin_amdgcn_exp2f(pA1[r]);
  WAIT_BAR(0);
  DMA_K(3,0);DMA_V(1,SLOTB);
  ROT();
  kload8(kf,kp0+sl_cur);
  WAIT_BAR(2);
  s16x4 vlo[8],vhi[8]; u32x4 pw0,pw1,pw2,pw3;
  #define PKW(P,B) cvtpk_s(P[B],P[B+1])
  #define PAF(k) __builtin_bit_cast(bf16x8,pw##k)
  #define VFR(i) (bf16x8){vlo[i][0],vlo[i][1],vlo[i][2],vlo[i][3],vhi[i][0],vhi[i][1],vhi[i][2],vhi[i][3]}
  #define PIN(x) asm volatile("":"+v"(x))
  #define MX3(a,b,c) __builtin_fmaxf(__builtin_fmaxf((a),(b)),(c))
  #define GAPA(MF,A0,A1,A2,A3,W0,W1,PW) do{ MF; sacc+=A0; sacc+=A1; sacc+=A2; sacc+=A3; PIN(sacc); W0; W1; PIN(PW); SBAR(); }while(0)
  #define EX(v) __builtin_amdgcn_exp2f(v)
  #define GAPB(MF,X,B) do{ MF; X[B]=EX(X[B]); X[B+1]=EX(X[B+1]); X[B+2]=EX(X[B+2]); X[B+3]=EX(X[B+3]); PIN(X); SBAR(); }while(0)
  #define VRD(i) do{ vlo[i]=vtr(vp_+(((i)>>2)*4096+((i)&3)*1024)); vhi[i]=vtr(vp_+(((i)>>2)*4096+((i)&3)*1024+512)); }while(0)
  #define KRD(G,j) do{ if(G){ kload2(kf,kp0+sl_next,j); SBAR(); } }while(0)
  #define STEP(C0,C1,P0,P1,t,GK,GV,GL) do{ SBAR(); \
    const lds_cptr vp_=vp0+sl_prev; \
    VRD(0); SBAR(); float sacc=(P0[0]+P0[1]); \
    GAPA(C0=__builtin_amdgcn_mfma_f32_32x32x16_bf16(kf[0],qr[0],negm,0,0,0), P0[2],P0[3],P0[4],P0[5],     pw0[0]=PKW(P0,0), pw0[1]=PKW(P0,2), pw0); \
    VRD(4); SBAR(); GAPA(C1=__builtin_amdgcn_mfma_f32_32x32x16_bf16(kf[1],qr[0],negm,0,0,0), P0[6],P0[7],P0[8],P0[9],     pw0[2]=PKW(P0,4), pw0[3]=PKW(P0,6), pw0); \
    VRD(1); SBAR(); GAPA(C0=__builtin_amdgcn_mfma_f32_32x32x16_bf16(kf[2],qr[1],C0,0,0,0),   P0[10],P0[11],P0[12],P0[13], pw1[0]=PKW(P0,8), pw1[1]=PKW(P0,10), pw1); \
    VRD(5); SBAR(); GAPA(C1=__builtin_amdgcn_mfma_f32_32x32x16_bf16(kf[3],qr[1],C1,0,0,0),   P0[14],P0[15],P1[0],P1[1],   pw1[2]=PKW(P0,12),pw1[3]=PKW(P0,14), pw1); \
    VRD(2); SBAR(); GAPA(C0=__builtin_amdgcn_mfma_f32_32x32x16_bf16(kf[4],qr[2],C0,0,0,0),   P1[2],P1[3],P1[4],P1[5],     pw2[0]=PKW(P1,0), pw2[1]=PKW(P1,2), pw2); \
    VRD(6); SBAR(); GAPA(C1=__builtin_amdgcn_mfma_f32_32x32x16_bf16(kf[5],qr[2],C1,0,0,0),   P1[6],P1[7],P1[8],P1[9],     pw2[2]=PKW(P1,4), pw2[3]=PKW(P1,6), pw2); \
    VRD(3); SBAR(); GAPA(C0=__builtin_amdgcn_mfma_f32_32x32x16_bf16(kf[6],qr[3],C0,0,0,0),   P1[10],P1[11],P1[12],P1[13], pw3[0]=PKW(P1,8), pw3[1]=PKW(P1,10), pw3); \
    VRD(7); SBAR(); GAPA(C1=__builtin_amdgcn_mfma_f32_32x32x16_bf16(kf[7],qr[3],C1,0,0,0),   P1[14],P1[15],0.f,0.f,       pw3[2]=PKW(P1,12),pw3[3]=PKW(P1,14), pw3); \
    l_reg+=sacc; \
    if(GK){DMA_K((t)+3,sl_cur);} if(GV){DMA_V((t)+1,sl_next);} \
    CMASK(C0,C1,t); \
    { float a=MX3(C0[0],C0[1],C1[0]),b=MX3(C0[2],C0[3],C1[1]); a=MX3(a,C1[2],C1[3]); \
      _Pragma("unroll") for(int r=4;r<16;r+=4){a=MX3(a,C0[r],C0[r+1]);b=MX3(b,C0[r+2],C0[r+3]);a=MX3(a,C1[r],C1[r+1]);b=MX3(b,C1[r+2],C1[r+3]);} \
      float rm=__builtin_fmaxf(a,b); { auto rr=__builtin_amdgcn_permlane32_swap(__float_as_uint(rm),__float_as_uint(rm),false,false); rm=__builtin_fmaxf(__uint_as_float(rr[0]),__uint_as_float(rr[1])); } \
      resc=false; \
      if(__builtin_expect(__any(rm>(float)THRL),0)){ const float dl=__builtin_fmaxf(rm,0.f); mhat+=dl; \
        _Pragma("unroll") for(int r=0;r<16;++r){C0[r]-=dl;C1[r]-=dl;} \
        _Pragma("unroll") for(int r=0;r<16;++r)negm[r]=-mhat; asm volatile("":"+v"(negm)); \
        const float f=__builtin_amdgcn_exp2f(-dl); l_reg*=f; if(hi==0)wsf[r32]=f; resc=true; } } \
    SBAR(); \
    GAPB(o[0]=__builtin_amdgcn_mfma_f32_32x32x16_bf16(PAF(0),VFR(0),o[0],0,0,0), C0,0); \
    GAPB(o[1]=__builtin_amdgcn_mfma_f32_32x32x16_bf16(PAF(0),VFR(4),o[1],0,0,0), C0,4); \
    KRD(GL,0); GAPB(o[0]=__builtin_amdgcn_mfma_f32_32x32x16_bf16(PAF(1),VFR(1),o[0],0,0,0), C0,8); \
    KRD(GL,1); GAPB(o[1]=__builtin_amdgcn_mfma_f32_32x32x16_bf16(PAF(1),VFR(5),o[1],0,0,0), C0,12); \
    KRD(GL,2); GAPB(o[0]=__builtin_amdgcn_mfma_f32_32x32x16_bf16(PAF(2),VFR(2),o[0],0,0,0), C1,0); \
    KRD(GL,3); GAPB(o[1]=__builtin_amdgcn_mfma_f32_32x32x16_bf16(PAF(2),VFR(6),o[1],0,0,0), C1,4); \
    GAPB(o[0]=__builtin_amdgcn_mfma_f32_32x32x16_bf16(PAF(3),VFR(3),o[0],0,0,0), C1,8); \
    GAPB(o[1]=__builtin_amdgcn_mfma_f32_32x32x16_bf16(PAF(3),VFR(7),o[1],0,0,0), C1,12); \
    }while(0)
  int t=1;
  #undef CMASK
  #define CMASK(P0,P1,t) do{}while(0)
  for(;t+5<NT;t+=2){
    STEP(pB0,pB1,pA0,pA1,t,true,true,true);     WAIT_BAR(2); RESC(); ROT();
    STEP(pA0,pA1,pB0,pB1,t+1,true,true,true);   WAIT_BAR(2); RESC(); ROT();
  }
  #undef CMASK
  #define CMASK(P0,P1,t) do{}while(0)
  #define ENDW(tt) do{ if((tt)+3<NT){WAIT_BAR(2);} else if((tt)+2<NT){WAIT_BAR(1);} else {WAIT_BAR(0);} }while(0)
  for(;t+1<NT;t+=2){
    STEP(pB0,pB1,pA0,pA1,t,(t+3<NT),(t+1<NT),(t+1<NT));       ENDW(t);   RESC(); ROT();
    STEP(pA0,pA1,pB0,pB1,t+1,(t+4<NT),(t+2<NT),(t+2<NT));     ENDW(t+1); RESC(); ROT();
  }
  STEP(pB0,pB1,pA0,pA1,NT-1,false,false,false); RESC();
  { float sacc=pB0[0]+pB0[1]; _Pragma("unroll") for(int r=2;r<16;++r)sacc+=pB0[r]; _Pragma("unroll") for(int r=0;r<16;++r)sacc+=pB1[r]; l_reg+=sacc;
    pw0=(u32x4){PKW(pB0,0),PKW(pB0,2),PKW(pB0,4),PKW(pB0,6)};pw1=(u32x4){PKW(pB0,8),PKW(pB0,10),PKW(pB0,12),PKW(pB0,14)};pw2=(u32x4){PKW(pB1,0),PKW(pB1,2),PKW(pB1,4),PKW(pB1,6)};pw3=(u32x4){PKW(pB1,8),PKW(pB1,10),PKW(pB1,12),PKW(pB1,14)};
    SBAR(); pv(o,vb0+sl_cur,PAF(0),PAF(1),PAF(2),PAF(3)); }
  #undef PKW
  #undef PAF
  #undef VFR
  #undef PIN
  #undef MX3
  #undef GAPA
  #undef GAPB
  #undef EX
  #undef VRD
  #undef KRD
  #undef STEP
  #undef ENDW
  {auto rr=__builtin_amdgcn_permlane32_swap(__float_as_uint(l_reg),__float_as_uint(l_reg),false,false);l_reg=__uint_as_float(rr[0])+__uint_as_float(rr[1]);}
  if(hi==0)wsf[32+r32]=l_reg;asm volatile("s_waitcnt lgkmcnt(0)":::"memory");
  float rli[16];
  #pragma unroll
  for(int r=0;r<16;++r)rli[r]=__builtin_amdgcn_rcpf(wsf[32+crow(r,hi)]);
  bf16*Ow=O+(rowq+q0+wid*QBLK)*OP+h*D;
  { bf16*stg=(bf16*)(shm+LDS_OST)+wid*2048;
    #pragma unroll
    for(int r=0;r<16;++r){const int orow=crow(r,hi);
      #pragma unroll
      for(int d0=0;d0<2;++d0)stg[orow*64+d0*32+r32]=__float2bfloat16(o[d0][r]*rli[r]);}
    asm volatile("s_waitcnt lgkmcnt(0)":::"memory");
    #pragma unroll
    for(int i=0;i<4;++i){const int row=i*8+(lane>>3),ch=lane&7; const u32x4 v=*(const u32x4*)(stg+row*64+ch*8); ATTN_STORE16(Ow+(long)row*OP+ch*8,v);} }
  asm volatile("s_waitcnt lgkmcnt(0)\n\ts_barrier":::"memory");
  #undef DMA_K
  #undef DMA_V
  #undef CMASK
  #undef START
  #undef RESC
  #undef ROT
}
constexpr int ATTN_LDS_BYTES=LDS_BYTES;
struct AttnTensors { const bf16* Q; const bf16* K; const bf16* V; bf16* O; };
template<int THRL=8> __device__ __forceinline__ void attn_phase(char*lds,const AttnTensors&T,int vcu,int G,int wave_in){
  for(int u=vcu;u<2*8*NQB;u+=G){ attn_unit<THRL>(u>>8,(u>>5)&7,u&31,T.Q,T.K,T.V,T.O,lds,wave_in); }
}
#undef SBAR
#undef WAIT_BAR
}
#define XB_TMO      128
#define XB_XCNT(j)  (256  + 64 * (j))
#define XB_XSUB(j)  (1280 + 64 * (j))
#define XB_XGEN(j)  (2304 + 64 * (j))
#define XB_TOP      3328
#define XB_TOPGEN   3392
#define XCD_BAR_WORDS 3456
#define XB_SPIN_CAP (1u << 18)

__device__ __forceinline__ unsigned xb_ld(unsigned* p)              { return __hip_atomic_load(p, __ATOMIC_RELAXED, __HIP_MEMORY_SCOPE_AGENT); }
__device__ __forceinline__ unsigned xb_add(unsigned* p, unsigned v) { return __hip_atomic_fetch_add(p, v, __ATOMIC_RELAXED, __HIP_MEMORY_SCOPE_AGENT); }
__device__ __forceinline__ unsigned xb_xcc_id() { return (unsigned)__builtin_amdgcn_s_getreg((3 << 11) | 20) & 0xFu; }
#define XB_SPIN(cond, bar) do { unsigned _sp = 0; while (cond) { __builtin_amdgcn_s_sleep(1); \
    if ((++_sp & 255u) == 0u) { if (xb_ld(&(bar)[XB_TMO])) break; if (_sp > XB_SPIN_CAP) { atomicAdd(&(bar)[XB_TMO], 1u); break; } } } } while (0)

struct XcdBarrier {
    unsigned* bar; unsigned x;
    int wv;
    volatile LAS unsigned* st;
};

__device__ __forceinline__ bool xb_thread0(int wv) { int ln_; asm volatile("v_mbcnt_lo_u32_b32 %0, -1, 0\n\tv_mbcnt_hi_u32_b32 %0, -1, %0" : "=v"(ln_)); return wv == 0 && ln_ == 0; }
__device__ __forceinline__ XcdBarrier xcd_barrier_post(unsigned* bar, volatile LAS unsigned* st, int wv) {
    XcdBarrier b; b.bar = bar; b.x = xb_xcc_id(); b.st = st; b.wv = wv;
    if (xb_thread0(wv)) (void)xb_add(&bar[XB_XCNT(b.x)], 1u);
    return b;
}
__device__ __forceinline__ void xcd_barrier_complete(unsigned* bar, unsigned x, unsigned& nloc, unsigned& nx) {
    const unsigned G = gridDim.x * gridDim.y * gridDim.z;
    unsigned sum, cnt, mine, sp = 0u;
    for (;;) {
        sum = 0u; cnt = 0u; mine = 0u;
#pragma unroll
        for (unsigned j = 0; j < 16; ++j) { const unsigned c = xb_ld(&bar[XB_XCNT(j)]); sum += c; cnt += (c > 0u) ? 1u : 0u; mine = (j == x) ? c : mine; }
        if (sum == G) break;
        __builtin_amdgcn_s_sleep(1);
        if ((++sp & 255u) == 0u) { if (xb_ld(&bar[XB_TMO])) break; if (sp > XB_SPIN_CAP) { atomicAdd(&bar[XB_TMO], 1u); break; } }
    }
    nloc = mine > 0u ? mine : 1u; nx = cnt > 0u ? cnt : 1u;
}

__device__ __forceinline__ void xcd_barrier(const XcdBarrier& b) {
    asm volatile("s_waitcnt vmcnt(0)" ::: "memory");
    __syncthreads();
    if (xb_thread0(b.wv)) {
        unsigned* bar = b.bar;
        __builtin_amdgcn_s_waitcnt(0);
        unsigned nloc = b.st[0], nx = b.st[1];
        if (nloc == 0u) { xcd_barrier_complete(bar, b.x, nloc, nx); b.st[0] = nloc; b.st[1] = nx; }
        const unsigned old = xb_add(&bar[XB_XSUB(b.x)], 1u);
        const unsigned gen = old / nloc;
        if (old + 1u == (gen + 1u) * nloc) {
            __builtin_amdgcn_fence(__ATOMIC_RELEASE, "agent");
            asm volatile("s_waitcnt vmcnt(0)" ::: "memory");
            const unsigned og = xb_add(&bar[XB_TOP], 1u);
            const unsigned tg = og / nx;
            if (og + 1u == (tg + 1u) * nx) xb_add(&bar[XB_TOPGEN], 1u);
            else XB_SPIN(xb_ld(&bar[XB_TOPGEN]) == tg, bar);
            __builtin_amdgcn_fence(__ATOMIC_ACQUIRE, "agent");
            xb_add(&bar[XB_XGEN(b.x)], 1u);
            asm volatile("s_waitcnt vmcnt(0)" ::: "memory");
        } else {
            XB_SPIN(xb_ld(&bar[XB_XGEN(b.x)]) == gen, bar);
            __builtin_amdgcn_fence(__ATOMIC_ACQUIRE, "agent");
            asm volatile("s_waitcnt vmcnt(0)" ::: "memory");
        }
    }
    __syncthreads();
}

struct Args { const float* in[33]; float* out; unsigned char* ws; int gp_lo, gp_hi, use_bar, pad; };
enum { I_X = 0, I_C, I_CTX, I_CCTX, I_ADAW, I_ADAB, I_N1G, I_N2G, I_WIN, I_RPB, I_QG, I_KG, I_MURKV, I_MUW, I_MUA, I_MUG, I_W0, I_W2, I_A0, I_A2, I_G2,
       I_KK, I_KA, I_RK, I_LNXG, I_LNXB, I_GRPG, I_WOUT, I_FUP, I_CONVW, I_CONVB, I_FDN, I_FING };
struct Frame {
    LAS unsigned char* lds;
    int tid, lane, wave, vcu, G;
    GAS unsigned char* ws;
};
#define WSP(T, off) ((T*)(GAS T*)(f.ws + (off)))
__device__ __forceinline__ const float* karg_in(int idx) {
    const GAS float* p; const void* ka = (const void*)__builtin_amdgcn_kernarg_segment_ptr();
    asm volatile("s_load_dwordx2 %0, %1, %2\n\ts_waitcnt lgkmcnt(0)" : "=s"(p) : "s"(ka), "i"(idx * 8) : "memory");
    return (const float*)p;
}
__device__ __forceinline__ void launder_ws(Frame& f) {
    GAS unsigned char* w = f.ws; int wv = f.wave, v = f.vcu, g = f.G, ln;
    asm volatile("" : "+s"(w), "+s"(wv), "+s"(v), "+s"(g));
    asm volatile("v_mbcnt_lo_u32_b32 %0, -1, 0\n\tv_mbcnt_hi_u32_b32 %0, -1, %0" : "=v"(ln));
    f.ws = w; f.wave = wv; f.lane = ln; f.tid = wv * 64 + ln; f.vcu = v; f.G = g;
}

struct RowInfo { int t, T, b, isctx; };
__device__ __forceinline__ RowInfo row_info(int m) {
    RowInfo r;
    if (m < MLAT) { r.b = m >> 13; r.t = m & (SEQ - 1); r.T = SEQ; r.isctx = 0; }
    else { const int mm = m - MLAT; r.b = mm >> 8; r.t = mm & (CTXL - 1); r.T = CTXL; r.isctx = 1; }
    return r;
}

__device__ __forceinline__ void transpose_item(const float* W, int K, int N, bf16* WT, LAS float* scr, int item, int lane) {
    const int nblk = N / 32, kb = item / nblk, nb = item % nblk, k0 = 64 * kb, n0 = 32 * nb;
    float tv[32];
#pragma unroll
    for (int i = 0; i < 32; ++i) { const int kk = 2 * i + (lane >> 5); tv[i] = W[(size_t)(k0 + kk) * N + n0 + (lane & 31)]; }
#pragma unroll
    for (int i = 0; i < 32; ++i) { const int kk = 2 * i + (lane >> 5); scr[kk * 33 + (lane & 31)] = tv[i]; }
    LDS_WAIT(); asm volatile("" ::: "memory");
    const int c = lane & 7;
#pragma unroll
    for (int j = 0; j < 4; ++j) { const int n = (lane >> 3) + 8 * j; const LAS float* s = scr + (8 * c) * 33 + n;
        v4u o; o.x = pk2(s[0 * 33], s[1 * 33]); o.y = pk2(s[2 * 33], s[3 * 33]); o.z = pk2(s[4 * 33], s[5 * 33]); o.w = pk2(s[6 * 33], s[7 * 33]);
        *(v4u*)(WT + (size_t)(n0 + n) * K + k0 + 8 * c) = o; }
    LDS_WAIT(); asm volatile("" ::: "memory");
}
__device__ __forceinline__ void ph_convert(Frame& f) { const float* in_I_ADAW = karg_in(I_ADAW); const float* in_I_C = karg_in(I_C); const float* in_I_CCTX = karg_in(I_CCTX); const float* in_I_CTX = karg_in(I_CTX); const float* in_I_FDN = karg_in(I_FDN); const float* in_I_FUP = karg_in(I_FUP); const float* in_I_WIN = karg_in(I_WIN); const float* in_I_WOUT = karg_in(I_WOUT); const float* in_I_X = karg_in(I_X); launder_ws(f);
    LAS float* scr = (LAS float*)(f.lds + f.wave * 16384);
    const int gw = f.vcu * NWAVES + f.wave, NGW = f.G * NWAVES;
    constexpr int I_IN = (DM / 64) * (INC / 32), I_OUT = (DM / 64) * (DM / 32), I_UP = (DM / 64) * (UPN / 32), I_DN = (DFF / 64) * (DM / 32), I_L = I_IN + I_OUT + I_UP + I_DN;
    for (int it = gw; it < DEPTH * I_L; it += NGW) {
        const int l = it / I_L; int r = it % I_L;
        if (r < I_IN) { transpose_item(in_I_WIN + (size_t)l * DM * INC, DM, INC, WSP(bf16, WS_WIN) + (size_t)l * INP * DM, scr, r, f.lane); continue; } r -= I_IN;
        if (r < I_OUT) { transpose_item(in_I_WOUT + (size_t)l * DM * DM, DM, DM, WSP(bf16, WS_WOUT) + (size_t)l * DM * DM, scr, r, f.lane); continue; } r -= I_OUT;
        if (r < I_UP) {
            const int nb = r % (UPN / 32), n0 = 32 * nb, ch = n0 >= DFF ? n0 - DFF : n0, drow = (ch >> 7) * 256 + (n0 >= DFF ? 128 : 0) + (ch & 127);
            transpose_item(in_I_FUP + (size_t)l * DM * UPN, DM, UPN, WSP(bf16, WS_WUP) + (size_t)l * UPN * DM + (size_t)(drow - n0) * DM, scr, r, f.lane); continue; } r -= I_UP;
        transpose_item(in_I_FDN + (size_t)l * DFF * DM, DFF, DM, WSP(bf16, WS_WDN) + (size_t)l * DM * DFF, scr, r, f.lane);
    }
    for (int it = gw; it < DEPTH * (INP - INC); it += NGW) {
        const int l = it / (INP - INC), r = INC + it % (INP - INC);
        v4u* p = (v4u*)(WSP(bf16, WS_WIN) + ((size_t)l * INP + r) * DM) + f.lane;
#pragma unroll
        for (int j = 0; j < 4; ++j) p[64 * j] = (v4u){0u, 0u, 0u, 0u};
    }
    for (int it = gw; it < DEPTH * 48 * 16; it += NGW) {
        const int l = it / 768, rem = it % 768, cg = rem / 16, ks = rem % 16;
#pragma unroll
        for (int q = 0; q < 2; ++q) { const int kk = f.lane + 64 * q, k = ks * 128 + kk;
            const float c0 = in_I_C[k], c1 = in_I_C[DM + k], c2 = in_I_CCTX[k];
            scr[kk] = c0 * sigmoidf_(c0); scr[128 + kk] = c1 * sigmoidf_(c1); scr[256 + kk] = c2 * sigmoidf_(c2); }
        LDS_WAIT(); asm volatile("" ::: "memory");
        const f32x4* Wp = (const f32x4*)(in_I_ADAW + ((size_t)l * DM + ks * 128) * MODW + cg * 256) + f.lane;
        f32x4 a0 = {0.f, 0.f, 0.f, 0.f}, a1 = a0, a2 = a0;
#pragma unroll 8
        for (int kk = 0; kk < 128; ++kk) { const f32x4 w = Wp[(size_t)kk * (MODW / 4)]; a0 += w * scr[kk]; a1 += w * scr[128 + kk]; a2 += w * scr[256 + kk]; }
        float* o = WSP(float, WS_MODP) + ((size_t)(ks * DEPTH + l) * 3) * MODW + cg * 256 + f.lane * 4;
        *(f32x4*)(o) = a0; *(f32x4*)(o + MODW) = a1; *(f32x4*)(o + 2 * MODW) = a2;
        LDS_WAIT(); asm volatile("" ::: "memory");
    }
}
__device__ __forceinline__ void ph_modsum(Frame& f) { const float* in_I_ADAB = karg_in(I_ADAB); launder_ws(f);
    const int gt = f.vcu * 512 + f.tid, GT = f.G * 512;
    for (int i = gt; i < DEPTH * 3 * MODW; i += GT) {
        const int l = i / (3 * MODW), j = i % MODW;
        float s = in_I_ADAB[l * MODW + j];
#pragma unroll
        for (int ks = 0; ks < 16; ++ks) s += WSP(float, WS_MODP)[(size_t)ks * DEPTH * 3 * MODW + i];
        WSP(float, WS_MOD)[i] = s;
    }
}

__device__ __forceinline__ void ph_norm(Frame& f, int l, int which, int mrows) { const float* in_I_N1G = karg_in(I_N1G); const float* in_I_N2G = karg_in(I_N2G); launder_ws(f);
    const int gw = f.vcu * NWAVES + f.wave, NGW = f.G * NWAVES;
    const float* g = (which == 0 ? in_I_N1G : in_I_N2G) + l * DM;
    const int offsh = which == 0 ? 0 : 3 * DM, offsc = offsh + DM;
    for (int m = gw; m < mrows; m += NGW) {
        const int s = m < SEQ ? 0 : (m < MLAT ? 1 : 2);
        const float* mod = WSP(float, WS_MOD) + (size_t)(l * 3 + s) * MODW;
        const f32x4* xr = (const f32x4*)(WSP(float, WS_H) + (size_t)m * DM) + f.lane;
        f32x4 v[8]; float ss = 0.f;
#pragma unroll
        for (int j = 0; j < 8; ++j) { v[j] = xr[64 * j]; ss += (v[j].x * v[j].x + v[j].y * v[j].y) + (v[j].z * v[j].z + v[j].w * v[j].w); }
        const float rs = 1.0f / sqrtf(wave_sum(ss) * (1.f / DM) + 1e-6f);
        v2u* o = (v2u*)(WSP(bf16, WS_XN) + (size_t)m * DM) + f.lane;
#pragma unroll
        for (int j = 0; j < 8; ++j) { const int col = f.lane * 4 + 256 * j;
            const f32x4 g4 = *(const f32x4*)(g + col), sc = *(const f32x4*)(mod + offsc + col), sh = *(const f32x4*)(mod + offsh + col);
            const f32x4 r = (v[j] * rs) * g4 * (sc + 1.0f) + sh;
            v2u w; w.x = pk2(r.x, r.y); w.y = pk2(r.z, r.w); o[64 * j] = w; }
    }
}

__device__ __forceinline__ void ph_prep(Frame& f, int l) { const float* in_I_KG = karg_in(I_KG); const float* in_I_QG = karg_in(I_QG); launder_ws(f);
    const int gw = f.vcu * NWAVES + f.wave, NGW = f.G * NWAVES, lane = f.lane;
    const float qg = in_I_QG[l * HD + lane], kg = in_I_KG[l * HD + lane];
    const int ri = lane & 15, ra = lane >> 5, rp = (lane >> 4) & 1;
    const float inv_freq = powf(10000.0f, -(float)ri / 16.0f);
    for (int m = gw; m < MALL; m += NGW) {
        const RowInfo R = row_info(m);
        const bf16* y = WSP(bf16, WS_Y1) + (size_t)m * INP;
        float sn = 0.f, cs = 1.f;
        if (!R.isctx) { const int pos = ra == 0 ? (R.t / GRIDW) : (R.t % GRIDW); const float ang = (float)pos * inv_freq; sincosf(ang, &sn, &cs); }
        const int kvpos = R.isctx ? R.t : CTXL + R.t;
        const size_t kvrow = ((size_t)R.b * SKV + kvpos) * 128;
#pragma unroll
        for (int hh = 0; hh < 10; ++hh) {
            const int col = hh < 8 ? C_QB + hh * 64 + lane : C_KB + (hh - 8) * 64 + lane;
            const float x = bf2f(y[col]);
            const float ss = wave_sum(x * x);
            float xn = x * (1.0f / sqrtf(ss * (1.f / HD) + 1e-6f)) * (hh < 8 ? qg : kg);
            const float xp = __shfl_xor(xn, 16);
            if (!R.isctx) xn = rp == 0 ? (xn * cs - xp * sn) : (xp * sn + xn * cs);
            if (hh < 8) WSP(bf16, WS_QBP)[(size_t)m * 512 + hh * 64 + lane] = (bf16)f2bf(xn * QSCALE);
            else WSP(bf16, WS_KBP)[kvrow + (hh - 8) * 64 + lane] = (bf16)f2bf(xn);
        }
#pragma unroll
        for (int hv = 0; hv < 2; ++hv) WSP(bf16, WS_VBP)[kvrow + hv * 64 + lane] = y[C_VB + hv * 64 + lane];
    }
}

template <int KR> __device__ __forceinline__ void lora_mm(const LAS float* X, const float* W, int c0, float (&acc)[32][2]) {
#pragma unroll
    for (int t = 0; t < 32; ++t) { acc[t][0] = 0.f; acc[t][1] = 0.f; }
    for (int r4 = 0; r4 < KR / 4; ++r4) {
        float wa[4], wb[4];
#pragma unroll
        for (int i = 0; i < 4; ++i) { wa[i] = W[(size_t)(4 * r4 + i) * CW + c0]; wb[i] = W[(size_t)(4 * r4 + i) * CW + c0 + 512]; }
#pragma unroll
        for (int t = 0; t < 32; ++t) { const f32x4 x = *(const LAS f32x4*)(X + t * KR + 4 * r4);
            acc[t][0] += x.x * wa[0] + x.y * wa[1] + x.z * wa[2] + x.w * wa[3];
            acc[t][1] += x.x * wb[0] + x.y * wb[1] + x.z * wb[2] + x.w * wb[3]; }
    }
}
__device__ __forceinline__ void ph_lora(Frame& f, int l) { const float* in_I_A0 = karg_in(I_A0); const float* in_I_A2 = karg_in(I_A2); const float* in_I_G2 = karg_in(I_G2); const float* in_I_MUA = karg_in(I_MUA); const float* in_I_MUG = karg_in(I_MUG); const float* in_I_MUW = karg_in(I_MUW); const float* in_I_W0 = karg_in(I_W0); const float* in_I_W2 = karg_in(I_W2); launder_ws(f);
    LAS float* tw = (LAS float*)f.lds;
    LAS float* ta = tw + 4096;
    LAS float* sg = ta + 4096;
    const bf16* Y1 = WSP(bf16, WS_Y1);
    const int c0 = f.tid;
    __syncthreads();
    for (int tile = f.vcu; tile < MALL / 32; tile += f.G) {
        const int m0 = tile * 32;
        for (int idx = f.tid; idx < 32 * 416; idx += 512) {
            const int tok = idx / 416, col = idx % 416, m = m0 + tok;
            const RowInfo R = row_info(m);
            const float cur = bf2f(Y1[(size_t)m * INP + C_WD + col]);
            const float prev = R.t > 0 ? bf2f(Y1[(size_t)(m - 1) * INP + C_WD + col]) : 0.f;
            const float next = R.t < R.T - 1 ? bf2f(Y1[(size_t)(m + 1) * INP + C_WD + col]) : 0.f;
            if (col < 128) { const int d = col >> 6, r = col & 63; const float nb = d ? next : prev;
                tw[(d * 32 + tok) * 64 + r] = tanhf(cur + in_I_MUW[l * 128 + col] * (nb - cur)); }
            else if (col < 256) { const int c2 = col - 128, d = c2 >> 6, r = c2 & 63; const float nb = d ? next : prev;
                ta[(d * 32 + tok) * 64 + r] = cur + in_I_MUA[l * 128 + c2] * (nb - cur); }
            else { const int r = col - 256;
                sg[tok * 160 + r] = sigmoidf_(cur + in_I_MUG[l * 320 + r] * (prev - cur) + in_I_MUG[l * 320 + 160 + r] * (next - cur)); }
        }
        __syncthreads();
        float acc[32][2];
#pragma unroll 1
        for (int d = 0; d < 2; ++d) {
            lora_mm<64>(tw + d * 2048, in_I_W2 + ((size_t)(l * 2 + d) * 64) * CW, c0, acc);
            { float* o = WSP(float, WS_WDEC) + ((size_t)d * MALL + m0) * CW + c0;
              const float b0 = in_I_W0[(l * 2 + d) * CW + c0], b1 = in_I_W0[(l * 2 + d) * CW + c0 + 512];
#pragma unroll
              for (int t = 0; t < 32; ++t) {
#pragma unroll
                  for (int q = 0; q < 2; ++q) { const float z = (q ? b1 : b0) + acc[t][q];
                      const float nz = -z, sp = fmaxf(nz, 0.f) + log1pf(expf(-fabsf(nz)));
                      const float wlog = -sp - 0.5f;
                      o[(size_t)t * CW + 512 * q] = expf(-expf(wlog)); } } }
            lora_mm<64>(ta + d * 2048, in_I_A2 + ((size_t)(l * 2 + d) * 64) * CW, c0, acc);
            { float* o = WSP(float, WS_AIC) + ((size_t)d * MALL + m0) * CW + c0;
              const float b0 = in_I_A0[(l * 2 + d) * CW + c0], b1 = in_I_A0[(l * 2 + d) * CW + c0 + 512];
#pragma unroll
              for (int t = 0; t < 32; ++t) { o[(size_t)t * CW] = sigmoidf_(b0 + acc[t][0]); o[(size_t)t * CW + 512] = sigmoidf_(b1 + acc[t][1]); } }
        }
        lora_mm<160>(sg, in_I_G2 + (size_t)l * 160 * CW, c0, acc);
        { float* o = WSP(float, WS_G) + (size_t)m0 * CW + c0;
#pragma unroll
          for (int t = 0; t < 32; ++t) { o[(size_t)t * CW] = acc[t][0]; o[(size_t)t * CW + 512] = acc[t][1]; } }
        __syncthreads();
    }
}
struct AttState { float mx, ls; float o[64]; };
__device__ __forceinline__ void att_init(AttState& S) { S.mx = -1e30f; S.ls = 0.f;
#pragma unroll
    for (int d = 0; d < 64; ++d) S.o[d] = 0.f; }
__device__ __forceinline__ void load_row64(float (&q)[64], const bf16* p, float scale) {
#pragma unroll
    for (int c = 0; c < 8; ++c) { const v4u w = ((const v4u*)p)[c];
        q[8 * c + 0] = bflo(w.x) * scale; q[8 * c + 1] = bfhi(w.x) * scale; q[8 * c + 2] = bflo(w.y) * scale; q[8 * c + 3] = bfhi(w.y) * scale;
        q[8 * c + 4] = bflo(w.z) * scale; q[8 * c + 5] = bfhi(w.z) * scale; q[8 * c + 6] = bflo(w.w) * scale; q[8 * c + 7] = bfhi(w.w) * scale; }
}
__device__ __forceinline__ void att_key(AttState& S, const float (&q)[64], const bf16* kp, const bf16* vp, float bias) {
    float s0 = 0.f, s1 = 0.f, s2 = 0.f, s3 = 0.f;
#pragma unroll
    for (int c = 0; c < 8; ++c) { const v4u w = ((const v4u*)kp)[c];
        s0 += q[8 * c + 0] * bflo(w.x) + q[8 * c + 1] * bfhi(w.x); s1 += q[8 * c + 2] * bflo(w.y) + q[8 * c + 3] * bfhi(w.y);
        s2 += q[8 * c + 4] * bflo(w.z) + q[8 * c + 5] * bfhi(w.z); s3 += q[8 * c + 6] * bflo(w.w) + q[8 * c + 7] * bfhi(w.w); }
    const float s = (s0 + s1) + (s2 + s3) + bias;
    const float mn = fmaxf(S.mx, s), fo = exp2f(S.mx - mn), p = exp2f(s - mn);
    S.mx = mn; S.ls = S.ls * fo + p;
#pragma unroll
    for (int c = 0; c < 8; ++c) { const v4u w = ((const v4u*)vp)[c];
        S.o[8 * c + 0] = S.o[8 * c + 0] * fo + p * bflo(w.x); S.o[8 * c + 1] = S.o[8 * c + 1] * fo + p * bfhi(w.x);
        S.o[8 * c + 2] = S.o[8 * c + 2] * fo + p * bflo(w.y); S.o[8 * c + 3] = S.o[8 * c + 3] * fo + p * bfhi(w.y);
        S.o[8 * c + 4] = S.o[8 * c + 4] * fo + p * bflo(w.z); S.o[8 * c + 5] = S.o[8 * c + 5] * fo + p * bfhi(w.z);
        S.o[8 * c + 6] = S.o[8 * c + 6] * fo + p * bflo(w.w); S.o[8 * c + 7] = S.o[8 * c + 7] * fo + p * bfhi(w.w); }
}
__device__ __forceinline__ void att_finish(AttState& S, bf16* op, int sub) {
    float M = S.mx;
    M = fmaxf(M, __shfl_xor(M, 1)); M = fmaxf(M, __shfl_xor(M, 2)); M = fmaxf(M, __shfl_xor(M, 4));
    const float fo = exp2f(S.mx - M);
    float L = S.ls * fo; L += __shfl_xor(L, 1); L += __shfl_xor(L, 2); L += __shfl_xor(L, 4);
    const float inv = 1.0f / L;
    float r[8];
#pragma unroll
    for (int i = 0; i < 8; ++i) r[i] = 0.f;
#pragma unroll
    for (int d = 0; d < 64; ++d) { float v = S.o[d] * fo; v += __shfl_xor(v, 1); v += __shfl_xor(v, 2); v += __shfl_xor(v, 4);
        if ((d >> 3) == sub) r[d & 7] = v * inv; }
    v4u w; w.x = pk2(r[0], r[1]); w.y = pk2(r[2], r[3]); w.z = pk2(r[4], r[5]); w.w = pk2(r[6], r[7]);
    *(v4u*)(op + 8 * sub) = w;
}
__device__ __forceinline__ void ph_attn_naive(Frame& f, int l, int item_lo, int item_hi, bool do_ctx) { const float* in_I_RPB = karg_in(I_RPB); launder_ws(f);
    const bf16* Y1 = WSP(bf16, WS_Y1);
    const int qx = f.tid >> 3, sub = f.tid & 7;
    for (int it = item_lo + f.vcu; it < item_hi; it += f.G) {
        float q[64]; AttState S; att_init(S);
        if (it < 2048) {
            const int b = it >> 10, h = (it >> 7) & 7, i = it & 127;
            const int m = b * SEQ + i * GRIDW + qx;
            load_row64(q, Y1 + (size_t)m * INP + C_QA + h * 64, QSCALE);
            int rs = i - 4; rs = rs < 0 ? 0 : (rs > 120 ? 120 : rs);
            int cst = qx - 8; cst = cst < 0 ? 0 : (cst > 48 ? 48 : cst);
            const int jr = rs + sub;
            const float* rpb = in_I_RPB + ((size_t)(l * 8 + h) * 15 + (jr - i + 7)) * 31;
            for (int yy = 0; yy < 16; ++yy) { const int y = cst + yy, mk = b * SEQ + jr * GRIDW + y;
                int co = y - qx; co = co < -15 ? -15 : (co > 15 ? 15 : co);
                att_key(S, q, Y1 + (size_t)mk * INP + C_KA + h * 64, Y1 + (size_t)mk * INP + C_VA + h * 64, rpb[co + 15] * LOG2E); }
            for (int n = 0; n < 32; ++n) { const int mk = MLAT + b * CTXL + sub + 8 * n;
                att_key(S, q, Y1 + (size_t)mk * INP + C_KA + h * 64, Y1 + (size_t)mk * INP + C_VA + h * 64, 0.f); }
            att_finish(S, WSP(bf16, WS_OA) + (size_t)m * 512 + h * 64, sub);
        } else if (it < 2112) {
            if (!do_ctx) continue;
            const int r = it - 2048, b = r >> 5, h = (r >> 2) & 7, qt = r & 3;
            const int m = MLAT + b * CTXL + qt * 64 + qx;
            load_row64(q, Y1 + (size_t)m * INP + C_QA + h * 64, QSCALE);
            for (int n = 0; n < 32; ++n) { const int mk = MLAT + b * CTXL + sub + 8 * n;
                att_key(S, q, Y1 + (size_t)mk * INP + C_KA + h * 64, Y1 + (size_t)mk * INP + C_VA + h * 64, 0.f); }
            att_finish(S, WSP(bf16, WS_OA) + (size_t)m * 512 + h * 64, sub);
        } else if (it < 2176) {
            if (!do_ctx) continue;
            const int r = it - 2112, b = r >> 5, h = (r >> 2) & 7, qt = r & 3;
            const int m = MLAT + b * CTXL + qt * 64 + qx;
            load_row64(q, WSP(bf16, WS_QBP) + (size_t)m * 512 + h * 64, 1.0f);
            const bf16* kb = WSP(bf16, WS_KBP) + (size_t)b * SKV * 128 + (h >> 2) * 64; const bf16* vb = WSP(bf16, WS_VBP) + (size_t)b * SKV * 128 + (h >> 2) * 64;
            for (int n = 0; n < 32; ++n) { const int kp = sub + 8 * n; att_key(S, q, kb + (size_t)kp * 128, vb + (size_t)kp * 128, 0.f); }
            att_finish(S, WSP(bf16, WS_OB) + (size_t)m * 512 + h * 64, sub);
        } else {
            const int r = it - 2176, b = r >> 10, h = (r >> 7) & 7, qt = r & 127;
            const int m = b * SEQ + qt * 64 + qx;
            load_row64(q, WSP(bf16, WS_QBP) + (size_t)m * 512 + h * 64, 1.0f);
            const bf16* kb = WSP(bf16, WS_KBP) + (size_t)b * SKV * 128 + (h >> 2) * 64; const bf16* vb = WSP(bf16, WS_VBP) + (size_t)b * SKV * 128 + (h >> 2) * 64;
            for (int n = 0; n < SKV / 8; ++n) { const int kp = sub + 8 * n; att_key(S, q, kb + (size_t)kp * 128, vb + (size_t)kp * 128, 0.f); }
            att_finish(S, WSP(bf16, WS_OB) + (size_t)m * 512 + h * 64, sub);
        }
    }
}

__device__ __forceinline__ void ph_scan(Frame& f, int l) { const float* in_I_KA = karg_in(I_KA); const float* in_I_KK = karg_in(I_KK); const float* in_I_MURKV = karg_in(I_MURKV); launder_ws(f);
    LAS float* F = (LAS float*)f.lds;
    LAS float* YT = F + 32 * 6 * 64;
    const bf16* Y1 = WSP(bf16, WS_Y1);
    const int lane = f.lane, rg = lane >> 4, j = lane & 15;
    for (int it = f.vcu; it < 128; it += f.G) {
        const int half = it & 1, chain = it >> 1, b = chain >> 5, d = (chain >> 4) & 1, h = chain & 15;
        const int col = h * 64 + lane;
        const float mur = in_I_MURKV[(l * 2 + d) * 3072 + col], muk = in_I_MURKV[(l * 2 + d) * 3072 + 1024 + col], muv = in_I_MURKV[(l * 2 + d) * 3072 + 2048 + col];
        const float k_k = in_I_KK[l * CW + col], k_a = in_I_KA[l * CW + col];
        float s0 = 0.f, s1 = 0.f, s2 = 0.f, s3 = 0.f;
        const int myrow = half * 32 + f.wave * 4 + rg;
        for (int ch = 0; ch < SKV / 32; ++ch) {
#pragma unroll
            for (int q = 0; q < 4; ++q) {
                const int sl = f.wave * 4 + q, st = ch * 32 + sl;
                int m, t, T;
                if (st < CTXL) { t = d ? (CTXL - 1 - st) : st; T = CTXL; m = MLAT + b * CTXL + t; }
                else { const int u = st - CTXL; t = d ? (SEQ - 1 - u) : u; T = SEQ; m = b * SEQ + t; }
                const bool hasn = d ? (t < T - 1) : (t > 0); const int mn = d ? m + 1 : m - 1;
                const bf16* y = Y1 + (size_t)m * INP; const bf16* yn = Y1 + (size_t)mn * INP;
                const float r0 = bf2f(y[C_R + col]), k0 = bf2f(y[C_K + col]), v0 = bf2f(y[C_V + col]);
                const float rn = hasn ? bf2f(yn[C_R + col]) : 0.f, kn = hasn ? bf2f(yn[C_K + col]) : 0.f, vn = hasn ? bf2f(yn[C_V + col]) : 0.f;
                const float r = r0 + mur * (rn - r0), k = k0 + muk * (kn - k0), v = v0 + muv * (vn - v0);
                const float a = WSP(float, WS_AIC)[((size_t)d * MALL + m) * CW + col], w = WSP(float, WS_WDEC)[((size_t)d * MALL + m) * CW + col];
                float kk = k * k_k; const float nrm = sqrtf(wave_sum(kk * kk)); kk = kk / fmaxf(nrm, 1e-12f);
                const float km = k * (1.0f + (a - 1.0f) * k_a);
                LAS float* Fs = F + sl * 384;
                Fs[lane] = r; Fs[64 + lane] = w; Fs[128 + lane] = km; Fs[192 + lane] = -kk; Fs[256 + lane] = kk * a; Fs[320 + lane] = v;
            }
            __syncthreads();
#pragma unroll 4
            for (int sl = 0; sl < 32; ++sl) {
                const LAS float* Fs = F + sl * 384;
                const f32x4 r4 = *(const LAS f32x4*)(Fs + 4 * j), w4 = *(const LAS f32x4*)(Fs + 64 + 4 * j), k4 = *(const LAS f32x4*)(Fs + 128 + 4 * j);
                const f32x4 a4 = *(const LAS f32x4*)(Fs + 192 + 4 * j), b4 = *(const LAS f32x4*)(Fs + 256 + 4 * j);
                const float vv = Fs[320 + myrow];
                float sa = (s0 * a4.x + s1 * a4.y) + (s2 * a4.z + s3 * a4.w);
                sa += __shfl_xor(sa, 1); sa += __shfl_xor(sa, 2); sa += __shfl_xor(sa, 4); sa += __shfl_xor(sa, 8);
                s0 = s0 * w4.x + sa * b4.x + vv * k4.x; s1 = s1 * w4.y + sa * b4.y + vv * k4.y;
                s2 = s2 * w4.z + sa * b4.z + vv * k4.z; s3 = s3 * w4.w + sa * b4.w + vv * k4.w;
                float yv = (s0 * r4.x + s1 * r4.y) + (s2 * r4.z + s3 * r4.w);
                yv += __shfl_xor(yv, 1); yv += __shfl_xor(yv, 2); yv += __shfl_xor(yv, 4); yv += __shfl_xor(yv, 8);
                if (j == 0) YT[sl * 32 + f.wave * 4 + rg] = yv;
            }
            __syncthreads();
#pragma unroll
            for (int q = 0; q < 2; ++q) { const int idx = f.tid + 512 * q, sl = idx >> 5, rr = idx & 31, st = ch * 32 + sl;
                int m; if (st < CTXL) m = MLAT + b * CTXL + (d ? (CTXL - 1 - st) : st); else { const int u = st - CTXL; m = b * SEQ + (d ? (SEQ - 1 - u) : u); }
                WSP(float, WS_YS)[((size_t)d * MALL + m) * CW + h * 64 + half * 32 + rr] = YT[idx]; }
        }
        __syncthreads();
    }
}

__device__ __forceinline__ f32x4 bf4(v2u w) { return (f32x4){bflo(w.x), bfhi(w.x), bflo(w.y), bfhi(w.y)}; }
__device__ __forceinline__ float hsum4(f32x4 v) { return (v.x + v.y) + (v.z + v.w); }
__device__ __forceinline__ void ph_mix(Frame& f, int l, int mrows) { const float* in_I_GRPG = karg_in(I_GRPG); const float* in_I_KA = karg_in(I_KA); const float* in_I_LNXB = karg_in(I_LNXB); const float* in_I_LNXG = karg_in(I_LNXG); const float* in_I_MURKV = karg_in(I_MURKV); const float* in_I_RK = karg_in(I_RK); launder_ws(f);
    const int gw = f.vcu * NWAVES + f.wave, NGW = f.G * NWAVES, lane = f.lane, hq = lane >> 4, j = lane & 15;
    const bf16* Y1 = WSP(bf16, WS_Y1);
    LAS float* T_LG = (LAS float*)f.lds; LAS float* T_LB = T_LG + 1024; LAS float* T_RK = T_LG + 2048; LAS float* T_KA = T_LG + 3072; LAS float* T_MU = T_LG + 4096; LAS float* gg = T_LG + 10240;
    __syncthreads();
    for (int i = f.tid; i < 256; i += NWAVES * 64) { ((LAS f32x4*)T_LG)[i] = ((const f32x4*)(in_I_LNXG + l * CW))[i]; ((LAS f32x4*)T_LB)[i] = ((const f32x4*)(in_I_LNXB + l * CW))[i];
        ((LAS f32x4*)T_RK)[i] = ((const f32x4*)(in_I_RK + l * CW))[i]; ((LAS f32x4*)T_KA)[i] = ((const f32x4*)(in_I_KA + l * CW))[i]; }
    for (int i = f.tid; i < 1536; i += NWAVES * 64) ((LAS f32x4*)T_MU)[i] = ((const f32x4*)(in_I_MURKV + (size_t)l * 6144))[i];
    for (int i = f.tid; i < 512; i += NWAVES * 64) ((LAS f32x4*)gg)[i] = ((const f32x4*)(in_I_GRPG + l * DM))[i];
    __syncthreads();
    const float* YS0 = WSP(float, WS_YS); const float* YS1 = YS0 + (size_t)MALL * CW;
    const bf16* AIC0 = WSP(bf16, WS_AIC); const bf16* AIC1 = AIC0 + (size_t)MALL * CW;
    for (int m = gw; m < mrows; m += NGW) {
        const RowInfo R = row_info(m);
        const bool hasp = R.t > 0, hasn = R.t < R.T - 1;
        const bf16* y = Y1 + (size_t)m * INP; const bf16* yp = hasp ? y - INP : y; const bf16* yn = hasn ? y + INP : y;
        const bf16* gbuf = WSP(bf16, WS_G) + (size_t)m * CW; LAS float* obuf = (LAS float*)(f.lds + 65536 + f.wave * 4096);
        float ssc = 0.f;
#pragma unroll
        for (int it4 = 0; it4 < 4; ++it4) {
            const int c = (it4 * 4 + hq) * 64 + 4 * j;
            const f32x4 yv = *(const f32x4*)(YS0 + (size_t)m * CW + c) + *(const f32x4*)(YS1 + (size_t)m * CW + c);
            const float mean = sum16(hsum4(yv)) * (1.f / 64.f); const f32x4 dv = yv - mean; const float var = sum16(hsum4(dv * dv)) * (1.f / 64.f);
            f32x4 o = dv * __builtin_amdgcn_rsqf(var + 64e-5f) * *(const LAS f32x4*)(T_LG + c) + *(const LAS f32x4*)(T_LB + c);
            const f32x4 r0 = bf4(*(const v2u*)(y + C_R + c)), k0 = bf4(*(const v2u*)(y + C_K + c)), v0 = bf4(*(const v2u*)(y + C_V + c));
            const f32x4 rkw = *(const LAS f32x4*)(T_RK + c), k_a = *(const LAS f32x4*)(T_KA + c);
#pragma unroll
            for (int d = 0; d < 2; ++d) {
                const bf16* yb = d ? yn : yp; const bool has = d ? hasn : hasp;
                f32x4 rn = bf4(*(const v2u*)(yb + C_R + c)), kn = bf4(*(const v2u*)(yb + C_K + c)), vn = bf4(*(const v2u*)(yb + C_V + c));
                if (!has) { rn = (f32x4){0.f, 0.f, 0.f, 0.f}; kn = rn; vn = rn; }
                const LAS float* mu = T_MU + d * 3072 + c;
                const f32x4 r = r0 + *(const LAS f32x4*)(mu) * (rn - r0), k = k0 + *(const LAS f32x4*)(mu + 1024) * (kn - k0), v = v0 + *(const LAS f32x4*)(mu + 2048) * (vn - v0);
                const f32x4 a = bf4(*(const v2u*)((d ? AIC1 : AIC0) + (size_t)m * CW + c));
                const f32x4 km = k * ((a - 1.0f) * k_a + 1.0f);
                o += v * sum16(hsum4(r * km * rkw));
            }
            o *= bf4(*(const v2u*)(gbuf + c));
            *(LAS f32x4*)(obuf + c) = o; ssc += hsum4(o * o);
            if (it4 == 1) asm volatile("" ::: "memory");
        }
        const float rc = __builtin_amdgcn_rsqf(sum64(ssc) * (1.f / 1024.f) + 1e-6f);
        const v4u wa = *(const v4u*)(WSP(bf16, WS_OA) + (size_t)m * 512 + lane * 8), wb = *(const v4u*)(WSP(bf16, WS_OB) + (size_t)m * 512 + lane * 8);
        const f32x4 a0 = bf4((v2u){wa.x, wa.y}), a1 = bf4((v2u){wa.z, wa.w}), b0 = bf4((v2u){wb.x, wb.y}), b1 = bf4((v2u){wb.z, wb.w});
        const float ra = __builtin_amdgcn_rsqf(sum64(hsum4(a0 * a0) + hsum4(a1 * a1)) * (1.f / 512.f) + 1e-6f), rb = __builtin_amdgcn_rsqf(sum64(hsum4(b0 * b0) + hsum4(b1 * b1)) * (1.f / 512.f) + 1e-6f);
        bf16* o = WSP(bf16, WS_MIX) + (size_t)m * DM;
        { const LAS float* ga = gg + lane * 8; const f32x4 x0 = a0 * ra * *(const LAS f32x4*)(ga), x1 = a1 * ra * *(const LAS f32x4*)(ga + 4);
          *(v4u*)(o + lane * 8) = (v4u){pk2(x0.x, x0.y), pk2(x0.z, x0.w), pk2(x1.x, x1.y), pk2(x1.z, x1.w)}; }
        { const LAS float* gb = gg + 512 + lane * 8; const f32x4 x0 = b0 * rb * *(const LAS f32x4*)(gb), x1 = b1 * rb * *(const LAS f32x4*)(gb + 4);
          *(v4u*)(o + 512 + lane * 8) = (v4u){pk2(x0.x, x0.y), pk2(x0.z, x0.w), pk2(x1.x, x1.y), pk2(x1.z, x1.w)}; }
#pragma unroll
        for (int q = 0; q < 4; ++q) { const int c = q * 256 + lane * 4; const f32x4 x = *(const LAS f32x4*)(obuf + c) * rc * *(const LAS f32x4*)(gg + 1024 + c);
            *(v2u*)(o + 1024 + c) = (v2u){pk2(x.x, x.y), pk2(x.z, x.w)}; }
    }
}

__device__ __forceinline__ void ph_convglu(Frame& f, int l, int mrows) { const float* in_I_CONVB = karg_in(I_CONVB); const float* in_I_CONVW = karg_in(I_CONVW); launder_ws(f);
    const int gt = f.vcu * 512 + f.tid, GT = f.G * 512;
    const bf16* U = WSP(bf16, WS_U); bf16* HB = WSP(bf16, WS_HB);
    const float* cw = in_I_CONVW + (size_t)l * 3 * DFF; const float* cb = in_I_CONVB + (size_t)l * DFF;
    constexpr int C8 = DFF / 8;
    for (int idx = gt; idx < mrows * C8; idx += GT) {
        const int m = idx / C8, c = (idx % C8) * 8;
        const RowInfo R = row_info(m);
        const v4u z = {0u, 0u, 0u, 0u};
        const v4u uc = *(const v4u*)(U + (size_t)m * UPN + c), vl = *(const v4u*)(U + (size_t)m * UPN + DFF + c);
        const v4u up = R.t > 0 ? *(const v4u*)(U + (size_t)(m - 1) * UPN + c) : z, un = R.t < R.T - 1 ? *(const v4u*)(U + (size_t)(m + 1) * UPN + c) : z;
        float r[8], gv[8];
#pragma unroll
        for (int i = 0; i < 8; ++i) {
            const unsigned wc_ = i < 2 ? uc.x : i < 4 ? uc.y : i < 6 ? uc.z : uc.w, wp_ = i < 2 ? up.x : i < 4 ? up.y : i < 6 ? up.z : up.w;
            const unsigned wn_ = i < 2 ? un.x : i < 4 ? un.y : i < 6 ? un.z : un.w, wv_ = i < 2 ? vl.x : i < 4 ? vl.y : i < 6 ? vl.z : vl.w;
            const float fc = (i & 1) ? bfhi(wc_) : bflo(wc_), fp = (i & 1) ? bfhi(wp_) : bflo(wp_), fn = (i & 1) ? bfhi(wn_) : bflo(wn_), fv = (i & 1) ? bfhi(wv_) : bflo(wv_);
            const float u = fp * cw[c + i] + fc * cw[DFF + c + i] + fn * cw[2 * DFF + c + i] + cb[c + i];
            r[i] = u; gv[i] = fv;
        }
#pragma unroll
        for (int i = 0; i < 8; i += 2) { const f32x2 g2 = pg8::gelu_pk((f32x2){r[i], r[i + 1]}); r[i] = g2.x * gv[i]; r[i + 1] = g2.y * gv[i + 1]; }
        v4u w; w.x = pk2(r[0], r[1]); w.y = pk2(r[2], r[3]); w.z = pk2(r[4], r[5]); w.w = pk2(r[6], r[7]);
        *(v4u*)(HB + (size_t)m * DFF + c) = w;
    }
}

__device__ __forceinline__ void ph_final(Frame& f) { const float* in_I_FING = karg_in(I_FING); float* out_p = (float*)karg_in(33); launder_ws(f);
    const int gw = f.vcu * NWAVES + f.wave, NGW = f.G * NWAVES;
    const float* g = in_I_FING;
    for (int m = gw; m < MLAT; m += NGW) {
        const f32x4* xr = (const f32x4*)(WSP(float, WS_H) + (size_t)m * DM) + f.lane;
        f32x4 v[8]; float ss = 0.f;
#pragma unroll
        for (int j = 0; j < 8; ++j) { v[j] = xr[64 * j]; ss += (v[j].x * v[j].x + v[j].y * v[j].y) + (v[j].z * v[j].z + v[j].w * v[j].w); }
        const float rs = 1.0f / sqrtf(wave_sum(ss) * (1.f / DM) + 1e-6f);
        f32x4* o = (f32x4*)(out_p + (size_t)m * DM) + f.lane;
#pragma unroll
        for (int j = 0; j < 8; ++j) { const f32x4 g4 = *(const f32x4*)(g + f.lane * 4 + 256 * j); o[64 * j] = (v[j] * rs) * g4; }
    }
}

struct EpiResGate {
    static constexpr bool PERM = true, AFTER_DRAIN = false;
    float* H; const float* mod;
    __device__ __forceinline__ void operator()(const pg8::f32x4 (&acc)[2][2][4][2], const pg8::Unit& u, int wr, int wc, int fr, int fq) const {
        const int row0 = u.pm * 256 + wr * 64 + fr, col0 = u.pn * 256 + wc * 32 + 8 * fq;
        const int s = u.pm < 32 ? 0 : (u.pm < 64 ? 1 : 2);
        const float* gp = mod + (size_t)s * MODW + col0;
        pg8::f32x4 gv[2][2];
#pragma unroll
        for (int bj = 0; bj < 2; ++bj)
#pragma unroll
            for (int n = 0; n < 2; ++n) gv[bj][n] = *(const pg8::f32x4*)(gp + bj * 128 + 4 * n);
#pragma unroll
        for (int ai = 0; ai < 2; ++ai)
#pragma unroll
            for (int m = 0; m < 4; ++m) { float* rowp = H + (size_t)(row0 + ai * 128 + m * 16) * DM + col0;
#pragma unroll
                for (int bj = 0; bj < 2; ++bj)
#pragma unroll
                    for (int n = 0; n < 2; ++n) { pg8::f32x4* p = (pg8::f32x4*)(rowp + bj * 128 + 4 * n); *p = *p + gv[bj][n] * acc[ai][bj][m][n]; } }
    }
};
struct ScanRaw { float r0, k0, v0, rn, kn, vn, a, w; };
struct ScanFeat { f32x4 r, w, k, a, b; float v; };
constexpr int SC_T = 16, SC_NCH = SKV / SC_T;
__device__ __forceinline__ int scan_row_of_step(int st, int b, int d) {
    if (st < CTXL) return MLAT + b * CTXL + (d ? (CTXL - 1 - st) : st);
    const int u = st - CTXL; return b * SEQ + (d ? (SEQ - 1 - u) : u);
}
__device__ __forceinline__ void scan_load_raw(ScanRaw& R, const bf16* Y1, const float* aic, const float* wdec, int st, int b, int d, int col) {
    int t, T, m;
    if (st < CTXL) { t = d ? (CTXL - 1 - st) : st; T = CTXL; m = MLAT + b * CTXL + t; } else { const int u = st - CTXL; t = d ? (SEQ - 1 - u) : u; T = SEQ; m = b * SEQ + t; }
    const bool hasn = d ? (t < T - 1) : (t > 0); const int mn = hasn ? (d ? m + 1 : m - 1) : m;
    const bf16* y = Y1 + (size_t)m * INP + col; const bf16* yn = Y1 + (size_t)mn * INP + col;
    R.r0 = bf2f(y[C_R]); R.k0 = bf2f(y[C_K]); R.v0 = bf2f(y[C_V]);
    const float rn = bf2f(yn[C_R]), kn = bf2f(yn[C_K]), vn = bf2f(yn[C_V]);
    R.rn = hasn ? rn : 0.f; R.kn = hasn ? kn : 0.f; R.vn = hasn ? vn : 0.f;
    R.a = aic[(size_t)m * CW + col]; R.w = wdec[(size_t)m * CW + col];
}
__device__ __forceinline__ void scan_emit(LAS float* Fs, const ScanRaw& R, float mur, float muk, float muv, float k_k, float k_a, int lane) {
    const float r = R.r0 + mur * (R.rn - R.r0), k = R.k0 + muk * (R.kn - R.k0), v = R.v0 + muv * (R.vn - R.v0);
    float kk = k * k_k; kk = kk * __builtin_amdgcn_rsqf(fmaxf(sum64(kk * kk), 1e-24f));
    const float km = k * (1.0f + (R.a - 1.0f) * k_a);
    Fs[lane] = r; Fs[64 + lane] = R.w; Fs[128 + lane] = km; Fs[192 + lane] = -kk; Fs[256 + lane] = kk * R.a; Fs[320 + lane] = v;
}
__device__ __forceinline__ void scan_ld_feat(ScanFeat& F, const LAS float* Fs, int j, int row) {
    F.r = *(const LAS f32x4*)(Fs + 4 * j); F.w = *(const LAS f32x4*)(Fs + 64 + 4 * j); F.k = *(const LAS f32x4*)(Fs + 128 + 4 * j);
    F.a = *(const LAS f32x4*)(Fs + 192 + 4 * j); F.b = *(const LAS f32x4*)(Fs + 256 + 4 * j); F.v = Fs[320 + row];
}
__device__ __forceinline__ void ph_scan2(Frame& f, int l) { const float* in_I_KA = karg_in(I_KA); const float* in_I_KK = karg_in(I_KK); const float* in_I_MURKV = karg_in(I_MURKV); launder_ws(f);
    LAS float* FB = (LAS float*)f.lds;
    LAS float* YP = FB + 2 * SC_T * 384;
    const bf16* Y1 = WSP(bf16, WS_Y1);
    const int lane = f.lane;
    for (int it = f.vcu; it < 256; it += f.G) {
        const int quarter = it & 3, chain = it >> 2, b = chain >> 5, d = (chain >> 4) & 1, h = chain & 15;
        if (f.wave >= 4) {
            const int pw = f.wave - 4, sq = lane >> 4, j = lane & 15, col = h * 64 + 4 * j;
            const float* murkv = in_I_MURKV + (l * 2 + d) * 3072 + col;
            const f32x4 mur = *(const f32x4*)(murkv), muk = *(const f32x4*)(murkv + 1024), muv = *(const f32x4*)(murkv + 2048);
            const f32x4 k_k = *(const f32x4*)(in_I_KK + l * CW + col), k_a = *(const f32x4*)(in_I_KA + l * CW + col);
            const bf16* aic = WSP(bf16, WS_AIC) + (size_t)d * MALL * CW + col; const bf16* wdec = WSP(bf16, WS_WDEC) + (size_t)d * MALL * CW + col;
            const bf16* y1c = Y1 + col;
            float* ys = WSP(float, WS_YS) + (size_t)d * MALL * CW + h * 64 + quarter * 16;
            const int pt = f.tid - 256, osl = pt >> 4, orr = pt & 15;
            struct PRaw { v2u r0, k0, v0, rn, kn, vn, a, w; bool has; };
            PRaw S0, S1, S2;
#define SC_LOAD(X, c) do { const int st_ = (c) * SC_T + pw * 4 + sq; int t_, T_, m_; \
        if (st_ < CTXL) { t_ = d ? (CTXL - 1 - st_) : st_; T_ = CTXL; m_ = MLAT + b * CTXL + t_; } else { const int u_ = st_ - CTXL; t_ = d ? (SEQ - 1 - u_) : u_; T_ = SEQ; m_ = b * SEQ + t_; } \
        X.has = d ? (t_ < T_ - 1) : (t_ > 0); const int mn_ = X.has ? (d ? m_ + 1 : m_ - 1) : m_; \
        const bf16* y_ = y1c + (size_t)m_ * INP; const bf16* yn_ = y1c + (size_t)mn_ * INP; \
        X.r0 = *(const v2u*)(y_ + C_R); X.k0 = *(const v2u*)(y_ + C_K); X.v0 = *(const v2u*)(y_ + C_V); X.rn = *(const v2u*)(yn_ + C_R); X.kn = *(const v2u*)(yn_ + C_K); X.vn = *(const v2u*)(yn_ + C_V); \
        X.a = *(const v2u*)(aic + (size_t)m_ * CW); X.w = *(const v2u*)(wdec + (size_t)m_ * CW); } while (0)
#define SC_EMIT(X, slot) do { const f32x4 z_ = {0.f, 0.f, 0.f, 0.f}; \
        const f32x4 r0_ = bf4(X.r0), k0_ = bf4(X.k0), v0_ = bf4(X.v0), rn_ = X.has ? bf4(X.rn) : z_, kn_ = X.has ? bf4(X.kn) : z_, vn_ = X.has ? bf4(X.vn) : z_; \
        const f32x4 r_ = r0_ + mur * (rn_ - r0_), k_ = k0_ + muk * (kn_ - k0_), v_ = v0_ + muv * (vn_ - v0_); \
        f32x4 kk_ = k_ * k_k; kk_ = kk_ * __builtin_amdgcn_rsqf(fmaxf(sum16(hsum4(kk_ * kk_)), 1e-24f)); \
        const f32x4 a_ = bf4(X.a), q_ = bf4(X.w); const f32x4 w_ = {__expf(-q_.x), __expf(-q_.y), __expf(-q_.z), __expf(-q_.w)}; \
        const f32x4 km_ = k_ * ((a_ - 1.0f) * k_a + 1.0f); \
        LAS float* Fs_ = FB + ((slot) * SC_T + pw * 4 + sq) * 384 + 4 * j; \
        *(LAS f32x4*)(Fs_) = r_; *(LAS f32x4*)(Fs_ + 64) = w_; *(LAS f32x4*)(Fs_ + 128) = km_; *(LAS f32x4*)(Fs_ + 192) = -kk_; *(LAS f32x4*)(Fs_ + 256) = kk_ * a_; *(LAS f32x4*)(Fs_ + 320) = v_; } while (0)
#define SC_YRED(c, slot) do { const LAS f32x4* yp = (const LAS f32x4*)(YP + (((slot) * SC_T + osl) * 16 + orr) * 16); const f32x4 y0 = yp[0], y1 = yp[1], y2 = yp[2], y3 = yp[3]; \
        const f32x4 ysum = (y0 + y1) + (y2 + y3); ys[(size_t)scan_row_of_step((c) * SC_T + osl, b, d) * CW + orr] = (ysum.x + ysum.y) + (ysum.z + ysum.w); } while (0)
#define SC_IVAL(c, XL, XE) do { if ((c) + 3 < SC_NCH) SC_LOAD(XL, (c) + 3); if ((c) >= 1) SC_YRED((c) - 1, ((c) - 1) & 1); if ((c) + 1 < SC_NCH) SC_EMIT(XE, ((c) + 1) & 1); \
        LDS_WAIT(); __builtin_amdgcn_s_barrier(); } while (0)
            SC_LOAD(S0, 0); SC_EMIT(S0, 0); SC_LOAD(S1, 1); SC_LOAD(S2, 2);
            LDS_WAIT(); __builtin_amdgcn_s_barrier();
            static_assert(SC_NCH % 6 == 0, "producer loop is unrolled by 6 intervals (3 register sets x 2 LDS slots)");
            for (int c = 0; c < SC_NCH; c += 6) {
                SC_IVAL(c, S0, S1); SC_IVAL(c + 1, S1, S2); SC_IVAL(c + 2, S2, S0); SC_IVAL(c + 3, S0, S1); SC_IVAL(c + 4, S1, S2); SC_IVAL(c + 5, S2, S0);
            }
            SC_YRED(SC_NCH - 1, (SC_NCH - 1) & 1);
#undef SC_LOAD
#undef SC_EMIT
#undef SC_YRED
#undef SC_IVAL
        } else {
            const int rg = lane >> 4, j = lane & 15, lrow = f.wave * 4 + rg, row = quarter * 16 + lrow;
            f32x2 s01 = {0.f, 0.f}, s23 = {0.f, 0.f};
            __builtin_amdgcn_s_setprio(3);
            const unsigned fb0 = (unsigned)(uintptr_t)FB, yp0 = (unsigned)(uintptr_t)YP;
            LDS_WAIT(); __builtin_amdgcn_s_barrier();
#define SC_LDF(Fv, sl) do { \
    asm volatile("ds_read_b128 %0, %1 offset:%2" : "=&v"(Fv.r) : "v"(adr), "n"((sl) * 1536)); \
    asm volatile("ds_read_b128 %0, %1 offset:%2" : "=&v"(Fv.w) : "v"(adr), "n"((sl) * 1536 + 256)); \
    asm volatile("ds_read_b128 %0, %1 offset:%2" : "=&v"(Fv.k) : "v"(adr), "n"((sl) * 1536 + 512)); \
    asm volatile("ds_read_b128 %0, %1 offset:%2" : "=&v"(Fv.a) : "v"(adr), "n"((sl) * 1536 + 768)); \
    asm volatile("ds_read_b128 %0, %1 offset:%2" : "=&v"(Fv.b) : "v"(adr), "n"((sl) * 1536 + 1024)); \
    asm volatile("ds_read_b32 %0, %1 offset:%2" : "=&v"(Fv.v) : "v"(adv), "n"((sl) * 1536 + 1280)); } while (0)
#define SC_WAITF(Fv, N) asm volatile("s_waitcnt lgkmcnt(" #N ")" : "+v"(Fv.r), "+v"(Fv.w), "+v"(Fv.k), "+v"(Fv.a), "+v"(Fv.b), "+v"(Fv.v))
#define SC_YOUT(sl) do { f32x2 y_ = s01 * (f32x2){rp.x, rp.y}; y_ = s23 * (f32x2){rp.z, rp.w} + y_; const float ys_ = y_.x + y_.y; \
    asm volatile("ds_write_b32 %0, %1 offset:%2" :: "v"(ady), "v"(ys_), "n"((sl) * 1024)); } while (0)
#define SC_STEP(X, Z, sl, N, HASLD, HASY) do { \
    if (HASLD) SC_LDF(Z, (sl) + 2); \
    SC_WAITF(X, N); \
    f32x2 p_ = s01 * (f32x2){X.a.x, X.a.y}; p_ = s23 * (f32x2){X.a.z, X.a.w} + p_; \
    const float sa_ = sum16(p_.x + p_.y); \
    if (HASY) SC_YOUT((sl) - 1); \
    const f32x2 sa2_ = {sa_, sa_}, vv2_ = {X.v, X.v}; \
    f32x2 t01_ = s01 * (f32x2){X.w.x, X.w.y}; t01_ = vv2_ * (f32x2){X.k.x, X.k.y} + t01_; \
    f32x2 t23_ = s23 * (f32x2){X.w.z, X.w.w}; t23_ = vv2_ * (f32x2){X.k.z, X.k.w} + t23_; \
    s01 = sa2_ * (f32x2){X.b.x, X.b.y} + t01_; s23 = sa2_ * (f32x2){X.b.z, X.b.w} + t23_; \
    rp = X.r; } while (0)
            for (int c = 0; c < SC_NCH; ++c) {
                const unsigned adr = fb0 + (unsigned)((c & 1) * SC_T * 1536 + 16 * j), adv = fb0 + (unsigned)((c & 1) * SC_T * 1536 + 4 * row);
                const unsigned ady = yp0 + (unsigned)((((c & 1) * SC_T) * 16 + lrow) * 64 + 4 * j);
                ScanFeat FA, FBv, FC; f32x4 rp = {0.f, 0.f, 0.f, 0.f};
                SC_LDF(FA, 0); SC_LDF(FBv, 1);
                SC_STEP(FA, FC, 0, 12, true, false);   SC_STEP(FBv, FA, 1, 12, true, true);   SC_STEP(FC, FBv, 2, 13, true, true);
                SC_STEP(FA, FC, 3, 14, true, true);    SC_STEP(FBv, FA, 4, 14, true, true);   SC_STEP(FC, FBv, 5, 14, true, true);
                SC_STEP(FA, FC, 6, 14, true, true);    SC_STEP(FBv, FA, 7, 14, true, true);   SC_STEP(FC, FBv, 8, 14, true, true);
                SC_STEP(FA, FC, 9, 14, true, true);    SC_STEP(FBv, FA, 10, 14, true, true);  SC_STEP(FC, FBv, 11, 14, true, true);
                SC_STEP(FA, FC, 12, 14, true, true);   SC_STEP(FBv, FA, 13, 14, true, true);  SC_STEP(FC, FBv, 14, 8, false, true);
                SC_STEP(FA, FC, 15, 2, false, true);
                SC_YOUT(15);
                LDS_WAIT(); __builtin_amdgcn_s_barrier();
            }
            __builtin_amdgcn_s_setprio(0);
#undef SC_LDF
#undef SC_WAITF
#undef SC_YOUT
#undef SC_STEP
        }
        __syncthreads();
    }
}
typedef short bf16x8_t __attribute__((ext_vector_type(8)));
__device__ __forceinline__ unsigned cvtpk(float lo, float hi) { typedef float f2 __attribute__((ext_vector_type(2))); typedef __bf16 b2 __attribute__((ext_vector_type(2))); f2 v = {lo, hi}; b2 b = __builtin_convertvector(v, b2); return __builtin_bit_cast(unsigned, b); }
__device__ __forceinline__ void ph_na(Frame& f, int l, int slot0, int nslot) { const float* in_I_RPB = karg_in(I_RPB); launder_ws(f);
    const bf16* Y1 = WSP(bf16, WS_Y1); const bf16* VAT = WSP(bf16, WS_VAT);
    LAS float* btab = (LAS float*)(f.lds + 106496 + f.wave * 1024);
    const int lane = f.lane, g = lane >> 4, qi = lane & 15;
    for (int sl = 0; sl < nslot; ++sl) { const int it = (slot0 + sl) * NWAVES + f.wave;
        const int qb = it & 3, unit = it >> 2, b = unit >> 10, h = (unit >> 7) & 7, i = unit & 127;
        const int x = qb * 16 + qi, m = b * SEQ + i * GRIDW + x;
        int rs = i - 4; rs = rs < 0 ? 0 : (rs > 120 ? 120 : rs);
        int cs = x - 8; cs = cs < 0 ? 0 : (cs > 48 ? 48 : cs);
        const int cb = qb == 0 ? 0 : (qb == 1 ? 8 : (qb == 2 ? 24 : 32));
#pragma unroll
        for (int q = 0; q < 4; ++q) { const int idx = lane + 64 * q; if (idx < 248) { const int jrl = idx / 31, dxi = idx % 31;
            btab[jrl * 32 + dxi] = in_I_RPB[((size_t)(l * 8 + h) * 15 + (rs + jrl - i + 7)) * 31 + dxi] * LOG2E; } }
        bf16x8_t qf[2];
#pragma unroll
        for (int ks = 0; ks < 2; ++ks) qf[ks] = *(const bf16x8_t*)(Y1 + (size_t)m * INP + C_QA + h * 64 + 32 * ks + 8 * g);
        float sc[16][8];
#pragma unroll
        for (int blk = 0; blk < 16; ++blk) {
            const int mk0 = blk < 8 ? (b * SEQ + (rs + blk) * GRIDW + cb) : (MLAT + b * CTXL + (blk - 8) * 32);
#pragma unroll
            for (int T = 0; T < 2; ++T) {
                const int kidx = 8 * (qi >> 2) + 4 * T + (qi & 3);
                const bf16* kp = Y1 + (size_t)(mk0 + kidx) * INP + C_KA + h * 64 + 8 * g;
                f32x4 acc = {0.f, 0.f, 0.f, 0.f};
                acc = __builtin_amdgcn_mfma_f32_16x16x32_bf16(*(const bf16x8_t*)kp, qf[0], acc, 0, 0, 0);
                acc = __builtin_amdgcn_mfma_f32_16x16x32_bf16(*(const bf16x8_t*)(kp + 32), qf[1], acc, 0, 0, 0);
                sc[blk][4 * T + 0] = acc.x; sc[blk][4 * T + 1] = acc.y; sc[blk][4 * T + 2] = acc.z; sc[blk][4 * T + 3] = acc.w;
            }
        }
        LDS_WAIT(); asm volatile("" ::: "memory");
        float mx = -1e30f;
#pragma unroll
        for (int blk = 0; blk < 16; ++blk)
#pragma unroll
            for (int j = 0; j < 8; ++j) {
                float s = sc[blk][j] * QSCALE;
                if (blk < 8) { const int y = cb + 8 * g + j; const bool valid = (unsigned)(y - cs) < 16u; int bi = y - x + 15; bi = bi < 0 ? 0 : (bi > 30 ? 30 : bi);
                    s = valid ? s + btab[blk * 32 + bi] : -1e30f; }
                sc[blk][j] = s; mx = fmaxf(mx, s);
            }
        mx = fmaxf(mx, __shfl_xor(mx, 16)); mx = fmaxf(mx, __shfl_xor(mx, 32));
        float sum = 0.f;
        bf16x8_t pf[16];
#pragma unroll
        for (int blk = 0; blk < 16; ++blk) {
#pragma unroll
            for (int j = 0; j < 8; ++j) { const float p = __builtin_amdgcn_exp2f(sc[blk][j] - mx); sc[blk][j] = p; sum += p; }
            const v4u w = {cvtpk(sc[blk][0], sc[blk][1]), cvtpk(sc[blk][2], sc[blk][3]), cvtpk(sc[blk][4], sc[blk][5]), cvtpk(sc[blk][6], sc[blk][7])};
            pf[blk] = __builtin_bit_cast(bf16x8_t, w);
        }
        sum += __shfl_xor(sum, 16); sum += __shfl_xor(sum, 32);
        f32x4 o[4];
#pragma unroll
        for (int dt = 0; dt < 4; ++dt) o[dt] = (f32x4){0.f, 0.f, 0.f, 0.f};
        const bf16* vbase = VAT + ((size_t)(b * 8 + h) * 64 + qi) * SKV + 8 * g;
#pragma unroll
        for (int blk = 0; blk < 16; ++blk) {
            const int pos0 = blk < 8 ? (CTXL + (rs + blk) * GRIDW + cb) : (blk - 8) * 32;
#pragma unroll
            for (int dt = 0; dt < 4; ++dt) o[dt] = __builtin_amdgcn_mfma_f32_16x16x32_bf16(*(const bf16x8_t*)(vbase + (size_t)dt * 16 * SKV + pos0), pf[blk], o[dt], 0, 0, 0);
        }
        const float inv = 1.0f / sum;
        bf16* op = WSP(bf16, WS_OA) + (size_t)m * 512 + h * 64 + 4 * g;
#pragma unroll
        for (int dt = 0; dt < 4; ++dt) { const f32x4 r = o[dt] * inv; *(v2u*)(op + dt * 16) = (v2u){cvtpk(r.x, r.y), cvtpk(r.z, r.w)}; }
        LDS_WAIT(); asm volatile("" ::: "memory");
    }
}
__device__ __forceinline__ void ph_vat(Frame& f) { launder_ws(f);
    const bf16* Y1 = WSP(bf16, WS_Y1); bf16* VAT = WSP(bf16, WS_VAT);
    LAS bf16* tile = (LAS bf16*)(f.lds + f.wave * 16384);
    const int lane = f.lane, gw = f.vcu * NWAVES + f.wave, NGW = f.G * NWAVES;
    constexpr int NA_ITEMS = 2 * 8 * (SKV / 64);
    for (int it = gw; it < NA_ITEMS + 16; it += NGW) {
        const bool grpb = it >= NA_ITEMS;
        const int itb = it - NA_ITEMS;
        const int pt = grpb ? (itb & 3) : it % (SKV / 64), bh = grpb ? (itb >> 2) : it / (SKV / 64), b = grpb ? (bh >> 1) : (bh >> 3), h = grpb ? (bh & 1) : (bh & 7);
        const int pos = pt * 64 + lane, m = pos < CTXL ? (MLAT + b * CTXL + pos) : (b * SEQ + pos - CTXL);
        const bf16* vp = Y1 + (size_t)m * INP + (grpb ? C_VB : C_VA) + h * 64;
#pragma unroll
        for (int c = 0; c < 8; ++c) { const v4u w = ((const v4u*)vp)[c];
            tile[(8 * c + 0) * 72 + lane] = (bf16)(w.x & 0xffffu); tile[(8 * c + 1) * 72 + lane] = (bf16)(w.x >> 16); tile[(8 * c + 2) * 72 + lane] = (bf16)(w.y & 0xffffu); tile[(8 * c + 3) * 72 + lane] = (bf16)(w.y >> 16);
            tile[(8 * c + 4) * 72 + lane] = (bf16)(w.z & 0xffffu); tile[(8 * c + 5) * 72 + lane] = (bf16)(w.z >> 16); tile[(8 * c + 6) * 72 + lane] = (bf16)(w.w & 0xffffu); tile[(8 * c + 7) * 72 + lane] = (bf16)(w.w >> 16); }
        LDS_WAIT(); asm volatile("" ::: "memory");
        bf16* op = grpb ? WSP(bf16, WS_VBT) + ((size_t)bh * 64 + lane) * CTXL + pt * 64 : VAT + ((size_t)bh * 64 + lane) * SKV + pt * 64;
#pragma unroll
        for (int c = 0; c < 8; ++c) *(v4u*)(op + 8 * c) = *(const LAS v4u*)(tile + lane * 72 + 8 * c);
        LDS_WAIT(); asm volatile("" ::: "memory");
    }
}
__device__ __forceinline__ void ph_ctxattn(Frame& f, int vrot) { launder_ws(f);
    const bf16* Y1 = WSP(bf16, WS_Y1);
    const int lane = f.lane, g = lane >> 4, qi = lane & 15;
    const int gw = ((f.vcu + vrot) % f.G) * NWAVES + f.wave, NGW = f.G * NWAVES;
    for (int it = gw; it < 512; it += NGW) {
        const int kind = it >> 8, r = it & 255, b = r >> 7, h = (r >> 4) & 7, qb = r & 15;
        const int m = MLAT + b * CTXL + qb * 16 + qi;
        const bf16* qp = kind ? WSP(bf16, WS_QBP) + (size_t)m * 512 + h * 64 : Y1 + (size_t)m * INP + C_QA + h * 64;
        const bf16* kbase = kind ? WSP(bf16, WS_KBP) + (size_t)b * SKV * 128 + (h >> 2) * 64 : Y1 + (size_t)(MLAT + b * CTXL) * INP + C_KA + h * 64;
        const int kpitch = kind ? 128 : INP;
        const bf16* vbase = kind ? WSP(bf16, WS_VBT) + (size_t)((b * 2 + (h >> 2)) * 64) * CTXL : WSP(bf16, WS_VAT) + (size_t)((b * 8 + h) * 64) * SKV;
        const int vpitch = kind ? CTXL : SKV;
        const float scale = kind ? 1.0f : QSCALE;
        bf16x8_t qf[2];
#pragma unroll
        for (int ks = 0; ks < 2; ++ks) qf[ks] = *(const bf16x8_t*)(qp + 32 * ks + 8 * g);
        float sc[8][8];
#pragma unroll
        for (int blk = 0; blk < 8; ++blk)
#pragma unroll
            for (int T = 0; T < 2; ++T) {
                const int kidx = 8 * (qi >> 2) + 4 * T + (qi & 3);
                const bf16* kp = kbase + (size_t)(blk * 32 + kidx) * kpitch + 8 * g;
                f32x4 acc = {0.f, 0.f, 0.f, 0.f};
                acc = __builtin_amdgcn_mfma_f32_16x16x32_bf16(*(const bf16x8_t*)kp, qf[0], acc, 0, 0, 0);
                acc = __builtin_amdgcn_mfma_f32_16x16x32_bf16(*(const bf16x8_t*)(kp + 32), qf[1], acc, 0, 0, 0);
                sc[blk][4 * T + 0] = acc.x * scale; sc[blk][4 * T + 1] = acc.y * scale; sc[blk][4 * T + 2] = acc.z * scale; sc[blk][4 * T + 3] = acc.w * scale;
            }
        float mx = -1e30f;
#pragma unroll
        for (int blk = 0; blk < 8; ++blk)
#pragma unroll
            for (int j = 0; j < 8; ++j) mx = fmaxf(mx, sc[blk][j]);
        mx = fmaxf(mx, __shfl_xor(mx, 16)); mx = fmaxf(mx, __shfl_xor(mx, 32));
        float sum = 0.f;
        bf16x8_t pf[8];
#pragma unroll
        for (int blk = 0; blk < 8; ++blk) {
#pragma unroll
            for (int j = 0; j < 8; ++j) { const float p = __builtin_amdgcn_exp2f(sc[blk][j] - mx); sc[blk][j] = p; sum += p; }
            const v4u w = {cvtpk(sc[blk][0], sc[blk][1]), cvtpk(sc[blk][2], sc[blk][3]), cvtpk(sc[blk][4], sc[blk][5]), cvtpk(sc[blk][6], sc[blk][7])};
            pf[blk] = __builtin_bit_cast(bf16x8_t, w);
        }
        sum += __shfl_xor(sum, 16); sum += __shfl_xor(sum, 32);
        f32x4 o[4];
#pragma unroll
        for (int dt = 0; dt < 4; ++dt) o[dt] = (f32x4){0.f, 0.f, 0.f, 0.f};
#pragma unroll
        for (int blk = 0; blk < 8; ++blk)
#pragma unroll
            for (int dt = 0; dt < 4; ++dt) o[dt] = __builtin_amdgcn_mfma_f32_16x16x32_bf16(*(const bf16x8_t*)(vbase + (size_t)(dt * 16 + qi) * vpitch + blk * 32 + 8 * g), pf[blk], o[dt], 0, 0, 0);
        const float inv = 1.0f / sum;
        bf16* op = (kind ? WSP(bf16, WS_OB) : WSP(bf16, WS_OA)) + (size_t)m * 512 + h * 64 + 4 * g;
#pragma unroll
        for (int dt = 0; dt < 4; ++dt) { const f32x4 rr = o[dt] * inv; *(v2u*)(op + dt * 16) = (v2u){cvtpk(rr.x, rr.y), cvtpk(rr.z, rr.w)}; }
    }
}
struct F8 { f32x4 lo, hi; };
__device__ __forceinline__ F8 unpack8(v4u w) { F8 r; r.lo = (f32x4){bflo(w.x), bfhi(w.x), bflo(w.y), bfhi(w.y)}; r.hi = (f32x4){bflo(w.z), bfhi(w.z), bflo(w.w), bfhi(w.w)}; return r; }
__device__ __forceinline__ bf16x8_t pack8(f32x4 lo, f32x4 hi) { const v4u w = {cvtpk(lo.x, lo.y), cvtpk(lo.z, lo.w), cvtpk(hi.x, hi.y), cvtpk(hi.z, hi.w)}; return __builtin_bit_cast(bf16x8_t, w); }
__device__ __forceinline__ float fast_tanh(float x) { const float e = __expf(2.0f * x); return 1.0f - 2.0f / (1.0f + e); }
__device__ __forceinline__ f32x4 tanh4(f32x4 v) { return (f32x4){fast_tanh(v.x), fast_tanh(v.y), fast_tanh(v.z), fast_tanh(v.w)}; }
__device__ __forceinline__ f32x4 sigm4(f32x4 v) { return (f32x4){sigmoidf_(v.x), sigmoidf_(v.y), sigmoidf_(v.z), sigmoidf_(v.w)}; }
__device__ __forceinline__ v4u sel4(bool c, v4u v) { return c ? v : (v4u){0u, 0u, 0u, 0u}; }
__device__ __forceinline__ void ph_lora2(Frame& f, int l) { const float* in_I_A0 = karg_in(I_A0); const float* in_I_MUA = karg_in(I_MUA); const float* in_I_MUG = karg_in(I_MUG); const float* in_I_MUW = karg_in(I_MUW); const float* in_I_W0 = karg_in(I_W0); launder_ws(f);
    const bf16* Y1 = WSP(bf16, WS_Y1);
    const bf16* W2T = WSP(bf16, WS_LW) + (size_t)l * 2 * CW * 64; const bf16* A2T = WSP(bf16, WS_LW + 1 * MiB) + (size_t)l * 2 * CW * 64; const bf16* G2T = WSP(bf16, WS_LW + 2 * MiB) + (size_t)l * CW * 160;
    const int lane = f.lane, g = lane >> 4, qi = lane & 15, gw = f.vcu * NWAVES + f.wave, NGW = f.G * NWAVES;
    const v4u zero4 = {0u, 0u, 0u, 0u};
    const int NFULL = (f.G * NWAVES < (MALL / 16) * 2) ? f.G * NWAVES : (MALL / 16) * 2, NREST = (MALL / 16) * 2 - NFULL;
    for (int it0 = gw; it0 < NFULL + NREST * 8; it0 += NGW) {
        const int it = it0 < NFULL ? it0 : NFULL + (it0 - NFULL) / 8, ct_lo = it0 < NFULL ? 0 : (it0 - NFULL) % 8, ct_hi = it0 < NFULL ? 8 : ct_lo + 1;
        const int half = it & 1, m = (it >> 1) * 16 + qi;
        const RowInfo R = row_info(m);
        const bool hasp = R.t > 0, hasn = R.t < R.T - 1;
        const bf16* y = Y1 + (size_t)m * INP; const bf16* yp = hasp ? y - INP : y; const bf16* yn = hasn ? y + INP : y;
        bf16x8_t xw[2][2], xa[2][2], xg[5];
#pragma unroll
        for (int d = 0; d < 2; ++d)
#pragma unroll
            for (int ks = 0; ks < 2; ++ks) {
                const int col = d * 64 + 32 * ks + 8 * g; const bf16* yb = d ? yn : yp; const bool has = d ? hasn : hasp;
                { const F8 cur = unpack8(*(const v4u*)(y + C_WD + col)), nb = unpack8(sel4(has, *(const v4u*)(yb + C_WD + col)));
                  const f32x4 m0 = *(const f32x4*)(in_I_MUW + l * 128 + col), m1 = *(const f32x4*)(in_I_MUW + l * 128 + col + 4);
                  xw[d][ks] = pack8(tanh4(cur.lo + m0 * (nb.lo - cur.lo)), tanh4(cur.hi + m1 * (nb.hi - cur.hi))); }
                asm volatile("" : "+v"(xw[d][ks]) :: "memory");
                { const F8 cur = unpack8(*(const v4u*)(y + C_AD + col)), nb = unpack8(sel4(has, *(const v4u*)(yb + C_AD + col)));
                  const f32x4 m0 = *(const f32x4*)(in_I_MUA + l * 128 + col), m1 = *(const f32x4*)(in_I_MUA + l * 128 + col + 4);
                  xa[d][ks] = pack8(cur.lo + m0 * (nb.lo - cur.lo), cur.hi + m1 * (nb.hi - cur.hi)); }
                asm volatile("" : "+v"(xa[d][ks]) :: "memory");
            }
#pragma unroll
        for (int ks = 0; ks < 5; ++ks) {
            const int col = 32 * ks + 8 * g;
            const F8 cur = unpack8(*(const v4u*)(y + C_GD + col)), pv = unpack8(sel4(hasp, *(const v4u*)(yp + C_GD + col))), nx = unpack8(sel4(hasn, *(const v4u*)(yn + C_GD + col)));
            const f32x4 p0 = *(const f32x4*)(in_I_MUG + l * 320 + col), p1 = *(const f32x4*)(in_I_MUG + l * 320 + col + 4), n0 = *(const f32x4*)(in_I_MUG + l * 320 + 160 + col), n1 = *(const f32x4*)(in_I_MUG + l * 320 + 160 + col + 4);
            xg[ks] = pack8(sigm4(cur.lo + p0 * (pv.lo - cur.lo) + n0 * (nx.lo - cur.lo)), sigm4(cur.hi + p1 * (pv.hi - cur.hi) + n1 * (nx.hi - cur.hi)));
            asm volatile("" : "+v"(xg[ks]) :: "memory");
        }
        bf16* wq = WSP(bf16, WS_WDEC); bf16* ai = WSP(bf16, WS_AIC); bf16* gq = WSP(bf16, WS_G);
        struct LwSet { bf16x8_t w[4][2]; f32x4 bias[4]; };
#define LW_LOAD(S_, base_, bias_, d_, c0_) do { const int cr_ = (c0_) + 16 * (qi >> 2) + (qi & 3), cc_ = (c0_) + 16 * g; _Pragma("unroll") for (int T = 0; T < 4; ++T) { \
            const bf16* wp_ = (base_) + ((size_t)(d_) * CW + cr_ + 4 * T) * 64 + 8 * g; S_.w[T][0] = *(const bf16x8_t*)wp_; S_.w[T][1] = *(const bf16x8_t*)(wp_ + 32); \
            S_.bias[T] = *(const f32x4*)((bias_) + (l * 2 + (d_)) * CW + cc_ + 4 * T); } } while (0)
#define LW_MMA(acc_, S_, x_) do { _Pragma("unroll") for (int T = 0; T < 4; ++T) { acc_[T] = (f32x4){0.f, 0.f, 0.f, 0.f}; \
            acc_[T] = __builtin_amdgcn_mfma_f32_16x16x32_bf16(S_.w[T][0], x_[0], acc_[T], 0, 0, 0); acc_[T] = __builtin_amdgcn_mfma_f32_16x16x32_bf16(S_.w[T][1], x_[1], acc_[T], 0, 0, 0); } } while (0)
#define LW_ST16(op_, o_) do { *(v4u*)(op_) = (v4u){cvtpk(o_[0].x, o_[0].y), cvtpk(o_[0].z, o_[0].w), cvtpk(o_[1].x, o_[1].y), cvtpk(o_[1].z, o_[1].w)}; \
            *(v4u*)((op_) + 8) = (v4u){cvtpk(o_[2].x, o_[2].y), cvtpk(o_[2].z, o_[2].w), cvtpk(o_[3].x, o_[3].y), cvtpk(o_[3].z, o_[3].w)}; } while (0)
#define LW_EPI(acc_, S_, dstb_, d_, c0_, scale_) do { f32x4 o_[4]; _Pragma("unroll") for (int T = 0; T < 4; ++T) { const f32x4 z_ = acc_[T] + S_.bias[T]; \
            _Pragma("unroll") for (int q = 0; q < 4; ++q) o_[T][q] = (scale_) * __builtin_amdgcn_rcpf(1.0f + __expf(-z_[q])); } \
            bf16* op_ = (dstb_) + ((size_t)(d_) * MALL + m) * CW + (c0_) + 16 * g; LW_ST16(op_, o_); } while (0)
#define LW_FENCE() asm volatile("" ::: "memory")
        LwSet SA, SB; bf16x8_t GW[4][5];
        { const int c0 = half * 512 + ct_lo * 64; LW_LOAD(SA, W2T, in_I_W0, 0, c0); }
        LW_FENCE();
#pragma unroll 1
        for (int ct = ct_lo; ct < ct_hi; ++ct) {
            const int c0 = half * 512 + ct * 64, cr = c0 + 16 * (qi >> 2) + (qi & 3), cc = c0 + 16 * g;
            const int c0n = half * 512 + (ct + 1 < ct_hi ? ct + 1 : ct) * 64;
            f32x4 acc[4];
            LW_MMA(acc, SA, xw[0]); LW_LOAD(SB, A2T, in_I_A0, 0, c0); LW_FENCE(); LW_EPI(acc, SA, wq, 0, c0, 0.60653065971f); LW_FENCE();
            LW_MMA(acc, SB, xa[0]); LW_LOAD(SA, W2T, in_I_W0, 1, c0); LW_FENCE(); LW_EPI(acc, SB, ai, 0, c0, 1.0f); LW_FENCE();
            LW_MMA(acc, SA, xw[1]); LW_LOAD(SB, A2T, in_I_A0, 1, c0); LW_FENCE(); LW_EPI(acc, SA, wq, 1, c0, 0.60653065971f); LW_FENCE();
            LW_MMA(acc, SB, xa[1]);
#pragma unroll
            for (int T = 0; T < 4; ++T) { const bf16* gp = G2T + (size_t)(cr + 4 * T) * 160 + 8 * g;
#pragma unroll
                for (int ks = 0; ks < 5; ++ks) GW[T][ks] = *(const bf16x8_t*)(gp + 32 * ks); }
            LW_FENCE(); LW_EPI(acc, SB, ai, 1, c0, 1.0f); LW_FENCE();
#pragma unroll
            for (int T = 0; T < 4; ++T) { acc[T] = (f32x4){0.f, 0.f, 0.f, 0.f};
#pragma unroll
                for (int ks = 0; ks < 5; ++ks) acc[T] = __builtin_amdgcn_mfma_f32_16x16x32_bf16(GW[T][ks], xg[ks], acc[T], 0, 0, 0); }
            LW_LOAD(SA, W2T, in_I_W0, 0, c0n); LW_FENCE();
            { bf16* op = gq + (size_t)m * CW + cc; LW_ST16(op, acc); }
            LW_FENCE();
        }
#undef LW_LOAD
#undef LW_MMA
#undef LW_ST16
#undef LW_EPI
#undef LW_FENCE
    }
}
__device__ __forceinline__ void ph_lora_weights(Frame& f) { const float* in_I_A2 = karg_in(I_A2); const float* in_I_G2 = karg_in(I_G2); const float* in_I_W2 = karg_in(I_W2); launder_ws(f);
    const int gt = f.vcu * 512 + f.tid, GT = f.G * 512;
    for (int i = gt; i < DEPTH * 2 * CW * 64; i += GT) { const int r = i & 63, c = (i >> 6) & (CW - 1), ld = i >> 16;
        WSP(bf16, WS_LW)[i] = (bf16)f2bf(in_I_W2[((size_t)ld * 64 + r) * CW + c]); WSP(bf16, WS_LW + 1 * MiB)[i] = (bf16)f2bf(in_I_A2[((size_t)ld * 64 + r) * CW + c]); }
    for (int i = gt; i < DEPTH * CW * 160; i += GT) { const int r = i % 160, c = (i / 160) % CW, l = i / (160 * CW);
        WSP(bf16, WS_LW + 2 * MiB)[i] = (bf16)f2bf(in_I_G2[((size_t)l * 160 + r) * CW + c]); }
}
__device__ __forceinline__ void ph_setup2(Frame& f) { const float* in_I_CTX = karg_in(I_CTX); const float* in_I_N1G = karg_in(I_N1G); const float* in_I_N2G = karg_in(I_N2G); const float* in_I_X = karg_in(I_X); launder_ws(f);
    const int gt = f.vcu * 512 + f.tid, GT = f.G * 512, gw = f.vcu * NWAVES + f.wave, NGW = f.G * NWAVES, lane = f.lane;
    const float* MOD = WSP(float, WS_MOD);
    for (int i = gt; i < DEPTH * 2 * 3 * DM; i += GT) { const int k = i & (DM - 1), s = (i >> 11) % 3, w = (i / (3 * DM)) & 1, l = i / (6 * DM);
        WSP(float, WS_GK)[i] = (w ? in_I_N2G : in_I_N1G)[l * DM + k] * (1.0f + MOD[(size_t)(l * 3 + s) * MODW + (w ? 4 : 1) * DM + k]); }
    for (int it = gw; it < DEPTH * (INP + UPN); it += NGW) {
        const int l = it / (INP + UPN), r = it % (INP + UPN); const bool up = r >= INP; const int n = up ? r - INP : r;
        const bf16* wrow = up ? WSP(bf16, WS_WUP) + ((size_t)l * UPN + n) * DM : WSP(bf16, WS_WIN) + ((size_t)l * INP + n) * DM;
        const float* sh = MOD + (size_t)l * 3 * MODW + (up ? 3 * DM : 0);
        float a0 = 0.f, a1 = 0.f, a2 = 0.f;
#pragma unroll
        for (int c = 0; c < 4; ++c) { const int k = c * 512 + lane * 8; const v4u w = *(const v4u*)(wrow + k);
            const f32x4 wl = bf4((v2u){w.x, w.y}), wh = bf4((v2u){w.z, w.w});
            a0 += hsum4(wl * *(const f32x4*)(sh + k)) + hsum4(wh * *(const f32x4*)(sh + k + 4));
            a1 += hsum4(wl * *(const f32x4*)(sh + MODW + k)) + hsum4(wh * *(const f32x4*)(sh + MODW + k + 4));
            a2 += hsum4(wl * *(const f32x4*)(sh + 2 * MODW + k)) + hsum4(wh * *(const f32x4*)(sh + 2 * MODW + k + 4)); }
        a0 = sum64(a0); a1 = sum64(a1); a2 = sum64(a2);
        if (lane == 0) { float* o = up ? WSP(float, WS_BIAS3) + (size_t)l * 3 * UPN + n : WSP(float, WS_BIAS1) + (size_t)l * 3 * INP + n; const int ld = up ? UPN : INP; o[0] = a0; o[ld] = a1; o[2 * ld] = a2; }
    }
    for (int m = gw; m < MALL; m += NGW) {
        const int s = m < SEQ ? 0 : (m < MLAT ? 1 : 2);
        const f32x4* xr = (const f32x4*)(m < MLAT ? in_I_X + (size_t)m * DM : in_I_CTX + (size_t)(m - MLAT) * DM) + lane;
        f32x4* hr = (f32x4*)(WSP(float, WS_H) + (size_t)m * DM) + lane; v2u* o = (v2u*)(WSP(bf16, WS_XN) + (size_t)m * DM) + lane;
        const float* sc = MOD + (size_t)s * MODW + DM;
        float ss = 0.f;
#pragma unroll
        for (int j = 0; j < 8; ++j) { const int col = lane * 4 + 256 * j; const f32x4 v = xr[64 * j]; hr[64 * j] = v; ss += hsum4(v * v);
            const f32x4 r = v * *(const f32x4*)(in_I_N1G + col) * (*(const f32x4*)(sc + col) + 1.0f);
            o[64 * j] = (v2u){pk2(r.x, r.y), pk2(r.z, r.w)}; }
        ss = sum64(ss);
        if (lane == 0) WSP(float, WS_RS)[m] = __builtin_amdgcn_rsqf(ss * (1.f / DM) + 1e-6f);
    }
}
struct EpiScaleBias {
    static constexpr bool PERM = true, AFTER_DRAIN = false;
    bf16* O; int ldc; const float* ss; const float* bias; int bias_ld;
    __device__ __forceinline__ void operator()(const pg8::f32x4 (&acc)[2][2][4][2], const pg8::Unit& u, int wr, int wc, int fr, int fq) const {
        const int row0 = u.pm * 256 + wr * 64 + fr, col0 = u.pn * 256 + wc * 32 + 8 * fq;
        const int s = u.pm < 32 ? 0 : (u.pm < 64 ? 1 : 2);
        const float* bp = bias + (size_t)s * bias_ld + col0;
        pg8::f32x4 bv[2][2];
#pragma unroll
        for (int bj = 0; bj < 2; ++bj)
#pragma unroll
            for (int n = 0; n < 2; ++n) bv[bj][n] = *(const pg8::f32x4*)(bp + bj * 128 + 4 * n);
#pragma unroll
        for (int ai = 0; ai < 2; ++ai)
#pragma unroll
            for (int m = 0; m < 4; ++m) { const int row = row0 + ai * 128 + m * 16; const float rs = ss[row];
                bf16* rowp = O + (size_t)row * ldc + col0;
#pragma unroll
                for (int bj = 0; bj < 2; ++bj) { const pg8::f32x4 v0 = acc[ai][bj][m][0] * rs + bv[bj][0], v1 = acc[ai][bj][m][1] * rs + bv[bj][1];
                    *(v4u*)(rowp + bj * 128) = (v4u){pg8::cvt_pk_bf16(v0[0], v0[1]), pg8::cvt_pk_bf16(v0[2], v0[3]), pg8::cvt_pk_bf16(v1[0], v1[1]), pg8::cvt_pk_bf16(v1[2], v1[3])}; } }
    }
};
struct EpiResGateNorm {
    static constexpr bool PERM = true, AFTER_DRAIN = false;
    float* H; const float* mod; const float* gk; bf16* AH; float* ss;
    __device__ __forceinline__ void operator()(const pg8::f32x4 (&acc)[2][2][4][2], const pg8::Unit& u, int wr, int wc, int fr, int fq) const {
        const int row0 = u.pm * 256 + wr * 64 + fr, col0 = u.pn * 256 + wc * 32 + 8 * fq;
        const int s = u.pm < 32 ? 0 : (u.pm < 64 ? 1 : 2);
        const float* gp = mod + (size_t)s * MODW + col0; const float* kp = gk + (size_t)s * DM + col0;
        pg8::f32x4 gv[2][2], kv[2][2];
#pragma unroll
        for (int bj = 0; bj < 2; ++bj)
#pragma unroll
            for (int n = 0; n < 2; ++n) { gv[bj][n] = *(const pg8::f32x4*)(gp + bj * 128 + 4 * n); kv[bj][n] = gk ? *(const pg8::f32x4*)(kp + bj * 128 + 4 * n) : (pg8::f32x4){0.f, 0.f, 0.f, 0.f}; }
#pragma unroll
        for (int ai = 0; ai < 2; ++ai)
#pragma unroll
            for (int m = 0; m < 4; ++m) { const int row = row0 + ai * 128 + m * 16; float* rowp = H + (size_t)row * DM + col0; float sq = 0.f;
#pragma unroll
                for (int bj = 0; bj < 2; ++bj) { pg8::f32x4* p0 = (pg8::f32x4*)(rowp + bj * 128); pg8::f32x4* p1 = p0 + 1;
                    const pg8::f32x4 h0 = *p0 + gv[bj][0] * acc[ai][bj][m][0], h1 = *p1 + gv[bj][1] * acc[ai][bj][m][1];
                    *p0 = h0; *p1 = h1;
                    if (gk) { sq += (h0[0] * h0[0] + h0[1] * h0[1]) + (h0[2] * h0[2] + h0[3] * h0[3]) + (h1[0] * h1[0] + h1[1] * h1[1]) + (h1[2] * h1[2] + h1[3] * h1[3]);
                        const pg8::f32x4 a0 = h0 * kv[bj][0], a1 = h1 * kv[bj][1];
                        *(v4u*)(AH + (size_t)row * DM + col0 + bj * 128) = (v4u){pg8::cvt_pk_bf16(a0[0], a0[1]), pg8::cvt_pk_bf16(a0[2], a0[3]), pg8::cvt_pk_bf16(a1[0], a1[1]), pg8::cvt_pk_bf16(a1[2], a1[3])}; } }
                if (gk) { sq += __shfl_xor(sq, 16); sq += __shfl_xor(sq, 32); if (fq == 0) ss[(size_t)row * 32 + u.pn * 4 + wc] = sq; } }
    }
};

struct CtxSplitOrder {
    int G, c, KS, ksub;
    __device__ __forceinline__ bool next(int i, pg8::Unit& u) const { const int L = i * G + c; if (L >= 16 * KS) return false; const int r = L & 15; u.kb = (L >> 4) * ksub; u.pm = 64 + (r & 1); u.pn = r >> 1; return true; }
    __device__ __forceinline__ void a_ready(const pg8::Unit&) const {}
    __device__ __forceinline__ void done(const pg8::Unit&) const {}
};
struct EpiPartial {
    static constexpr bool PERM = true, AFTER_DRAIN = false;
    float* P; int ksub;
    __device__ __forceinline__ void operator()(const pg8::f32x4 (&acc)[2][2][4][2], const pg8::Unit& u, int wr, int wc, int fr, int fq) const {
        const int row0 = (u.pm - 64) * 256 + wr * 64 + fr, col0 = u.pn * 256 + wc * 32 + 8 * fq, ks = u.kb / ksub;
#pragma unroll
        for (int ai = 0; ai < 2; ++ai)
#pragma unroll
            for (int m = 0; m < 4; ++m) { float* rowp = P + ((size_t)ks * MCTX + row0 + ai * 128 + m * 16) * DM + col0;
#pragma unroll
                for (int bj = 0; bj < 2; ++bj) { *(pg8::f32x4*)(rowp + bj * 128) = acc[ai][bj][m][0]; *(pg8::f32x4*)(rowp + bj * 128 + 4) = acc[ai][bj][m][1]; } }
    }
};
template <int KS> __device__ __forceinline__ void ph_rs(Frame& f, int which, const float* gate, const float* gk) { launder_ws(f);
    const int gt = f.vcu * 512 + f.tid, GT = f.G * 512;
    for (int m = gt; m < MLAT; m += GT) { const f32x4* p = (const f32x4*)(WSP(float, WS_SSP) + ((size_t)which * MALL + m) * 32);
        f32x4 a = p[0];
#pragma unroll
        for (int j = 1; j < 8; ++j) a += p[j];
        WSP(float, WS_RS)[(size_t)which * MALL + m] = __builtin_amdgcn_rsqf(hsum4(a) * (1.f / DM) + 1e-6f); }
    if (KS > 0) {
        LAS float* red = (LAS float*)f.lds;
        const int lane = f.lane;
        for (int rb = f.vcu; rb < MCTX / 2; rb += f.G) { const int r = rb * 2 + (f.wave >> 2), jq = f.wave & 3, m = MLAT + r;
            f32x4* hr = (f32x4*)(WSP(float, WS_H) + (size_t)m * DM) + lane; v2u* o = (v2u*)(WSP(bf16, WS_XN) + (size_t)m * DM) + lane;
            const f32x4* pp = (const f32x4*)(WSP(float, WS_PART) + (size_t)r * DM) + lane;
            float ss = 0.f;
#pragma unroll
            for (int jj = 0; jj < 2; ++jj) { const int j = jq * 2 + jj, col = lane * 4 + 256 * j;
                f32x4 pv[KS > 0 ? KS : 1];
#pragma unroll
                for (int ks = 0; ks < KS; ++ks) pv[ks] = pp[(size_t)ks * MCTX * DM / 4 + 64 * j];
                f32x4 acc = pv[0];
#pragma unroll
                for (int ks = 1; ks < KS; ++ks) acc += pv[ks];
                const f32x4 h = hr[64 * j] + *(const f32x4*)(gate + col) * acc;
                hr[64 * j] = h; ss += hsum4(h * h);
                const f32x4 a = h * *(const f32x4*)(gk + col);
                o[64 * j] = (v2u){pk2(a.x, a.y), pk2(a.z, a.w)}; }
            ss = sum64(ss);
            __syncthreads();
            if (lane == 0) red[f.wave] = ss;
            __syncthreads();
            if (jq == 0 && lane == 0) WSP(float, WS_RS)[(size_t)which * MALL + m] = __builtin_amdgcn_rsqf(((red[f.wave] + red[f.wave + 1]) + (red[f.wave + 2] + red[f.wave + 3])) * (1.f / DM) + 1e-6f);
        }
    }
}
template <int CTRL> __device__ __forceinline__ float dpp_mov(float v) { return __builtin_bit_cast(float, __builtin_amdgcn_update_dpp(0, __builtin_bit_cast(int, v), CTRL, 0xF, 0xF, true)); }
template <int CTRL> __device__ __forceinline__ float dpp_keep(float old, float v) { return __builtin_bit_cast(float, __builtin_amdgcn_update_dpp(__builtin_bit_cast(int, old), __builtin_bit_cast(int, v), CTRL, 0xF, 0xF, false)); }
struct EpiConvGlu {
    static constexpr bool PERM = true, AFTER_DRAIN = false;
    bf16* HB; bf16* U; const float* rsv; const float* bias; const float* cw; const float* cb;
    __device__ __forceinline__ void operator()(const pg8::f32x4 (&acc)[2][2][4][2], const pg8::Unit& u, int wr, int wc, int fr, int fq) const {
        const int row0 = u.pm * 256 + wr * 64 + fr, col0 = u.pn * 256 + wc * 32 + 8 * fq, ch0 = u.pn * 128 + wc * 32 + 8 * fq;
        const int s = u.pm < 32 ? 0 : (u.pm < 64 ? 1 : 2);
        const float* bp = bias + (size_t)s * UPN + col0;
        pg8::f32x4 bu[2], bv[2], w0[2], w1[2], w2[2], cbv[2];
#pragma unroll
        for (int n = 0; n < 2; ++n) { bu[n] = *(const pg8::f32x4*)(bp + 4 * n); bv[n] = *(const pg8::f32x4*)(bp + 128 + 4 * n);
            w0[n] = *(const pg8::f32x4*)(cw + ch0 + 4 * n); w1[n] = *(const pg8::f32x4*)(cw + DFF + ch0 + 4 * n); w2[n] = *(const pg8::f32x4*)(cw + 2 * DFF + ch0 + 4 * n); cbv[n] = *(const pg8::f32x4*)(cb + ch0 + 4 * n); }
#pragma unroll
        for (int ai = 0; ai < 2; ++ai) {
            pg8::f32x4 uu[4][2];
            float rs[4];
#pragma unroll
            for (int m = 0; m < 4; ++m) { rs[m] = rsv[row0 + ai * 128 + m * 16];
#pragma unroll
                for (int n = 0; n < 2; ++n) uu[m][n] = acc[ai][0][m][n] * rs[m] + bu[n]; }
#pragma unroll
            for (int m = 0; m < 4; ++m) {
                const int row = row0 + ai * 128 + m * 16;
                const bool edge = (m == 0 && fr == 0) || (m == 3 && fr == 15);
                unsigned hw[4];
#pragma unroll
                for (int n = 0; n < 2; ++n) {
                    pg8::f32x4 g;
#pragma unroll
                    for (int i = 0; i < 4; ++i) {
                        const float pold = m > 0 ? dpp_mov<0x121>(uu[m - 1][n][i]) : 0.f, nold = m < 3 ? dpp_mov<0x12F>(uu[m + 1][n][i]) : 0.f;
                        const float up = dpp_keep<0x111>(pold, uu[m][n][i]), un = dpp_keep<0x101>(nold, uu[m][n][i]);
                        g[i] = up * w0[n][i] + uu[m][n][i] * w1[n][i] + un * w2[n][i] + cbv[n][i];
                    }
                    const pg8::f32x2 g0 = pg8::gelu_pk((pg8::f32x2){g[0], g[1]}), g1 = pg8::gelu_pk((pg8::f32x2){g[2], g[3]});
                    const pg8::f32x4 vv = acc[ai][1][m][n] * rs[m] + bv[n];
                    hw[2 * n] = pg8::cvt_pk_bf16(g0.x * vv[0], g0.y * vv[1]); hw[2 * n + 1] = pg8::cvt_pk_bf16(g1.x * vv[2], g1.y * vv[3]);
                }
                if (!edge) *(v4u*)(HB + (size_t)row * DFF + ch0) = (v4u){hw[0], hw[1], hw[2], hw[3]};
                if ((m == 0 && fr < 2) || (m == 3 && fr >= 14)) {
                    const pg8::f32x4 v0 = acc[ai][1][m][0] * rs[m] + bv[0], v1 = acc[ai][1][m][1] * rs[m] + bv[1];
                    bf16* up_ = U + (size_t)row * UPN + col0;
                    *(v4u*)(up_) = (v4u){pg8::cvt_pk_bf16(uu[m][0][0], uu[m][0][1]), pg8::cvt_pk_bf16(uu[m][0][2], uu[m][0][3]), pg8::cvt_pk_bf16(uu[m][1][0], uu[m][1][1]), pg8::cvt_pk_bf16(uu[m][1][2], uu[m][1][3])};
                    *(v4u*)(up_ + 128) = (v4u){pg8::cvt_pk_bf16(v0[0], v0[1]), pg8::cvt_pk_bf16(v0[2], v0[3]), pg8::cvt_pk_bf16(v1[0], v1[1]), pg8::cvt_pk_bf16(v1[2], v1[3])};
                }
            }
        }
    }
};
__device__ __forceinline__ void ph_convfix(Frame& f, int l, int mrows) { const float* in_I_CONVB = karg_in(I_CONVB); const float* in_I_CONVW = karg_in(I_CONVW); launder_ws(f);
    const int gt = f.vcu * 512 + f.tid, GT = f.G * 512;
    const bf16* U = WSP(bf16, WS_U); bf16* HB = WSP(bf16, WS_HB);
    const float* cw = in_I_CONVW + (size_t)l * 3 * DFF; const float* cb = in_I_CONVB + (size_t)l * DFF;
    constexpr int C8 = DFF / 8;
    for (int idx = gt; idx < (mrows / 32) * C8; idx += GT) {
        const int ri = idx / C8, c = (idx % C8) * 8, m = (ri >> 1) * 64 + ((ri & 1) ? 63 : 0), nc = (c >> 7) * 256 + (c & 127);
        const RowInfo R = row_info(m);
        const v4u z = {0u, 0u, 0u, 0u};
        const v4u uc = *(const v4u*)(U + (size_t)m * UPN + nc), vl = *(const v4u*)(U + (size_t)m * UPN + nc + 128);
        const v4u up = R.t > 0 ? *(const v4u*)(U + (size_t)(m - 1) * UPN + nc) : z, un = R.t < R.T - 1 ? *(const v4u*)(U + (size_t)(m + 1) * UPN + nc) : z;
        float r[8], gv[8];
#pragma unroll
        for (int i = 0; i < 8; ++i) {
            const unsigned wc_ = i < 2 ? uc.x : i < 4 ? uc.y : i < 6 ? uc.z : uc.w, wp_ = i < 2 ? up.x : i < 4 ? up.y : i < 6 ? up.z : up.w;
            const unsigned wn_ = i < 2 ? un.x : i < 4 ? un.y : i < 6 ? un.z : un.w, wv_ = i < 2 ? vl.x : i < 4 ? vl.y : i < 6 ? vl.z : vl.w;
            const float fc = (i & 1) ? bfhi(wc_) : bflo(wc_), fp = (i & 1) ? bfhi(wp_) : bflo(wp_), fn = (i & 1) ? bfhi(wn_) : bflo(wn_), fv = (i & 1) ? bfhi(wv_) : bflo(wv_);
            r[i] = fp * cw[c + i] + fc * cw[DFF + c + i] + fn * cw[2 * DFF + c + i] + cb[c + i]; gv[i] = fv;
        }
#pragma unroll
        for (int i = 0; i < 8; i += 2) { const f32x2 g2 = pg8::gelu_pk((f32x2){r[i], r[i + 1]}); r[i] = g2.x * gv[i]; r[i + 1] = g2.y * gv[i + 1]; }
        *(v4u*)(HB + (size_t)m * DFF + c) = (v4u){pk2(r[0], r[1]), pk2(r[2], r[3]), pk2(r[4], r[5]), pk2(r[6], r[7])};
    }
}
typedef float f32x16 __attribute__((ext_vector_type(16)));
#ifndef CHUNK_CHECK_C0
#define CHUNK_CHECK_C0 0
#define CHUNK_CHECK_C1 100000
#endif
#ifndef CK_SELFTEST_E
#define CK_SELFTEST_E 0
#endif
#ifndef CHUNK_CHECK_T1
#define CHUNK_CHECK_T1 32
#endif
constexpr int CK_C = 32, CK_NCH = SKV / CK_C;
constexpr size_t CK_REC = 24 * 1024;
__device__ __forceinline__ int ck_rho(int i, int h) { return (i & 3) + 8 * (i >> 2) + 4 * h; }
__device__ __forceinline__ bf16x8_t ck_frag(const f32x16& a, int s) {
    const v4u w = {cvtpk(a[8 * s + 0], a[8 * s + 1]), cvtpk(a[8 * s + 2], a[8 * s + 3]), cvtpk(a[8 * s + 4], a[8 * s + 5]), cvtpk(a[8 * s + 6], a[8 * s + 7])};
    return __builtin_bit_cast(bf16x8_t, w);
}
__device__ __forceinline__ f32x16 ck_mm(bf16x8_t a, bf16x8_t b, f32x16 c) { return __builtin_amdgcn_mfma_f32_32x32x16_bf16(a, b, c, 0, 0, 0); }
__device__ __forceinline__ void ck_swap32(float v, float& lo, float& hi) {
    const auto rr = __builtin_amdgcn_permlane32_swap(__float_as_uint(v), __float_as_uint(v), false, false); const unsigned r0 = rr[0], r1 = rr[1]; lo = __uint_as_float(r0); hi = __uint_as_float(r1); }
__device__ __forceinline__ float ck_sum2(float v) { float lo, hi; ck_swap32(v, lo, hi); return lo + hi; }
template <int CTRL, int RMASK> __device__ __forceinline__ float dpp_add0(float v) { return v + __builtin_bit_cast(float, __builtin_amdgcn_update_dpp(0, __builtin_bit_cast(int, v), CTRL, RMASK, 0xF, false)); }
__device__ __forceinline__ float ck_prefix32(float v) {
    v = dpp_add0<0x111, 0xF>(v); v = dpp_add0<0x112, 0xF>(v); v = dpp_add0<0x114, 0xF>(v); v = dpp_add0<0x118, 0xF>(v); v = dpp_add0<0x142, 0xA>(v);
    return v; }
__device__ __forceinline__ f32x4 exp4(f32x4 v) { return (f32x4){__expf(v.x), __expf(v.y), __expf(v.z), __expf(v.w)}; }

__device__ __forceinline__ f32x16 ck_unpack(v4u lo, v4u hi) { f32x16 r;
    r[0] = bflo(lo.x); r[1] = bfhi(lo.x); r[2] = bflo(lo.y); r[3] = bfhi(lo.y); r[4] = bflo(lo.z); r[5] = bfhi(lo.z); r[6] = bflo(lo.w); r[7] = bfhi(lo.w);
    r[8] = bflo(hi.x); r[9] = bfhi(hi.x); r[10] = bflo(hi.y); r[11] = bfhi(hi.y); r[12] = bflo(hi.z); r[13] = bfhi(hi.z); r[14] = bflo(hi.w); r[15] = bfhi(hi.w); return r; }
__device__ __forceinline__ bf16x8_t ck_ident(int s, int t, int h) {
    unsigned w[4];
#pragma unroll
    for (int p = 0; p < 4; ++p) { const int e0 = 2 * p, e1 = 2 * p + 1; const int r0 = 16 * s + 8 * (e0 >> 2) + 4 * h + (e0 & 3), r1 = 16 * s + 8 * (e1 >> 2) + 4 * h + (e1 & 3);
        w[p] = (r0 == t ? 0x3F80u : 0u) | (r1 == t ? 0x3F800000u : 0u); }
    return __builtin_bit_cast(bf16x8_t, (v4u){w[0], w[1], w[2], w[3]});
}
#if defined(CK_SELFTEST)
__device__ __forceinline__ void ck_report(Frame& f, float v) {
    unsigned u = __builtin_bit_cast(unsigned, v);
#pragma unroll
    for (int n = 1; n < 64; n <<= 1) { const unsigned o = (unsigned)__shfl_xor((int)u, n, 64); u = o > u ? o : u; }
    if (f.lane == 0) __hip_atomic_fetch_max((unsigned*)(f.ws + WS_CTL) + 8194, u, __ATOMIC_RELAXED, __HIP_MEMORY_SCOPE_AGENT);
}
#endif
  template <int MODE> __device__ __forceinline__ void ph_scanA(Frame& f, int l) { const float* in_I_KA = karg_in(I_KA); const float* in_I_KK = karg_in(I_KK); const float* in_I_MURKV = karg_in(I_MURKV); launder_ws(f);
    const bf16* Y1 = WSP(bf16, WS_Y1);
    LAS float* Lt = (LAS float*)(f.lds + f.wave * 12800);
    LAS float* QC = Lt + 1024;
    LAS v4u* PKL = (LAS v4u*)(Lt + 1024 + 64);
    LAS float* RV = Lt + 1024 + 64 + 2048;
    LAS float* PT = (LAS float*)(f.lds + 102400);
    LAS float* PA = (LAS float*)(f.lds + 133120);
    __syncthreads();
    for (int i = f.tid; i < 1536; i += NWAVES * 64) ((LAS f32x4*)PT)[i] = ((const f32x4*)(in_I_MURKV + (size_t)l * 6144))[i];
    for (int i = f.tid; i < 256; i += NWAVES * 64) { ((LAS f32x4*)(PT + 6144))[i] = ((const f32x4*)(in_I_KK + (size_t)l * CW))[i]; ((LAS f32x4*)PA)[i] = ((const f32x4*)(in_I_KA + (size_t)l * CW))[i]; }
    __syncthreads();
    const int gw = f.vcu * NWAVES + f.wave, NGW = f.G * NWAVES;
#if defined(CK_STAGGER)
    for (int k_ = (f.wave * 8 + (f.vcu & 7)) * CK_STAGGER; k_ > 0; --k_) __builtin_amdgcn_s_sleep(16);
#endif
    struct CkRaw { v4u q[2], k0[2], kn[2], ic[2], r0[2], rn[2], v0[2], vn[2]; };
    struct CkAddr { unsigned oy, oyn, o2, oc; int has, d; };
#define CK_ADDR(A_, it_, t_, h_) do { const int chain_ = (it_) / CK_NCH, c_ = (it_) % CK_NCH, b_ = chain_ >> 5, d_ = (chain_ >> 4) & 1, hd_ = chain_ & 15; \
        const int st_ = c_ * CK_C + (t_); int tt_, TT_, m_; \
        if (st_ < CTXL) { tt_ = d_ ? (CTXL - 1 - st_) : st_; TT_ = CTXL; m_ = MLAT + b_ * CTXL + tt_; } else { const int u_ = st_ - CTXL; tt_ = d_ ? (SEQ - 1 - u_) : u_; TT_ = SEQ; m_ = b_ * SEQ + tt_; } \
        const bool has_ = d_ ? (tt_ < TT_ - 1) : (tt_ > 0); const int mn_ = has_ ? (d_ ? m_ + 1 : m_ - 1) : m_; \
        A_.oy = ((unsigned)m_ * INP + hd_ * 64 + 16 * (h_)) * 2u; A_.oyn = ((unsigned)mn_ * INP + hd_ * 64 + 16 * (h_)) * 2u; A_.o2 = (((unsigned)d_ * MALL + m_) * CW + hd_ * 64 + 16 * (h_)) * 2u; \
        A_.oc = (unsigned)(hd_ * 64 + 16 * (h_)) * 4u; A_.has = has_ ? 1 : 0; A_.d = d_; } while (0)
#define CK_GLD(dst_, off_, base_, imm_) asm volatile("global_load_dwordx4 %0, %1, %2 offset:%3" : "=&v"(dst_) : "v"(off_), "s"(base_), "n"(imm_))
#define CK_LD(X, T_, A_) do { const char* wqb_ = (const char*)WSP(bf16, WS_WDEC); const char* aib_ = (const char*)WSP(bf16, WS_AIC); \
        const char* ykb_ = (const char*)Y1 + C_K * 2; const char* yrb_ = (const char*)Y1 + C_R * 2; const char* yvb_ = (const char*)Y1 + C_V * 2; \
        _Pragma("unroll") for (int j_ = 0; j_ < 2; ++j_) { \
            CK_GLD(X.q[j_], A_.o2, wqb_, 64 * (T_) + 16 * j_); CK_GLD(X.k0[j_], A_.oy, ykb_, 64 * (T_) + 16 * j_); CK_GLD(X.kn[j_], A_.oyn, ykb_, 64 * (T_) + 16 * j_); CK_GLD(X.ic[j_], A_.o2, aib_, 64 * (T_) + 16 * j_); \
            CK_GLD(X.r0[j_], A_.oy, yrb_, 64 * (T_) + 16 * j_); CK_GLD(X.rn[j_], A_.oyn, yrb_, 64 * (T_) + 16 * j_); CK_GLD(X.v0[j_], A_.oy, yvb_, 64 * (T_) + 16 * j_); CK_GLD(X.vn[j_], A_.oyn, yvb_, 64 * (T_) + 16 * j_); } } while (0)
#define CK_LDWAIT(X, N_) do { asm volatile("s_waitcnt vmcnt(" #N_ ")" : "+v"(X.q[0]), "+v"(X.q[1]), "+v"(X.k0[0]), "+v"(X.k0[1]), "+v"(X.kn[0]), "+v"(X.kn[1]), "+v"(X.ic[0]), "+v"(X.ic[1]), \
            "+v"(X.r0[0]), "+v"(X.r0[1]), "+v"(X.rn[0]), "+v"(X.rn[1]), "+v"(X.v0[0]), "+v"(X.v0[1]), "+v"(X.vn[0]), "+v"(X.vn[1])); } while (0)
#define CK_PREF2 CK_LD(RB, 1, AD);
    CkRaw RA, RB; CkAddr AD;
    const int nfull = (64 * CK_NCH) / NGW, ntail = 64 * CK_NCH - nfull * NGW, ts = (f.wave & 1) ? -1 : (f.wave >> 1) * f.G + f.vcu;
    const int nk = nfull + ((ts >= 0 && ts < ntail) ? 1 : 0);
#define CK_ITEM(k_) ((k_) < nfull ? (k_) * NGW + gw : nfull * NGW + ts)
    { const int it0 = nk > 0 ? CK_ITEM(0) : 0; CK_ADDR(AD, it0, f.lane & 31, f.lane >> 5); CK_LD(RA, 0, AD); CK_PREF2 }
    CK_LDWAIT(RA, 0); CK_LDWAIT(RB, 0);
    for (int k = 0; k < nk; ++k) { const int it = CK_ITEM(k);
        int lane_ = f.lane; asm volatile("" : "+v"(lane_));
        launder_ws(f);
        const int lane = lane_, t = lane & 31, h = lane >> 5;
        LAS float* LtW = Lt + 4 * h * 32 + t;
        const bool has = AD.has != 0;
        const LAS float* pmu = PT + AD.d * 3072 + (AD.oc >> 2); const LAS float* pkk = PT + 6144 + (AD.oc >> 2); const LAS float* pka = PA + (AD.oc >> 2);
        const f32x4 z4 = {0.f, 0.f, 0.f, 0.f};
#define CK_PC(A_, g_) (((g_) & 1) ? (v2u){A_[(g_) >> 1].z, A_[(g_) >> 1].w} : (v2u){A_[(g_) >> 1].x, A_[(g_) >> 1].y})
#define CK_FEAT(X, T_, g_, u_) do { const f32x4 qv = bf4(CK_PC(X.q, g_)); const int pf_ = 32 * (T_) + 4 * (g_); \
            f32x4 Qi; Qi.x = ck_prefix32(qv.x); Qi.y = ck_prefix32(qv.y); Qi.z = ck_prefix32(qv.z); Qi.w = ck_prefix32(qv.w);         \
            if (t == 31) *(LAS f32x4*)(QC + 32 * (T_) + 8 * (g_) + 4 * h) = Qi; \
            const f32x4 k0 = bf4(CK_PC(X.k0, g_)), kn = has ? bf4(CK_PC(X.kn, g_)) : z4, kx = k0 + *(const LAS f32x4*)(pmu + (1024 + pf_)) * (kn - k0), ic = bf4(CK_PC(X.ic, g_)), kk = kx * *(const LAS f32x4*)(pkk + pf_); \
            ss += hsum4(kk * kk); \
            const f32x4 ep = exp4(Qi), em = exp4(-Qi), emx = exp4(qv - Qi); \
            const f32x4 r0 = bf4(CK_PC(X.r0, g_)), rn = has ? bf4(CK_PC(X.rn, g_)) : z4, r = r0 + *(const LAS f32x4*)(pmu + pf_) * (rn - r0); \
            const f32x4 v0 = bf4(CK_PC(X.v0, g_)), vn = has ? bf4(CK_PC(X.vn, g_)) : z4; \
            vv[u_] = v0 + *(const LAS f32x4*)(pmu + (2048 + pf_)) * (vn - v0); \
            av[u_] = -kk * emx; rv[u_] = r * em; bv[u_] = kk * ic * ep; kv2[u_] = kx * ((ic - 1.0f) * *(const LAS f32x4*)(pka + pf_) + 1.0f) * ep; \
            asm volatile("" : "+v"(av[u_]), "+v"(rv[u_]), "+v"(bv[u_]), "+v"(kv2[u_]), "+v"(vv[u_]) :: "memory"); } while (0)
        float ss = 0.f;
        bf16x8_t Ac[2][2], Rc[2][2], Bc[2][2], Kc[2][2], Vc[2][2];
#define CK_TILE(X, T_) do { _Pragma("unroll") for (int s = 0; s < 2; ++s) { f32x4 av[2], rv[2], bv[2], kv2[2], vv[2]; \
                CK_FEAT(X, T_, 2 * s, 0); CK_FEAT(X, T_, 2 * s + 1, 1); \
                Ac[T_][s] = pack8(av[0], av[1]); Rc[T_][s] = pack8(rv[0], rv[1]); Bc[T_][s] = pack8(bv[0], bv[1]); Kc[T_][s] = pack8(kv2[0], kv2[1]); Vc[T_][s] = pack8(vv[0], vv[1]); \
                asm volatile("" : "+v"(Ac[T_][s]), "+v"(Rc[T_][s]), "+v"(Bc[T_][s]), "+v"(Kc[T_][s]), "+v"(Vc[T_][s]) :: "memory"); } } while (0)
        CK_TILE(RA, 0); CK_TILE(RB, 1);
#undef CK_TILE
#undef CK_PC
#undef CK_FEAT
        ss = ck_sum2(ss);
        const float rinv = __builtin_amdgcn_rsqf(fmaxf(ss, 1e-24f));
        if (h == 0) RV[t] = rinv;
        LDS_WAIT(); asm volatile("" ::: "memory");
#define CK_RROW(i_) (RV[8 * ((i_) >> 2) + 4 * h + ((i_) & 3)])
        const f32x16 zero16 = {0.f, 0.f, 0.f, 0.f, 0.f, 0.f, 0.f, 0.f, 0.f, 0.f, 0.f, 0.f, 0.f, 0.f, 0.f, 0.f};
        bf16x8_t Vs[2][2];
#pragma unroll
        for (int T = 0; T < 2; ++T) { f32x16 x = ck_mm(Vc[T][0], ck_ident(0, t, h), zero16); x = ck_mm(Vc[T][1], ck_ident(1, t, h), x); Vs[T][0] = ck_frag(x, 0); Vs[T][1] = ck_frag(x, 1); asm volatile("" : "+v"(Vs[T][0]), "+v"(Vs[T][1])); }
        f32x16 XW[2], XU[2];
#pragma unroll
        for (int T = 0; T < 2; ++T) { XW[T] = ck_mm(Ac[T][0], ck_ident(0, t, h), zero16); XW[T] = ck_mm(Ac[T][1], ck_ident(1, t, h), XW[T]);
#pragma unroll
            for (int i = 0; i < 16; ++i) XW[T][i] *= CK_RROW(i); }
        bf16x8_t G2f[2], G3f[2], G4f[2];
        { f32x16 g = zero16;
#pragma unroll
          for (int T = 0; T < 2; ++T)
#pragma unroll
              for (int s = 0; s < 2; ++s) g = ck_mm(Bc[T][s], Ac[T][s], g);
#pragma unroll
          for (int i = 0; i < 16; ++i) LtW[((i & 3) + 8 * (i >> 2)) * 32] = ck_rho(i, h) < t ? g[i] * (CK_RROW(i) * RV[t]) : 0.f; }
        __builtin_amdgcn_sched_barrier(0);
        { f32x16 g = zero16;
#pragma unroll
          for (int T = 0; T < 2; ++T)
#pragma unroll
              for (int s = 0; s < 2; ++s) g = ck_mm(Kc[T][s], Ac[T][s], g);
#pragma unroll
          for (int i = 0; i < 16; ++i) g[i] = ck_rho(i, h) < t ? g[i] * RV[t] : 0.f;
          G2f[0] = ck_frag(g, 0); G2f[1] = ck_frag(g, 1); asm volatile("" : "+v"(G2f[0]), "+v"(G2f[1])); }
        __builtin_amdgcn_sched_barrier(0);
        { f32x16 g = zero16;
#pragma unroll
          for (int T = 0; T < 2; ++T)
#pragma unroll
              for (int s = 0; s < 2; ++s) g = ck_mm(Bc[T][s], Rc[T][s], g);
#pragma unroll
          for (int i = 0; i < 16; ++i) g[i] = ck_rho(i, h) <= t ? g[i] * CK_RROW(i) : 0.f;
          G3f[0] = ck_frag(g, 0); G3f[1] = ck_frag(g, 1); asm volatile("" : "+v"(G3f[0]), "+v"(G3f[1])); }
        __builtin_amdgcn_sched_barrier(0);
        { f32x16 g = zero16;
#pragma unroll
          for (int T = 0; T < 2; ++T)
#pragma unroll
              for (int s = 0; s < 2; ++s) g = ck_mm(Kc[T][s], Rc[T][s], g);
#pragma unroll
          for (int i = 0; i < 16; ++i) g[i] = ck_rho(i, h) <= t ? g[i] : 0.f;
#if defined(CK_SELFTEST)
          { float rd = 0.f;
#define CK_RD(x) do { const float r_ = (x); rd = (r_ == r_) ? fmaxf(rd, r_) : 1e30f; } while (0)
            if (CK_SELFTEST & 3) { float dref = 0.f, sref = 0.f, daref = 0.f, saref = 0.f;
#pragma unroll
              for (int T = 0; T < 2; ++T)
#pragma unroll
                for (int s2 = 0; s2 < 2; ++s2) { const v4u kw = __builtin_bit_cast(v4u, Kc[T][s2]), rw = __builtin_bit_cast(v4u, Rc[T][s2]);
                    const unsigned kk_[4] = {kw.x, kw.y, kw.z, kw.w}, rr_[4] = {rw.x, rw.y, rw.z, rw.w};
#pragma unroll
                    for (int q = 0; q < 4; ++q) { const float k0_ = bflo(kk_[q]), k1_ = bfhi(kk_[q]), r0_ = bflo(rr_[q]), r1_ = bfhi(rr_[q]);
                        dref += k0_ * r0_ + k1_ * r1_; daref += fabsf(k0_ * r0_) + fabsf(k1_ * r1_);
                        saref += fabsf(__shfl_up(k0_, 1, 32) * r0_) + fabsf(__shfl_up(k1_, 1, 32) * r1_);
                        sref += __shfl_up(k0_, 1, 32) * r0_ + __shfl_up(k1_, 1, 32) * r1_; } }
              dref = ck_sum2(dref);
              sref = ck_sum2(sref);
              daref = ck_sum2(daref);
              saref = ck_sum2(saref);
              float dm = 0.f, sm = 0.f;
#pragma unroll
              for (int i = 0; i < 16; ++i) { if (ck_rho(i, h) == t) dm = g[i]; if (ck_rho(i, h) == t - 1) sm = g[i]; }
              dm = ck_sum2(dm);
              sm = ck_sum2(sm);
              if (CK_SELFTEST & 1) CK_RD(fabsf(dm - dref) / (daref + 1e-30f));
              if ((CK_SELFTEST & 2) && t >= 1) CK_RD(fabsf(sm - sref) / (saref + 1e-30f)); }
            if (CK_SELFTEST & 128) {
                const unsigned av_ = pk2((float)(t + 1), (float)(t + 1)); const v4u aw = {av_, av_, av_, av_}; const v4u one4 = {0x3F803F80u, 0x3F803F80u, 0x3F803F80u, 0x3F803F80u};
                const f32x16 dd = ck_mm(__builtin_bit_cast(bf16x8_t, aw), __builtin_bit_cast(bf16x8_t, one4), zero16);
#pragma unroll
                for (int i = 0; i < 16; ++i) CK_RD(fabsf(dd[i] - 16.0f * (ck_rho(i, h) + 1)) / (16.0f * (ck_rho(i, h) + 1))); }
            if (CK_SELFTEST & 256) {
                const unsigned bv_ = pk2((float)(t + 1), (float)(t + 1)); const v4u bw = {bv_, bv_, bv_, bv_}; const v4u one4 = {0x3F803F80u, 0x3F803F80u, 0x3F803F80u, 0x3F803F80u};
                const f32x16 dd = ck_mm(__builtin_bit_cast(bf16x8_t, one4), __builtin_bit_cast(bf16x8_t, bw), zero16);
#pragma unroll
                for (int i = 0; i < 16; ++i) CK_RD(fabsf(dd[i] - 16.0f * (t + 1)) / (16.0f * (t + 1))); }
            if (CK_SELFTEST & 32) {
                const f32x16 dd = ck_mm(Kc[0][0], Rc[0][0], zero16);
                const v4u kw = __builtin_bit_cast(v4u, Kc[0][0]), rw = __builtin_bit_cast(v4u, Rc[0][0]);
                float d1 = bflo(kw.x) * bflo(rw.x) + bfhi(kw.x) * bfhi(rw.x) + bflo(kw.y) * bflo(rw.y) + bfhi(kw.y) * bfhi(rw.y) + bflo(kw.z) * bflo(rw.z) + bfhi(kw.z) * bfhi(rw.z) + bflo(kw.w) * bflo(rw.w) + bfhi(kw.w) * bfhi(rw.w);
                float a1 = fabsf(bflo(kw.x) * bflo(rw.x)) + fabsf(bfhi(kw.x) * bfhi(rw.x)) + fabsf(bflo(kw.y) * bflo(rw.y)) + fabsf(bfhi(kw.y) * bfhi(rw.y)) + fabsf(bflo(kw.z) * bflo(rw.z)) + fabsf(bfhi(kw.z) * bfhi(rw.z)) + fabsf(bflo(kw.w) * bflo(rw.w)) + fabsf(bfhi(kw.w) * bfhi(rw.w));
                d1 = ck_sum2(d1);
                a1 = ck_sum2(a1);
                float m1 = 0.f;
#pragma unroll
                for (int i = 0; i < 16; ++i) if (ck_rho(i, h) == t) m1 = dd[i];
                m1 = ck_sum2(m1);
                CK_RD(fabsf(m1 - d1) / (a1 + 1e-30f)); }
            if (CK_SELFTEST & (4096 | 65536)) CK_RD(rdq);
            ck_report(f, rd); }
#endif
          G4f[0] = ck_frag(g, 0); G4f[1] = ck_frag(g, 1); asm volatile("" : "+v"(G4f[0]), "+v"(G4f[1])); }
        __builtin_amdgcn_sched_barrier(0);
        bf16x8_t Bs[2][2], Ks[2][2];
        LDS_WAIT(); asm volatile("" ::: "memory");
#pragma unroll
        for (int T = 0; T < 2; ++T) { const float gc = __expf(-QC[32 * T + t]);
            f32x16 x = ck_mm(Bc[T][0], ck_ident(0, t, h), zero16); x = ck_mm(Bc[T][1], ck_ident(1, t, h), x);
#pragma unroll
            for (int i = 0; i < 16; ++i) x[i] *= gc * CK_RROW(i);
            Bs[T][0] = ck_frag(x, 0); Bs[T][1] = ck_frag(x, 1);
            x = ck_mm(Kc[T][0], ck_ident(0, t, h), zero16); x = ck_mm(Kc[T][1], ck_ident(1, t, h), x); x = x * gc; Ks[T][0] = ck_frag(x, 0); Ks[T][1] = ck_frag(x, 1);
            asm volatile("" : "+v"(Bs[T][0]), "+v"(Bs[T][1]), "+v"(Ks[T][0]), "+v"(Ks[T][1])); }
#pragma unroll
        for (int T = 0; T < 2; ++T)
#pragma unroll
            for (int s2 = 0; s2 < 2; ++s2) PKL[(T * 2 + s2) * 64 + lane] = __builtin_bit_cast(v4u, Rc[T][s2]);
        PKL[4 * 64 + lane] = __builtin_bit_cast(v4u, G3f[0]); PKL[5 * 64 + lane] = __builtin_bit_cast(v4u, G3f[1]); PKL[6 * 64 + lane] = __builtin_bit_cast(v4u, G4f[0]); PKL[7 * 64 + lane] = __builtin_bit_cast(v4u, G4f[1]);
        LDS_WAIT(); asm volatile("" ::: "memory");
#define CK_CFLD(dst_, p_) do { _Pragma("unroll") for (int g4 = 0; g4 < 4; ++g4) if (8 * g4 + 4 + 3 > (p_)) dst_[g4] = *(const LAS f32x4*)(Lt + (p_) * 32 + 8 * g4 + 4 * h); } while (0)
#define CK_SOLVE2(X0, X1) do { f32x4 cfa_[4], cfb_[4]; CK_CFLD(cfa_, 0); \
        _Pragma("unroll") for (int p = 0; p < 31; ++p) { \
            const int ip = (p & 3) + 4 * (p >> 3), hp = (p >> 2) & 1;               \
            if (p + 1 < 31) { if (p & 1) CK_CFLD(cfa_, p + 1); else CK_CFLD(cfb_, p + 1); }         \
            float xp0, xp1; \
            { const float xv_ = X0[ip]; float lo_, hi_; ck_swap32(xv_, lo_, hi_); xp0 = hp ? hi_ : lo_; } \
            { const float xv_ = X1[ip]; float lo_, hi_; ck_swap32(xv_, lo_, hi_); xp1 = hp ? hi_ : lo_; } \
            _Pragma("unroll") for (int g4 = 0; g4 < 4; ++g4) { if (8 * g4 + 4 + 3 <= p) continue;       \
                const f32x4 cf = (p & 1) ? cfb_[g4] : cfa_[g4]; \
                _Pragma("unroll") for (int e = 0; e < 4; ++e) { const int i = 4 * g4 + e; X0[i] += cf[e] * xp0; X1[i] += cf[e] * xp1; } } \
            asm volatile("" ::: "memory"); } } while (0)
        CK_SOLVE2(XW[0], XW[1]);
        bf16x8_t Uf[2][2];
        int lane_q = lane; asm volatile("" : "+v"(lane_q));
        const int tq = lane_q & 31, hq = lane_q >> 5;
        v4u* rec = (v4u*)(f.ws + WS_CK + (size_t)it * CK_REC) + lane_q;
#define CK_ST(r_, x_) do { const v4u sv_ = (x_); if (MODE == 0) __builtin_nontemporal_store(sv_, &rec[64 * (r_)]); else asm volatile("" :: "v"(sv_)); } while (0)
        { bf16x8_t Wf[2][2];
#pragma unroll
          for (int T = 0; T < 2; ++T) { Wf[T][0] = ck_frag(XW[T], 0); Wf[T][1] = ck_frag(XW[T], 1); }
          asm volatile("" : "+v"(Wf[0][0]), "+v"(Wf[0][1]), "+v"(Wf[1][0]), "+v"(Wf[1][1]));
#pragma unroll
          for (int Ti = 0; Ti < 2; ++Ti)
#pragma unroll
              for (int To = 0; To < 2; ++To) { f32x16 mt = ck_mm(Wf[Ti][0], Bs[To][0], zero16); mt = ck_mm(Wf[Ti][1], Bs[To][1], mt);
                  if (Ti == To) { const float gc = __expf(-QC[32 * To + tq]);
#pragma unroll
                      for (int i = 0; i < 16; ++i) mt[i] += (ck_rho(i, hq) == tq) ? gc : 0.f; }
                  CK_ST(((Ti * 2 + To) * 2 + 0), __builtin_bit_cast(v4u, ck_frag(mt, 0))); CK_ST(((Ti * 2 + To) * 2 + 1), __builtin_bit_cast(v4u, ck_frag(mt, 1))); asm volatile("" ::: "memory"); }
          { const bf16x8_t g30 = __builtin_bit_cast(bf16x8_t, PKL[4 * 64 + lane_q]), g31 = __builtin_bit_cast(bf16x8_t, PKL[5 * 64 + lane_q]);
#pragma unroll
            for (int Tc = 0; Tc < 2; ++Tc) { f32x16 p1 = ck_unpack(PKL[(Tc * 2 + 0) * 64 + lane_q], PKL[(Tc * 2 + 1) * 64 + lane_q]);
                p1 = ck_mm(Wf[Tc][0], g30, p1); p1 = ck_mm(Wf[Tc][1], g31, p1);
                CK_ST((16 + Tc * 2 + 0), __builtin_bit_cast(v4u, ck_frag(p1, 0))); CK_ST((16 + Tc * 2 + 1), __builtin_bit_cast(v4u, ck_frag(p1, 1))); asm volatile("" ::: "memory"); } } }
#pragma unroll
        for (int T = 0; T < 2; ++T) { XU[T] = ck_mm(G2f[0], Vs[T][0], zero16); XU[T] = ck_mm(G2f[1], Vs[T][1], XU[T]); }
        CK_SOLVE2(XU[0], XU[1]);
#if defined(PROBE_SOLVE)
        { f32x16 D0 = XU[0], D1 = XU[1]; CK_SOLVE2(D0, D1); asm volatile("" :: "v"(D0), "v"(D1)); }
        { f32x16 D0 = XU[1], D1 = XU[0]; CK_SOLVE2(D0, D1); asm volatile("" :: "v"(D0), "v"(D1)); }
#endif
#undef CK_SOLVE2
#undef CK_CFLD
#pragma unroll
        for (int T = 0; T < 2; ++T) { Uf[T][0] = ck_frag(XU[T], 0); Uf[T][1] = ck_frag(XU[T], 1); }
        { const int itn = CK_ITEM(k + 1 < nk ? k + 1 : k); CK_ADDR(AD, itn, tq, hq); CK_LD(RA, 0, AD); CK_PREF2 }
        asm volatile("" ::: "memory");
#pragma unroll
        for (int To = 0; To < 2; ++To)
#pragma unroll
            for (int Tn = 0; Tn < 2; ++Tn) { f32x16 nn = ck_mm(Bs[To][0], Uf[Tn][0], zero16); nn = ck_mm(Bs[To][1], Uf[Tn][1], nn); nn = ck_mm(Ks[To][0], Vs[Tn][0], nn); nn = ck_mm(Ks[To][1], Vs[Tn][1], nn);
                CK_ST((8 + (Tn * 2 + To) * 2 + 0), __builtin_bit_cast(v4u, ck_frag(nn, 0))); CK_ST((8 + (Tn * 2 + To) * 2 + 1), __builtin_bit_cast(v4u, ck_frag(nn, 1))); asm volatile("" ::: "memory"); }
        G3f[0] = __builtin_bit_cast(bf16x8_t, PKL[4 * 64 + lane_q]); G3f[1] = __builtin_bit_cast(bf16x8_t, PKL[5 * 64 + lane_q]);
        G4f[0] = __builtin_bit_cast(bf16x8_t, PKL[6 * 64 + lane_q]); G4f[1] = __builtin_bit_cast(bf16x8_t, PKL[7 * 64 + lane_q]);
#pragma unroll
        for (int Tn = 0; Tn < 2; ++Tn) { f32x16 y0 = ck_mm(G3f[0], Uf[Tn][0], zero16); y0 = ck_mm(G3f[1], Uf[Tn][1], y0); y0 = ck_mm(G4f[0], Vs[Tn][0], y0); y0 = ck_mm(G4f[1], Vs[Tn][1], y0);
            CK_ST((20 + Tn * 2 + 0), __builtin_bit_cast(v4u, ck_frag(y0, 0))); CK_ST((20 + Tn * 2 + 1), __builtin_bit_cast(v4u, ck_frag(y0, 1))); asm volatile("" ::: "memory"); }
        LDS_WAIT(); asm volatile("" ::: "memory");
        if (MODE == 0) { CK_LDWAIT(RA, 12); CK_LDWAIT(RB, 12); } else { CK_LDWAIT(RA, 0); CK_LDWAIT(RB, 0); }
    }
#undef CK_ITEM
#undef CK_ADDR
#undef CK_LD
#undef CK_ST
#undef CK_PREF2
#undef CK_GLD
#undef CK_LDWAIT
}
template <int CHECK> __device__ __forceinline__ void ph_scanB(Frame& f, int l, int item_lo, int item_step) { launder_ws(f);
    LAS v4u* SL = (LAS v4u*)f.lds;
    LAS v4u* SFB = SL + 3 * 24 * 64;
    const int lane = f.lane;
    for (int it = item_lo + f.vcu; it < 64; it += item_step) {
        const int chain = it, b = chain >> 5, d = (chain >> 4) & 1, hd = chain & 15;
        if (f.wave >= 4) {
            const int w = f.wave - 4;
            const v4u* rec0 = (const v4u*)(f.ws + WS_CK + (size_t)chain * CK_NCH * CK_REC) + lane + 64 * w;
            struct LSet { v4u v0, v1, v2, v3, v4, v5; };
            LSet L0, L1, L2, L3, L4, L5, L6, L7;
#define CKB_LOAD(X, c) do { const v4u* rp_ = rec0 + (size_t)(c) * (CK_REC / 16); X.v0 = __builtin_nontemporal_load(rp_); X.v1 = __builtin_nontemporal_load(rp_ + 64 * 4); X.v2 = __builtin_nontemporal_load(rp_ + 64 * 8); X.v3 = __builtin_nontemporal_load(rp_ + 64 * 12); X.v4 = __builtin_nontemporal_load(rp_ + 64 * 16); X.v5 = __builtin_nontemporal_load(rp_ + 64 * 20); } while (0)
#define CKB_PUT(X, sb_) do { (sb_)[64 * w] = X.v0; (sb_)[64 * (4 + w)] = X.v1; (sb_)[64 * (8 + w)] = X.v2; (sb_)[64 * (12 + w)] = X.v3; (sb_)[64 * (16 + w)] = X.v4; (sb_)[64 * (20 + w)] = X.v5; } while (0)
            int sl = 1;
#define CKB_IVAL(c, XP, XL) do { CKB_PUT(XP, SL + sl * 24 * 64 + lane); sl = sl == 2 ? 0 : sl + 1; { const int cl_ = (c) + 8 < CK_NCH ? (c) + 8 : CK_NCH - 1; CKB_LOAD(XL, cl_); } LDS_WAIT(); __builtin_amdgcn_s_barrier(); } while (0)
            CKB_LOAD(L0, 0); CKB_LOAD(L1, 1); CKB_LOAD(L2, 2); CKB_LOAD(L3, 3); CKB_LOAD(L4, 4); CKB_LOAD(L5, 5); CKB_LOAD(L6, 6); CKB_LOAD(L7, 7);
            CKB_PUT(L0, SL + lane);
            LDS_WAIT(); __builtin_amdgcn_s_barrier();
            static_assert(CK_NCH % 8 == 0, "loader loop unrolled by eight register sets");
            for (int c = 0; c < CK_NCH; c += 8) {
                CKB_IVAL(c, L1, L0); CKB_IVAL(c + 1, L2, L1); CKB_IVAL(c + 2, L3, L2); CKB_IVAL(c + 3, L4, L3); CKB_IVAL(c + 4, L5, L4); CKB_IVAL(c + 5, L6, L5); CKB_IVAL(c + 6, L7, L6); CKB_IVAL(c + 7, L0, L7);
            }
            LDS_WAIT(); __builtin_amdgcn_s_barrier();
#undef CKB_LOAD
#undef CKB_PUT
#undef CKB_IVAL
        } else if (f.wave < 2) {
            const int Tn = f.wave;
            const f32x16 zero16 = {0.f, 0.f, 0.f, 0.f, 0.f, 0.f, 0.f, 0.f, 0.f, 0.f, 0.f, 0.f, 0.f, 0.f, 0.f, 0.f};
            f32x16 ST[2] = {zero16, zero16};
            __builtin_amdgcn_s_setprio(3);
            LDS_WAIT(); __builtin_amdgcn_s_barrier();
            int sl = 0;
            for (int c = 0; c < CK_NCH; ++c) {
                const LAS v4u* sp = SL + sl * 24 * 64 + lane; sl = sl == 2 ? 0 : sl + 1;
                LAS v4u* sf = SFB + ((c & 1) * 2 + Tn) * 4 * 64 + lane;
                v4u rm[8], rn[4];
#pragma unroll
                for (int k = 0; k < 8; ++k) rm[k] = sp[64 * k];
#pragma unroll
                for (int k = 0; k < 4; ++k) rn[k] = sp[64 * (8 + 4 * Tn + k)];
                bf16x8_t Sf[2][2];
#pragma unroll
                for (int Ti = 0; Ti < 2; ++Ti) { Sf[Ti][0] = ck_frag(ST[Ti], 0); Sf[Ti][1] = ck_frag(ST[Ti], 1); }
#pragma unroll
                for (int Ti = 0; Ti < 2; ++Ti) { sf[64 * (Ti * 2 + 0)] = __builtin_bit_cast(v4u, Sf[Ti][0]); sf[64 * (Ti * 2 + 1)] = __builtin_bit_cast(v4u, Sf[Ti][1]); }
                asm volatile("s_waitcnt lgkmcnt(0)" : "+v"(rm[0]), "+v"(rm[1]), "+v"(rm[2]), "+v"(rm[3]), "+v"(rm[4]), "+v"(rm[5]), "+v"(rm[6]), "+v"(rm[7]) :: "memory");
                asm volatile("" : "+v"(rn[0]), "+v"(rn[1]), "+v"(rn[2]), "+v"(rn[3]));
#pragma unroll
                for (int To = 0; To < 2; ++To) { f32x16 sn = ck_unpack(rn[To * 2], rn[To * 2 + 1]);
#pragma unroll
                    for (int Ti = 0; Ti < 2; ++Ti)
#pragma unroll
                        for (int s = 0; s < 2; ++s) sn = ck_mm(__builtin_bit_cast(bf16x8_t, rm[(Ti * 2 + To) * 2 + s]), Sf[Ti][s], sn);
                    ST[To] = sn; }
                LDS_WAIT(); __builtin_amdgcn_s_barrier();
            }
            __builtin_amdgcn_s_setprio(0);
            LDS_WAIT(); __builtin_amdgcn_s_barrier();
        } else {
            const int Tn = f.wave - 2, t = lane & 31, h = lane >> 5;
            const unsigned voff = (unsigned)(32 * Tn + 16 * ((t >> 2) & 1) + 4 * (t >> 3) + (t & 3)) + (unsigned)(4 * CW) * (unsigned)(d ? 1 - h : h);
            const float* ysu = WSP(float, WS_YS) + (size_t)d * MALL * CW + hd * 64;
            LDS_WAIT(); __builtin_amdgcn_s_barrier();
            LDS_WAIT(); __builtin_amdgcn_s_barrier();
            int sl = 0;
            for (int c = 0; c < CK_NCH; ++c) {
                const LAS v4u* sp = SL + sl * 24 * 64 + lane; sl = sl == 2 ? 0 : sl + 1;
                const LAS v4u* sf = SFB + ((c & 1) * 2 + Tn) * 4 * 64 + lane;
                v4u rs[4], rp[4], ry[2];
#pragma unroll
                for (int k = 0; k < 4; ++k) rs[k] = sf[64 * k];
#pragma unroll
                for (int k = 0; k < 4; ++k) rp[k] = sp[64 * (16 + k)];
                ry[0] = sp[64 * (20 + 2 * Tn)]; ry[1] = sp[64 * (21 + 2 * Tn)];
                asm volatile("s_waitcnt lgkmcnt(0)" : "+v"(rs[0]), "+v"(rs[1]), "+v"(rs[2]), "+v"(rs[3]), "+v"(rp[0]), "+v"(rp[1]), "+v"(rp[2]), "+v"(rp[3]), "+v"(ry[0]), "+v"(ry[1]) :: "memory");
                f32x16 yv = ck_unpack(ry[0], ry[1]);
#pragma unroll
                for (int k = 0; k < 4; ++k) yv = ck_mm(__builtin_bit_cast(bf16x8_t, rp[k]), __builtin_bit_cast(bf16x8_t, rs[k]), yv);
                { const int st0 = c * CK_C; int seg, pos0;
                  if (st0 < CTXL) { seg = MLAT + b * CTXL; pos0 = d ? (CTXL - 1 - st0) : st0; } else { seg = b * SEQ; pos0 = d ? (SEQ - 1 - (st0 - CTXL)) : (st0 - CTXL); }
                  const int mb = seg + pos0 - (d ? 4 : 0);
#pragma unroll
                  for (int i = 0; i < 16; ++i) { const int ci = (i & 3) + 8 * (i >> 2); const int mi = d ? mb - ci : mb + ci;
                    if (CHECK == 0) ((float*)ysu + (size_t)mi * CW)[voff] = yv[i]; else asm volatile("" :: "v"(yv[i])); } }
                LDS_WAIT(); __builtin_amdgcn_s_barrier();
            }
        }
        __syncthreads();
    }
}
#ifndef NA_BSLOTS
#define NA_BSLOTS 0
#endif
constexpr int GP_LAYER0 = 3, GP_PER_LAYER = 12, GP_FINAL = GP_LAYER0 + GP_PER_LAYER * DEPTH, GP_COUNT = GP_FINAL + 1;
#ifndef MK_ONE_LAUNCH
#define MK_ONE_LAUNCH 1
#endif
__global__ void __launch_bounds__(NWAVES * 64, 2) fwd(Args A) {
    extern __shared__ __attribute__((aligned(16))) unsigned char lds_raw[];
    Frame f;
    f.lds = (LAS unsigned char*)lds_raw;
    f.tid = threadIdx.x; f.lane = f.tid & 63; f.wave = __builtin_amdgcn_readfirstlane(f.tid >> 6);
    f.G = gridDim.x; { const int bx = blockIdx.x; f.vcu = (f.G % 8 == 0) ? (bx % 8) * (f.G / 8) + bx / 8 : bx; }
    f.ws = (GAS unsigned char*)A.ws;
    volatile LAS unsigned* MISC = (volatile LAS unsigned*)(f.lds + MISC_OFF);
    for (int u = f.tid; u < (LDS_BYTES - LDSCTL_OFF) / 4; u += NWAVES * 64) ((LAS unsigned*)(f.lds + LDSCTL_OFF))[u] = 0u;
    __syncthreads();
    unsigned* ctl = (unsigned*)WSP(unsigned, WS_CTL);
    XcdBarrier bar; bar.bar = ctl + CW_BAR; bar.x = 0; bar.st = MISC + 8; bar.wv = f.wave;
    if (A.use_bar) bar = xcd_barrier_post(ctl + CW_BAR, MISC + 8, f.wave);
    const int lo = A.gp_lo, hi = A.gp_hi;
#define IN(k) (lo <= (k) && (k) < hi)
#define BAR_AFTER(k) do { if (IN(k) && hi > (k) + 1) xcd_barrier(bar); } while (0)

    if (IN(0)) { ph_convert(f); ph_lora_weights(f); }
    BAR_AFTER(0);
    if (IN(1)) ph_modsum(f);
    BAR_AFTER(1);
    if (IN(2)) ph_setup2(f);
    BAR_AFTER(2);
    for (int l = 0; l < DEPTH; ++l) {
        const int g0 = GP_LAYER0 + GP_PER_LAYER * l;
        const bool lastl = (l == DEPTH - 1);
        const int mrows = lastl ? MLAT : MALL;
        if (IN(g0 + 0) && l > 0) ph_rs<11>(f, 0, WSP(float, WS_MOD) + (size_t)((l - 1) * 3 + 2) * MODW + 5 * DM, WSP(float, WS_GK) + (size_t)((l * 2 + 0) * 3 + 2) * DM);
        if (l > 0) BAR_AFTER(g0 + 0);
        if (IN(g0 + 1)) {
            launder_ws(f); pg8::Gemm g{WSP(bf16, WS_XN), WSP(bf16, WS_WIN) + (size_t)l * INP * DM, MALL, INP, DM}; pg8::StaticOrder S; S.init(MALL, INP, f.G, (int)blockIdx.x);
            EpiScaleBias E{WSP(bf16, WS_Y1), INP, WSP(float, WS_RS), WSP(float, WS_BIAS1) + (size_t)l * 3 * INP, INP};
            pg8::gemm_phase<EpiScaleBias, pg8::StaticOrder, true, true>(f.lds, g, S, E, f.wave);
        }
        BAR_AFTER(g0 + 1);
        if (IN(g0 + 2)) { ph_prep(f, l); ph_vat(f); ph_lora2(f, l); }
        BAR_AFTER(g0 + 2);
#if defined(SEQ_SCAN)
        if (IN(g0 + 3)) { for (int s_ = f.vcu; s_ < 1024; s_ += f.G) ph_na(f, l, s_, 1); if (!lastl) ph_ctxattn(f, 0); }
        if (IN(g0 + 4)) { launder_ws(f);
            const attn_body::AttnTensors AT{(const attn_body::bf16*)WSP(bf16, WS_QBP), (const attn_body::bf16*)WSP(bf16, WS_KBP), (const attn_body::bf16*)WSP(bf16, WS_VBP), (attn_body::bf16*)WSP(bf16, WS_OB)};
            attn_body::attn_phase<8>((char*)lds_raw, AT, f.vcu, f.G, f.wave);
        }
        if (IN(g0 + 5)) ph_scan2(f, l);
#if defined(CHUNK_CHECK)
        if (IN(g0 + 5)) { xcd_barrier(bar); ph_scanA<0>(f, l); xcd_barrier(bar); ph_scanB<1>(f, l, 0, f.G); }
#endif
#else
        if (IN(g0 + 3)) { ph_scanA<0>(f, l);
#if defined(PROBE_A2)
            ph_scanA<PROBE_A2 - 1>(f, l);
#endif
        }
        BAR_AFTER(g0 + 3);
        if (IN(g0 + 4)) {
            if (f.G == 256) {
                if (f.vcu < 64) { ph_scanB<0>(f, l, 0, f.G);
#if defined(PROBE_B2)
                    ph_scanB<PROBE_B2 - 1>(f, l, 0, f.G);
#endif
                    ph_na(f, l, 960 + f.vcu, NA_BSLOTS);
                } else if (NA_BSLOTS) ph_na(f, l, 5 * (f.vcu - 64), 5); else if (f.vcu < 128) ph_na(f, l, 6 * (f.vcu - 64), 6); else ph_na(f, l, 384 + 5 * (f.vcu - 128), 5); }
            else { ph_scanB<0>(f, l, 0, f.G); for (int s_ = f.vcu; s_ < 1024; s_ += f.G) ph_na(f, l, s_, 1); }
            if (!lastl) ph_ctxattn(f, 128);
        }
        if (IN(g0 + 5)) { __syncthreads(); launder_ws(f);
            const attn_body::AttnTensors AT{(const attn_body::bf16*)WSP(bf16, WS_QBP), (const attn_body::bf16*)WSP(bf16, WS_KBP), (const attn_body::bf16*)WSP(bf16, WS_VBP), (attn_body::bf16*)WSP(bf16, WS_OB)};
            attn_body::attn_phase<8>((char*)lds_raw, AT, f.vcu, f.G, f.wave);
        }
#endif
        BAR_AFTER(g0 + 5);
        if (IN(g0 + 6)) ph_mix(f, l, mrows);
        BAR_AFTER(g0 + 6);
        if (IN(g0 + 7)) {
            launder_ws(f); pg8::Gemm g{WSP(bf16, WS_MIX), WSP(bf16, WS_WOUT) + (size_t)l * DM * DM, MLAT, DM, DM}; pg8::StaticOrder S; S.init(MLAT, DM, f.G, (int)blockIdx.x);
            EpiResGateNorm E{WSP(float, WS_H), WSP(float, WS_MOD) + (size_t)l * 3 * MODW + 2 * DM, WSP(float, WS_GK) + (size_t)(l * 2 + 1) * 3 * DM, WSP(bf16, WS_XN), WSP(float, WS_SSP) + (size_t)MALL * 32};
            pg8::gemm_phase<EpiResGateNorm, pg8::StaticOrder, true, true>(f.lds, g, S, E, f.wave);
            if (!lastl) { pg8::Gemm g2{WSP(bf16, WS_MIX), WSP(bf16, WS_WOUT) + (size_t)l * DM * DM, MALL, DM, 256, DM}; CtxSplitOrder S2{f.G, (int)blockIdx.x, 8, 256}; EpiPartial E2{WSP(float, WS_PART), 256};
                pg8::gemm_phase<EpiPartial, CtxSplitOrder, true, true>(f.lds, g2, S2, E2, f.wave); }
        }
        BAR_AFTER(g0 + 7);
        if (IN(g0 + 8)) { const float* gate_ = WSP(float, WS_MOD) + (size_t)(l * 3 + 2) * MODW + 2 * DM; const float* gk_ = WSP(float, WS_GK) + (size_t)((l * 2 + 1) * 3 + 2) * DM;
            if (lastl) ph_rs<0>(f, 1, gate_, gk_); else ph_rs<8>(f, 1, gate_, gk_); }
        BAR_AFTER(g0 + 8);
        if (IN(g0 + 9)) {
            launder_ws(f); pg8::Gemm g{WSP(bf16, WS_XN), WSP(bf16, WS_WUP) + (size_t)l * UPN * DM, mrows, UPN, DM}; pg8::StaticOrder S; S.init(mrows, UPN, f.G, (int)blockIdx.x);
            const float* cw_ = karg_in(I_CONVW) + (size_t)l * 3 * DFF; const float* cb_ = karg_in(I_CONVB) + (size_t)l * DFF;
            EpiConvGlu E{WSP(bf16, WS_HB), WSP(bf16, WS_U), WSP(float, WS_RS) + MALL, WSP(float, WS_BIAS3) + (size_t)l * 3 * UPN, cw_, cb_};
            pg8::gemm_phase<EpiConvGlu, pg8::StaticOrder, true, true>(f.lds, g, S, E, f.wave);
        }
        BAR_AFTER(g0 + 9);
        if (IN(g0 + 10)) ph_convfix(f, l, mrows);
        BAR_AFTER(g0 + 10);
        if (IN(g0 + 11)) {
            launder_ws(f); pg8::Gemm g{WSP(bf16, WS_HB), WSP(bf16, WS_WDN) + (size_t)l * DM * DFF, MLAT, DM, DFF}; pg8::StaticOrder S; S.init(MLAT, DM, f.G, (int)blockIdx.x);
            EpiResGateNorm E{WSP(float, WS_H), WSP(float, WS_MOD) + (size_t)l * 3 * MODW + 5 * DM, lastl ? (const float*)nullptr : (const float*)(WSP(float, WS_GK) + (size_t)((l + 1) * 2 + 0) * 3 * DM), WSP(bf16, WS_XN), WSP(float, WS_SSP)};
            pg8::gemm_phase<EpiResGateNorm, pg8::StaticOrder, true, true>(f.lds, g, S, E, f.wave);
            if (!lastl) { pg8::Gemm g2{WSP(bf16, WS_HB), WSP(bf16, WS_WDN) + (size_t)l * DM * DFF, MALL, DM, 512, DFF}; CtxSplitOrder S2{f.G, (int)blockIdx.x, 11, 512}; EpiPartial E2{WSP(float, WS_PART), 512};
                pg8::gemm_phase<EpiPartial, CtxSplitOrder, true, true>(f.lds, g2, S2, E2, f.wave); }
        }
        BAR_AFTER(g0 + 11);
    }
    if (IN(GP_FINAL)) ph_final(f);
#if defined(CK_READOUT)
    if (IN(GP_FINAL)) { xcd_barrier(bar);
        if (blockIdx.x == 0 && f.tid == 0) { const float* cw_ = (const float*)(f.ws + WS_CTL) + 8192; const float e_ = __hip_atomic_load(cw_, __ATOMIC_RELAXED, __HIP_MEMORY_SCOPE_AGENT), r_ = __hip_atomic_load(cw_ + 1, __ATOMIC_RELAXED, __HIP_MEMORY_SCOPE_AGENT);
            const float m_ = __builtin_bit_cast(float, __hip_atomic_load((const unsigned*)cw_ + 2, __ATOMIC_RELAXED, __HIP_MEMORY_SCOPE_AGENT));
            float v_ = (CK_READOUT == 1) ? sqrtf(e_ / r_) : m_;
            if (CK_READOUT == 1 && v_ == v_ && v_ > 0.f) v_ = exp2f(rintf(log2f(v_) * 8.0f) * 0.125f);
            float* o_ = (float*)karg_in(33); o_[0] = (v_ == v_) ? fminf(v_ * 1.0e6f, 1.0e9f) : 4.0e9f; } }
#elif defined(CHUNK_CHECK)
    if (IN(GP_FINAL)) { const float* cw_ = (const float*)(f.ws + WS_CTL) + 8192; const float e_ = __hip_atomic_load(cw_, __ATOMIC_RELAXED, __HIP_MEMORY_SCOPE_AGENT), r_ = __hip_atomic_load(cw_ + 1, __ATOMIC_RELAXED, __HIP_MEMORY_SCOPE_AGENT);
        if (!(e_ <= CHUNK_CHECK * r_)) { __syncthreads(); float* o_ = (float*)karg_in(33); for (int i = f.vcu * 512 + f.tid; i < MLAT * DM; i += f.G * 512) o_[i] = __builtin_nanf(""); } }
#endif
#undef IN
#undef BAR_AFTER
}

extern "C" void kernel_launch(void* const* d_in, const int* in_sizes, int n_in, void* d_out, int out_size, void* d_ws, size_t ws_size, hipStream_t stream) {
    static int grid = 0;
    if (grid == 0) {
        if (n_in != 33 || in_sizes[0] != MLAT * DM || out_size != MLAT * DM || ws_size < WS_END) {
            fprintf(stderr, "kernel_launch: unexpected shapes (n_in %d, in0 %d, out %d, ws %zu); nothing launched\n", n_in, n_in > 0 ? in_sizes[0] : -1, out_size, ws_size); grid = -1; return; }
        int dev = 0, cus = 0;
        if (hipGetDevice(&dev) != hipSuccess || hipDeviceGetAttribute(&cus, hipDeviceAttributeMultiprocessorCount, dev) != hipSuccess) { grid = -1; return; }
        if (hipFuncSetAttribute((const void*)fwd, hipFuncAttributeMaxDynamicSharedMemorySize, LDS_BYTES) != hipSuccess) { fprintf(stderr, "kernel_launch: hipFuncSetAttribute failed\n"); grid = -1; return; }
        (void)hipGetLastError();
        grid = cus;
    }
    if (grid < 0) return;
    if (hipMemsetAsync((char*)d_ws + WS_CTL, 0, CTL_ZERO_BYTES, stream) != hipSuccess) return;
    Args a{};
    for (int i = 0; i < 33; ++i) a.in[i] = (const float*)d_in[i];
    a.out = (float*)d_out; a.ws = (unsigned char*)d_ws; a.pad = 0;
#if MK_ONE_LAUNCH
    a.gp_lo = 0; a.gp_hi = GP_COUNT; a.use_bar = 1;
    hipLaunchKernelGGL(fwd, dim3(grid), dim3(NWAVES * 64), LDS_BYTES, stream, a);
#else
    for (int gp = 0; gp < GP_COUNT; ++gp) {
        a.gp_lo = gp; a.gp_hi = gp + 1; a.use_bar = 0;
        hipLaunchKernelGGL(fwd, dim3(grid), dim3(NWAVES * 64), LDS_BYTES, stream, a);
    }
#endif
}
```

```cpp
#include <hip/hip_runtime.h>
#include <hip/hip_bf16.h>
#include <cstdio>
#include <cstdint>
#include <cmath>
namespace pg8 {
#define PG8_LAS __attribute__((address_space(3)))
typedef unsigned short bf16_t;
typedef short bf16x8 __attribute__((ext_vector_type(8)));
typedef float f32x4 __attribute__((ext_vector_type(4)));
typedef unsigned u32x4 __attribute__((ext_vector_type(4)));
constexpr int BM = 256, BK = 64, HALF = 128, HTB = HALF * BK * 2  , STAGE_BYTES = 8 * HTB, NXCD = 8, WGM = 8;

__host__ __device__ __forceinline__ int lds_byte(int r, int c) { const int st = (r >> 4) * 2 + (c >> 5), rr = r & 15, cc = c & 31, ob = rr * 64 + cc * 2; return st * 1024 + (ob ^ (((ob >> 9) & 1) << 5)); }
__host__ __device__ __forceinline__ void stage_rc(int b, int& R, int& C) { const int st = b / 1024, sb = b % 1024, swz = sb ^ (((sb >> 9) & 1) << 5); R = (st >> 1) * 16 + swz / 64; C = (st & 1) * 32 + (swz % 64) / 2; }
__host__ __device__ __forceinline__ int perm32(int rho) { const int n = rho >> 4, i = rho & 15; return 8 * (i >> 2) + 4 * n + (i & 3); }

struct Unit { int pm, pn, kb; };
struct Gemm { const bf16_t* A; const bf16_t* Bt; int M, N, K; int ld = 0; };

struct StaticOrder {
    int nM, nN, nwg, G, c;
    __host__ __device__ void init(int M, int N, int G_, int c_) { nM = M / BM; nN = N / BM; nwg = nM * nN; G = G_; c = c_; }
    __host__ __device__ bool next(int i, Unit& u) const {
        const long L = (long)i * G + c; if (L >= nwg) return false;
        int wgid = (int)L; { const int q = nwg / NXCD, r = nwg % NXCD, xcd = wgid % NXCD, off = wgid / NXCD; wgid = (xcd < r ? xcd * (q + 1) : r * (q + 1) + (xcd - r) * q) + off; }
        const int nig = WGM * nN, gid = wgid / nig, fm = gid * WGM, gsz = (nM - fm) < WGM ? (nM - fm) : WGM;
        u.pm = fm + ((wgid % nig) % gsz); u.pn = (wgid % nig) / gsz; u.kb = 0; return true;
    }
    __device__ __forceinline__ void a_ready(const Unit&) const {}
    __device__ __forceinline__ void done(const Unit&) const {}
};

__device__ __forceinline__ unsigned cvt_pk_bf16(float lo, float hi) { unsigned r; asm volatile("v_cvt_pk_bf16_f32 %0, %1, %2" : "=v"(r) : "v"(lo), "v"(hi)); return r; }
typedef float f32x2 __attribute__((ext_vector_type(2)));
__device__ __forceinline__ f32x2 gelu_pk(f32x2 v) {
    const f32x2 av = __builtin_elementwise_abs(v), d = av * 0.2316418882f + 1.0f;
    f32x2 t; t.x = __builtin_amdgcn_rcpf(d.x); t.y = __builtin_amdgcn_rcpf(d.y);
    f32x2 q = t * 0.5307027145f + (-0.7265760135f); q = q * t + 0.7107068705f; q = q * t + (-0.142248368f); q = q * t + 0.127414796f; q = q * t;
    const f32x2 s = (v * v) * (-0.72134752044f);
    f32x2 e; e.x = __builtin_amdgcn_exp2f(s.x); e.y = __builtin_amdgcn_exp2f(s.y);
    const f32x2 m = v * (q * e), r = v - m;
    f32x2 o; o.x = v.x < 0.f ? m.x : r.x; o.y = v.y < 0.f ? m.y : r.y; return o;
}

template <int ACT  > struct EpiBf16 {
    static constexpr bool PERM = true, AFTER_DRAIN = false; static_assert(ACT == 0 || ACT == 1, "EpiBf16: ACT is 0 (none) or 1 (gelu_pk)");
    bf16_t* O; int ldc; const float* bias; int split_cols; size_t split_stride; float scale0;
    __device__ __forceinline__ void operator()(const f32x4 (&acc)[2][2][4][2], const Unit& u, int wr, int wc, int fr, int fq) const {
        const int row0 = u.pm * BM + wr * 64 + fr; int colt = u.pn * BM; bf16_t* base = O;
        float sc = 1.f; if (split_cols) { const int t = colt / split_cols; base += (size_t)t * split_stride; colt -= t * split_cols; if (t == 0) sc = scale0; }
        const int col0 = colt + wc * 32 + 8 * fq, bcol0 = u.pn * BM + wc * 32 + 8 * fq;
        f32x4 bv[2][2];
#pragma unroll
        for (int bj = 0; bj < 2; ++bj)
#pragma unroll
            for (int n = 0; n < 2; ++n) bv[bj][n] = bias ? *(const f32x4*)(bias + bcol0 + bj * HALF + 4 * n) : (f32x4){0.f, 0.f, 0.f, 0.f};
#pragma unroll
        for (int ai = 0; ai < 2; ++ai)
#pragma unroll
            for (int m = 0; m < 4; ++m) { bf16_t* rowp = base + (size_t)(row0 + ai * HALF + m * 16) * ldc + col0;
#pragma unroll
                for (int bj = 0; bj < 2; ++bj) { f32x4 v0 = acc[ai][bj][m][0] + bv[bj][0], v1 = acc[ai][bj][m][1] + bv[bj][1];
                    if (ACT == 1) { f32x2 a = gelu_pk((f32x2){v0[0], v0[1]}), b = gelu_pk((f32x2){v0[2], v0[3]}), c = gelu_pk((f32x2){v1[0], v1[1]}), d = gelu_pk((f32x2){v1[2], v1[3]});
                        v0 = (f32x4){a.x, a.y, b.x, b.y}; v1 = (f32x4){c.x, c.y, d.x, d.y}; }
                    v0 = v0 * sc; v1 = v1 * sc; u32x4 w; w.x = cvt_pk_bf16(v0[0], v0[1]); w.y = cvt_pk_bf16(v0[2], v0[3]); w.z = cvt_pk_bf16(v1[0], v1[1]); w.w = cvt_pk_bf16(v1[2], v1[3]);
                    *(u32x4*)(rowp + bj * HALF) = w; } }
    }
};
template <class Epi, class Sched, bool ALIGN_EPI = false, bool SP2 = false>
__device__ __forceinline__ void gemm_phase(PG8_LAS unsigned char* lds, const Gemm g, const Sched& S, const Epi& E, int wave_in) {
    int ln_; asm volatile("v_mbcnt_lo_u32_b32 %0, -1, 0\n\tv_mbcnt_hi_u32_b32 %0, -1, %0" : "=v"(ln_)); asm volatile("" : "+s"(wave_in)); int tid_ = wave_in * 64 + ln_;
    const int tid = tid_, wid = __builtin_amdgcn_readfirstlane(tid >> 6), lane = tid & 63, wr = wid >> 2, wc = wid & 3, fr = lane & 15, fq = lane >> 4;
    const int K = g.ld ? g.ld : g.K, nt = g.K / BK;
    unsigned voffA[2], voffB[2];
#pragma unroll
    for (int i = 0; i < 2; ++i) { int R, C; stage_rc(tid * 16 + i * 8192, R, C); const int Rb = Epi::PERM ? ((R & ~31) + perm32(R & 31)) : R;
        voffA[i] = (unsigned)(R * K + C) * 2u; voffB[i] = (unsigned)(Rb * K + C) * 2u; }
    const size_t kstep = (size_t)(BK * 2);
    const size_t hstep = (size_t)HALF * K * 2;
    const size_t tstep = 2 * hstep;
    const unsigned ldsw = (unsigned)wid * 1024u;
    const int aoff = lds_byte(wr * 64 + fr, fq * 8), boff = lds_byte(wc * 32 + fr, fq * 8);
#define PG8_SA(b, h) (((b) * 2 + (h)) * HTB)
#define PG8_SB(b, h) ((4 + (b) * 2 + (h)) * HTB)
#define PG8_STAGE(bufoff, gbase, voff) do { _Pragma("unroll") for (int _i = 0; _i < 2; ++_i) \
        __builtin_amdgcn_global_load_lds((const unsigned*)((const char*)(gbase) + (voff)[_i]), (PG8_LAS unsigned*)(lds + (bufoff) + ldsw + _i * 8192), 16, 0, 0); } while (0)
#define PG8_LDA(dst, b, h) do { _Pragma("unroll") for (int m = 0; m < 4; ++m) _Pragma("unroll") for (int k = 0; k < 2; ++k) dst[m][k] = *(const PG8_LAS bf16x8*)(lds + PG8_SA(b, h) + aoff + m * 2048 + k * 1024); } while (0)
#define PG8_LDB(dst, b, h) do { _Pragma("unroll") for (int n = 0; n < 2; ++n) _Pragma("unroll") for (int k = 0; k < 2; ++k) dst[n][k] = *(const PG8_LAS bf16x8*)(lds + PG8_SB(b, h) + boff + n * 2048 + k * 1024); } while (0)
#define PG8_MMA(ai, bj, At, Bt) do { __builtin_amdgcn_s_setprio(1); _Pragma("unroll") for (int m = 0; m < 4; ++m) _Pragma("unroll") for (int n = 0; n < 2; ++n) _Pragma("unroll") for (int k = 0; k < 2; ++k) \
        acc[ai][bj][m][n] = __builtin_amdgcn_mfma_f32_16x16x32_bf16(Bt[n][k], At[m][k], acc[ai][bj][m][n], 0, 0, 0); __builtin_amdgcn_s_setprio(0); } while (0)
#define PG8_WAIT_V(n) asm volatile("s_waitcnt vmcnt(" #n ")" ::: "memory")
#define PG8_WAIT_L(n) asm volatile("s_waitcnt lgkmcnt(" #n ")" ::: "memory")
#define PG8_BAR __builtin_amdgcn_s_barrier()
#define PG8_SCHED __builtin_amdgcn_sched_barrier(0)
    Unit cur, nxt; int ui = 0;
    if (!S.next(0, cur)) return;
    f32x4 acc[2][2][4][2];
#pragma unroll
    for (int a = 0; a < 2; ++a)
#pragma unroll
        for (int b = 0; b < 2; ++b)
#pragma unroll
            for (int m = 0; m < 4; ++m)
#pragma unroll
                for (int n = 0; n < 2; ++n) acc[a][b][m][n] = (f32x4){0.f, 0.f, 0.f, 0.f};
    bf16x8 At[4][2], B0[2][2], B1[2][2];
    const char* cA = (const char*)g.A + (size_t)cur.pm * tstep + (size_t)cur.kb * 2; const char* cB = (const char*)g.Bt + (size_t)cur.pn * tstep + (size_t)cur.kb * 2;
    S.a_ready(cur);
    if constexpr (SP2) {
        PG8_STAGE(PG8_SB(0, 0), cB, voffB); PG8_STAGE(PG8_SB(0, 1), cB + hstep, voffB); PG8_STAGE(PG8_SA(0, 0), cA, voffA); PG8_STAGE(PG8_SA(0, 1), cA + hstep, voffA);
        if (wr == 1) PG8_BAR;
        PG8_WAIT_V(2); PG8_BAR;
        PG8_STAGE(PG8_SB(1, 0), cB + kstep, voffB); PG8_STAGE(PG8_SA(1, 0), cA + kstep, voffA); PG8_STAGE(PG8_SB(1, 1), cB + hstep + kstep, voffB);
        PG8_WAIT_V(6); PG8_BAR;
    } else {
        PG8_STAGE(PG8_SB(0, 0), cB, voffB); PG8_STAGE(PG8_SA(0, 0), cA, voffA); PG8_STAGE(PG8_SB(0, 1), cB + hstep, voffB); PG8_STAGE(PG8_SA(0, 1), cA + hstep, voffA);
        if (wr == 1) PG8_BAR;
        PG8_WAIT_V(4); PG8_BAR;
        PG8_STAGE(PG8_SB(1, 0), cB + kstep, voffB); PG8_STAGE(PG8_SA(1, 0), cA + kstep, voffA); PG8_STAGE(PG8_SB(1, 1), cB + hstep + kstep, voffB);
        PG8_WAIT_V(6); PG8_BAR;
    }
    for (;;) {
        const bool has_next = S.next(ui + 1, nxt);
        const char* nA = has_next ? (const char*)g.A + (size_t)nxt.pm * tstep + (size_t)nxt.kb * 2 : cA; const char* nB = has_next ? (const char*)g.Bt + (size_t)nxt.pn * tstep + (size_t)nxt.kb * 2 : cB;
        for (int t = 0; t < nt; t += 2) {
            const bool last = (t == nt - 2);
            const char* a1 = cA + (size_t)(t + 1) * kstep;
            const char* a2 = last ? nA : cA + (size_t)(t + 2) * kstep; const char* b2 = last ? nB : cB + (size_t)(t + 2) * kstep;
            const char* a3 = a2 + kstep; const char* b3 = b2 + kstep;
            if (last && has_next) S.a_ready(nxt);
            if constexpr (SP2) {
            PG8_LDB(B0, 0, 0); PG8_LDB(B1, 0, 1); PG8_SCHED; PG8_LDA(At, 0, 0); PG8_STAGE(PG8_SA(1, 1), a1 + hstep, voffA);
            PG8_WAIT_V(8); PG8_WAIT_L(0); PG8_BAR; PG8_MMA(0, 0, At, B0); PG8_MMA(0, 1, At, B1); PG8_BAR; PG8_SCHED;
            PG8_LDA(At, 0, 1); PG8_STAGE(PG8_SB(0, 0), b2, voffB); PG8_STAGE(PG8_SB(0, 1), b2 + hstep, voffB); PG8_STAGE(PG8_SA(0, 0), a2, voffA);
            PG8_WAIT_V(8); PG8_WAIT_L(0); PG8_BAR; PG8_MMA(1, 0, At, B0); PG8_MMA(1, 1, At, B1); PG8_BAR; PG8_SCHED;
            PG8_LDB(B0, 1, 0); PG8_LDB(B1, 1, 1); PG8_SCHED; PG8_LDA(At, 1, 0); PG8_STAGE(PG8_SA(0, 1), a2 + hstep, voffA);
            PG8_WAIT_V(8); PG8_WAIT_L(0); PG8_BAR; PG8_MMA(0, 0, At, B0); PG8_MMA(0, 1, At, B1); PG8_BAR; PG8_SCHED;
            PG8_LDA(At, 1, 1); PG8_STAGE(PG8_SB(1, 0), b3, voffB); PG8_STAGE(PG8_SB(1, 1), b3 + hstep, voffB); PG8_STAGE(PG8_SA(1, 0), a3, voffA);
            PG8_WAIT_V(8); PG8_WAIT_L(0); PG8_BAR; PG8_MMA(1, 0, At, B0); PG8_MMA(1, 1, At, B1); PG8_BAR; PG8_SCHED;
            } else {
            PG8_LDB(B0, 0, 0); PG8_SCHED; PG8_LDA(At, 0, 0); PG8_STAGE(PG8_SA(1, 1), a1 + hstep, voffA);
            PG8_WAIT_L(8); PG8_BAR; PG8_WAIT_L(0); PG8_MMA(0, 0, At, B0); PG8_BAR; PG8_SCHED;
            PG8_LDB(B1, 0, 1); PG8_STAGE(PG8_SB(0, 0), b2, voffB);
            PG8_BAR; PG8_WAIT_L(0); PG8_MMA(0, 1, At, B1); PG8_BAR;
            PG8_LDA(At, 0, 1); PG8_STAGE(PG8_SA(0, 0), a2, voffA);
            PG8_BAR; PG8_WAIT_L(0); PG8_MMA(1, 0, At, B0); PG8_BAR; PG8_SCHED;
            PG8_STAGE(PG8_SB(0, 1), b2 + hstep, voffB);
            PG8_WAIT_V(6); PG8_BAR; PG8_MMA(1, 1, At, B1); PG8_BAR;
            PG8_LDB(B0, 1, 0); PG8_SCHED; PG8_LDA(At, 1, 0); PG8_STAGE(PG8_SA(0, 1), a2 + hstep, voffA);
            PG8_WAIT_L(8); PG8_BAR; PG8_WAIT_L(0); PG8_MMA(0, 0, At, B0); PG8_BAR; PG8_SCHED;
            PG8_LDB(B1, 1, 1); PG8_STAGE(PG8_SB(1, 0), b3, voffB);
            PG8_BAR; PG8_WAIT_L(0); PG8_MMA(0, 1, At, B1); PG8_BAR;
            PG8_LDA(At, 1, 1); PG8_STAGE(PG8_SA(1, 0), a3, voffA);
            PG8_BAR; PG8_WAIT_L(0); PG8_MMA(1, 0, At, B0); PG8_BAR; PG8_SCHED;
            PG8_STAGE(PG8_SB(1, 1), b3 + hstep, voffB);
            PG8_WAIT_V(6); PG8_BAR; PG8_MMA(1, 1, At, B1); PG8_BAR;
            }
        }
        if constexpr (ALIGN_EPI) { if (wr == 0) PG8_BAR; }
        if constexpr (!Epi::AFTER_DRAIN) { E(acc, cur, wr, wc, fr, fq); S.done(cur); }
        if (!has_next) break;
#pragma unroll
        for (int a = 0; a < 2; ++a)
#pragma unroll
            for (int b = 0; b < 2; ++b)
#pragma unroll
                for (int m = 0; m < 4; ++m)
#pragma unroll
                    for (int n = 0; n < 2; ++n) acc[a][b][m][n] = (f32x4){0.f, 0.f, 0.f, 0.f};
        cur = nxt; cA = nA; cB = nB; ++ui;
        if constexpr (ALIGN_EPI) { if (wr == 1) PG8_BAR; }
    }
    PG8_WAIT_V(0);
    if constexpr (!ALIGN_EPI) { if (wr == 0) PG8_BAR; }
    PG8_BAR;
    if constexpr (Epi::AFTER_DRAIN) { E.fused(acc, cur, wr, wc, fr, fq, lds, wid, lane); S.done(cur); }
#undef PG8_SA
#undef PG8_SB
#undef PG8_STAGE
#undef PG8_LDA
#undef PG8_LDB
#undef PG8_MMA
#undef PG8_WAIT_V
#undef PG8_WAIT_L
#undef PG8_BAR
#undef PG8_SCHED
}
}

constexpr int NWAVES = 8;
constexpr int DM = 2048, NB = 2, SEQ = 8192, DEPTH = 4, GRIDW = 64, CTXL = 256, HD = 64;
constexpr int MLAT = NB * SEQ, MCTX = NB * CTXL, MALL = MLAT + MCTX;
constexpr int INC = 5792, INP = 5888;
constexpr int C_QA = 0, C_KA = 512, C_VA = 1024, C_QB = 1536, C_KB = 2048, C_VB = 2176, C_R = 2304, C_K = 3328, C_V = 4352, C_WD = 5376, C_AD = 5504, C_GD = 5632;
constexpr int CW = 1024;
constexpr int DFF = 5632, UPN = 2 * DFF;
constexpr int SKV = CTXL + SEQ;
constexpr int MODW = 6 * DM;
constexpr float LOG2E = 1.4426950408889634f;
constexpr float QSCALE = 0.125f * LOG2E;

constexpr size_t MiB = 1u << 20;
constexpr size_t WS_CTL = 0, CTL_ZERO_BYTES = 1 * MiB;
constexpr size_t WS_MOD = 1 * MiB;
constexpr size_t WS_MODP = 2 * MiB;
constexpr size_t WS_WIN = 12 * MiB;
constexpr size_t WS_WOUT = 104 * MiB;
constexpr size_t WS_WUP = 136 * MiB;
constexpr size_t WS_WDN = 312 * MiB;
constexpr size_t WS_H = 400 * MiB;
constexpr size_t WS_XN = 1111 * MiB;
constexpr size_t WS_Y1 = 532 * MiB;
constexpr size_t WS_QBP = 722 * MiB;
constexpr size_t WS_KBP = 739 * MiB;
constexpr size_t WS_VBP = 744 * MiB;
constexpr size_t WS_OA = 749 * MiB;
constexpr size_t WS_OB = 766 * MiB;
constexpr size_t WS_WDEC = 783 * MiB;
constexpr size_t WS_AIC = 849 * MiB;
constexpr size_t WS_G = 915 * MiB;
constexpr size_t WS_YS = 948 * MiB;
constexpr size_t WS_MIX = 1177 * MiB;
constexpr size_t WS_U = 532 * MiB;
constexpr size_t WS_HB = 895 * MiB;
constexpr size_t WS_VAT = 1080 * MiB;
constexpr size_t WS_LW = 1097 * MiB;
constexpr size_t WS_OC = 1243 * MiB;
constexpr size_t WS_GK = 1101 * MiB;
constexpr size_t WS_BIAS1 = 1102 * MiB;
constexpr size_t WS_BIAS3 = 1103 * MiB;
constexpr size_t WS_SS = 256 * 1024;
constexpr size_t WS_SSP = 1104 * MiB;
constexpr size_t WS_RS = 1109 * MiB;
constexpr size_t WS_PART = 1309 * MiB;
constexpr size_t WS_VBT = 1110 * MiB;
constexpr size_t WS_CK = 1111 * MiB;
constexpr size_t WS_CKS = 1498 * MiB;
constexpr size_t WS_END = 1530 * MiB;
static_assert(WS_U + (size_t)MALL * UPN * 2 <= WS_HB && WS_HB + (size_t)MALL * DFF * 2 <= WS_VAT, "overlay map");
constexpr int CW_BAR = 4096;
static_assert(WS_SS + (size_t)DEPTH * 2 * MALL * 4 <= CTL_ZERO_BYTES && (size_t)(CW_BAR + 3456) * 4 <= WS_SS, "control-region map");

constexpr int RING_BYTES = 131072;
constexpr int LDSCTL_OFF = RING_BYTES, MISC_OFF = LDSCTL_OFF + 320;
constexpr int LDS_BYTES = 147456;

#define GAS __attribute__((address_space(1)))
#define LAS __attribute__((address_space(3)))
typedef unsigned short bf16;
typedef unsigned v4u __attribute__((ext_vector_type(4)));
typedef unsigned v2u __attribute__((ext_vector_type(2)));
typedef float f32x4 __attribute__((ext_vector_type(4)));
typedef GAS unsigned gu32;
#define RLX_AGENT __ATOMIC_RELAXED, __HIP_MEMORY_SCOPE_AGENT
#define LDS_WAIT() asm volatile("s_waitcnt lgkmcnt(0)" ::: "memory")
#define VM_WAIT() asm volatile("s_waitcnt vmcnt(0)" ::: "memory")
__device__ __forceinline__ unsigned f2bf(float f) { unsigned u = __builtin_bit_cast(unsigned, f); return (u + 0x7fffu + ((u >> 16) & 1u)) >> 16; }
__device__ __forceinline__ unsigned pk2(float lo, float hi) { return f2bf(lo) | (f2bf(hi) << 16); }
__device__ __forceinline__ float bf2f(bf16 u) { return __uint_as_float((unsigned)u << 16); }
__device__ __forceinline__ float bflo(unsigned w) { return __uint_as_float(w << 16); }
__device__ __forceinline__ float bfhi(unsigned w) { return __uint_as_float(w & 0xffff0000u); }
template <int CTRL> __device__ __forceinline__ float dpp_f(float v) { return __builtin_bit_cast(float, __builtin_amdgcn_update_dpp(0, __builtin_bit_cast(int, v), CTRL, 0xF, 0xF, true)); }
__device__ __forceinline__ float sum16(float v) { v += dpp_f<0xB1>(v); v += dpp_f<0x4E>(v); v += dpp_f<0x141>(v); v += dpp_f<0x140>(v); return v; }
__device__ __forceinline__ float sum64(float v) { v = sum16(v); const int b = __builtin_bit_cast(int, v);
    return (__builtin_bit_cast(float, __builtin_amdgcn_readlane(b, 0)) + __builtin_bit_cast(float, __builtin_amdgcn_readlane(b, 16))) + (__builtin_bit_cast(float, __builtin_amdgcn_readlane(b, 32)) + __builtin_bit_cast(float, __builtin_amdgcn_readlane(b, 48))); }
__device__ __forceinline__ float wave_sum(float v) { return sum64(v); }
typedef float f32x2 __attribute__((ext_vector_type(2)));
__device__ __forceinline__ float sigmoidf_(float x) { return 1.f / (1.f + __expf(-x)); }

namespace attn_body {
using bf16=__hip_bfloat16;
using bf16x8=__attribute__((ext_vector_type(8)))short;
using s16x4=__attribute__((ext_vector_type(4)))short;
using f32x16=__attribute__((ext_vector_type(16)))float;
using u32x4=__attribute__((ext_vector_type(4)))unsigned;
constexpr int D=64,QP=512,KP=128,OP=512,SEQQ=8192,SEQK=8448;
constexpr int NW=8,QBLK=32,QB=QBLK*NW,KVBLK=64,NQB=SEQQ/QB;
constexpr int ATTN_UNIT_ROWS=QB;
__device__ __forceinline__ int crow(int r,int hi){return (r&3)+8*(r>>2)+4*hi;}
#define SBAR() __builtin_amdgcn_sched_barrier(0)
__device__ __forceinline__ void cmask(f32x16&p0,f32x16&p1,int jb,int qrel,int hi){
  const float NEG=-INFINITY; int kb=64*jb+4*hi;
  #pragma unroll
  for(int r=0;r<16;++r){int kv=kb+(r&3)+8*(r>>2); if(kv>qrel)p0[r]=NEG; if(kv+32>qrel)p1[r]=NEG;}
}

constexpr int NSLOT=3, SLOTB=8192;
constexpr int LDS_K=0, LDS_V=NSLOT*SLOTB, LDS_WS=2*NSLOT*SLOTB, LDS_OST=LDS_WS+NW*64*4, LDS_BYTES=LDS_OST+NW*4096;
constexpr float C2=0.125f*1.4426950408889634f;
__device__ __forceinline__ void glds16(const void*gsrc,unsigned lds_dst){unsigned keep;
  asm volatile("s_mov_b32 %0, m0\n\ts_mov_b32 m0, %2\n\ts_nop 0\n\tglobal_load_lds_dwordx4 %1, off\n\ts_mov_b32 m0, %0":"=&s"(keep):"v"(gsrc),"s"(lds_dst):"memory");}
__device__ __forceinline__ float max3f(float a,float b,float c){float r;asm("v_max3_f32 %0, %1, %2, %3":"=v"(r):"v"(a),"v"(b),"v"(c));return r;}
__device__ __forceinline__ float max2f(float a,float b){float r;asm("v_max_f32_e32 %0, %1, %2":"=v"(r):"v"(a),"v"(b));return r;}
__device__ __forceinline__ float fadd_s(float a,float b){float r;asm("v_add_f32_e32 %0, %1, %2":"=v"(r):"v"(a),"v"(b));return r;}
__device__ __forceinline__ float fsub_s(float a,float b){float r;asm("v_sub_f32_e32 %0, %1, %2":"=v"(r):"v"(a),"v"(b));return r;}
typedef float f32x2_t __attribute__((ext_vector_type(2))); typedef __bf16 bf16x2_t __attribute__((ext_vector_type(2)));
__device__ __forceinline__ unsigned cvtpk_s(float lo,float hi){f32x2_t v={lo,hi};bf16x2_t b=__builtin_convertvector(v,bf16x2_t);return __builtin_bit_cast(unsigned,b);}
#define WAIT_BAR(N) asm volatile("s_waitcnt vmcnt(" #N ") lgkmcnt(0)\n\ts_barrier":::"memory")

__device__ __forceinline__ void qkt(f32x16&p0,f32x16&p1,const char*Kslot,const bf16x8*qr,const f32x16&negm,int r32,int hi){
  const char*kb=Kslot+hi*1024+r32*16;
  #pragma unroll
  for(int d0=0;d0<4;++d0){
    const bf16x8 b0=*reinterpret_cast<const bf16x8*>(kb+d0*2048);
    const bf16x8 b1=*reinterpret_cast<const bf16x8*>(kb+d0*2048+512);
    if(d0==0){p0=__builtin_amdgcn_mfma_f32_32x32x16_bf16(b0,qr[0],negm,0,0,0);p1=__builtin_amdgcn_mfma_f32_32x32x16_bf16(b1,qr[0],negm,0,0,0);}
    else{p0=__builtin_amdgcn_mfma_f32_32x32x16_bf16(b0,qr[d0],p0,0,0,0);p1=__builtin_amdgcn_mfma_f32_32x32x16_bf16(b1,qr[d0],p1,0,0,0);}}
}
typedef __attribute__((address_space(3))) const char* lds_cptr;
typedef short v4i16_t __attribute__((ext_vector_type(4)));
__device__ __forceinline__ void kload8(bf16x8*kf,lds_cptr kp){
  kf[0]=*(const __attribute__((address_space(3))) bf16x8*)(kp);      kf[1]=*(const __attribute__((address_space(3))) bf16x8*)(kp+512);
  kf[2]=*(const __attribute__((address_space(3))) bf16x8*)(kp+2048); kf[3]=*(const __attribute__((address_space(3))) bf16x8*)(kp+2560);
  kf[4]=*(const __attribute__((address_space(3))) bf16x8*)(kp+4096); kf[5]=*(const __attribute__((address_space(3))) bf16x8*)(kp+4608);
  kf[6]=*(const __attribute__((address_space(3))) bf16x8*)(kp+6144); kf[7]=*(const __attribute__((address_space(3))) bf16x8*)(kp+6656);
}
__device__ __forceinline__ void kload2(bf16x8*kf,lds_cptr kp,int j){ kf[2*j]=*(const __attribute__((address_space(3))) bf16x8*)(kp+j*2048); kf[2*j+1]=*(const __attribute__((address_space(3))) bf16x8*)(kp+j*2048+512); }
__device__ __forceinline__ s16x4 vtr(lds_cptr p){ return __builtin_bit_cast(s16x4,__builtin_amdgcn_ds_read_tr16_b64_v4i16((__attribute__((address_space(3))) v4i16_t*)p)); }
__device__ __forceinline__ float rowmax(const f32x16&p0,const f32x16&p1){
  float a=max3f(p0[0],p0[1],p1[0]),b=max3f(p0[2],p0[3],p1[1]);a=max3f(a,p1[2],p1[3]);
  #pragma unroll
  for(int r=4;r<16;r+=4){a=max3f(a,p0[r],p0[r+1]);b=max3f(b,p0[r+2],p0[r+3]);a=max3f(a,p1[r],p1[r+1]);b=max3f(b,p1[r+2],p1[r+3]);}
  const float m=max2f(a,b);
  auto rr=__builtin_amdgcn_permlane32_swap(__float_as_uint(m),__float_as_uint(m),false,false);
  return max2f(__uint_as_float(rr[0]),__uint_as_float(rr[1]));
}
__device__ __forceinline__ void pv(f32x16*o,int vb,bf16x8 pa0,bf16x8 pa1,bf16x8 pa2,bf16x8 pa3){
  #pragma unroll
  for(int d0=0;d0<2;++d0){s16x4 lo[4],hi[4];
    #pragma unroll
    for(int ks=0;ks<4;++ks){
      asm volatile("ds_read_b64_tr_b16 %0,%1 offset:%c2":"=&v"(lo[ks]):"v"(vb),"i"(d0*4096+ks*1024):"memory");
      asm volatile("ds_read_b64_tr_b16 %0,%1 offset:%c2":"=&v"(hi[ks]):"v"(vb),"i"(d0*4096+ks*1024+512):"memory");}
    asm volatile("s_waitcnt lgkmcnt(0)":::"memory");SBAR();
    #define PK(k) (bf16x8){lo[k][0],lo[k][1],lo[k][2],lo[k][3],hi[k][0],hi[k][1],hi[k][2],hi[k][3]}
    o[d0]=__builtin_amdgcn_mfma_f32_32x32x16_bf16(pa0,PK(0),o[d0],0,0,0);
    o[d0]=__builtin_amdgcn_mfma_f32_32x32x16_bf16(pa1,PK(1),o[d0],0,0,0);
    o[d0]=__builtin_amdgcn_mfma_f32_32x32x16_bf16(pa2,PK(2),o[d0],0,0,0);
    o[d0]=__builtin_amdgcn_mfma_f32_32x32x16_bf16(pa3,PK(3),o[d0],0,0,0);
    #undef PK
  }
}

#ifndef ATTN_STORE16
#define ATTN_STORE16(p,v) (*(u32x4*)(p)=(v))
#endif
template<int THRL> __device__ __forceinline__ void attn_unit(int b,int h,int qb,const bf16*Q,const bf16*__restrict__ K,const bf16*__restrict__ V,bf16*O,char*shm,int wave_in){
  int ln_; asm volatile("v_mbcnt_lo_u32_b32 %0, -1, 0\n\tv_mbcnt_hi_u32_b32 %0, -1, %0" : "=v"(ln_)); asm volatile("" : "+s"(wave_in)); int tid_=wave_in*64+ln_; const int tid=tid_,lane=tid&63,r32=lane&31,hi=lane>>5; const int wid=__builtin_amdgcn_readfirstlane(tid>>6);
  const long rowq=(long)b*SEQQ, rowk=(long)b*SEQK; const int q0=qb*QB;
  const bf16*Qw=Q+(rowq+q0+wid*QBLK)*QP+h*D;
  const bf16*Kh=K+rowk*KP+(h>>2)*D,*Vh=V+rowk*KP+(h>>2)*D;
  const unsigned lds0=(unsigned)(uintptr_t)shm;
  float*wsf=(float*)(shm+LDS_WS)+wid*64;
  const bf16*ksrc=Kh+(long)lane*KP+wid*8;
  const bf16*vsrc=Vh+(long)(16*(wid&3)+(lane>>2))*KP+(wid>>2)*32+(lane&3)*8;
  const unsigned kdst=lds0+LDS_K+wid*1024, vdst=lds0+LDS_V+wid*1024;
  #define DMA_K(t,slot) glds16(ksrc+(long)(t)*KVBLK*KP,(unsigned)__builtin_amdgcn_readfirstlane(kdst+(slot)))
  #define DMA_V(t,slot) glds16(vsrc+(long)(t)*KVBLK*KP,(unsigned)__builtin_amdgcn_readfirstlane(vdst+(slot)))
  const int vb0=(int)(lds0+LDS_V)+((lane>>4)&1)*32+(lane&3)*8+(4*hi+((lane&15)>>2))*64;
  const char*Kbase=shm+LDS_K; bf16x8 kf[8];
  const lds_cptr shm3=(lds_cptr)shm; const lds_cptr kp0=shm3+LDS_K+hi*1024+r32*16; const lds_cptr vp0=shm3+LDS_V+((lane>>4)&1)*32+(lane&3)*8+(4*hi+((lane&15)>>2))*64;
  constexpr int NT=SEQK/KVBLK;
  DMA_K(0,0);DMA_V(0,0);DMA_K(1,SLOTB);
  bf16x8 qr[4];
  #pragma unroll
  for(int d0=0;d0<4;++d0)qr[d0]=*reinterpret_cast<const bf16x8*>(&Qw[(long)r32*QP+d0*16+hi*8]);
  float mhat=0.f,l_reg=0.f;f32x16 o[2];o[0]=f32x16{};o[1]=f32x16{};f32x16 negm=f32x16{};asm volatile("":"+v"(negm));

  #define CMASK(P0,P1,t) do{}while(0)
  bool resc=false;
  #define START(P0,P1) do{ const float rm=rowmax(P0,P1); resc=false; \
    { const float dl=rm; mhat=fadd_s(mhat,dl); \
      _Pragma("unroll") for(int r=0;r<16;++r){P0[r]=fsub_s(P0[r],dl);P1[r]=fsub_s(P1[r],dl);} \
      _Pragma("unroll") for(int r=0;r<16;++r)negm[r]=-mhat; asm volatile("":"+v"(negm)); } \
    _Pragma("unroll") for(int r=0;r<16;++r)P0[r]=__builtin_amdgcn_exp2f(P0[r]); }while(0)
  #define RESC() do{ if(resc){ asm volatile("s_waitcnt lgkmcnt(0)":::"memory"); \
      _Pragma("unroll") for(int d_=0;d_<2;++d_) _Pragma("unroll") for(int r=0;r<16;++r)o[d_][r]*=wsf[crow(r,hi)]; } }while(0)
  f32x16 pA0,pA1,pB0,pB1;
  int sl_prev=0,sl_cur=0,sl_next=SLOTB;
  #define ROT() do{sl_prev=sl_cur;sl_cur=sl_next;sl_next=(sl_next==(NSLOT-1)*SLOTB)?0:sl_next+SLOTB;}while(0)
  DMA_K(2,2*SLOTB);
  WAIT_BAR(3);
  qkt(pA0,pA1,Kbase,qr,negm,r32,hi);asm volatile("s_nop 15\n\ts_nop 7":"+v"(pA0),"+v"(pA1));CMASK(pA0,pA1,0);
  START(pA0,pA1);
  _Pragma("unroll") for(int r=0;r<16;++r)pA1[r]=__builtin_amdgcn_exp2f(pA1[r]);
  WAIT_BAR(0);
  DMA_K(3,0);DMA_V(1,SLOTB);
  ROT();
  kload8(kf,kp0+sl_cur);
  WAIT_BAR(2);
  s16x4 vlo[8],vhi[8]; u32x4 pw0,pw1,pw2,pw3;
  #define PKW(P,B) cvtpk_s(P[B],P[B+1])
  #define PAF(k) __builtin_bit_cast(bf16x8,pw##k)
  #define VFR(i) (bf16x8){vlo[i][0],vlo[i][1],vlo[i][2],vlo[i][3],vhi[i][0],vhi[i][1],vhi[i][2],vhi[i][3]}
  #define PIN(x) asm volatile("":"+v"(x))
  #define MX3(a,b,c) __builtin_fmaxf(__builtin_fmaxf((a),(b)),(c))
  #define GAPA(MF,A0,A1,A2,A3,W0,W1,PW) do{ MF; sacc+=A0; sacc+=A1; sacc+=A2; sacc+=A3; PIN(sacc); W0; W1; PIN(PW); SBAR(); }while(0)
  #define EX(v) __builtin_amdgcn_exp2f(v)
  #define GAPB(MF,X,B) do{ MF; X[B]=EX(X[B]); X[B+1]=EX(X[B+1]); X[B+2]=EX(X[B+2]); X[B+3]=EX(X[B+3]); PIN(X); SBAR(); }while(0)
  #define VRD(i) do{ vlo[i]=vtr(vp_+(((i)>>2)*4096+((i)&3)*1024)); vhi[i]=vtr(vp_+(((i)>>2)*4096+((i)&3)*1024+512)); }while(0)
  #define KRD(G,j) do{ if(G){ kload2(kf,kp0+sl_next,j); SBAR(); } }while(0)
  #define STEP(C0,C1,P0,P1,t,GK,GV,GL) do{ SBAR(); \
    const lds_cptr vp_=vp0+sl_prev; \
    VRD(0); SBAR(); float sacc=(P0[0]+P0[1]); \
    GAPA(C0=__builtin_amdgcn_mfma_f32_32x32x16_bf16(kf[0],qr[0],negm,0,0,0), P0[2],P0[3],P0[4],P0[5],     pw0[0]=PKW(P0,0), pw0[1]=PKW(P0,2), pw0); \
    VRD(4); SBAR(); GAPA(C1=__builtin_amdgcn_mfma_f32_32x32x16_bf16(kf[1],qr[0],negm,0,0,0), P0[6],P0[7],P0[8],P0[9],     pw0[2]=PKW(P0,4), pw0[3]=PKW(P0,6), pw0); \
    VRD(1); SBAR(); GAPA(C0=__builtin_amdgcn_mfma_f32_32x32x16_bf16(kf[2],qr[1],C0,0,0,0),   P0[10],P0[11],P0[12],P0[13], pw1[0]=PKW(P0,8), pw1[1]=PKW(P0,10), pw1); \
    VRD(5); SBAR(); GAPA(C1=__builtin_amdgcn_mfma_f32_32x32x16_bf16(kf[3],qr[1],C1,0,0,0),   P0[14],P0[15],P1[0],P1[1],   pw1[2]=PKW(P0,12),pw1[3]=PKW(P0,14), pw1); \
    VRD(2); SBAR(); GAPA(C0=__builtin_amdgcn_mfma_f32_32x32x16_bf16(kf[4],qr[2],C0,0,0,0),   P1[2],P1[3],P1[4],P1[5],     pw2[0]=PKW(P1,0), pw2[1]=PKW(P1,2), pw2); \
    VRD(6); SBAR(); GAPA(C1=__builtin_amdgcn_mfma_f32_32x32x16_bf16(kf[5],qr[2],C1,0,0,0),   P1[6],P1[7],P1[8],P1[9],     pw2[2]=PKW(P1,4), pw2[3]=PKW(P1,6), pw2); \
    VRD(3); SBAR(); GAPA(C0=__builtin_amdgcn_mfma_f32_32x32x16_bf16(kf[6],qr[3],C0,0,0,0),   P1[10],P1[11],P1[12],P1[13], pw3[0]=PKW(P1,8), pw3[1]=PKW(P1,10), pw3); \
    VRD(7); SBAR(); GAPA(C1=__builtin_amdgcn_mfma_f32_32x32x16_bf16(kf[7],qr[3],C1,0,0,0),   P1[14],P1[15],0.f,0.f,       pw3[2]=PKW(P1,12),pw3[3]=PKW(P1,14), pw3); \
    l_reg+=sacc; \
    if(GK){DMA_K((t)+3,sl_cur);} if(GV){DMA_V((t)+1,sl_next);} \
    CMASK(C0,C1,t); \
    { float a=MX3(C0[0],C0[1],C1[0]),b=MX3(C0[2],C0[3],C1[1]); a=MX3(a,C1[2],C1[3]); \
      _Pragma("unroll") for(int r=4;r<16;r+=4){a=MX3(a,C0[r],C0[r+1]);b=MX3(b,C0[r+2],C0[r+3]);a=MX3(a,C1[r],C1[r+1]);b=MX3(b,C1[r+2],C1[r+3]);} \
      float rm=__builtin_fmaxf(a,b); { auto rr=__builtin_amdgcn_permlane32_swap(__float_as_uint(rm),__float_as_uint(rm),false,false); rm=__builtin_fmaxf(__uint_as_float(rr[0]),__uint_as_float(rr[1])); } \
      resc=false; \
      if(__builtin_expect(__any(rm>(float)THRL),0)){ const float dl=__builtin_fmaxf(rm,0.f); mhat+=dl; \
        _Pragma("unroll") for(int r=0;r<16;++r){C0[r]-=dl;C1[r]-=dl;} \
        _Pragma("unroll") for(int r=0;r<16;++r)negm[r]=-mhat; asm volatile("":"+v"(negm)); \
        const float f=__builtin_amdgcn_exp2f(-dl); l_reg*=f; if(hi==0)wsf[r32]=f; resc=true; } } \
    SBAR(); \
    GAPB(o[0]=__builtin_amdgcn_mfma_f32_32x32x16_bf16(PAF(0),VFR(0),o[0],0,0,0), C0,0); \
    GAPB(o[1]=__builtin_amdgcn_mfma_f32_32x32x16_bf16(PAF(0),VFR(4),o[1],0,0,0), C0,4); \
    KRD(GL,0); GAPB(o[0]=__builtin_amdgcn_mfma_f32_32x32x16_bf16(PAF(1),VFR(1),o[0],0,0,0), C0,8); \
    KRD(GL,1); GAPB(o[1]=__builtin_amdgcn_mfma_f32_32x32x16_bf16(PAF(1),VFR(5),o[1],0,0,0), C0,12); \
    KRD(GL,2); GAPB(o[0]=__builtin_amdgcn_mfma_f32_32x32x16_bf16(PAF(2),VFR(2),o[0],0,0,0), C1,0); \
    KRD(GL,3); GAPB(o[1]=__builtin_amdgcn_mfma_f32_32x32x16_bf16(PAF(2),VFR(6),o[1],0,0,0), C1,4); \
    GAPB(o[0]=__builtin_amdgcn_mfma_f32_32x32x16_bf16(PAF(3),VFR(3),o[0],0,0,0), C1,8); \
    GAPB(o[1]=__builtin_amdgcn_mfma_f32_32x32x16_bf16(PAF(3),VFR(7),o[1],0,0,0), C1,12); \
    }while(0)
  int t=1;
  #undef CMASK
  #define CMASK(P0,P1,t) do{}while(0)
  for(;t+5<NT;t+=2){
    STEP(pB0,pB1,pA0,pA1,t,true,true,true);     WAIT_BAR(2); RESC(); ROT();
    STEP(pA0,pA1,pB0,pB1,t+1,true,true,true);   WAIT_BAR(2); RESC(); ROT();
  }
  #undef CMASK
  #define CMASK(P0,P1,t) do{}while(0)
  #define ENDW(tt) do{ if((tt)+3<NT){WAIT_BAR(2);} else if((tt)+2<NT){WAIT_BAR(1);} else {WAIT_BAR(0);} }while(0)
  for(;t+1<NT;t+=2){
    STEP(pB0,pB1,pA0,pA1,t,(t+3<NT),(t+1<NT),(t+1<NT));       ENDW(t);   RESC(); ROT();
    STEP(pA0,pA1,pB0,pB1,t+1,(t+4<NT),(t+2<NT),(t+2<NT));     ENDW(t+1); RESC(); ROT();
  }
  STEP(pB0,pB1,pA0,pA1,NT-1,false,false,false); RESC();
  { float sacc=pB0[0]+pB0[1]; _Pragma("unroll") for(int r=2;r<16;++r)sacc+=pB0[r]; _Pragma("unroll") for(int r=0;r<16;++r)sacc+=pB1[r]; l_reg+=sacc;
    pw0=(u32x4){PKW(pB0,0),PKW(pB0,2),PKW(pB0,4),PKW(pB0,6)};pw1=(u32x4){PKW(pB0,8),PKW(pB0,10),PKW(pB0,12),PKW(pB0,14)};pw2=(u32x4){PKW(pB1,0),PKW(pB1,2),PKW(pB1,4),PKW(pB1,6)};pw3=(u32x4){PKW(pB1,8),PKW(pB1,10),PKW(pB1,12),PKW(pB1,14)};
    SBAR(); pv(o,vb0+sl_cur,PAF(0),PAF(1),PAF(2),PAF(3)); }
  #undef PKW
  #undef PAF
  #undef VFR
  #undef PIN
  #undef MX3
  #undef GAPA
  #undef GAPB
  #undef EX
  #undef VRD
  #undef KRD
  #undef STEP
  #undef ENDW
  {auto rr=__builtin_amdgcn_permlane32_swap(__float_as_uint(l_reg),__float_as_uint(l_reg),false,false);l_reg=__uint_as_float(rr[0])+__uint_as_float(rr[1]);}
  if(hi==0)wsf[32+r32]=l_reg;asm volatile("s_waitcnt lgkmcnt(0)":::"memory");
  float rli[16];
  #pragma unroll
  for(int r=0;r<16;++r)rli[r]=__builtin_amdgcn_rcpf(wsf[32+crow(r,hi)]);
  bf16*Ow=O+(rowq+q0+wid*QBLK)*OP+h*D;
  { bf16*stg=(bf16*)(shm+LDS_OST)+wid*2048;
    #pragma unroll
    for(int r=0;r<16;++r){const int orow=crow(r,hi);
      #pragma unroll
      for(int d0=0;d0<2;++d0)stg[orow*64+d0*32+r32]=__float2bfloat16(o[d0][r]*rli[r]);}
    asm volatile("s_waitcnt lgkmcnt(0)":::"memory");
    #pragma unroll
    for(int i=0;i<4;++i){const int row=i*8+(lane>>3),ch=lane&7; const u32x4 v=*(const u32x4*)(stg+row*64+ch*8); ATTN_STORE16(Ow+(long)row*OP+ch*8,v);} }
  asm volatile("s_waitcnt lgkmcnt(0)\n\ts_barrier":::"memory");
  #undef DMA_K
  #undef DMA_V
  #undef CMASK
  #undef START
  #undef RESC
  #undef ROT
}
constexpr int ATTN_LDS_BYTES=LDS_BYTES;
struct AttnTensors { const bf16* Q; const bf16* K; const bf16* V; bf16* O; };
template<int THRL=8> __device__ __forceinline__ void attn_phase(char*lds,const AttnTensors&T,int vcu,int G,int wave_in){
  for(int u=vcu;u<2*8*NQB;u+=G){ attn_unit<THRL>(u>>8,(u>>5)&7,u&31,T.Q,T.K,T.V,T.O,lds,wave_in); }
}
#undef SBAR
#undef WAIT_BAR
}
#define XB_TMO      128
#define XB_XCNT(j)  (256  + 64 * (j))
#define XB_XSUB(j)  (1280 + 64 * (j))
#define XB_XGEN(j)  (2304 + 64 * (j))
#define XB_TOP      3328
#define XB_TOPGEN   3392
#define XCD_BAR_WORDS 3456
#define XB_SPIN_CAP (1u << 18)

__device__ __forceinline__ unsigned xb_ld(unsigned* p)              { return __hip_atomic_load(p, __ATOMIC_RELAXED, __HIP_MEMORY_SCOPE_AGENT); }
__device__ __forceinline__ unsigned xb_add(unsigned* p, unsigned v) { return __hip_atomic_fetch_add(p, v, __ATOMIC_RELAXED, __HIP_MEMORY_SCOPE_AGENT); }
__device__ __forceinline__ unsigned xb_xcc_id() { return (unsigned)__builtin_amdgcn_s_getreg((3 << 11) | 20) & 0xFu; }
#define XB_SPIN(cond, bar) do { unsigned _sp = 0; while (cond) { __builtin_amdgcn_s_sleep(1); \
    if ((++_sp & 255u) == 0u) { if (xb_ld(&(bar)[XB_TMO])) break; if (_sp > XB_SPIN_CAP) { atomicAdd(&(bar)[XB_TMO], 1u); break; } } } } while (0)

struct XcdBarrier {
    unsigned* bar; unsigned x;
    int wv;
    volatile LAS unsigned* st;
};

__device__ __forceinline__ bool xb_thread0(int wv) { int ln_; asm volatile("v_mbcnt_lo_u32_b32 %0, -1, 0\n\tv_mbcnt_hi_u32_b32 %0, -1, %0" : "=v"(ln_)); return wv == 0 && ln_ == 0; }
__device__ __forceinline__ XcdBarrier xcd_barrier_post(unsigned* bar, volatile LAS unsigned* st, int wv) {
    XcdBarrier b; b.bar = bar; b.x = xb_xcc_id(); b.st = st; b.wv = wv;
    if (xb_thread0(wv)) (void)xb_add(&bar[XB_XCNT(b.x)], 1u);
    return b;
}
__device__ __forceinline__ void xcd_barrier_complete(unsigned* bar, unsigned x, unsigned& nloc, unsigned& nx) {
    const unsigned G = gridDim.x * gridDim.y * gridDim.z;
    unsigned sum, cnt, mine, sp = 0u;
    for (;;) {
        sum = 0u; cnt = 0u; mine = 0u;
#pragma unroll
        for (unsigned j = 0; j < 16; ++j) { const unsigned c = xb_ld(&bar[XB_XCNT(j)]); sum += c; cnt += (c > 0u) ? 1u : 0u; mine = (j == x) ? c : mine; }
        if (sum == G) break;
        __builtin_amdgcn_s_sleep(1);
        if ((++sp & 255u) == 0u) { if (xb_ld(&bar[XB_TMO])) break; if (sp > XB_SPIN_CAP) { atomicAdd(&bar[XB_TMO], 1u); break; } }
    }
    nloc = mine > 0u ? mine : 1u; nx = cnt > 0u ? cnt : 1u;
}

__device__ __forceinline__ void xcd_barrier(const XcdBarrier& b) {
    asm volatile("s_waitcnt vmcnt(0)" ::: "memory");
    __syncthreads();
    if (xb_thread0(b.wv)) {
        unsigned* bar = b.bar;
        __builtin_amdgcn_s_waitcnt(0);
        unsigned nloc = b.st[0], nx = b.st[1];
        if (nloc == 0u) { xcd_barrier_complete(bar, b.x, nloc, nx); b.st[0] = nloc; b.st[1] = nx; }
        const unsigned old = xb_add(&bar[XB_XSUB(b.x)], 1u);
        const unsigned gen = old / nloc;
        if (old + 1u == (gen + 1u) * nloc) {
            __builtin_amdgcn_fence(__ATOMIC_RELEASE, "agent");
            asm volatile("s_waitcnt vmcnt(0)" ::: "memory");
            const unsigned og = xb_add(&bar[XB_TOP], 1u);
            const unsigned tg = og / nx;
            if (og + 1u == (tg + 1u) * nx) xb_add(&bar[XB_TOPGEN], 1u);
            else XB_SPIN(xb_ld(&bar[XB_TOPGEN]) == tg, bar);
            __builtin_amdgcn_fence(__ATOMIC_ACQUIRE, "agent");
            xb_add(&bar[XB_XGEN(b.x)], 1u);
            asm volatile("s_waitcnt vmcnt(0)" ::: "memory");
        } else {
            XB_SPIN(xb_ld(&bar[XB_XGEN(b.x)]) == gen, bar);
            __builtin_amdgcn_fence(__ATOMIC_ACQUIRE, "agent");
            asm volatile("s_waitcnt vmcnt(0)" ::: "memory");
        }
    }
    __syncthreads();
}

struct Args { const float* in[33]; float* out; unsigned char* ws; int gp_lo, gp_hi, use_bar, pad; };
enum { I_X = 0, I_C, I_CTX, I_CCTX, I_ADAW, I_ADAB, I_N1G, I_N2G, I_WIN, I_RPB, I_QG, I_KG, I_MURKV, I_MUW, I_MUA, I_MUG, I_W0, I_W2, I_A0, I_A2, I_G2,
       I_KK, I_KA, I_RK, I_LNXG, I_LNXB, I_GRPG, I_WOUT, I_FUP, I_CONVW, I_CONVB, I_FDN, I_FING };
struct Frame {
    LAS unsigned char* lds;
    int tid, lane, wave, vcu, G;
    GAS unsigned char* ws;
};
#define WSP(T, off) ((T*)(GAS T*)(f.ws + (off)))
__device__ __forceinline__ const float* karg_in(int idx) {
    const GAS float* p; const void* ka = (const void*)__builtin_amdgcn_kernarg_segment_ptr();
    asm volatile("s_load_dwordx2 %0, %1, %2\n\ts_waitcnt lgkmcnt(0)" : "=s"(p) : "s"(ka), "i"(idx * 8) : "memory");
    return (const float*)p;
}
__device__ __forceinline__ void launder_ws(Frame& f) {
    GAS unsigned char* w = f.ws; int wv = f.wave, v = f.vcu, g = f.G, ln;
    asm volatile("" : "+s"(w), "+s"(wv), "+s"(v), "+s"(g));
    asm volatile("v_mbcnt_lo_u32_b32 %0, -1, 0\n\tv_mbcnt_hi_u32_b32 %0, -1, %0" : "=v"(ln));
    f.ws = w; f.wave = wv; f.lane = ln; f.tid = wv * 64 + ln; f.vcu = v; f.G = g;
}

struct RowInfo { int t, T, b, isctx; };
__device__ __forceinline__ RowInfo row_info(int m) {
    RowInfo r;
    if (m < MLAT) { r.b = m >> 13; r.t = m & (SEQ - 1); r.T = SEQ; r.isctx = 0; }
    else { const int mm = m - MLAT; r.b = mm >> 8; r.t = mm & (CTXL - 1); r.T = CTXL; r.isctx = 1; }
    return r;
}

__device__ __forceinline__ void transpose_item(const float* W, int K, int N, bf16* WT, LAS float* scr, int item, int lane) {
    const int nblk = N / 32, kb = item / nblk, nb = item % nblk, k0 = 64 * kb, n0 = 32 * nb;
    float tv[32];
#pragma unroll
    for (int i = 0; i < 32; ++i) { const int kk = 2 * i + (lane >> 5); tv[i] = W[(size_t)(k0 + kk) * N + n0 + (lane & 31)]; }
#pragma unroll
    for (int i = 0; i < 32; ++i) { const int kk = 2 * i + (lane >> 5); scr[kk * 33 + (lane & 31)] = tv[i]; }
    LDS_WAIT(); asm volatile("" ::: "memory");
    const int c = lane & 7;
#pragma unroll
    for (int j = 0; j < 4; ++j) { const int n = (lane >> 3) + 8 * j; const LAS float* s = scr + (8 * c) * 33 + n;
        v4u o; o.x = pk2(s[0 * 33], s[1 * 33]); o.y = pk2(s[2 * 33], s[3 * 33]); o.z = pk2(s[4 * 33], s[5 * 33]); o.w = pk2(s[6 * 33], s[7 * 33]);
        *(v4u*)(WT + (size_t)(n0 + n) * K + k0 + 8 * c) = o; }
    LDS_WAIT(); asm volatile("" ::: "memory");
}
__device__ __forceinline__ void ph_convert(Frame& f) { const float* in_I_ADAW = karg_in(I_ADAW); const float* in_I_C = karg_in(I_C); const float* in_I_CCTX = karg_in(I_CCTX); const float* in_I_CTX = karg_in(I_CTX); const float* in_I_FDN = karg_in(I_FDN); const float* in_I_FUP = karg_in(I_FUP); const float* in_I_WIN = karg_in(I_WIN); const float* in_I_WOUT = karg_in(I_WOUT); const float* in_I_X = karg_in(I_X); launder_ws(f);
    LAS float* scr = (LAS float*)(f.lds + f.wave * 16384);
    const int gw = f.vcu * NWAVES + f.wave, NGW = f.G * NWAVES;
    constexpr int I_IN = (DM / 64) * (INC / 32), I_OUT = (DM / 64) * (DM / 32), I_UP = (DM / 64) * (UPN / 32), I_DN = (DFF / 64) * (DM / 32), I_L = I_IN + I_OUT + I_UP + I_DN;
    for (int it = gw; it < DEPTH * I_L; it += NGW) {
        const int l = it / I_L; int r = it % I_L;
        if (r < I_IN) { transpose_item(in_I_WIN + (size_t)l * DM * INC, DM, INC, WSP(bf16, WS_WIN) + (size_t)l * INP * DM, scr, r, f.lane); continue; } r -= I_IN;
        if (r < I_OUT) { transpose_item(in_I_WOUT + (size_t)l * DM * DM, DM, DM, WSP(bf16, WS_WOUT) + (size_t)l * DM * DM, scr, r, f.lane); continue; } r -= I_OUT;
        if (r < I_UP) {
            const int nb = r % (UPN / 32), n0 = 32 * nb, ch = n0 >= DFF ? n0 - DFF : n0, drow = (ch >> 7) * 256 + (n0 >= DFF ? 128 : 0) + (ch & 127);
            transpose_item(in_I_FUP + (size_t)l * DM * UPN, DM, UPN, WSP(bf16, WS_WUP) + (size_t)l * UPN * DM + (size_t)(drow - n0) * DM, scr, r, f.lane); continue; } r -= I_UP;
        transpose_item(in_I_FDN + (size_t)l * DFF * DM, DFF, DM, WSP(bf16, WS_WDN) + (size_t)l * DM * DFF, scr, r, f.lane);
    }
    for (int it = gw; it < DEPTH * (INP - INC); it += NGW) {
        const int l = it / (INP - INC), r = INC + it % (INP - INC);
        v4u* p = (v4u*)(WSP(bf16, WS_WIN) + ((size_t)l * INP + r) * DM) + f.lane;
#pragma unroll
        for (int j = 0; j < 4; ++j) p[64 * j] = (v4u){0u, 0u, 0u, 0u};
    }
    for (int it = gw; it < DEPTH * 48 * 16; it += NGW) {
        const int l = it / 768, rem = it % 768, cg = rem / 16, ks = rem % 16;
#pragma unroll
        for (int q = 0; q < 2; ++q) { const int kk = f.lane + 64 * q, k = ks * 128 + kk;
            const float c0 = in_I_C[k], c1 = in_I_C[DM + k], c2 = in_I_CCTX[k];
            scr[kk] = c0 * sigmoidf_(c0); scr[128 + kk] = c1 * sigmoidf_(c1); scr[256 + kk] = c2 * sigmoidf_(c2); }
        LDS_WAIT(); asm volatile("" ::: "memory");
        const f32x4* Wp = (const f32x4*)(in_I_ADAW + ((size_t)l * DM + ks * 128) * MODW + cg * 256) + f.lane;
        f32x4 a0 = {0.f, 0.f, 0.f, 0.f}, a1 = a0, a2 = a0;
#pragma unroll 8
        for (int kk = 0; kk < 128; ++kk) { const f32x4 w = Wp[(size_t)kk * (MODW / 4)]; a0 += w * scr[kk]; a1 += w * scr[128 + kk]; a2 += w * scr[256 + kk]; }
        float* o = WSP(float, WS_MODP) + ((size_t)(ks * DEPTH + l) * 3) * MODW + cg * 256 + f.lane * 4;
        *(f32x4*)(o) = a0; *(f32x4*)(o + MODW) = a1; *(f32x4*)(o + 2 * MODW) = a2;
        LDS_WAIT(); asm volatile("" ::: "memory");
    }
}
__device__ __forceinline__ void ph_modsum(Frame& f) { const float* in_I_ADAB = karg_in(I_ADAB); launder_ws(f);
    const int gt = f.vcu * 512 + f.tid, GT = f.G * 512;
    for (int i = gt; i < DEPTH * 3 * MODW; i += GT) {
        const int l = i / (3 * MODW), j = i % MODW;
        float s = in_I_ADAB[l * MODW + j];
#pragma unroll
        for (int ks = 0; ks < 16; ++ks) s += WSP(float, WS_MODP)[(size_t)ks * DEPTH * 3 * MODW + i];
        WSP(float, WS_MOD)[i] = s;
    }
}

__device__ __forceinline__ void ph_norm(Frame& f, int l, int which, int mrows) { const float* in_I_N1G = karg_in(I_N1G); const float* in_I_N2G = karg_in(I_N2G); launder_ws(f);
    const int gw = f.vcu * NWAVES + f.wave, NGW = f.G * NWAVES;
    const float* g = (which == 0 ? in_I_N1G : in_I_N2G) + l * DM;
    const int offsh = which == 0 ? 0 : 3 * DM, offsc = offsh + DM;
    for (int m = gw; m < mrows; m += NGW) {
        const int s = m < SEQ ? 0 : (m < MLAT ? 1 : 2);
        const float* mod = WSP(float, WS_MOD) + (size_t)(l * 3 + s) * MODW;
        const f32x4* xr = (const f32x4*)(WSP(float, WS_H) + (size_t)m * DM) + f.lane;
        f32x4 v[8]; float ss = 0.f;
#pragma unroll
        for (int j = 0; j < 8; ++j) { v[j] = xr[64 * j]; ss += (v[j].x * v[j].x + v[j].y * v[j].y) + (v[j].z * v[j].z + v[j].w * v[j].w); }
        const float rs = 1.0f / sqrtf(wave_sum(ss) * (1.f / DM) + 1e-6f);
        v2u* o = (v2u*)(WSP(bf16, WS_XN) + (size_t)m * DM) + f.lane;
#pragma unroll
        for (int j = 0; j < 8; ++j) { const int col = f.lane * 4 + 256 * j;
            const f32x4 g4 = *(const f32x4*)(g + col), sc = *(const f32x4*)(mod + offsc + col), sh = *(const f32x4*)(mod + offsh + col);
            const f32x4 r = (v[j] * rs) * g4 * (sc + 1.0f) + sh;
            v2u w; w.x = pk2(r.x, r.y); w.y = pk2(r.z, r.w); o[64 * j] = w; }
    }
}

__device__ __forceinline__ void ph_prep(Frame& f, int l) { const float* in_I_KG = karg_in(I_KG); const float* in_I_QG = karg_in(I_QG); launder_ws(f);
    const int gw = f.vcu * NWAVES + f.wave, NGW = f.G * NWAVES, lane = f.lane;
    const float qg = in_I_QG[l * HD + lane], kg = in_I_KG[l * HD + lane];
    const int ri = lane & 15, ra = lane >> 5, rp = (lane >> 4) & 1;
    const float inv_freq = powf(10000.0f, -(float)ri / 16.0f);
    for (int m = gw; m < MALL; m += NGW) {
        const RowInfo R = row_info(m);
        const bf16* y = WSP(bf16, WS_Y1) + (size_t)m * INP;
        float sn = 0.f, cs = 1.f;
        if (!R.isctx) { const int pos = ra == 0 ? (R.t / GRIDW) : (R.t % GRIDW); const float ang = (float)pos * inv_freq; sincosf(ang, &sn, &cs); }
        const int kvpos = R.isctx ? R.t : CTXL + R.t;
        const size_t kvrow = ((size_t)R.b * SKV + kvpos) * 128;
#pragma unroll
        for (int hh = 0; hh < 10; ++hh) {
            const int col = hh < 8 ? C_QB + hh * 64 + lane : C_KB + (hh - 8) * 64 + lane;
            const float x = bf2f(y[col]);
            const float ss = wave_sum(x * x);
            float xn = x * (1.0f / sqrtf(ss * (1.f / HD) + 1e-6f)) * (hh < 8 ? qg : kg);
            const float xp = __shfl_xor(xn, 16);
            if (!R.isctx) xn = rp == 0 ? (xn * cs - xp * sn) : (xp * sn + xn * cs);
            if (hh < 8) WSP(bf16, WS_QBP)[(size_t)m * 512 + hh * 64 + lane] = (bf16)f2bf(xn * QSCALE);
            else WSP(bf16, WS_KBP)[kvrow + (hh - 8) * 64 + lane] = (bf16)f2bf(xn);
        }
#pragma unroll
        for (int hv = 0; hv < 2; ++hv) WSP(bf16, WS_VBP)[kvrow + hv * 64 + lane] = y[C_VB + hv * 64 + lane];
    }
}

template <int KR> __device__ __forceinline__ void lora_mm(const LAS float* X, const float* W, int c0, float (&acc)[32][2]) {
#pragma unroll
    for (int t = 0; t < 32; ++t) { acc[t][0] = 0.f; acc[t][1] = 0.f; }
    for (int r4 = 0; r4 < KR / 4; ++r4) {
        float wa[4], wb[4];
#pragma unroll
        for (int i = 0; i < 4; ++i) { wa[i] = W[(size_t)(4 * r4 + i) * CW + c0]; wb[i] = W[(size_t)(4 * r4 + i) * CW + c0 + 512]; }
#pragma unroll
        for (int t = 0; t < 32; ++t) { const f32x4 x = *(const LAS f32x4*)(X + t * KR + 4 * r4);
            acc[t][0] += x.x * wa[0] + x.y * wa[1] + x.z * wa[2] + x.w * wa[3];
            acc[t][1] += x.x * wb[0] + x.y * wb[1] + x.z * wb[2] + x.w * wb[3]; }
    }
}
__device__ __forceinline__ void ph_lora(Frame& f, int l) { const float* in_I_A0 = karg_in(I_A0); const float* in_I_A2 = karg_in(I_A2); const float* in_I_G2 = karg_in(I_G2); const float* in_I_MUA = karg_in(I_MUA); const float* in_I_MUG = karg_in(I_MUG); const float* in_I_MUW = karg_in(I_MUW); const float* in_I_W0 = karg_in(I_W0); const float* in_I_W2 = karg_in(I_W2); launder_ws(f);
    LAS float* tw = (LAS float*)f.lds;
    LAS float* ta = tw + 4096;
    LAS float* sg = ta + 4096;
    const bf16* Y1 = WSP(bf16, WS_Y1);
    const int c0 = f.tid;
    __syncthreads();
    for (int tile = f.vcu; tile < MALL / 32; tile += f.G) {
        const int m0 = tile * 32;
        for (int idx = f.tid; idx < 32 * 416; idx += 512) {
            const int tok = idx / 416, col = idx % 416, m = m0 + tok;
            const RowInfo R = row_info(m);
            const float cur = bf2f(Y1[(size_t)m * INP + C_WD + col]);
            const float prev = R.t > 0 ? bf2f(Y1[(size_t)(m - 1) * INP + C_WD + col]) : 0.f;
            const float next = R.t < R.T - 1 ? bf2f(Y1[(size_t)(m + 1) * INP + C_WD + col]) : 0.f;
            if (col < 128) { const int d = col >> 6, r = col & 63; const float nb = d ? next : prev;
                tw[(d * 32 + tok) * 64 + r] = tanhf(cur + in_I_MUW[l * 128 + col] * (nb - cur)); }
            else if (col < 256) { const int c2 = col - 128, d = c2 >> 6, r = c2 & 63; const float nb = d ? next : prev;
                ta[(d * 32 + tok) * 64 + r] = cur + in_I_MUA[l * 128 + c2] * (nb - cur); }
            else { const int r = col - 256;
                sg[tok * 160 + r] = sigmoidf_(cur + in_I_MUG[l * 320 + r] * (prev - cur) + in_I_MUG[l * 320 + 160 + r] * (next - cur)); }
        }
        __syncthreads();
        float acc[32][2];
#pragma unroll 1
        for (int d = 0; d < 2; ++d) {
            lora_mm<64>(tw + d * 2048, in_I_W2 + ((size_t)(l * 2 + d) * 64) * CW, c0, acc);
            { float* o = WSP(float, WS_WDEC) + ((size_t)d * MALL + m0) * CW + c0;
              const float b0 = in_I_W0[(l * 2 + d) * CW + c0], b1 = in_I_W0[(l * 2 + d) * CW + c0 + 512];
#pragma unroll
              for (int t = 0; t < 32; ++t) {
#pragma unroll
                  for (int q = 0; q < 2; ++q) { const float z = (q ? b1 : b0) + acc[t][q];
                      const float nz = -z, sp = fmaxf(nz, 0.f) + log1pf(expf(-fabsf(nz)));
                      const float wlog = -sp - 0.5f;
                      o[(size_t)t * CW + 512 * q] = expf(-expf(wlog)); } } }
            lora_mm<64>(ta + d * 2048, in_I_A2 + ((size_t)(l * 2 + d) * 64) * CW, c0, acc);
            { float* o = WSP(float, WS_AIC) + ((size_t)d * MALL + m0) * CW + c0;
              const float b0 = in_I_A0[(l * 2 + d) * CW + c0], b1 = in_I_A0[(l * 2 + d) * CW + c0 + 512];
#pragma unroll
              for (int t = 0; t < 32; ++t) { o[(size_t)t * CW] = sigmoidf_(b0 + acc[t][0]); o[(size_t)t * CW + 512] = sigmoidf_(b1 + acc[t][1]); } }
        }
        lora_mm<160>(sg, in_I_G2 + (size_t)l * 160 * CW, c0, acc);
        { float* o = WSP(float, WS_G) + (size_t)m0 * CW + c0;
#pragma unroll
          for (int t = 0; t < 32; ++t) { o[(size_t)t * CW] = acc[t][0]; o[(size_t)t * CW + 512] = acc[t][1]; } }
        __syncthreads();
    }
}
struct AttState { float mx, ls; float o[64]; };
__device__ __forceinline__ void att_init(AttState& S) { S.mx = -1e30f; S.ls = 0.f;
#pragma unroll
    for (int d = 0; d < 64; ++d) S.o[d] = 0.f; }
__device__ __forceinline__ void load_row64(float (&q)[64], const bf16* p, float scale) {
#pragma unroll
    for (int c = 0; c < 8; ++c) { const v4u w = ((const v4u*)p)[c];
        q[8 * c + 0] = bflo(w.x) * scale; q[8 * c + 1] = bfhi(w.x) * scale; q[8 * c + 2] = bflo(w.y) * scale; q[8 * c + 3] = bfhi(w.y) * scale;
        q[8 * c + 4] = bflo(w.z) * scale; q[8 * c + 5] = bfhi(w.z) * scale; q[8 * c + 6] = bflo(w.w) * scale; q[8 * c + 7] = bfhi(w.w) * scale; }
}
__device__ __forceinline__ void att_key(AttState& S, const float (&q)[64], const bf16* kp, const bf16* vp, float bias) {
    float s0 = 0.f, s1 = 0.f, s2 = 0.f, s3 = 0.f;
#pragma unroll
    for (int c = 0; c < 8; ++c) { const v4u w = ((const v4u*)kp)[c];
        s0 += q[8 * c + 0] * bflo(w.x) + q[8 * c + 1] * bfhi(w.x); s1 += q[8 * c + 2] * bflo(w.y) + q[8 * c + 3] * bfhi(w.y);
        s2 += q[8 * c + 4] * bflo(w.z) + q[8 * c + 5] * bfhi(w.z); s3 += q[8 * c + 6] * bflo(w.w) + q[8 * c + 7] * bfhi(w.w); }
    const float s = (s0 + s1) + (s2 + s3) + bias;
    const float mn = fmaxf(S.mx, s), fo = exp2f(S.mx - mn), p = exp2f(s - mn);
    S.mx = mn; S.ls = S.ls * fo + p;
#pragma unroll
    for (int c = 0; c < 8; ++c) { const v4u w = ((const v4u*)vp)[c];
        S.o[8 * c + 0] = S.o[8 * c + 0] * fo + p * bflo(w.x); S.o[8 * c + 1] = S.o[8 * c + 1] * fo + p * bfhi(w.x);
        S.o[8 * c + 2] = S.o[8 * c + 2] * fo + p * bflo(w.y); S.o[8 * c + 3] = S.o[8 * c + 3] * fo + p * bfhi(w.y);
        S.o[8 * c + 4] = S.o[8 * c + 4] * fo + p * bflo(w.z); S.o[8 * c + 5] = S.o[8 * c + 5] * fo + p * bfhi(w.z);
        S.o[8 * c + 6] = S.o[8 * c + 6] * fo + p * bflo(w.w); S.o[8 * c + 7] = S.o[8 * c + 7] * fo + p * bfhi(w.w); }
}
__device__ __forceinline__ void att_finish(AttState& S, bf16* op, int sub) {
    float M = S.mx;
    M = fmaxf(M, __shfl_xor(M, 1)); M = fmaxf(M, __shfl_xor(M, 2)); M = fmaxf(M, __shfl_xor(M, 4));
    const float fo = exp2f(S.mx - M);
    float L = S.ls * fo; L += __shfl_xor(L, 1); L += __shfl_xor(L, 2); L += __shfl_xor(L, 4);
    const float inv = 1.0f / L;
    float r[8];
#pragma unroll
    for (int i = 0; i < 8; ++i) r[i] = 0.f;
#pragma unroll
    for (int d = 0; d < 64; ++d) { float v = S.o[d] * fo; v += __shfl_xor(v, 1); v += __shfl_xor(v, 2); v += __shfl_xor(v, 4);
        if ((d >> 3) == sub) r[d & 7] = v * inv; }
    v4u w; w.x = pk2(r[0], r[1]); w.y = pk2(r[2], r[3]); w.z = pk2(r[4], r[5]); w.w = pk2(r[6], r[7]);
    *(v4u*)(op + 8 * sub) = w;
}
__device__ __forceinline__ void ph_attn_naive(Frame& f, int l, int item_lo, int item_hi, bool do_ctx) { const float* in_I_RPB = karg_in(I_RPB); launder_ws(f);
    const bf16* Y1 = WSP(bf16, WS_Y1);
    const int qx = f.tid >> 3, sub = f.tid & 7;
    for (int it = item_lo + f.vcu; it < item_hi; it += f.G) {
        float q[64]; AttState S; att_init(S);
        if (it < 2048) {
            const int b = it >> 10, h = (it >> 7) & 7, i = it & 127;
            const int m = b * SEQ + i * GRIDW + qx;
            load_row64(q, Y1 + (size_t)m * INP + C_QA + h * 64, QSCALE);
            int rs = i - 4; rs = rs < 0 ? 0 : (rs > 120 ? 120 : rs);
            int cst = qx - 8; cst = cst < 0 ? 0 : (cst > 48 ? 48 : cst);
            const int jr = rs + sub;
            const float* rpb = in_I_RPB + ((size_t)(l * 8 + h) * 15 + (jr - i + 7)) * 31;
            for (int yy = 0; yy < 16; ++yy) { const int y = cst + yy, mk = b * SEQ + jr * GRIDW + y;
                int co = y - qx; co = co < -15 ? -15 : (co > 15 ? 15 : co);
                att_key(S, q, Y1 + (size_t)mk * INP + C_KA + h * 64, Y1 + (size_t)mk * INP + C_VA + h * 64, rpb[co + 15] * LOG2E); }
            for (int n = 0; n < 32; ++n) { const int mk = MLAT + b * CTXL + sub + 8 * n;
                att_key(S, q, Y1 + (size_t)mk * INP + C_KA + h * 64, Y1 + (size_t)mk * INP + C_VA + h * 64, 0.f); }
            att_finish(S, WSP(bf16, WS_OA) + (size_t)m * 512 + h * 64, sub);
        } else if (it < 2112) {
            if (!do_ctx) continue;
            const int r = it - 2048, b = r >> 5, h = (r >> 2) & 7, qt = r & 3;
            const int m = MLAT + b * CTXL + qt * 64 + qx;
            load_row64(q, Y1 + (size_t)m * INP + C_QA + h * 64, QSCALE);
            for (int n = 0; n < 32; ++n) { const int mk = MLAT + b * CTXL + sub + 8 * n;
                att_key(S, q, Y1 + (size_t)mk * INP + C_KA + h * 64, Y1 + (size_t)mk * INP + C_VA + h * 64, 0.f); }
            att_finish(S, WSP(bf16, WS_OA) + (size_t)m * 512 + h * 64, sub);
        } else if (it < 2176) {
            if (!do_ctx) continue;
            const int r = it - 2112, b = r >> 5, h = (r >> 2) & 7, qt = r & 3;
            const int m = MLAT + b * CTXL + qt * 64 + qx;
            load_row64(q, WSP(bf16, WS_QBP) + (size_t)m * 512 + h * 64, 1.0f);
            const bf16* kb = WSP(bf16, WS_KBP) + (size_t)b * SKV * 128 + (h >> 2) * 64; const bf16* vb = WSP(bf16, WS_VBP) + (size_t)b * SKV * 128 + (h >> 2) * 64;
            for (int n = 0; n < 32; ++n) { const int kp = sub + 8 * n; att_key(S, q, kb + (size_t)kp * 128, vb + (size_t)kp * 128, 0.f); }
            att_finish(S, WSP(bf16, WS_OB) + (size_t)m * 512 + h * 64, sub);
        } else {
            const int r = it - 2176, b = r >> 10, h = (r >> 7) & 7, qt = r & 127;
            const int m = b * SEQ + qt * 64 + qx;
            load_row64(q, WSP(bf16, WS_QBP) + (size_t)m * 512 + h * 64, 1.0f);
            const bf16* kb = WSP(bf16, WS_KBP) + (size_t)b * SKV * 128 + (h >> 2) * 64; const bf16* vb = WSP(bf16, WS_VBP) + (size_t)b * SKV * 128 + (h >> 2) * 64;
            for (int n = 0; n < SKV / 8; ++n) { const int kp = sub + 8 * n; att_key(S, q, kb + (size_t)kp * 128, vb + (size_t)kp * 128, 0.f); }
            att_finish(S, WSP(bf16, WS_OB) + (size_t)m * 512 + h * 64, sub);
        }
    }
}

__device__ __forceinline__ void ph_scan(Frame& f, int l) { const float* in_I_KA = karg_in(I_KA); const float* in_I_KK = karg_in(I_KK); const float* in_I_MURKV = karg_in(I_MURKV); launder_ws(f);
    LAS float* F = (LAS float*)f.lds;
    LAS float* YT = F + 32 * 6 * 64;
    const bf16* Y1 = WSP(bf16, WS_Y1);
    const int lane = f.lane, rg = lane >> 4, j = lane & 15;
    for (int it = f.vcu; it < 128; it += f.G) {
        const int half = it & 1, chain = it >> 1, b = chain >> 5, d = (chain >> 4) & 1, h = chain & 15;
        const int col = h * 64 + lane;
        const float mur = in_I_MURKV[(l * 2 + d) * 3072 + col], muk = in_I_MURKV[(l * 2 + d) * 3072 + 1024 + col], muv = in_I_MURKV[(l * 2 + d) * 3072 + 2048 + col];
        const float k_k = in_I_KK[l * CW + col], k_a = in_I_KA[l * CW + col];
        float s0 = 0.f, s1 = 0.f, s2 = 0.f, s3 = 0.f;
        const int myrow = half * 32 + f.wave * 4 + rg;
        for (int ch = 0; ch < SKV / 32; ++ch) {
#pragma unroll
            for (int q = 0; q < 4; ++q) {
                const int sl = f.wave * 4 + q, st = ch * 32 + sl;
                int m, t, T;
                if (st < CTXL) { t = d ? (CTXL - 1 - st) : st; T = CTXL; m = MLAT + b * CTXL + t; }
                else { const int u = st - CTXL; t = d ? (SEQ - 1 - u) : u; T = SEQ; m = b * SEQ + t; }
                const bool hasn = d ? (t < T - 1) : (t > 0); const int mn = d ? m + 1 : m - 1;
                const bf16* y = Y1 + (size_t)m * INP; const bf16* yn = Y1 + (size_t)mn * INP;
                const float r0 = bf2f(y[C_R + col]), k0 = bf2f(y[C_K + col]), v0 = bf2f(y[C_V + col]);
                const float rn = hasn ? bf2f(yn[C_R + col]) : 0.f, kn = hasn ? bf2f(yn[C_K + col]) : 0.f, vn = hasn ? bf2f(yn[C_V + col]) : 0.f;
                const float r = r0 + mur * (rn - r0), k = k0 + muk * (kn - k0), v = v0 + muv * (vn - v0);
                const float a = WSP(float, WS_AIC)[((size_t)d * MALL + m) * CW + col], w = WSP(float, WS_WDEC)[((size_t)d * MALL + m) * CW + col];
                float kk = k * k_k; const float nrm = sqrtf(wave_sum(kk * kk)); kk = kk / fmaxf(nrm, 1e-12f);
                const float km = k * (1.0f + (a - 1.0f) * k_a);
                LAS float* Fs = F + sl * 384;
                Fs[lane] = r; Fs[64 + lane] = w; Fs[128 + lane] = km; Fs[192 + lane] = -kk; Fs[256 + lane] = kk * a; Fs[320 + lane] = v;
            }
            __syncthreads();
#pragma unroll 4
            for (int sl = 0; sl < 32; ++sl) {
                const LAS float* Fs = F + sl * 384;
                const f32x4 r4 = *(const LAS f32x4*)(Fs + 4 * j), w4 = *(const LAS f32x4*)(Fs + 64 + 4 * j), k4 = *(const LAS f32x4*)(Fs + 128 + 4 * j);
                const f32x4 a4 = *(const LAS f32x4*)(Fs + 192 + 4 * j), b4 = *(const LAS f32x4*)(Fs + 256 + 4 * j);
                const float vv = Fs[320 + myrow];
                float sa = (s0 * a4.x + s1 * a4.y) + (s2 * a4.z + s3 * a4.w);
                sa += __shfl_xor(sa, 1); sa += __shfl_xor(sa, 2); sa += __shfl_xor(sa, 4); sa += __shfl_xor(sa, 8);
                s0 = s0 * w4.x + sa * b4.x + vv * k4.x; s1 = s1 * w4.y + sa * b4.y + vv * k4.y;
                s2 = s2 * w4.z + sa * b4.z + vv * k4.z; s3 = s3 * w4.w + sa * b4.w + vv * k4.w;
                float yv = (s0 * r4.x + s1 * r4.y) + (s2 * r4.z + s3 * r4.w);
                yv += __shfl_xor(yv, 1); yv += __shfl_xor(yv, 2); yv += __shfl_xor(yv, 4); yv += __shfl_xor(yv, 8);
                if (j == 0) YT[sl * 32 + f.wave * 4 + rg] = yv;
            }
            __syncthreads();
#pragma unroll
            for (int q = 0; q < 2; ++q) { const int idx = f.tid + 512 * q, sl = idx >> 5, rr = idx & 31, st = ch * 32 + sl;
                int m; if (st < CTXL) m = MLAT + b * CTXL + (d ? (CTXL - 1 - st) : st); else { const int u = st - CTXL; m = b * SEQ + (d ? (SEQ - 1 - u) : u); }
                WSP(float, WS_YS)[((size_t)d * MALL + m) * CW + h * 64 + half * 32 + rr] = YT[idx]; }
        }
        __syncthreads();
    }
}

__device__ __forceinline__ f32x4 bf4(v2u w) { return (f32x4){bflo(w.x), bfhi(w.x), bflo(w.y), bfhi(w.y)}; }
__device__ __forceinline__ float hsum4(f32x4 v) { return (v.x + v.y) + (v.z + v.w); }
__device__ __forceinline__ void ph_mix(Frame& f, int l, int mrows) { const float* in_I_GRPG = karg_in(I_GRPG); const float* in_I_KA = karg_in(I_KA); const float* in_I_LNXB = karg_in(I_LNXB); const float* in_I_LNXG = karg_in(I_LNXG); const float* in_I_MURKV = karg_in(I_MURKV); const float* in_I_RK = karg_in(I_RK); launder_ws(f);
    const int gw = f.vcu * NWAVES + f.wave, NGW = f.G * NWAVES, lane = f.lane, hq = lane >> 4, j = lane & 15;
    const bf16* Y1 = WSP(bf16, WS_Y1);
    LAS float* T_LG = (LAS float*)f.lds; LAS float* T_LB = T_LG + 1024; LAS float* T_RK = T_LG + 2048; LAS float* T_KA = T_LG + 3072; LAS float* T_MU = T_LG + 4096; LAS float* gg = T_LG + 10240;
    __syncthreads();
    for (int i = f.tid; i < 256; i += NWAVES * 64) { ((LAS f32x4*)T_LG)[i] = ((const f32x4*)(in_I_LNXG + l * CW))[i]; ((LAS f32x4*)T_LB)[i] = ((const f32x4*)(in_I_LNXB + l * CW))[i];
        ((LAS f32x4*)T_RK)[i] = ((const f32x4*)(in_I_RK + l * CW))[i]; ((LAS f32x4*)T_KA)[i] = ((const f32x4*)(in_I_KA + l * CW))[i]; }
    for (int i = f.tid; i < 1536; i += NWAVES * 64) ((LAS f32x4*)T_MU)[i] = ((const f32x4*)(in_I_MURKV + (size_t)l * 6144))[i];
    for (int i = f.tid; i < 512; i += NWAVES * 64) ((LAS f32x4*)gg)[i] = ((const f32x4*)(in_I_GRPG + l * DM))[i];
    __syncthreads();
    const float* YS0 = WSP(float, WS_YS); const float* YS1 = YS0 + (size_t)MALL * CW;
    const bf16* AIC0 = WSP(bf16, WS_AIC); const bf16* AIC1 = AIC0 + (size_t)MALL * CW;
    for (int m = gw; m < mrows; m += NGW) {
        const RowInfo R = row_info(m);
        const bool hasp = R.t > 0, hasn = R.t < R.T - 1;
        const bf16* y = Y1 + (size_t)m * INP; const bf16* yp = hasp ? y - INP : y; const bf16* yn = hasn ? y + INP : y;
        const bf16* gbuf = WSP(bf16, WS_G) + (size_t)m * CW; LAS float* obuf = (LAS float*)(f.lds + 65536 + f.wave * 4096);
        float ssc = 0.f;
#pragma unroll
        for (int it4 = 0; it4 < 4; ++it4) {
            const int c = (it4 * 4 + hq) * 64 + 4 * j;
            const f32x4 yv = *(const f32x4*)(YS0 + (size_t)m * CW + c) + *(const f32x4*)(YS1 + (size_t)m * CW + c);
            const float mean = sum16(hsum4(yv)) * (1.f / 64.f); const f32x4 dv = yv - mean; const float var = sum16(hsum4(dv * dv)) * (1.f / 64.f);
            f32x4 o = dv * __builtin_amdgcn_rsqf(var + 64e-5f) * *(const LAS f32x4*)(T_LG + c) + *(const LAS f32x4*)(T_LB + c);
            const f32x4 r0 = bf4(*(const v2u*)(y + C_R + c)), k0 = bf4(*(const v2u*)(y + C_K + c)), v0 = bf4(*(const v2u*)(y + C_V + c));
            const f32x4 rkw = *(const LAS f32x4*)(T_RK + c), k_a = *(const LAS f32x4*)(T_KA + c);
#pragma unroll
            for (int d = 0; d < 2; ++d) {
                const bf16* yb = d ? yn : yp; const bool has = d ? hasn : hasp;
                f32x4 rn = bf4(*(const v2u*)(yb + C_R + c)), kn = bf4(*(const v2u*)(yb + C_K + c)), vn = bf4(*(const v2u*)(yb + C_V + c));
                if (!has) { rn = (f32x4){0.f, 0.f, 0.f, 0.f}; kn = rn; vn = rn; }
                const LAS float* mu = T_MU + d * 3072 + c;
                const f32x4 r = r0 + *(const LAS f32x4*)(mu) * (rn - r0), k = k0 + *(const LAS f32x4*)(mu + 1024) * (kn - k0), v = v0 + *(const LAS f32x4*)(mu + 2048) * (vn - v0);
                const f32x4 a = bf4(*(const v2u*)((d ? AIC1 : AIC0) + (size_t)m * CW + c));
                const f32x4 km = k * ((a - 1.0f) * k_a + 1.0f);
                o += v * sum16(hsum4(r * km * rkw));
            }
            o *= bf4(*(const v2u*)(gbuf + c));
            *(LAS f32x4*)(obuf + c) = o; ssc += hsum4(o * o);
            if (it4 == 1) asm volatile("" ::: "memory");
        }
        const float rc = __builtin_amdgcn_rsqf(sum64(ssc) * (1.f / 1024.f) + 1e-6f);
        const v4u wa = *(const v4u*)(WSP(bf16, WS_OA) + (size_t)m * 512 + lane * 8), wb = *(const v4u*)(WSP(bf16, WS_OB) + (size_t)m * 512 + lane * 8);
        const f32x4 a0 = bf4((v2u){wa.x, wa.y}), a1 = bf4((v2u){wa.z, wa.w}), b0 = bf4((v2u){wb.x, wb.y}), b1 = bf4((v2u){wb.z, wb.w});
        const float ra = __builtin_amdgcn_rsqf(sum64(hsum4(a0 * a0) + hsum4(a1 * a1)) * (1.f / 512.f) + 1e-6f), rb = __builtin_amdgcn_rsqf(sum64(hsum4(b0 * b0) + hsum4(b1 * b1)) * (1.f / 512.f) + 1e-6f);
        bf16* o = WSP(bf16, WS_MIX) + (size_t)m * DM;
        { const LAS float* ga = gg + lane * 8; const f32x4 x0 = a0 * ra * *(const LAS f32x4*)(ga), x1 = a1 * ra * *(const LAS f32x4*)(ga + 4);
          *(v4u*)(o + lane * 8) = (v4u){pk2(x0.x, x0.y), pk2(x0.z, x0.w), pk2(x1.x, x1.y), pk2(x1.z, x1.w)}; }
        { const LAS float* gb = gg + 512 + lane * 8; const f32x4 x0 = b0 * rb * *(const LAS f32x4*)(gb), x1 = b1 * rb * *(const LAS f32x4*)(gb + 4);
          *(v4u*)(o + 512 + lane * 8) = (v4u){pk2(x0.x, x0.y), pk2(x0.z, x0.w), pk2(x1.x, x1.y), pk2(x1.z, x1.w)}; }
#pragma unroll
        for (int q = 0; q < 4; ++q) { const int c = q * 256 + lane * 4; const f32x4 x = *(const LAS f32x4*)(obuf + c) * rc * *(const LAS f32x4*)(gg + 1024 + c);
            *(v2u*)(o + 1024 + c) = (v2u){pk2(x.x, x.y), pk2(x.z, x.w)}; }
    }
}

__device__ __forceinline__ void ph_convglu(Frame& f, int l, int mrows) { const float* in_I_CONVB = karg_in(I_CONVB); const float* in_I_CONVW = karg_in(I_CONVW); launder_ws(f);
    const int gt = f.vcu * 512 + f.tid, GT = f.G * 512;
    const bf16* U = WSP(bf16, WS_U); bf16* HB = WSP(bf16, WS_HB);
    const float* cw = in_I_CONVW + (size_t)l * 3 * DFF; const float* cb = in_I_CONVB + (size_t)l * DFF;
    constexpr int C8 = DFF / 8;
    for (int idx = gt; idx < mrows * C8; idx += GT) {
        const int m = idx / C8, c = (idx % C8) * 8;
        const RowInfo R = row_info(m);
        const v4u z = {0u, 0u, 0u, 0u};
        const v4u uc = *(const v4u*)(U + (size_t)m * UPN + c), vl = *(const v4u*)(U + (size_t)m * UPN + DFF + c);
        const v4u up = R.t > 0 ? *(const v4u*)(U + (size_t)(m - 1) * UPN + c) : z, un = R.t < R.T - 1 ? *(const v4u*)(U + (size_t)(m + 1) * UPN + c) : z;
        float r[8], gv[8];
#pragma unroll
        for (int i = 0; i < 8; ++i) {
            const unsigned wc_ = i < 2 ? uc.x : i < 4 ? uc.y : i < 6 ? uc.z : uc.w, wp_ = i < 2 ? up.x : i < 4 ? up.y : i < 6 ? up.z : up.w;
            const unsigned wn_ = i < 2 ? un.x : i < 4 ? un.y : i < 6 ? un.z : un.w, wv_ = i < 2 ? vl.x : i < 4 ? vl.y : i < 6 ? vl.z : vl.w;
            const float fc = (i & 1) ? bfhi(wc_) : bflo(wc_), fp = (i & 1) ? bfhi(wp_) : bflo(wp_), fn = (i & 1) ? bfhi(wn_) : bflo(wn_), fv = (i & 1) ? bfhi(wv_) : bflo(wv_);
            const float u = fp * cw[c + i] + fc * cw[DFF + c + i] + fn * cw[2 * DFF + c + i] + cb[c + i];
            r[i] = u; gv[i] = fv;
        }
#pragma unroll
        for (int i = 0; i < 8; i += 2) { const f32x2 g2 = pg8::gelu_pk((f32x2){r[i], r[i + 1]}); r[i] = g2.x * gv[i]; r[i + 1] = g2.y * gv[i + 1]; }
        v4u w; w.x = pk2(r[0], r[1]); w.y = pk2(r[2], r[3]); w.z = pk2(r[4], r[5]); w.w = pk2(r[6], r[7]);
        *(v4u*)(HB + (size_t)m * DFF + c) = w;
    }
}

__device__ __forceinline__ void ph_final(Frame& f) { const float* in_I_FING = karg_in(I_FING); float* out_p = (float*)karg_in(33); launder_ws(f);
    const int gw = f.vcu * NWAVES + f.wave, NGW = f.G * NWAVES;
    const float* g = in_I_FING;
    for (int m = gw; m < MLAT; m += NGW) {
        const f32x4* xr = (const f32x4*)(WSP(float, WS_H) + (size_t)m * DM) + f.lane;
        f32x4 v[8]; float ss = 0.f;
#pragma unroll
        for (int j = 0; j < 8; ++j) { v[j] = xr[64 * j]; ss += (v[j].x * v[j].x + v[j].y * v[j].y) + (v[j].z * v[j].z + v[j].w * v[j].w); }
        const float rs = 1.0f / sqrtf(wave_sum(ss) * (1.f / DM) + 1e-6f);
        f32x4* o = (f32x4*)(out_p + (size_t)m * DM) + f.lane;
#pragma unroll
        for (int j = 0; j < 8; ++j) { const f32x4 g4 = *(const f32x4*)(g + f.lane * 4 + 256 * j); o[64 * j] = (v[j] * rs) * g4; }
    }
}

struct EpiResGate {
    static constexpr bool PERM = true, AFTER_DRAIN = false;
    float* H; const float* mod;
    __device__ __forceinline__ void operator()(const pg8::f32x4 (&acc)[2][2][4][2], const pg8::Unit& u, int wr, int wc, int fr, int fq) const {
        const int row0 = u.pm * 256 + wr * 64 + fr, col0 = u.pn * 256 + wc * 32 + 8 * fq;
        const int s = u.pm < 32 ? 0 : (u.pm < 64 ? 1 : 2);
        const float* gp = mod + (size_t)s * MODW + col0;
        pg8::f32x4 gv[2][2];
#pragma unroll
        for (int bj = 0; bj < 2; ++bj)
#pragma unroll
            for (int n = 0; n < 2; ++n) gv[bj][n] = *(const pg8::f32x4*)(gp + bj * 128 + 4 * n);
#pragma unroll
        for (int ai = 0; ai < 2; ++ai)
#pragma unroll
            for (int m = 0; m < 4; ++m) { float* rowp = H + (size_t)(row0 + ai * 128 + m * 16) * DM + col0;
#pragma unroll
                for (int bj = 0; bj < 2; ++bj)
#pragma unroll
                    for (int n = 0; n < 2; ++n) { pg8::f32x4* p = (pg8::f32x4*)(rowp + bj * 128 + 4 * n); *p = *p + gv[bj][n] * acc[ai][bj][m][n]; } }
    }
};
struct ScanRaw { float r0, k0, v0, rn, kn, vn, a, w; };
struct ScanFeat { f32x4 r, w, k, a, b; float v; };
constexpr int SC_T = 16, SC_NCH = SKV / SC_T;
__device__ __forceinline__ int scan_row_of_step(int st, int b, int d) {
    if (st < CTXL) return MLAT + b * CTXL + (d ? (CTXL - 1 - st) : st);
    const int u = st - CTXL; return b * SEQ + (d ? (SEQ - 1 - u) : u);
}
__device__ __forceinline__ void scan_load_raw(ScanRaw& R, const bf16* Y1, const float* aic, const float* wdec, int st, int b, int d, int col) {
    int t, T, m;
    if (st < CTXL) { t = d ? (CTXL - 1 - st) : st; T = CTXL; m = MLAT + b * CTXL + t; } else { const int u = st - CTXL; t = d ? (SEQ - 1 - u) : u; T = SEQ; m = b * SEQ + t; }
    const bool hasn = d ? (t < T - 1) : (t > 0); const int mn = hasn ? (d ? m + 1 : m - 1) : m;
    const bf16* y = Y1 + (size_t)m * INP + col; const bf16* yn = Y1 + (size_t)mn * INP + col;
    R.r0 = bf2f(y[C_R]); R.k0 = bf2f(y[C_K]); R.v0 = bf2f(y[C_V]);
    const float rn = bf2f(yn[C_R]), kn = bf2f(yn[C_K]), vn = bf2f(yn[C_V]);
    R.rn = hasn ? rn : 0.f; R.kn = hasn ? kn : 0.f; R.vn = hasn ? vn : 0.f;
    R.a = aic[(size_t)m * CW + col]; R.w = wdec[(size_t)m * CW + col];
}
__device__ __forceinline__ void scan_emit(LAS float* Fs, const ScanRaw& R, float mur, float muk, float muv, float k_k, float k_a, int lane) {
    const float r = R.r0 + mur * (R.rn - R.r0), k = R.k0 + muk * (R.kn - R.k0), v = R.v0 + muv * (R.vn - R.v0);
    float kk = k * k_k; kk = kk * __builtin_amdgcn_rsqf(fmaxf(sum64(kk * kk), 1e-24f));
    const float km = k * (1.0f + (R.a - 1.0f) * k_a);
    Fs[lane] = r; Fs[64 + lane] = R.w; Fs[128 + lane] = km; Fs[192 + lane] = -kk; Fs[256 + lane] = kk * R.a; Fs[320 + lane] = v;
}
__device__ __forceinline__ void scan_ld_feat(ScanFeat& F, const LAS float* Fs, int j, int row) {
    F.r = *(const LAS f32x4*)(Fs + 4 * j); F.w = *(const LAS f32x4*)(Fs + 64 + 4 * j); F.k = *(const LAS f32x4*)(Fs + 128 + 4 * j);
    F.a = *(const LAS f32x4*)(Fs + 192 + 4 * j); F.b = *(const LAS f32x4*)(Fs + 256 + 4 * j); F.v = Fs[320 + row];
}
__device__ __forceinline__ void ph_scan2(Frame& f, int l) { const float* in_I_KA = karg_in(I_KA); const float* in_I_KK = karg_in(I_KK); const float* in_I_MURKV = karg_in(I_MURKV); launder_ws(f);
    LAS float* FB = (LAS float*)f.lds;
    LAS float* YP = FB + 2 * SC_T * 384;
    const bf16* Y1 = WSP(bf16, WS_Y1);
    const int lane = f.lane;
    for (int it = f.vcu; it < 256; it += f.G) {
        const int quarter = it & 3, chain = it >> 2, b = chain >> 5, d = (chain >> 4) & 1, h = chain & 15;
        if (f.wave >= 4) {
            const int pw = f.wave - 4, sq = lane >> 4, j = lane & 15, col = h * 64 + 4 * j;
            const float* murkv = in_I_MURKV + (l * 2 + d) * 3072 + col;
            const f32x4 mur = *(const f32x4*)(murkv), muk = *(const f32x4*)(murkv + 1024), muv = *(const f32x4*)(murkv + 2048);
            const f32x4 k_k = *(const f32x4*)(in_I_KK + l * CW + col), k_a = *(const f32x4*)(in_I_KA + l * CW + col);
            const bf16* aic = WSP(bf16, WS_AIC) + (size_t)d * MALL * CW + col; const bf16* wdec = WSP(bf16, WS_WDEC) + (size_t)d * MALL * CW + col;
            const bf16* y1c = Y1 + col;
            float* ys = WSP(float, WS_YS) + (size_t)d * MALL * CW + h * 64 + quarter * 16;
            const int pt = f.tid - 256, osl = pt >> 4, orr = pt & 15;
            struct PRaw { v2u r0, k0, v0, rn, kn, vn, a, w; bool has; };
            PRaw S0, S1, S2;
#define SC_LOAD(X, c) do { const int st_ = (c) * SC_T + pw * 4 + sq; int t_, T_, m_; \
        if (st_ < CTXL) { t_ = d ? (CTXL - 1 - st_) : st_; T_ = CTXL; m_ = MLAT + b * CTXL + t_; } else { const int u_ = st_ - CTXL; t_ = d ? (SEQ - 1 - u_) : u_; T_ = SEQ; m_ = b * SEQ + t_; } \
        X.has = d ? (t_ < T_ - 1) : (t_ > 0); const int mn_ = X.has ? (d ? m_ + 1 : m_ - 1) : m_; \
        const bf16* y_ = y1c + (size_t)m_ * INP; const bf16* yn_ = y1c + (size_t)mn_ * INP; \
        X.r0 = *(const v2u*)(y_ + C_R); X.k0 = *(const v2u*)(y_ + C_K); X.v0 = *(const v2u*)(y_ + C_V); X.rn = *(const v2u*)(yn_ + C_R); X.kn = *(const v2u*)(yn_ + C_K); X.vn = *(const v2u*)(yn_ + C_V); \
        X.a = *(const v2u*)(aic + (size_t)m_ * CW); X.w = *(const v2u*)(wdec + (size_t)m_ * CW); } while (0)
#define SC_EMIT(X, slot) do { const f32x4 z_ = {0.f, 0.f, 0.f, 0.f}; \
        const f32x4 r0_ = bf4(X.r0), k0_ = bf4(X.k0), v0_ = bf4(X.v0), rn_ = X.has ? bf4(X.rn) : z_, kn_ = X.has ? bf4(X.kn) : z_, vn_ = X.has ? bf4(X.vn) : z_; \
        const f32x4 r_ = r0_ + mur * (rn_ - r0_), k_ = k0_ + muk * (kn_ - k0_), v_ = v0_ + muv * (vn_ - v0_); \
        f32x4 kk_ = k_ * k_k; kk_ = kk_ * __builtin_amdgcn_rsqf(fmaxf(sum16(hsum4(kk_ * kk_)), 1e-24f)); \
        const f32x4 a_ = bf4(X.a), q_ = bf4(X.w); const f32x4 w_ = {__expf(-q_.x), __expf(-q_.y), __expf(-q_.z), __expf(-q_.w)}; \
        const f32x4 km_ = k_ * ((a_ - 1.0f) * k_a + 1.0f); \
        LAS float* Fs_ = FB + ((slot) * SC_T + pw * 4 + sq) * 384 + 4 * j; \
        *(LAS f32x4*)(Fs_) = r_; *(LAS f32x4*)(Fs_ + 64) = w_; *(LAS f32x4*)(Fs_ + 128) = km_; *(LAS f32x4*)(Fs_ + 192) = -kk_; *(LAS f32x4*)(Fs_ + 256) = kk_ * a_; *(LAS f32x4*)(Fs_ + 320) = v_; } while (0)
#define SC_YRED(c, slot) do { const LAS f32x4* yp = (const LAS f32x4*)(YP + (((slot) * SC_T + osl) * 16 + orr) * 16); const f32x4 y0 = yp[0], y1 = yp[1], y2 = yp[2], y3 = yp[3]; \
        const f32x4 ysum = (y0 + y1) + (y2 + y3); ys[(size_t)scan_row_of_step((c) * SC_T + osl, b, d) * CW + orr] = (ysum.x + ysum.y) + (ysum.z + ysum.w); } while (0)
#define SC_IVAL(c, XL, XE) do { if ((c) + 3 < SC_NCH) SC_LOAD(XL, (c) + 3); if ((c) >= 1) SC_YRED((c) - 1, ((c) - 1) & 1); if ((c) + 1 < SC_NCH) SC_EMIT(XE, ((c) + 1) & 1); \
        LDS_WAIT(); __builtin_amdgcn_s_barrier(); } while (0)
            SC_LOAD(S0, 0); SC_EMIT(S0, 0); SC_LOAD(S1, 1); SC_LOAD(S2, 2);
            LDS_WAIT(); __builtin_amdgcn_s_barrier();
            static_assert(SC_NCH % 6 == 0, "producer loop is unrolled by 6 intervals (3 register sets x 2 LDS slots)");
            for (int c = 0; c < SC_NCH; c += 6) {
                SC_IVAL(c, S0, S1); SC_IVAL(c + 1, S1, S2); SC_IVAL(c + 2, S2, S0); SC_IVAL(c + 3, S0, S1); SC_IVAL(c + 4, S1, S2); SC_IVAL(c + 5, S2, S0);
            }
            SC_YRED(SC_NCH - 1, (SC_NCH - 1) & 1);
#undef SC_LOAD
#undef SC_EMIT
#undef SC_YRED
#undef SC_IVAL
        } else {
            const int rg = lane >> 4, j = lane & 15, lrow = f.wave * 4 + rg, row = quarter * 16 + lrow;
            f32x2 s01 = {0.f, 0.f}, s23 = {0.f, 0.f};
            __builtin_amdgcn_s_setprio(3);
            const unsigned fb0 = (unsigned)(uintptr_t)FB, yp0 = (unsigned)(uintptr_t)YP;
            LDS_WAIT(); __builtin_amdgcn_s_barrier();
#define SC_LDF(Fv, sl) do { \
    asm volatile("ds_read_b128 %0, %1 offset:%2" : "=&v"(Fv.r) : "v"(adr), "n"((sl) * 1536)); \
    asm volatile("ds_read_b128 %0, %1 offset:%2" : "=&v"(Fv.w) : "v"(adr), "n"((sl) * 1536 + 256)); \
    asm volatile("ds_read_b128 %0, %1 offset:%2" : "=&v"(Fv.k) : "v"(adr), "n"((sl) * 1536 + 512)); \
    asm volatile("ds_read_b128 %0, %1 offset:%2" : "=&v"(Fv.a) : "v"(adr), "n"((sl) * 1536 + 768)); \
    asm volatile("ds_read_b128 %0, %1 offset:%2" : "=&v"(Fv.b) : "v"(adr), "n"((sl) * 1536 + 1024)); \
    asm volatile("ds_read_b32 %0, %1 offset:%2" : "=&v"(Fv.v) : "v"(adv), "n"((sl) * 1536 + 1280)); } while (0)
#define SC_WAITF(Fv, N) asm volatile("s_waitcnt lgkmcnt(" #N ")" : "+v"(Fv.r), "+v"(Fv.w), "+v"(Fv.k), "+v"(Fv.a), "+v"(Fv.b), "+v"(Fv.v))
#define SC_YOUT(sl) do { f32x2 y_ = s01 * (f32x2){rp.x, rp.y}; y_ = s23 * (f32x2){rp.z, rp.w} + y_; const float ys_ = y_.x + y_.y; \
    asm volatile("ds_write_b32 %0, %1 offset:%2" :: "v"(ady), "v"(ys_), "n"((sl) * 1024)); } while (0)
#define SC_STEP(X, Z, sl, N, HASLD, HASY) do { \
    if (HASLD) SC_LDF(Z, (sl) + 2); \
    SC_WAITF(X, N); \
    f32x2 p_ = s01 * (f32x2){X.a.x, X.a.y}; p_ = s23 * (f32x2){X.a.z, X.a.w} + p_; \
    const float sa_ = sum16(p_.x + p_.y); \
    if (HASY) SC_YOUT((sl) - 1); \
    const f32x2 sa2_ = {sa_, sa_}, vv2_ = {X.v, X.v}; \
    f32x2 t01_ = s01 * (f32x2){X.w.x, X.w.y}; t01_ = vv2_ * (f32x2){X.k.x, X.k.y} + t01_; \
    f32x2 t23_ = s23 * (f32x2){X.w.z, X.w.w}; t23_ = vv2_ * (f32x2){X.k.z, X.k.w} + t23_; \
    s01 = sa2_ * (f32x2){X.b.x, X.b.y} + t01_; s23 = sa2_ * (f32x2){X.b.z, X.b.w} + t23_; \
    rp = X.r; } while (0)
            for (int c = 0; c < SC_NCH; ++c) {
                const unsigned adr = fb0 + (unsigned)((c & 1) * SC_T * 1536 + 16 * j), adv = fb0 + (unsigned)((c & 1) * SC_T * 1536 + 4 * row);
                const unsigned ady = yp0 + (unsigned)((((c & 1) * SC_T) * 16 + lrow) * 64 + 4 * j);
                ScanFeat FA, FBv, FC; f32x4 rp = {0.f, 0.f, 0.f, 0.f};
                SC_LDF(FA, 0); SC_LDF(FBv, 1);
                SC_STEP(FA, FC, 0, 12, true, false);   SC_STEP(FBv, FA, 1, 12, true, true);   SC_STEP(FC, FBv, 2, 13, true, true);
                SC_STEP(FA, FC, 3, 14, true, true);    SC_STEP(FBv, FA, 4, 14, true, true);   SC_STEP(FC, FBv, 5, 14, true, true);
                SC_STEP(FA, FC, 6, 14, true, true);    SC_STEP(FBv, FA, 7, 14, true, true);   SC_STEP(FC, FBv, 8, 14, true, true);
                SC_STEP(FA, FC, 9, 14, true, true);    SC_STEP(FBv, FA, 10, 14, true, true);  SC_STEP(FC, FBv, 11, 14, true, true);
                SC_STEP(FA, FC, 12, 14, true, true);   SC_STEP(FBv, FA, 13, 14, true, true);  SC_STEP(FC, FBv, 14, 8, false, true);
                SC_STEP(FA, FC, 15, 2, false, true);
                SC_YOUT(15);
                LDS_WAIT(); __builtin_amdgcn_s_barrier();
            }
            __builtin_amdgcn_s_setprio(0);
#undef SC_LDF
#undef SC_WAITF
#undef SC_YOUT
#undef SC_STEP
        }
        __syncthreads();
    }
}
typedef short bf16x8_t __attribute__((ext_vector_type(8)));
__device__ __forceinline__ unsigned cvtpk(float lo, float hi) { typedef float f2 __attribute__((ext_vector_type(2))); typedef __bf16 b2 __attribute__((ext_vector_type(2))); f2 v = {lo, hi}; b2 b = __builtin_convertvector(v, b2); return __builtin_bit_cast(unsigned, b); }
__device__ __forceinline__ void ph_na(Frame& f, int l, int slot0, int nslot) { const float* in_I_RPB = karg_in(I_RPB); launder_ws(f);
    const bf16* Y1 = WSP(bf16, WS_Y1); const bf16* VAT = WSP(bf16, WS_VAT);
    LAS float* btab = (LAS float*)(f.lds + 106496 + f.wave * 1024);
    const int lane = f.lane, g = lane >> 4, qi = lane & 15;
    for (int sl = 0; sl < nslot; ++sl) { const int it = (slot0 + sl) * NWAVES + f.wave;
        const int qb = it & 3, unit = it >> 2, b = unit >> 10, h = (unit >> 7) & 7, i = unit & 127;
        const int x = qb * 16 + qi, m = b * SEQ + i * GRIDW + x;
        int rs = i - 4; rs = rs < 0 ? 0 : (rs > 120 ? 120 : rs);
        int cs = x - 8; cs = cs < 0 ? 0 : (cs > 48 ? 48 : cs);
        const int cb = qb == 0 ? 0 : (qb == 1 ? 8 : (qb == 2 ? 24 : 32));
#pragma unroll
        for (int q = 0; q < 4; ++q) { const int idx = lane + 64 * q; if (idx < 248) { const int jrl = idx / 31, dxi = idx % 31;
            btab[jrl * 32 + dxi] = in_I_RPB[((size_t)(l * 8 + h) * 15 + (rs + jrl - i + 7)) * 31 + dxi] * LOG2E; } }
        bf16x8_t qf[2];
#pragma unroll
        for (int ks = 0; ks < 2; ++ks) qf[ks] = *(const bf16x8_t*)(Y1 + (size_t)m * INP + C_QA + h * 64 + 32 * ks + 8 * g);
        float sc[16][8];
#pragma unroll
        for (int blk = 0; blk < 16; ++blk) {
            const int mk0 = blk < 8 ? (b * SEQ + (rs + blk) * GRIDW + cb) : (MLAT + b * CTXL + (blk - 8) * 32);
#pragma unroll
            for (int T = 0; T < 2; ++T) {
                const int kidx = 8 * (qi >> 2) + 4 * T + (qi & 3);
                const bf16* kp = Y1 + (size_t)(mk0 + kidx) * INP + C_KA + h * 64 + 8 * g;
                f32x4 acc = {0.f, 0.f, 0.f, 0.f};
                acc = __builtin_amdgcn_mfma_f32_16x16x32_bf16(*(const bf16x8_t*)kp, qf[0], acc, 0, 0, 0);
                acc = __builtin_amdgcn_mfma_f32_16x16x32_bf16(*(const bf16x8_t*)(kp + 32), qf[1], acc, 0, 0, 0);
                sc[blk][4 * T + 0] = acc.x; sc[blk][4 * T + 1] = acc.y; sc[blk][4 * T + 2] = acc.z; sc[blk][4 * T + 3] = acc.w;
            }
        }
        LDS_WAIT(); asm volatile("" ::: "memory");
        float mx = -1e30f;
#pragma unroll
        for (int blk = 0; blk < 16; ++blk)
#pragma unroll
            for (int j = 0; j < 8; ++j) {
                float s = sc[blk][j] * QSCALE;
                if (blk < 8) { const int y = cb + 8 * g + j; const bool valid = (unsigned)(y - cs) < 16u; int bi = y - x + 15; bi = bi < 0 ? 0 : (bi > 30 ? 30 : bi);
                    s = valid ? s + btab[blk * 32 + bi] : -1e30f; }
                sc[blk][j] = s; mx = fmaxf(mx, s);
            }
        mx = fmaxf(mx, __shfl_xor(mx, 16)); mx = fmaxf(mx, __shfl_xor(mx, 32));
        float sum = 0.f;
        bf16x8_t pf[16];
#pragma unroll
        for (int blk = 0; blk < 16; ++blk) {
#pragma unroll
            for (int j = 0; j < 8; ++j) { const float p = __builtin_amdgcn_exp2f(sc[blk][j] - mx); sc[blk][j] = p; sum += p; }
            const v4u w = {cvtpk(sc[blk][0], sc[blk][1]), cvtpk(sc[blk][2], sc[blk][3]), cvtpk(sc[blk][4], sc[blk][5]), cvtpk(sc[blk][6], sc[blk][7])};
            pf[blk] = __builtin_bit_cast(bf16x8_t, w);
        }
        sum += __shfl_xor(sum, 16); sum += __shfl_xor(sum, 32);
        f32x4 o[4];
#pragma unroll
        for (int dt = 0; dt < 4; ++dt) o[dt] = (f32x4){0.f, 0.f, 0.f, 0.f};
        const bf16* vbase = VAT + ((size_t)(b * 8 + h) * 64 + qi) * SKV + 8 * g;
#pragma unroll
        for (int blk = 0; blk < 16; ++blk) {
            const int pos0 = blk < 8 ? (CTXL + (rs + blk) * GRIDW + cb) : (blk - 8) * 32;
#pragma unroll
            for (int dt = 0; dt < 4; ++dt) o[dt] = __builtin_amdgcn_mfma_f32_16x16x32_bf16(*(const bf16x8_t*)(vbase + (size_t)dt * 16 * SKV + pos0), pf[blk], o[dt], 0, 0, 0);
        }
        const float inv = 1.0f / sum;
        bf16* op = WSP(bf16, WS_OA) + (size_t)m * 512 + h * 64 + 4 * g;
#pragma unroll
        for (int dt = 0; dt < 4; ++dt) { const f32x4 r = o[dt] * inv; *(v2u*)(op + dt * 16) = (v2u){cvtpk(r.x, r.y), cvtpk(r.z, r.w)}; }
        LDS_WAIT(); asm volatile("" ::: "memory");
    }
}
__device__ __forceinline__ void ph_vat(Frame& f) { launder_ws(f);
    const bf16* Y1 = WSP(bf16, WS_Y1); bf16* VAT = WSP(bf16, WS_VAT);
    LAS bf16* tile = (LAS bf16*)(f.lds + f.wave * 16384);
    const int lane = f.lane, gw = f.vcu * NWAVES + f.wave, NGW = f.G * NWAVES;
    constexpr int NA_ITEMS = 2 * 8 * (SKV / 64);
    for (int it = gw; it < NA_ITEMS + 16; it += NGW) {
        const bool grpb = it >= NA_ITEMS;
        const int itb = it - NA_ITEMS;
        const int pt = grpb ? (itb & 3) : it % (SKV / 64), bh = grpb ? (itb >> 2) : it / (SKV / 64), b = grpb ? (bh >> 1) : (bh >> 3), h = grpb ? (bh & 1) : (bh & 7);
        const int pos = pt * 64 + lane, m = pos < CTXL ? (MLAT + b * CTXL + pos) : (b * SEQ + pos - CTXL);
        const bf16* vp = Y1 + (size_t)m * INP + (grpb ? C_VB : C_VA) + h * 64;
#pragma unroll
        for (int c = 0; c < 8; ++c) { const v4u w = ((const v4u*)vp)[c];
            tile[(8 * c + 0) * 72 + lane] = (bf16)(w.x & 0xffffu); tile[(8 * c + 1) * 72 + lane] = (bf16)(w.x >> 16); tile[(8 * c + 2) * 72 + lane] = (bf16)(w.y & 0xffffu); tile[(8 * c + 3) * 72 + lane] = (bf16)(w.y >> 16);
            tile[(8 * c + 4) * 72 + lane] = (bf16)(w.z & 0xffffu); tile[(8 * c + 5) * 72 + lane] = (bf16)(w.z >> 16); tile[(8 * c + 6) * 72 + lane] = (bf16)(w.w & 0xffffu); tile[(8 * c + 7) * 72 + lane] = (bf16)(w.w >> 16); }
        LDS_WAIT(); asm volatile("" ::: "memory");
        bf16* op = grpb ? WSP(bf16, WS_VBT) + ((size_t)bh * 64 + lane) * CTXL + pt * 64 : VAT + ((size_t)bh * 64 + lane) * SKV + pt * 64;
#pragma unroll
        for (int c = 0; c < 8; ++c) *(v4u*)(op + 8 * c) = *(const LAS v4u*)(tile + lane * 72 + 8 * c);
        LDS_WAIT(); asm volatile("" ::: "memory");
    }
}
__device__ __forceinline__ void ph_ctxattn(Frame& f, int vrot) { launder_ws(f);
    const bf16* Y1 = WSP(bf16, WS_Y1);
    const int lane = f.lane, g = lane >> 4, qi = lane & 15;
    const int gw = ((f.vcu + vrot) % f.G) * NWAVES + f.wave, NGW = f.G * NWAVES;
    for (int it = gw; it < 512; it += NGW) {
        const int kind = it >> 8, r = it & 255, b = r >> 7, h = (r >> 4) & 7, qb = r & 15;
        const int m = MLAT + b * CTXL + qb * 16 + qi;
        const bf16* qp = kind ? WSP(bf16, WS_QBP) + (size_t)m * 512 + h * 64 : Y1 + (size_t)m * INP + C_QA + h * 64;
        const bf16* kbase = kind ? WSP(bf16, WS_KBP) + (size_t)b * SKV * 128 + (h >> 2) * 64 : Y1 + (size_t)(MLAT + b * CTXL) * INP + C_KA + h * 64;
        const int kpitch = kind ? 128 : INP;
        const bf16* vbase = kind ? WSP(bf16, WS_VBT) + (size_t)((b * 2 + (h >> 2)) * 64) * CTXL : WSP(bf16, WS_VAT) + (size_t)((b * 8 + h) * 64) * SKV;
        const int vpitch = kind ? CTXL : SKV;
        const float scale = kind ? 1.0f : QSCALE;
        bf16x8_t qf[2];
#pragma unroll
        for (int ks = 0; ks < 2; ++ks) qf[ks] = *(const bf16x8_t*)(qp + 32 * ks + 8 * g);
        float sc[8][8];
#pragma unroll
        for (int blk = 0; blk < 8; ++blk)
#pragma unroll
            for (int T = 0; T < 2; ++T) {
                const int kidx = 8 * (qi >> 2) + 4 * T + (qi & 3);
                const bf16* kp = kbase + (size_t)(blk * 32 + kidx) * kpitch + 8 * g;
                f32x4 acc = {0.f, 0.f, 0.f, 0.f};
                acc = __builtin_amdgcn_mfma_f32_16x16x32_bf16(*(const bf16x8_t*)kp, qf[0], acc, 0, 0, 0);
                acc = __builtin_amdgcn_mfma_f32_16x16x32_bf16(*(const bf16x8_t*)(kp + 32), qf[1], acc, 0, 0, 0);
                sc[blk][4 * T + 0] = acc.x * scale; sc[blk][4 * T + 1] = acc.y * scale; sc[blk][4 * T + 2] = acc.z * scale; sc[blk][4 * T + 3] = acc.w * scale;
            }
        float mx = -1e30f;
#pragma unroll
        for (int blk = 0; blk < 8; ++blk)
#pragma unroll
            for (int j = 0; j < 8; ++j) mx = fmaxf(mx, sc[blk][j]);
        mx = fmaxf(mx, __shfl_xor(mx, 16)); mx = fmaxf(mx, __shfl_xor(mx, 32));
        float sum = 0.f;
        bf16x8_t pf[8];
#pragma unroll
        for (int blk = 0; blk < 8; ++blk) {
#pragma unroll
            for (int j = 0; j < 8; ++j) { const float p = __builtin_amdgcn_exp2f(sc[blk][j] - mx); sc[blk][j] = p; sum += p; }
            const v4u w = {cvtpk(sc[blk][0], sc[blk][1]), cvtpk(sc[blk][2], sc[blk][3]), cvtpk(sc[blk][4], sc[blk][5]), cvtpk(sc[blk][6], sc[blk][7])};
            pf[blk] = __builtin_bit_cast(bf16x8_t, w);
        }
        sum += __shfl_xor(sum, 16); sum += __shfl_xor(sum, 32);
        f32x4 o[4];
#pragma unroll
        for (int dt = 0; dt < 4; ++dt) o[dt] = (f32x4){0.f, 0.f, 0.f, 0.f};
#pragma unroll
        for (int blk = 0; blk < 8; ++blk)
#pragma unroll
            for (int dt = 0; dt < 4; ++dt) o[dt] = __builtin_amdgcn_mfma_f32_16x16x32_bf16(*(const bf16x8_t*)(vbase + (size_t)(dt * 16 + qi) * vpitch + blk * 32 + 8 * g), pf[blk], o[dt], 0, 0, 0);
        const float inv = 1.0f / sum;
        bf16* op = (kind ? WSP(bf16, WS_OB) : WSP(bf16, WS_OA)) + (size_t)m * 512 + h * 64 + 4 * g;
#pragma unroll
        for (int dt = 0; dt < 4; ++dt) { const f32x4 rr = o[dt] * inv; *(v2u*)(op + dt * 16) = (v2u){cvtpk(rr.x, rr.y), cvtpk(rr.z, rr.w)}; }
    }
}
struct F8 { f32x4 lo, hi; };
__device__ __forceinline__ F8 unpack8(v4u w) { F8 r; r.lo = (f32x4){bflo(w.x), bfhi(w.x), bflo(w.y), bfhi(w.y)}; r.hi = (f32x4){bflo(w.z), bfhi(w.z), bflo(w.w), bfhi(w.w)}; return r; }
__device__ __forceinline__ bf16x8_t pack8(f32x4 lo, f32x4 hi) { const v4u w = {cvtpk(lo.x, lo.y), cvtpk(lo.z, lo.w), cvtpk(hi.x, hi.y), cvtpk(hi.z, hi.w)}; return __builtin_bit_cast(bf16x8_t, w); }
__device__ __forceinline__ float fast_tanh(float x) { const float e = __expf(2.0f * x); return 1.0f - 2.0f / (1.0f + e); }
__device__ __forceinline__ f32x4 tanh4(f32x4 v) { return (f32x4){fast_tanh(v.x), fast_tanh(v.y), fast_tanh(v.z), fast_tanh(v.w)}; }
__device__ __forceinline__ f32x4 sigm4(f32x4 v) { return (f32x4){sigmoidf_(v.x), sigmoidf_(v.y), sigmoidf_(v.z), sigmoidf_(v.w)}; }
__device__ __forceinline__ v4u sel4(bool c, v4u v) { return c ? v : (v4u){0u, 0u, 0u, 0u}; }
__device__ __forceinline__ void ph_lora2(Frame& f, int l) { const float* in_I_A0 = karg_in(I_A0); const float* in_I_MUA = karg_in(I_MUA); const float* in_I_MUG = karg_in(I_MUG); const float* in_I_MUW = karg_in(I_MUW); const float* in_I_W0 = karg_in(I_W0); launder_ws(f);
    const bf16* Y1 = WSP(bf16, WS_Y1);
    const bf16* W2T = WSP(bf16, WS_LW) + (size_t)l * 2 * CW * 64; const bf16* A2T = WSP(bf16, WS_LW + 1 * MiB) + (size_t)l * 2 * CW * 64; const bf16* G2T = WSP(bf16, WS_LW + 2 * MiB) + (size_t)l * CW * 160;
    const int lane = f.lane, g = lane >> 4, qi = lane & 15, gw = f.vcu * NWAVES + f.wave, NGW = f.G * NWAVES;
    const v4u zero4 = {0u, 0u, 0u, 0u};
    const int NFULL = (f.G * NWAVES < (MALL / 16) * 2) ? f.G * NWAVES : (MALL / 16) * 2, NREST = (MALL / 16) * 2 - NFULL;
    for (int it0 = gw; it0 < NFULL + NREST * 8; it0 += NGW) {
        const int it = it0 < NFULL ? it0 : NFULL + (it0 - NFULL) / 8, ct_lo = it0 < NFULL ? 0 : (it0 - NFULL) % 8, ct_hi = it0 < NFULL ? 8 : ct_lo + 1;
        const int half = it & 1, m = (it >> 1) * 16 + qi;
        const RowInfo R = row_info(m);
        const bool hasp = R.t > 0, hasn = R.t < R.T - 1;
        const bf16* y = Y1 + (size_t)m * INP; const bf16* yp = hasp ? y - INP : y; const bf16* yn = hasn ? y + INP : y;
        bf16x8_t xw[2][2], xa[2][2], xg[5];
#pragma unroll
        for (int d = 0; d < 2; ++d)
#pragma unroll
            for (int ks = 0; ks < 2; ++ks) {
                const int col = d * 64 + 32 * ks + 8 * g; const bf16* yb = d ? yn : yp; const bool has = d ? hasn : hasp;
                { const F8 cur = unpack8(*(const v4u*)(y + C_WD + col)), nb = unpack8(sel4(has, *(const v4u*)(yb + C_WD + col)));
                  const f32x4 m0 = *(const f32x4*)(in_I_MUW + l * 128 + col), m1 = *(const f32x4*)(in_I_MUW + l * 128 + col + 4);
                  xw[d][ks] = pack8(tanh4(cur.lo + m0 * (nb.lo - cur.lo)), tanh4(cur.hi + m1 * (nb.hi - cur.hi))); }
                asm volatile("" : "+v"(xw[d][ks]) :: "memory");
                { const F8 cur = unpack8(*(const v4u*)(y + C_AD + col)), nb = unpack8(sel4(has, *(const v4u*)(yb + C_AD + col)));
                  const f32x4 m0 = *(const f32x4*)(in_I_MUA + l * 128 + col), m1 = *(const f32x4*)(in_I_MUA + l * 128 + col + 4);
                  xa[d][ks] = pack8(cur.lo + m0 * (nb.lo - cur.lo), cur.hi + m1 * (nb.hi - cur.hi)); }
                asm volatile("" : "+v"(xa[d][ks]) :: "memory");
            }
#pragma unroll
        for (int ks = 0; ks < 5; ++ks) {
            const int col = 32 * ks + 8 * g;
            const F8 cur = unpack8(*(const v4u*)(y + C_GD + col)), pv = unpack8(sel4(hasp, *(const v4u*)(yp + C_GD + col))), nx = unpack8(sel4(hasn, *(const v4u*)(yn + C_GD + col)));
            const f32x4 p0 = *(const f32x4*)(in_I_MUG + l * 320 + col), p1 = *(const f32x4*)(in_I_MUG + l * 320 + col + 4), n0 = *(const f32x4*)(in_I_MUG + l * 320 + 160 + col), n1 = *(const f32x4*)(in_I_MUG + l * 320 + 160 + col + 4);
            xg[ks] = pack8(sigm4(cur.lo + p0 * (pv.lo - cur.lo) + n0 * (nx.lo - cur.lo)), sigm4(cur.hi + p1 * (pv.hi - cur.hi) + n1 * (nx.hi - cur.hi)));
            asm volatile("" : "+v"(xg[ks]) :: "memory");
        }
        bf16* wq = WSP(bf16, WS_WDEC); bf16* ai = WSP(bf16, WS_AIC); bf16* gq = WSP(bf16, WS_G);
        struct LwSet { bf16x8_t w[4][2]; f32x4 bias[4]; };
#define LW_LOAD(S_, base_, bias_, d_, c0_) do { const int cr_ = (c0_) + 16 * (qi >> 2) + (qi & 3), cc_ = (c0_) + 16 * g; _Pragma("unroll") for (int T = 0; T < 4; ++T) { \
            const bf16* wp_ = (base_) + ((size_t)(d_) * CW + cr_ + 4 * T) * 64 + 8 * g; S_.w[T][0] = *(const bf16x8_t*)wp_; S_.w[T][1] = *(const bf16x8_t*)(wp_ + 32); \
            S_.bias[T] = *(const f32x4*)((bias_) + (l * 2 + (d_)) * CW + cc_ + 4 * T); } } while (0)
#define LW_MMA(acc_, S_, x_) do { _Pragma("unroll") for (int T = 0; T < 4; ++T) { acc_[T] = (f32x4){0.f, 0.f, 0.f, 0.f}; \
            acc_[T] = __builtin_amdgcn_mfma_f32_16x16x32_bf16(S_.w[T][0], x_[0], acc_[T], 0, 0, 0); acc_[T] = __builtin_amdgcn_mfma_f32_16x16x32_bf16(S_.w[T][1], x_[1], acc_[T], 0, 0, 0); } } while (0)
#define LW_ST16(op_, o_) do { *(v4u*)(op_) = (v4u){cvtpk(o_[0].x, o_[0].y), cvtpk(o_[0].z, o_[0].w), cvtpk(o_[1].x, o_[1].y), cvtpk(o_[1].z, o_[1].w)}; \
            *(v4u*)((op_) + 8) = (v4u){cvtpk(o_[2].x, o_[2].y), cvtpk(o_[2].z, o_[2].w), cvtpk(o_[3].x, o_[3].y), cvtpk(o_[3].z, o_[3].w)}; } while (0)
#define LW_EPI(acc_, S_, dstb_, d_, c0_, scale_) do { f32x4 o_[4]; _Pragma("unroll") for (int T = 0; T < 4; ++T) { const f32x4 z_ = acc_[T] + S_.bias[T]; \
            _Pragma("unroll") for (int q = 0; q < 4; ++q) o_[T][q] = (scale_) * __builtin_amdgcn_rcpf(1.0f + __expf(-z_[q])); } \
            bf16* op_ = (dstb_) + ((size_t)(d_) * MALL + m) * CW + (c0_) + 16 * g; LW_ST16(op_, o_); } while (0)
#define LW_FENCE() asm volatile("" ::: "memory")
        LwSet SA, SB; bf16x8_t GW[4][5];
        { const int c0 = half * 512 + ct_lo * 64; LW_LOAD(SA, W2T, in_I_W0, 0, c0); }
        LW_FENCE();
#pragma unroll 1
        for (int ct = ct_lo; ct < ct_hi; ++ct) {
            const int c0 = half * 512 + ct * 64, cr = c0 + 16 * (qi >> 2) + (qi & 3), cc = c0 + 16 * g;
            const int c0n = half * 512 + (ct + 1 < ct_hi ? ct + 1 : ct) * 64;
            f32x4 acc[4];
            LW_MMA(acc, SA, xw[0]); LW_LOAD(SB, A2T, in_I_A0, 0, c0); LW_FENCE(); LW_EPI(acc, SA, wq, 0, c0, 0.60653065971f); LW_FENCE();
            LW_MMA(acc, SB, xa[0]); LW_LOAD(SA, W2T, in_I_W0, 1, c0); LW_FENCE(); LW_EPI(acc, SB, ai, 0, c0, 1.0f); LW_FENCE();
            LW_MMA(acc, SA, xw[1]); LW_LOAD(SB, A2T, in_I_A0, 1, c0); LW_FENCE(); LW_EPI(acc, SA, wq, 1, c0, 0.60653065971f); LW_FENCE();
            LW_MMA(acc, SB, xa[1]);
#pragma unroll
            for (int T = 0; T < 4; ++T) { const bf16* gp = G2T + (size_t)(cr + 4 * T) * 160 + 8 * g;
#pragma unroll
                for (int ks = 0; ks < 5; ++ks) GW[T][ks] = *(const bf16x8_t*)(gp + 32 * ks); }
            LW_FENCE(); LW_EPI(acc, SB, ai, 1, c0, 1.0f); LW_FENCE();
#pragma unroll
            for (int T = 0; T < 4; ++T) { acc[T] = (f32x4){0.f, 0.f, 0.f, 0.f};
#pragma unroll
                for (int ks = 0; ks < 5; ++ks) acc[T] = __builtin_amdgcn_mfma_f32_16x16x32_bf16(GW[T][ks], xg[ks], acc[T], 0, 0, 0); }
            LW_LOAD(SA, W2T, in_I_W0, 0, c0n); LW_FENCE();
            { bf16* op = gq + (size_t)m * CW + cc; LW_ST16(op, acc); }
            LW_FENCE();
        }
#undef LW_LOAD
#undef LW_MMA
#undef LW_ST16
#undef LW_EPI
#undef LW_FENCE
    }
}
__device__ __forceinline__ void ph_lora_weights(Frame& f) { const float* in_I_A2 = karg_in(I_A2); const float* in_I_G2 = karg_in(I_G2); const float* in_I_W2 = karg_in(I_W2); launder_ws(f);
    const int gt = f.vcu * 512 + f.tid, GT = f.G * 512;
    for (int i = gt; i < DEPTH * 2 * CW * 64; i += GT) { const int r = i & 63, c = (i >> 6) & (CW - 1), ld = i >> 16;
        WSP(bf16, WS_LW)[i] = (bf16)f2bf(in_I_W2[((size_t)ld * 64 + r) * CW + c]); WSP(bf16, WS_LW + 1 * MiB)[i] = (bf16)f2bf(in_I_A2[((size_t)ld * 64 + r) * CW + c]); }
    for (int i = gt; i < DEPTH * CW * 160; i += GT) { const int r = i % 160, c = (i / 160) % CW, l = i / (160 * CW);
        WSP(bf16, WS_LW + 2 * MiB)[i] = (bf16)f2bf(in_I_G2[((size_t)l * 160 + r) * CW + c]); }
}
__device__ __forceinline__ void ph_setup2(Frame& f) { const float* in_I_CTX = karg_in(I_CTX); const float* in_I_N1G = karg_in(I_N1G); const float* in_I_N2G = karg_in(I_N2G); const float* in_I_X = karg_in(I_X); launder_ws(f);
    const int gt = f.vcu * 512 + f.tid, GT = f.G * 512, gw = f.vcu * NWAVES + f.wave, NGW = f.G * NWAVES, lane = f.lane;
    const float* MOD = WSP(float, WS_MOD);
    for (int i = gt; i < DEPTH * 2 * 3 * DM; i += GT) { const int k = i & (DM - 1), s = (i >> 11) % 3, w = (i / (3 * DM)) & 1, l = i / (6 * DM);
        WSP(float, WS_GK)[i] = (w ? in_I_N2G : in_I_N1G)[l * DM + k] * (1.0f + MOD[(size_t)(l * 3 + s) * MODW + (w ? 4 : 1) * DM + k]); }
    for (int it = gw; it < DEPTH * (INP + UPN); it += NGW) {
        const int l = it / (INP + UPN), r = it % (INP + UPN); const bool up = r >= INP; const int n = up ? r - INP : r;
        const bf16* wrow = up ? WSP(bf16, WS_WUP) + ((size_t)l * UPN + n) * DM : WSP(bf16, WS_WIN) + ((size_t)l * INP + n) * DM;
        const float* sh = MOD + (size_t)l * 3 * MODW + (up ? 3 * DM : 0);
        float a0 = 0.f, a1 = 0.f, a2 = 0.f;
#pragma unroll
        for (int c = 0; c < 4; ++c) { const int k = c * 512 + lane * 8; const v4u w = *(const v4u*)(wrow + k);
            const f32x4 wl = bf4((v2u){w.x, w.y}), wh = bf4((v2u){w.z, w.w});
            a0 += hsum4(wl * *(const f32x4*)(sh + k)) + hsum4(wh * *(const f32x4*)(sh + k + 4));
            a1 += hsum4(wl * *(const f32x4*)(sh + MODW + k)) + hsum4(wh * *(const f32x4*)(sh + MODW + k + 4));
            a2 += hsum4(wl * *(const f32x4*)(sh + 2 * MODW + k)) + hsum4(wh * *(const f32x4*)(sh + 2 * MODW + k + 4)); }
        a0 = sum64(a0); a1 = sum64(a1); a2 = sum64(a2);
        if (lane == 0) { float* o = up ? WSP(float, WS_BIAS3) + (size_t)l * 3 * UPN + n : WSP(float, WS_BIAS1) + (size_t)l * 3 * INP + n; const int ld = up ? UPN : INP; o[0] = a0; o[ld] = a1; o[2 * ld] = a2; }
    }
    for (int m = gw; m < MALL; m += NGW) {
        const int s = m < SEQ ? 0 : (m < MLAT ? 1 : 2);
        const f32x4* xr = (const f32x4*)(m < MLAT ? in_I_X + (size_t)m * DM : in_I_CTX + (size_t)(m - MLAT) * DM) + lane;
        f32x4* hr = (f32x4*)(WSP(float, WS_H) + (size_t)m * DM) + lane; v2u* o = (v2u*)(WSP(bf16, WS_XN) + (size_t)m * DM) + lane;
        const float* sc = MOD + (size_t)s * MODW + DM;
        float ss = 0.f;
#pragma unroll
        for (int j = 0; j < 8; ++j) { const int col = lane * 4 + 256 * j; const f32x4 v = xr[64 * j]; hr[64 * j] = v; ss += hsum4(v * v);
            const f32x4 r = v * *(const f32x4*)(in_I_N1G + col) * (*(const f32x4*)(sc + col) + 1.0f);
            o[64 * j] = (v2u){pk2(r.x, r.y), pk2(r.z, r.w)}; }
        ss = sum64(ss);
        if (lane == 0) WSP(float, WS_RS)[m] = __builtin_amdgcn_rsqf(ss * (1.f / DM) + 1e-6f);
    }
}
struct EpiScaleBias {
    static constexpr bool PERM = true, AFTER_DRAIN = false;
    bf16* O; int ldc; const float* ss; const float* bias; int bias_ld;
    __device__ __forceinline__ void operator()(const pg8::f32x4 (&acc)[2][2][4][2], const pg8::Unit& u, int wr, int wc, int fr, int fq) const {
        const int row0 = u.pm * 256 + wr * 64 + fr, col0 = u.pn * 256 + wc * 32 + 8 * fq;
        const int s = u.pm < 32 ? 0 : (u.pm < 64 ? 1 : 2);
        const float* bp = bias + (size_t)s * bias_ld + col0;
        pg8::f32x4 bv[2][2];
#pragma unroll
        for (int bj = 0; bj < 2; ++bj)
#pragma unroll
            for (int n = 0; n < 2; ++n) bv[bj][n] = *(const pg8::f32x4*)(bp + bj * 128 + 4 * n);
#pragma unroll
        for (int ai = 0; ai < 2; ++ai)
#pragma unroll
            for (int m = 0; m < 4; ++m) { const int row = row0 + ai * 128 + m * 16; const float rs = ss[row];
                bf16* rowp = O + (size_t)row * ldc + col0;
#pragma unroll
                for (int bj = 0; bj < 2; ++bj) { const pg8::f32x4 v0 = acc[ai][bj][m][0] * rs + bv[bj][0], v1 = acc[ai][bj][m][1] * rs + bv[bj][1];
                    *(v4u*)(rowp + bj * 128) = (v4u){pg8::cvt_pk_bf16(v0[0], v0[1]), pg8::cvt_pk_bf16(v0[2], v0[3]), pg8::cvt_pk_bf16(v1[0], v1[1]), pg8::cvt_pk_bf16(v1[2], v1[3])}; } }
    }
};
struct EpiResGateNorm {
    static constexpr bool PERM = true, AFTER_DRAIN = false;
    float* H; const float* mod; const float* gk; bf16* AH; float* ss;
    __device__ __forceinline__ void operator()(const pg8::f32x4 (&acc)[2][2][4][2], const pg8::Unit& u, int wr, int wc, int fr, int fq) const {
        const int row0 = u.pm * 256 + wr * 64 + fr, col0 = u.pn * 256 + wc * 32 + 8 * fq;
        const int s = u.pm < 32 ? 0 : (u.pm < 64 ? 1 : 2);
        const float* gp = mod + (size_t)s * MODW + col0; const float* kp = gk + (size_t)s * DM + col0;
        pg8::f32x4 gv[2][2], kv[2][2];
#pragma unroll
        for (int bj = 0; bj < 2; ++bj)
#pragma unroll
            for (int n = 0; n < 2; ++n) { gv[bj][n] = *(const pg8::f32x4*)(gp + bj * 128 + 4 * n); kv[bj][n] = gk ? *(const pg8::f32x4*)(kp + bj * 128 + 4 * n) : (pg8::f32x4){0.f, 0.f, 0.f, 0.f}; }
#pragma unroll
        for (int ai = 0; ai < 2; ++ai)
#pragma unroll
            for (int m = 0; m < 4; ++m) { const int row = row0 + ai * 128 + m * 16; float* rowp = H + (size_t)row * DM + col0; float sq = 0.f;
#pragma unroll
                for (int bj = 0; bj < 2; ++bj) { pg8::f32x4* p0 = (pg8::f32x4*)(rowp + bj * 128); pg8::f32x4* p1 = p0 + 1;
                    const pg8::f32x4 h0 = *p0 + gv[bj][0] * acc[ai][bj][m][0], h1 = *p1 + gv[bj][1] * acc[ai][bj][m][1];
                    *p0 = h0; *p1 = h1;
                    if (gk) { sq += (h0[0] * h0[0] + h0[1] * h0[1]) + (h0[2] * h0[2] + h0[3] * h0[3]) + (h1[0] * h1[0] + h1[1] * h1[1]) + (h1[2] * h1[2] + h1[3] * h1[3]);
                        const pg8::f32x4 a0 = h0 * kv[bj][0], a1 = h1 * kv[bj][1];
                        *(v4u*)(AH + (size_t)row * DM + col0 + bj * 128) = (v4u){pg8::cvt_pk_bf16(a0[0], a0[1]), pg8::cvt_pk_bf16(a0[2], a0[3]), pg8::cvt_pk_bf16(a1[0], a1[1]), pg8::cvt_pk_bf16(a1[2], a1[3])}; } }
                if (gk) { sq += __shfl_xor(sq, 16); sq += __shfl_xor(sq, 32); if (fq == 0) ss[(size_t)row * 32 + u.pn * 4 + wc] = sq; } }
    }
};

struct CtxSplitOrder {
    int G, c, KS, ksub;
    __device__ __forceinline__ bool next(int i, pg8::Unit& u) const { const int L = i * G + c; if (L >= 16 * KS) return false; const int r = L & 15; u.kb = (L >> 4) * ksub; u.pm = 64 + (r & 1); u.pn = r >> 1; return true; }
    __device__ __forceinline__ void a_ready(const pg8::Unit&) const {}
    __device__ __forceinline__ void done(const pg8::Unit&) const {}
};
struct EpiPartial {
    static constexpr bool PERM = true, AFTER_DRAIN = false;
    float* P; int ksub;
    __device__ __forceinline__ void operator()(const pg8::f32x4 (&acc)[2][2][4][2], const pg8::Unit& u, int wr, int wc, int fr, int fq) const {
        const int row0 = (u.pm - 64) * 256 + wr * 64 + fr, col0 = u.pn * 256 + wc * 32 + 8 * fq, ks = u.kb / ksub;
#pragma unroll
        for (int ai = 0; ai < 2; ++ai)
#pragma unroll
            for (int m = 0; m < 4; ++m) { float* rowp = P + ((size_t)ks * MCTX + row0 + ai * 128 + m * 16) * DM + col0;
#pragma unroll
                for (int bj = 0; bj < 2; ++bj) { *(pg8::f32x4*)(rowp + bj * 128) = acc[ai][bj][m][0]; *(pg8::f32x4*)(rowp + bj * 128 + 4) = acc[ai][bj][m][1]; } }
    }
};
template <int KS> __device__ __forceinline__ void ph_rs(Frame& f, int which, const float* gate, const float* gk) { launder_ws(f);
    const int gt = f.vcu * 512 + f.tid, GT = f.G * 512;
    for (int m = gt; m < MLAT; m += GT) { const f32x4* p = (const f32x4*)(WSP(float, WS_SSP) + ((size_t)which * MALL + m) * 32);
        f32x4 a = p[0];
#pragma unroll
        for (int j = 1; j < 8; ++j) a += p[j];
        WSP(float, WS_RS)[(size_t)which * MALL + m] = __builtin_amdgcn_rsqf(hsum4(a) * (1.f / DM) + 1e-6f); }
    if (KS > 0) {
        LAS float* red = (LAS float*)f.lds;
        const int lane = f.lane;
        for (int rb = f.vcu; rb < MCTX / 2; rb += f.G) { const int r = rb * 2 + (f.wave >> 2), jq = f.wave & 3, m = MLAT + r;
            f32x4* hr = (f32x4*)(WSP(float, WS_H) + (size_t)m * DM) + lane; v2u* o = (v2u*)(WSP(bf16, WS_XN) + (size_t)m * DM) + lane;
            const f32x4* pp = (const f32x4*)(WSP(float, WS_PART) + (size_t)r * DM) + lane;
            float ss = 0.f;
#pragma unroll
            for (int jj = 0; jj < 2; ++jj) { const int j = jq * 2 + jj, col = lane * 4 + 256 * j;
                f32x4 pv[KS > 0 ? KS : 1];
#pragma unroll
                for (int ks = 0; ks < KS; ++ks) pv[ks] = pp[(size_t)ks * MCTX * DM / 4 + 64 * j];
                f32x4 acc = pv[0];
#pragma unroll
                for (int ks = 1; ks < KS; ++ks) acc += pv[ks];
                const f32x4 h = hr[64 * j] + *(const f32x4*)(gate + col) * acc;
                hr[64 * j] = h; ss += hsum4(h * h);
                const f32x4 a = h * *(const f32x4*)(gk + col);
                o[64 * j] = (v2u){pk2(a.x, a.y), pk2(a.z, a.w)}; }
            ss = sum64(ss);
            __syncthreads();
            if (lane == 0) red[f.wave] = ss;
            __syncthreads();
            if (jq == 0 && lane == 0) WSP(float, WS_RS)[(size_t)which * MALL + m] = __builtin_amdgcn_rsqf(((red[f.wave] + red[f.wave + 1]) + (red[f.wave + 2] + red[f.wave + 3])) * (1.f / DM) + 1e-6f);
        }
    }
}
template <int CTRL> __device__ __forceinline__ float dpp_mov(float v) { return __builtin_bit_cast(float, __builtin_amdgcn_update_dpp(0, __builtin_bit_cast(int, v), CTRL, 0xF, 0xF, true)); }
template <int CTRL> __device__ __forceinline__ float dpp_keep(float old, float v) { return __builtin_bit_cast(float, __builtin_amdgcn_update_dpp(__builtin_bit_cast(int, old), __builtin_bit_cast(int, v), CTRL, 0xF, 0xF, false)); }
struct EpiConvGlu {
    static constexpr bool PERM = true, AFTER_DRAIN = false;
    bf16* HB; bf16* U; const float* rsv; const float* bias; const float* cw; const float* cb;
    __device__ __forceinline__ void operator()(const pg8::f32x4 (&acc)[2][2][4][2], const pg8::Unit& u, int wr, int wc, int fr, int fq) const {
        const int row0 = u.pm * 256 + wr * 64 + fr, col0 = u.pn * 256 + wc * 32 + 8 * fq, ch0 = u.pn * 128 + wc * 32 + 8 * fq;
        const int s = u.pm < 32 ? 0 : (u.pm < 64 ? 1 : 2);
        const float* bp = bias + (size_t)s * UPN + col0;
        pg8::f32x4 bu[2], bv[2], w0[2], w1[2], w2[2], cbv[2];
#pragma unroll
        for (int n = 0; n < 2; ++n) { bu[n] = *(const pg8::f32x4*)(bp + 4 * n); bv[n] = *(const pg8::f32x4*)(bp + 128 + 4 * n);
            w0[n] = *(const pg8::f32x4*)(cw + ch0 + 4 * n); w1[n] = *(const pg8::f32x4*)(cw + DFF + ch0 + 4 * n); w2[n] = *(const pg8::f32x4*)(cw + 2 * DFF + ch0 + 4 * n); cbv[n] = *(const pg8::f32x4*)(cb + ch0 + 4 * n); }
#pragma unroll
        for (int ai = 0; ai < 2; ++ai) {
            pg8::f32x4 uu[4][2];
            float rs[4];
#pragma unroll
            for (int m = 0; m < 4; ++m) { rs[m] = rsv[row0 + ai * 128 + m * 16];
#pragma unroll
                for (int n = 0; n < 2; ++n) uu[m][n] = acc[ai][0][m][n] * rs[m] + bu[n]; }
#pragma unroll
            for (int m = 0; m < 4; ++m) {
                const int row = row0 + ai * 128 + m * 16;
                const bool edge = (m == 0 && fr == 0) || (m == 3 && fr == 15);
                unsigned hw[4];
#pragma unroll
                for (int n = 0; n < 2; ++n) {
                    pg8::f32x4 g;
#pragma unroll
                    for (int i = 0; i < 4; ++i) {
                        const float pold = m > 0 ? dpp_mov<0x121>(uu[m - 1][n][i]) : 0.f, nold = m < 3 ? dpp_mov<0x12F>(uu[m + 1][n][i]) : 0.f;
                        const float up = dpp_keep<0x111>(pold, uu[m][n][i]), un = dpp_keep<0x101>(nold, uu[m][n][i]);
                        g[i] = up * w0[n][i] + uu[m][n][i] * w1[n][i] + un * w2[n][i] + cbv[n][i];
                    }
                    const pg8::f32x2 g0 = pg8::gelu_pk((pg8::f32x2){g[0], g[1]}), g1 = pg8::gelu_pk((pg8::f32x2){g[2], g[3]});
                    const pg8::f32x4 vv = acc[ai][1][m][n] * rs[m] + bv[n];
                    hw[2 * n] = pg8::cvt_pk_bf16(g0.x * vv[0], g0.y * vv[1]); hw[2 * n + 1] = pg8::cvt_pk_bf16(g1.x * vv[2], g1.y * vv[3]);
                }
                if (!edge) *(v4u*)(HB + (size_t)row * DFF + ch0) = (v4u){hw[0], hw[1], hw[2], hw[3]};
                if ((m == 0 && fr < 2) || (m == 3 && fr >= 14)) {
                    const pg8::f32x4 v0 = acc[ai][1][m][0] * rs[m] + bv[0], v1 = acc[ai][1][m][1] * rs[m] + bv[1];
                    bf16* up_ = U + (size_t)row * UPN + col0;
                    *(v4u*)(up_) = (v4u){pg8::cvt_pk_bf16(uu[m][0][0], uu[m][0][1]), pg8::cvt_pk_bf16(uu[m][0][2], uu[m][0][3]), pg8::cvt_pk_bf16(uu[m][1][0], uu[m][1][1]), pg8::cvt_pk_bf16(uu[m][1][2], uu[m][1][3])};
                    *(v4u*)(up_ + 128) = (v4u){pg8::cvt_pk_bf16(v0[0], v0[1]), pg8::cvt_pk_bf16(v0[2], v0[3]), pg8::cvt_pk_bf16(v1[0], v1[1]), pg8::cvt_pk_bf16(v1[2], v1[3])};
                }
            }
        }
    }
};
__device__ __forceinline__ void ph_convfix(Frame& f, int l, int mrows) { const float* in_I_CONVB = karg_in(I_CONVB); const float* in_I_CONVW = karg_in(I_CONVW); launder_ws(f);
    const int gt = f.vcu * 512 + f.tid, GT = f.G * 512;
    const bf16* U = WSP(bf16, WS_U); bf16* HB = WSP(bf16, WS_HB);
    const float* cw = in_I_CONVW + (size_t)l * 3 * DFF; const float* cb = in_I_CONVB + (size_t)l * DFF;
    constexpr int C8 = DFF / 8;
    for (int idx = gt; idx < (mrows / 32) * C8; idx += GT) {
        const int ri = idx / C8, c = (idx % C8) * 8, m = (ri >> 1) * 64 + ((ri & 1) ? 63 : 0), nc = (c >> 7) * 256 + (c & 127);
        const RowInfo R = row_info(m);
        const v4u z = {0u, 0u, 0u, 0u};
        const v4u uc = *(const v4u*)(U + (size_t)m * UPN + nc), vl = *(const v4u*)(U + (size_t)m * UPN + nc + 128);
        const v4u up = R.t > 0 ? *(const v4u*)(U + (size_t)(m - 1) * UPN + nc) : z, un = R.t < R.T - 1 ? *(const v4u*)(U + (size_t)(m + 1) * UPN + nc) : z;
        float r[8], gv[8];
#pragma unroll
        for (int i = 0; i < 8; ++i) {
            const unsigned wc_ = i < 2 ? uc.x : i < 4 ? uc.y : i < 6 ? uc.z : uc.w, wp_ = i < 2 ? up.x : i < 4 ? up.y : i < 6 ? up.z : up.w;
            const unsigned wn_ = i < 2 ? un.x : i < 4 ? un.y : i < 6 ? un.z : un.w, wv_ = i < 2 ? vl.x : i < 4 ? vl.y : i < 6 ? vl.z : vl.w;
            const float fc = (i & 1) ? bfhi(wc_) : bflo(wc_), fp = (i & 1) ? bfhi(wp_) : bflo(wp_), fn = (i & 1) ? bfhi(wn_) : bflo(wn_), fv = (i & 1) ? bfhi(wv_) : bflo(wv_);
            r[i] = fp * cw[c + i] + fc * cw[DFF + c + i] + fn * cw[2 * DFF + c + i] + cb[c + i]; gv[i] = fv;
        }
#pragma unroll
        for (int i = 0; i < 8; i += 2) { const f32x2 g2 = pg8::gelu_pk((f32x2){r[i], r[i + 1]}); r[i] = g2.x * gv[i]; r[i + 1] = g2.y * gv[i + 1]; }
        *(v4u*)(HB + (size_t)m * DFF + c) = (v4u){pk2(r[0], r[1]), pk2(r[2], r[3]), pk2(r[4], r[5]), pk2(r[6], r[7])};
    }
}
typedef float f32x16 __attribute__((ext_vector_type(16)));
#ifndef CHUNK_CHECK_C0
#define CHUNK_CHECK_C0 0
#define CHUNK_CHECK_C1 100000
#endif
#ifndef CK_SELFTEST_E
#define CK_SELFTEST_E 0
#endif
#ifndef CHUNK_CHECK_T1
#define CHUNK_CHECK_T1 32
#endif
constexpr int CK_C = 32, CK_NCH = SKV / CK_C;
constexpr size_t CK_REC = 24 * 1024;
__device__ __forceinline__ int ck_rho(int i, int h) { return (i & 3) + 8 * (i >> 2) + 4 * h; }
__device__ __forceinline__ bf16x8_t ck_frag(const f32x16& a, int s) {
    const v4u w = {cvtpk(a[8 * s + 0], a[8 * s + 1]), cvtpk(a[8 * s + 2], a[8 * s + 3]), cvtpk(a[8 * s + 4], a[8 * s + 5]), cvtpk(a[8 * s + 6], a[8 * s + 7])};
    return __builtin_bit_cast(bf16x8_t, w);
}
__device__ __forceinline__ f32x16 ck_mm(bf16x8_t a, bf16x8_t b, f32x16 c) { return __builtin_amdgcn_mfma_f32_32x32x16_bf16(a, b, c, 0, 0, 0); }
__device__ __forceinline__ void ck_swap32(float v, float& lo, float& hi) {
    const auto rr = __builtin_amdgcn_permlane32_swap(__float_as_uint(v), __float_as_uint(v), false, false); const unsigned r0 = rr[0], r1 = rr[1]; lo = __uint_as_float(r0); hi = __uint_as_float(r1); }
__device__ __forceinline__ float ck_sum2(float v) { float lo, hi; ck_swap32(v, lo, hi); return lo + hi; }
template <int CTRL, int RMASK> __device__ __forceinline__ float dpp_add0(float v) { return v + __builtin_bit_cast(float, __builtin_amdgcn_update_dpp(0, __builtin_bit_cast(int, v), CTRL, RMASK, 0xF, false)); }
__device__ __forceinline__ float ck_prefix32(float v) {
    v = dpp_add0<0x111, 0xF>(v); v = dpp_add0<0x112, 0xF>(v); v = dpp_add0<0x114, 0xF>(v); v = dpp_add0<0x118, 0xF>(v); v = dpp_add0<0x142, 0xA>(v);
    return v; }
__device__ __forceinline__ f32x4 exp4(f32x4 v) { return (f32x4){__expf(v.x), __expf(v.y), __expf(v.z), __expf(v.w)}; }

__device__ __forceinline__ f32x16 ck_unpack(v4u lo, v4u hi) { f32x16 r;
    r[0] = bflo(lo.x); r[1] = bfhi(lo.x); r[2] = bflo(lo.y); r[3] = bfhi(lo.y); r[4] = bflo(lo.z); r[5] = bfhi(lo.z); r[6] = bflo(lo.w); r[7] = bfhi(lo.w);
    r[8] = bflo(hi.x); r[9] = bfhi(hi.x); r[10] = bflo(hi.y); r[11] = bfhi(hi.y); r[12] = bflo(hi.z); r[13] = bfhi(hi.z); r[14] = bflo(hi.w); r[15] = bfhi(hi.w); return r; }
__device__ __forceinline__ bf16x8_t ck_ident(int s, int t, int h) {
    unsigned w[4];
#pragma unroll
    for (int p = 0; p < 4; ++p) { const int e0 = 2 * p, e1 = 2 * p + 1; const int r0 = 16 * s + 8 * (e0 >> 2) + 4 * h + (e0 & 3), r1 = 16 * s + 8 * (e1 >> 2) + 4 * h + (e1 & 3);
        w[p] = (r0 == t ? 0x3F80u : 0u) | (r1 == t ? 0x3F800000u : 0u); }
    return __builtin_bit_cast(bf16x8_t, (v4u){w[0], w[1], w[2], w[3]});
}
#if defined(CK_SELFTEST)
__device__ __forceinline__ void ck_report(Frame& f, float v) {
    unsigned u = __builtin_bit_cast(unsigned, v);
#pragma unroll
    for (int n = 1; n < 64; n <<= 1) { const unsigned o = (unsigned)__shfl_xor((int)u, n, 64); u = o > u ? o : u; }
    if (f.lane == 0) __hip_atomic_fetch_max((unsigned*)(f.ws + WS_CTL) + 8194, u, __ATOMIC_RELAXED, __HIP_MEMORY_SCOPE_AGENT);
}
#endif
  template <int MODE> __device__ __forceinline__ void ph_scanA(Frame& f, int l) { const float* in_I_KA = karg_in(I_KA); const float* in_I_KK = karg_in(I_KK); const float* in_I_MURKV = karg_in(I_MURKV); launder_ws(f);
    const bf16* Y1 = WSP(bf16, WS_Y1);
    LAS float* Lt = (LAS float*)(f.lds + f.wave * 12800);
    LAS float* QC = Lt + 1024;
    LAS v4u* PKL = (LAS v4u*)(Lt + 1024 + 64);
    LAS float* RV = Lt + 1024 + 64 + 2048;
    LAS float* PT = (LAS float*)(f.lds + 102400);
    LAS float* PA = (LAS float*)(f.lds + 133120);
    __syncthreads();
    for (int i = f.tid; i < 1536; i += NWAVES * 64) ((LAS f32x4*)PT)[i] = ((const f32x4*)(in_I_MURKV + (size_t)l * 6144))[i];
    for (int i = f.tid; i < 256; i += NWAVES * 64) { ((LAS f32x4*)(PT + 6144))[i] = ((const f32x4*)(in_I_KK + (size_t)l * CW))[i]; ((LAS f32x4*)PA)[i] = ((const f32x4*)(in_I_KA + (size_t)l * CW))[i]; }
    __syncthreads();
    const int gw = f.vcu * NWAVES + f.wave, NGW = f.G * NWAVES;
#if defined(CK_STAGGER)
    for (int k_ = (f.wave * 8 + (f.vcu & 7)) * CK_STAGGER; k_ > 0; --k_) __builtin_amdgcn_s_sleep(16);
#endif
    struct CkRaw { v4u q[2], k0[2], kn[2], ic[2], r0[2], rn[2], v0[2], vn[2]; };
    struct CkAddr { unsigned oy, oyn, o2, oc; int has, d; };
#define CK_ADDR(A_, it_, t_, h_) do { const int chain_ = (it_) / CK_NCH, c_ = (it_) % CK_NCH, b_ = chain_ >> 5, d_ = (chain_ >> 4) & 1, hd_ = chain_ & 15; \
        const int st_ = c_ * CK_C + (t_); int tt_, TT_, m_; \
        if (st_ < CTXL) { tt_ = d_ ? (CTXL - 1 - st_) : st_; TT_ = CTXL; m_ = MLAT + b_ * CTXL + tt_; } else { const int u_ = st_ - CTXL; tt_ = d_ ? (SEQ - 1 - u_) : u_; TT_ = SEQ; m_ = b_ * SEQ + tt_; } \
        const bool has_ = d_ ? (tt_ < TT_ - 1) : (tt_ > 0); const int mn_ = has_ ? (d_ ? m_ + 1 : m_ - 1) : m_; \
        A_.oy = ((unsigned)m_ * INP + hd_ * 64 + 16 * (h_)) * 2u; A_.oyn = ((unsigned)mn_ * INP + hd_ * 64 + 16 * (h_)) * 2u; A_.o2 = (((unsigned)d_ * MALL + m_) * CW + hd_ * 64 + 16 * (h_)) * 2u; \
        A_.oc = (unsigned)(hd_ * 64 + 16 * (h_)) * 4u; A_.has = has_ ? 1 : 0; A_.d = d_; } while (0)
#define CK_GLD(dst_, off_, base_, imm_) asm volatile("global_load_dwordx4 %0, %1, %2 offset:%3" : "=&v"(dst_) : "v"(off_), "s"(base_), "n"(imm_))
#define CK_LD(X, T_, A_) do { const char* wqb_ = (const char*)WSP(bf16, WS_WDEC); const char* aib_ = (const char*)WSP(bf16, WS_AIC); \
        const char* ykb_ = (const char*)Y1 + C_K * 2; const char* yrb_ = (const char*)Y1 + C_R * 2; const char* yvb_ = (const char*)Y1 + C_V * 2; \
        _Pragma("unroll") for (int j_ = 0; j_ < 2; ++j_) { \
            CK_GLD(X.q[j_], A_.o2, wqb_, 64 * (T_) + 16 * j_); CK_GLD(X.k0[j_], A_.oy, ykb_, 64 * (T_) + 16 * j_); CK_GLD(X.kn[j_], A_.oyn, ykb_, 64 * (T_) + 16 * j_); CK_GLD(X.ic[j_], A_.o2, aib_, 64 * (T_) + 16 * j_); \
            CK_GLD(X.r0[j_], A_.oy, yrb_, 64 * (T_) + 16 * j_); CK_GLD(X.rn[j_], A_.oyn, yrb_, 64 * (T_) + 16 * j_); CK_GLD(X.v0[j_], A_.oy, yvb_, 64 * (T_) + 16 * j_); CK_GLD(X.vn[j_], A_.oyn, yvb_, 64 * (T_) + 16 * j_); } } while (0)
#define CK_LDWAIT(X, N_) do { asm volatile("s_waitcnt vmcnt(" #N_ ")" : "+v"(X.q[0]), "+v"(X.q[1]), "+v"(X.k0[0]), "+v"(X.k0[1]), "+v"(X.kn[0]), "+v"(X.kn[1]), "+v"(X.ic[0]), "+v"(X.ic[1]), \
            "+v"(X.r0[0]), "+v"(X.r0[1]), "+v"(X.rn[0]), "+v"(X.rn[1]), "+v"(X.v0[0]), "+v"(X.v0[1]), "+v"(X.vn[0]), "+v"(X.vn[1])); } while (0)
#define CK_PREF2 CK_LD(RB, 1, AD);
    CkRaw RA, RB; CkAddr AD;
    const int nfull = (64 * CK_NCH) / NGW, ntail = 64 * CK_NCH - nfull * NGW, ts = (f.wave & 1) ? -1 : (f.wave >> 1) * f.G + f.vcu;
    const int nk = nfull + ((ts >= 0 && ts < ntail) ? 1 : 0);
#define CK_ITEM(k_) ((k_) < nfull ? (k_) * NGW + gw : nfull * NGW + ts)
    { const int it0 = nk > 0 ? CK_ITEM(0) : 0; CK_ADDR(AD, it0, f.lane & 31, f.lane >> 5); CK_LD(RA, 0, AD); CK_PREF2 }
    CK_LDWAIT(RA, 0); CK_LDWAIT(RB, 0);
    for (int k = 0; k < nk; ++k) { const int it = CK_ITEM(k);
        int lane_ = f.lane; asm volatile("" : "+v"(lane_));
        launder_ws(f);
        const int lane = lane_, t = lane & 31, h = lane >> 5;
        LAS float* LtW = Lt + 4 * h * 32 + t;
        const bool has = AD.has != 0;
        const LAS float* pmu = PT + AD.d * 3072 + (AD.oc >> 2); const LAS float* pkk = PT + 6144 + (AD.oc >> 2); const LAS float* pka = PA + (AD.oc >> 2);
        const f32x4 z4 = {0.f, 0.f, 0.f, 0.f};
#define CK_PC(A_, g_) (((g_) & 1) ? (v2u){A_[(g_) >> 1].z, A_[(g_) >> 1].w} : (v2u){A_[(g_) >> 1].x, A_[(g_) >> 1].y})
#define CK_FEAT(X, T_, g_, u_) do { const f32x4 qv = bf4(CK_PC(X.q, g_)); const int pf_ = 32 * (T_) + 4 * (g_); \
            f32x4 Qi; Qi.x = ck_prefix32(qv.x); Qi.y = ck_prefix32(qv.y); Qi.z = ck_prefix32(qv.z); Qi.w = ck_prefix32(qv.w);         \
            if (t == 31) *(LAS f32x4*)(QC + 32 * (T_) + 8 * (g_) + 4 * h) = Qi; \
            const f32x4 k0 = bf4(CK_PC(X.k0, g_)), kn = has ? bf4(CK_PC(X.kn, g_)) : z4, kx = k0 + *(const LAS f32x4*)(pmu + (1024 + pf_)) * (kn - k0), ic = bf4(CK_PC(X.ic, g_)), kk = kx * *(const LAS f32x4*)(pkk + pf_); \
            ss += hsum4(kk * kk); \
            const f32x4 ep = exp4(Qi), em = exp4(-Qi), emx = exp4(qv - Qi); \
            const f32x4 r0 = bf4(CK_PC(X.r0, g_)), rn = has ? bf4(CK_PC(X.rn, g_)) : z4, r = r0 + *(const LAS f32x4*)(pmu + pf_) * (rn - r0); \
            const f32x4 v0 = bf4(CK_PC(X.v0, g_)), vn = has ? bf4(CK_PC(X.vn, g_)) : z4; \
            vv[u_] = v0 + *(const LAS f32x4*)(pmu + (2048 + pf_)) * (vn - v0); \
            av[u_] = -kk * emx; rv[u_] = r * em; bv[u_] = kk * ic * ep; kv2[u_] = kx * ((ic - 1.0f) * *(const LAS f32x4*)(pka + pf_) + 1.0f) * ep; \
            asm volatile("" : "+v"(av[u_]), "+v"(rv[u_]), "+v"(bv[u_]), "+v"(kv2[u_]), "+v"(vv[u_]) :: "memory"); } while (0)
        float ss = 0.f;
        bf16x8_t Ac[2][2], Rc[2][2], Bc[2][2], Kc[2][2], Vc[2][2];
#define CK_TILE(X, T_) do { _Pragma("unroll") for (int s = 0; s < 2; ++s) { f32x4 av[2], rv[2], bv[2], kv2[2], vv[2]; \
                CK_FEAT(X, T_, 2 * s, 0); CK_FEAT(X, T_, 2 * s + 1, 1); \
                Ac[T_][s] = pack8(av[0], av[1]); Rc[T_][s] = pack8(rv[0], rv[1]); Bc[T_][s] = pack8(bv[0], bv[1]); Kc[T_][s] = pack8(kv2[0], kv2[1]); Vc[T_][s] = pack8(vv[0], vv[1]); \
                asm volatile("" : "+v"(Ac[T_][s]), "+v"(Rc[T_][s]), "+v"(Bc[T_][s]), "+v"(Kc[T_][s]), "+v"(Vc[T_][s]) :: "memory"); } } while (0)
        CK_TILE(RA, 0); CK_TILE(RB, 1);
#undef CK_TILE
#undef CK_PC
#undef CK_FEAT
        ss = ck_sum2(ss);
        const float rinv = __builtin_amdgcn_rsqf(fmaxf(ss, 1e-24f));
        if (h == 0) RV[t] = rinv;
        LDS_WAIT(); asm volatile("" ::: "memory");
#define CK_RROW(i_) (RV[8 * ((i_) >> 2) + 4 * h + ((i_) & 3)])
        const f32x16 zero16 = {0.f, 0.f, 0.f, 0.f, 0.f, 0.f, 0.f, 0.f, 0.f, 0.f, 0.f, 0.f, 0.f, 0.f, 0.f, 0.f};
        bf16x8_t Vs[2][2];
#pragma unroll
        for (int T = 0; T < 2; ++T) { f32x16 x = ck_mm(Vc[T][0], ck_ident(0, t, h), zero16); x = ck_mm(Vc[T][1], ck_ident(1, t, h), x); Vs[T][0] = ck_frag(x, 0); Vs[T][1] = ck_frag(x, 1); asm volatile("" : "+v"(Vs[T][0]), "+v"(Vs[T][1])); }
        f32x16 XW[2], XU[2];
#pragma unroll
        for (int T = 0; T < 2; ++T) { XW[T] = ck_mm(Ac[T][0], ck_ident(0, t, h), zero16); XW[T] = ck_mm(Ac[T][1], ck_ident(1, t, h), XW[T]);
#pragma unroll
            for (int i = 0; i < 16; ++i) XW[T][i] *= CK_RROW(i); }
        bf16x8_t G2f[2], G3f[2], G4f[2];
        { f32x16 g = zero16;
#pragma unroll
          for (int T = 0; T < 2; ++T)
#pragma unroll
              for (int s = 0; s < 2; ++s) g = ck_mm(Bc[T][s], Ac[T][s], g);
#pragma unroll
          for (int i = 0; i < 16; ++i) LtW[((i & 3) + 8 * (i >> 2)) * 32] = ck_rho(i, h) < t ? g[i] * (CK_RROW(i) * RV[t]) : 0.f; }
        __builtin_amdgcn_sched_barrier(0);
        { f32x16 g = zero16;
#pragma unroll
          for (int T = 0; T < 2; ++T)
#pragma unroll
              for (int s = 0; s < 2; ++s) g = ck_mm(Kc[T][s], Ac[T][s], g);
#pragma unroll
          for (int i = 0; i < 16; ++i) g[i] = ck_rho(i, h) < t ? g[i] * RV[t] : 0.f;
          G2f[0] = ck_frag(g, 0); G2f[1] = ck_frag(g, 1); asm volatile("" : "+v"(G2f[0]), "+v"(G2f[1])); }
        __builtin_amdgcn_sched_barrier(0);
        { f32x16 g = zero16;
#pragma unroll
          for (int T = 0; T < 2; ++T)
#pragma unroll
              for (int s = 0; s < 2; ++s) g = ck_mm(Bc[T][s], Rc[T][s], g);
#pragma unroll
          for (int i = 0; i < 16; ++i) g[i] = ck_rho(i, h) <= t ? g[i] * CK_RROW(i) : 0.f;
          G3f[0] = ck_frag(g, 0); G3f[1] = ck_frag(g, 1); asm volatile("" : "+v"(G3f[0]), "+v"(G3f[1])); }
        __builtin_amdgcn_sched_barrier(0);
        { f32x16 g = zero16;
#pragma unroll
          for (int T = 0; T < 2; ++T)
#pragma unroll
              for (int s = 0; s < 2; ++s) g = ck_mm(Kc[T][s], Rc[T][s], g);
#pragma unroll
          for (int i = 0; i < 16; ++i) g[i] = ck_rho(i, h) <= t ? g[i] : 0.f;
#if defined(CK_SELFTEST)
          { float rd = 0.f;
#define CK_RD(x) do { const float r_ = (x); rd = (r_ == r_) ? fmaxf(rd, r_) : 1e30f; } while (0)
            if (CK_SELFTEST & 3) { float dref = 0.f, sref = 0.f, daref = 0.f, saref = 0.f;
#pragma unroll
              for (int T = 0; T < 2; ++T)
#pragma unroll
                for (int s2 = 0; s2 < 2; ++s2) { const v4u kw = __builtin_bit_cast(v4u, Kc[T][s2]), rw = __builtin_bit_cast(v4u, Rc[T][s2]);
                    const unsigned kk_[4] = {kw.x, kw.y, kw.z, kw.w}, rr_[4] = {rw.x, rw.y, rw.z, rw.w};
#pragma unroll
                    for (int q = 0; q < 4; ++q) { const float k0_ = bflo(kk_[q]), k1_ = bfhi(kk_[q]), r0_ = bflo(rr_[q]), r1_ = bfhi(rr_[q]);
                        dref += k0_ * r0_ + k1_ * r1_; daref += fabsf(k0_ * r0_) + fabsf(k1_ * r1_);
                        saref += fabsf(__shfl_up(k0_, 1, 32) * r0_) + fabsf(__shfl_up(k1_, 1, 32) * r1_);
                        sref += __shfl_up(k0_, 1, 32) * r0_ + __shfl_up(k1_, 1, 32) * r1_; } }
              dref = ck_sum2(dref);
              sref = ck_sum2(sref);
              daref = ck_sum2(daref);
              saref = ck_sum2(saref);
              float dm = 0.f, sm = 0.f;
#pragma unroll
              for (int i = 0; i < 16; ++i) { if (ck_rho(i, h) == t) dm = g[i]; if (ck_rho(i, h) == t - 1) sm = g[i]; }
              dm = ck_sum2(dm);
              sm = ck_sum2(sm);
              if (CK_SELFTEST & 1) CK_RD(fabsf(dm - dref) / (daref + 1e-30f));
              if ((CK_SELFTEST & 2) && t >= 1) CK_RD(fabsf(sm - sref) / (saref + 1e-30f)); }
            if (CK_SELFTEST & 128) {
                const unsigned av_ = pk2((float)(t + 1), (float)(t + 1)); const v4u aw = {av_, av_, av_, av_}; const v4u one4 = {0x3F803F80u, 0x3F803F80u, 0x3F803F80u, 0x3F803F80u};
                const f32x16 dd = ck_mm(__builtin_bit_cast(bf16x8_t, aw), __builtin_bit_cast(bf16x8_t, one4), zero16);
#pragma unroll
                for (int i = 0; i < 16; ++i) CK_RD(fabsf(dd[i] - 16.0f * (ck_rho(i, h) + 1)) / (16.0f * (ck_rho(i, h) + 1))); }
            if (CK_SELFTEST & 256) {
                const unsigned bv_ = pk2((float)(t + 1), (float)(t + 1)); const v4u bw = {bv_, bv_, bv_, bv_}; const v4u one4 = {0x3F803F80u, 0x3F803F80u, 0x3F803F80u, 0x3F803F80u};
                const f32x16 dd = ck_mm(__builtin_bit_cast(bf16x8_t, one4), __builtin_bit_cast(bf16x8_t, bw), zero16);
#pragma unroll
                for (int i = 0; i < 16; ++i) CK_RD(fabsf(dd[i] - 16.0f * (t + 1)) / (16.0f * (t + 1))); }
            if (CK_SELFTEST & 32) {
                const f32x16 dd = ck_mm(Kc[0][0], Rc[0][0], zero16);
                const v4u kw = __builtin_bit_cast(v4u, Kc[0][0]), rw = __builtin_bit_cast(v4u, Rc[0][0]);
                float d1 = bflo(kw.x) * bflo(rw.x) + bfhi(kw.x) * bfhi(rw.x) + bflo(kw.y) * bflo(rw.y) + bfhi(kw.y) * bfhi(rw.y) + bflo(kw.z) * bflo(rw.z) + bfhi(kw.z) * bfhi(rw.z) + bflo(kw.w) * bflo(rw.w) + bfhi(kw.w) * bfhi(rw.w);
                float a1 = fabsf(bflo(kw.x) * bflo(rw.x)) + fabsf(bfhi(kw.x) * bfhi(rw.x)) + fabsf(bflo(kw.y) * bflo(rw.y)) + fabsf(bfhi(kw.y) * bfhi(rw.y)) + fabsf(bflo(kw.z) * bflo(rw.z)) + fabsf(bfhi(kw.z) * bfhi(rw.z)) + fabsf(bflo(kw.w) * bflo(rw.w)) + fabsf(bfhi(kw.w) * bfhi(rw.w));
                d1 = ck_sum2(d1);
                a1 = ck_sum2(a1);
                float m1 = 0.f;
#pragma unroll
                for (int i = 0; i < 16; ++i) if (ck_rho(i, h) == t) m1 = dd[i];
                m1 = ck_sum2(m1);
                CK_RD(fabsf(m1 - d1) / (a1 + 1e-30f)); }
            if (CK_SELFTEST & (4096 | 65536)) CK_RD(rdq);
            ck_report(f, rd); }
#endif
          G4f[0] = ck_frag(g, 0); G4f[1] = ck_frag(g, 1); asm volatile("" : "+v"(G4f[0]), "+v"(G4f[1])); }
        __builtin_amdgcn_sched_barrier(0);
        bf16x8_t Bs[2][2], Ks[2][2];
        LDS_WAIT(); asm volatile("" ::: "memory");
#pragma unroll
        for (int T = 0; T < 2; ++T) { const float gc = __expf(-QC[32 * T + t]);
            f32x16 x = ck_mm(Bc[T][0], ck_ident(0, t, h), zero16); x = ck_mm(Bc[T][1], ck_ident(1, t, h), x);
#pragma unroll
            for (int i = 0; i < 16; ++i) x[i] *= gc * CK_RROW(i);
            Bs[T][0] = ck_frag(x, 0); Bs[T][1] = ck_frag(x, 1);
            x = ck_mm(Kc[T][0], ck_ident(0, t, h), zero16); x = ck_mm(Kc[T][1], ck_ident(1, t, h), x); x = x * gc; Ks[T][0] = ck_frag(x, 0); Ks[T][1] = ck_frag(x, 1);
            asm volatile("" : "+v"(Bs[T][0]), "+v"(Bs[T][1]), "+v"(Ks[T][0]), "+v"(Ks[T][1])); }
#pragma unroll
        for (int T = 0; T < 2; ++T)
#pragma unroll
            for (int s2 = 0; s2 < 2; ++s2) PKL[(T * 2 + s2) * 64 + lane] = __builtin_bit_cast(v4u, Rc[T][s2]);
        PKL[4 * 64 + lane] = __builtin_bit_cast(v4u, G3f[0]); PKL[5 * 64 + lane] = __builtin_bit_cast(v4u, G3f[1]); PKL[6 * 64 + lane] = __builtin_bit_cast(v4u, G4f[0]); PKL[7 * 64 + lane] = __builtin_bit_cast(v4u, G4f[1]);
        LDS_WAIT(); asm volatile("" ::: "memory");
#define CK_CFLD(dst_, p_) do { _Pragma("unroll") for (int g4 = 0; g4 < 4; ++g4) if (8 * g4 + 4 + 3 > (p_)) dst_[g4] = *(const LAS f32x4*)(Lt + (p_) * 32 + 8 * g4 + 4 * h); } while (0)
#define CK_SOLVE2(X0, X1) do { f32x4 cfa_[4], cfb_[4]; CK_CFLD(cfa_, 0); \
        _Pragma("unroll") for (int p = 0; p < 31; ++p) { \
            const int ip = (p & 3) + 4 * (p >> 3), hp = (p >> 2) & 1;               \
            if (p + 1 < 31) { if (p & 1) CK_CFLD(cfa_, p + 1); else CK_CFLD(cfb_, p + 1); }         \
            float xp0, xp1; \
            { const float xv_ = X0[ip]; float lo_, hi_; ck_swap32(xv_, lo_, hi_); xp0 = hp ? hi_ : lo_; } \
            { const float xv_ = X1[ip]; float lo_, hi_; ck_swap32(xv_, lo_, hi_); xp1 = hp ? hi_ : lo_; } \
            _Pragma("unroll") for (int g4 = 0; g4 < 4; ++g4) { if (8 * g4 + 4 + 3 <= p) continue;       \
                const f32x4 cf = (p & 1) ? cfb_[g4] : cfa_[g4]; \
                _Pragma("unroll") for (int e = 0; e < 4; ++e) { const int i = 4 * g4 + e; X0[i] += cf[e] * xp0; X1[i] += cf[e] * xp1; } } \
            asm volatile("" ::: "memory"); } } while (0)
        CK_SOLVE2(XW[0], XW[1]);
        bf16x8_t Uf[2][2];
        int lane_q = lane; asm volatile("" : "+v"(lane_q));
        const int tq = lane_q & 31, hq = lane_q >> 5;
        v4u* rec = (v4u*)(f.ws + WS_CK + (size_t)it * CK_REC) + lane_q;
#define CK_ST(r_, x_) do { const v4u sv_ = (x_); if (MODE == 0) __builtin_nontemporal_store(sv_, &rec[64 * (r_)]); else asm volatile("" :: "v"(sv_)); } while (0)
        { bf16x8_t Wf[2][2];
#pragma unroll
          for (int T = 0; T < 2; ++T) { Wf[T][0] = ck_frag(XW[T], 0); Wf[T][1] = ck_frag(XW[T], 1); }
          asm volatile("" : "+v"(Wf[0][0]), "+v"(Wf[0][1]), "+v"(Wf[1][0]), "+v"(Wf[1][1]));
#pragma unroll
          for (int Ti = 0; Ti < 2; ++Ti)
#pragma unroll
              for (int To = 0; To < 2; ++To) { f32x16 mt = ck_mm(Wf[Ti][0], Bs[To][0], zero16); mt = ck_mm(Wf[Ti][1], Bs[To][1], mt);
                  if (Ti == To) { const float gc = __expf(-QC[32 * To + tq]);
#pragma unroll
                      for (int i = 0; i < 16; ++i) mt[i] += (ck_rho(i, hq) == tq) ? gc : 0.f; }
                  CK_ST(((Ti * 2 + To) * 2 + 0), __builtin_bit_cast(v4u, ck_frag(mt, 0))); CK_ST(((Ti * 2 + To) * 2 + 1), __builtin_bit_cast(v4u, ck_frag(mt, 1))); asm volatile("" ::: "memory"); }
          { const bf16x8_t g30 = __builtin_bit_cast(bf16x8_t, PKL[4 * 64 + lane_q]), g31 = __builtin_bit_cast(bf16x8_t, PKL[5 * 64 + lane_q]);
#pragma unroll
            for (int Tc = 0; Tc < 2; ++Tc) { f32x16 p1 = ck_unpack(PKL[(Tc * 2 + 0) * 64 + lane_q], PKL[(Tc * 2 + 1) * 64 + lane_q]);
                p1 = ck_mm(Wf[Tc][0], g30, p1); p1 = ck_mm(Wf[Tc][1], g31, p1);
                CK_ST((16 + Tc * 2 + 0), __builtin_bit_cast(v4u, ck_frag(p1, 0))); CK_ST((16 + Tc * 2 + 1), __builtin_bit_cast(v4u, ck_frag(p1, 1))); asm volatile("" ::: "memory"); } } }
#pragma unroll
        for (int T = 0; T < 2; ++T) { XU[T] = ck_mm(G2f[0], Vs[T][0], zero16); XU[T] = ck_mm(G2f[1], Vs[T][1], XU[T]); }
        CK_SOLVE2(XU[0], XU[1]);
#if defined(PROBE_SOLVE)
        { f32x16 D0 = XU[0], D1 = XU[1]; CK_SOLVE2(D0, D1); asm volatile("" :: "v"(D0), "v"(D1)); }
        { f32x16 D0 = XU[1], D1 = XU[0]; CK_SOLVE2(D0, D1); asm volatile("" :: "v"(D0), "v"(D1)); }
#endif
#undef CK_SOLVE2
#undef CK_CFLD
#pragma unroll
        for (int T = 0; T < 2; ++T) { Uf[T][0] = ck_frag(XU[T], 0); Uf[T][1] = ck_frag(XU[T], 1); }
        { const int itn = CK_ITEM(k + 1 < nk ? k + 1 : k); CK_ADDR(AD, itn, tq, hq); CK_LD(RA, 0, AD); CK_PREF2 }
        asm volatile("" ::: "memory");
#pragma unroll
        for (int To = 0; To < 2; ++To)
#pragma unroll
            for (int Tn = 0; Tn < 2; ++Tn) { f32x16 nn = ck_mm(Bs[To][0], Uf[Tn][0], zero16); nn = ck_mm(Bs[To][1], Uf[Tn][1], nn); nn = ck_mm(Ks[To][0], Vs[Tn][0], nn); nn = ck_mm(Ks[To][1], Vs[Tn][1], nn);
                CK_ST((8 + (Tn * 2 + To) * 2 + 0), __builtin_bit_cast(v4u, ck_frag(nn, 0))); CK_ST((8 + (Tn * 2 + To) * 2 + 1), __builtin_bit_cast(v4u, ck_frag(nn, 1))); asm volatile("" ::: "memory"); }
        G3f[0] = __builtin_bit_cast(bf16x8_t, PKL[4 * 64 + lane_q]); G3f[1] = __builtin_bit_cast(bf16x8_t, PKL[5 * 64 + lane_q]);
        G4f[0] = __builtin_bit_cast(bf16x8_t, PKL[6 * 64 + lane_q]); G4f[1] = __builtin_bit_cast(bf16x8_t, PKL[7 * 64 + lane_q]);
#pragma unroll
        for (int Tn = 0; Tn < 2; ++Tn) { f32x16 y0 = ck_mm(G3f[0], Uf[Tn][0], zero16); y0 = ck_mm(G3f[1], Uf[Tn][1], y0); y0 = ck_mm(G4f[0], Vs[Tn][0], y0); y0 = ck_mm(G4f[1], Vs[Tn][1], y0);
            CK_ST((20 + Tn * 2 + 0), __builtin_bit_cast(v4u, ck_frag(y0, 0))); CK_ST((20 + Tn * 2 + 1), __builtin_bit_cast(v4u, ck_frag(y0, 1))); asm volatile("" ::: "memory"); }
        LDS_WAIT(); asm volatile("" ::: "memory");
        if (MODE == 0) { CK_LDWAIT(RA, 12); CK_LDWAIT(RB, 12); } else { CK_LDWAIT(RA, 0); CK_LDWAIT(RB, 0); }
    }
#undef CK_ITEM
#undef CK_ADDR
#undef CK_LD
#undef CK_ST
#undef CK_PREF2
#undef CK_GLD
#undef CK_LDWAIT
}
template <int CHECK> __device__ __forceinline__ void ph_scanB(Frame& f, int l, int item_lo, int item_step) { launder_ws(f);
    LAS v4u* SL = (LAS v4u*)f.lds;
    LAS v4u* SFB = SL + 3 * 24 * 64;
    const int lane = f.lane;
    for (int it = item_lo + f.vcu; it < 64; it += item_step) {
        const int chain = it, b = chain >> 5, d = (chain >> 4) & 1, hd = chain & 15;
        if (f.wave >= 4) {
            const int w = f.wave - 4;
            const v4u* rec0 = (const v4u*)(f.ws + WS_CK + (size_t)chain * CK_NCH * CK_REC) + lane + 64 * w;
            struct LSet { v4u v0, v1, v2, v3, v4, v5; };
            LSet L0, L1, L2, L3, L4, L5, L6, L7;
#define CKB_LOAD(X, c) do { const v4u* rp_ = rec0 + (size_t)(c) * (CK_REC / 16); X.v0 = __builtin_nontemporal_load(rp_); X.v1 = __builtin_nontemporal_load(rp_ + 64 * 4); X.v2 = __builtin_nontemporal_load(rp_ + 64 * 8); X.v3 = __builtin_nontemporal_load(rp_ + 64 * 12); X.v4 = __builtin_nontemporal_load(rp_ + 64 * 16); X.v5 = __builtin_nontemporal_load(rp_ + 64 * 20); } while (0)
#define CKB_PUT(X, sb_) do { (sb_)[64 * w] = X.v0; (sb_)[64 * (4 + w)] = X.v1; (sb_)[64 * (8 + w)] = X.v2; (sb_)[64 * (12 + w)] = X.v3; (sb_)[64 * (16 + w)] = X.v4; (sb_)[64 * (20 + w)] = X.v5; } while (0)
            int sl = 1;
#define CKB_IVAL(c, XP, XL) do { CKB_PUT(XP, SL + sl * 24 * 64 + lane); sl = sl == 2 ? 0 : sl + 1; { const int cl_ = (c) + 8 < CK_NCH ? (c) + 8 : CK_NCH - 1; CKB_LOAD(XL, cl_); } LDS_WAIT(); __builtin_amdgcn_s_barrier(); } while (0)
            CKB_LOAD(L0, 0); CKB_LOAD(L1, 1); CKB_LOAD(L2, 2); CKB_LOAD(L3, 3); CKB_LOAD(L4, 4); CKB_LOAD(L5, 5); CKB_LOAD(L6, 6); CKB_LOAD(L7, 7);
            CKB_PUT(L0, SL + lane);
            LDS_WAIT(); __builtin_amdgcn_s_barrier();
            static_assert(CK_NCH % 8 == 0, "loader loop unrolled by eight register sets");
            for (int c = 0; c < CK_NCH; c += 8) {
                CKB_IVAL(c, L1, L0); CKB_IVAL(c + 1, L2, L1); CKB_IVAL(c + 2, L3, L2); CKB_IVAL(c + 3, L4, L3); CKB_IVAL(c + 4, L5, L4); CKB_IVAL(c + 5, L6, L5); CKB_IVAL(c + 6, L7, L6); CKB_IVAL(c + 7, L0, L7);
            }
            LDS_WAIT(); __builtin_amdgcn_s_barrier();
#undef CKB_LOAD
#undef CKB_PUT
#undef CKB_IVAL
        } else if (f.wave < 2) {
            const int Tn = f.wave;
            const f32x16 zero16 = {0.f, 0.f, 0.f, 0.f, 0.f, 0.f, 0.f, 0.f, 0.f, 0.f, 0.f, 0.f, 0.f, 0.f, 0.f, 0.f};
            f32x16 ST[2] = {zero16, zero16};
            LDS_WAIT(); __builtin_amdgcn_s_barrier();
            int sl = 0;
            for (int c = 0; c < CK_NCH; ++c) {
                const LAS v4u* sp = SL + sl * 24 * 64 + lane; sl = sl == 2 ? 0 : sl + 1;
                LAS v4u* sf = SFB + ((c & 1) * 2 + Tn) * 4 * 64 + lane;
                v4u rm[8], rn[4];
#pragma unroll
                for (int k = 0; k < 8; ++k) rm[k] = sp[64 * k];
#pragma unroll
                for (int k = 0; k < 4; ++k) rn[k] = sp[64 * (8 + 4 * Tn + k)];
                bf16x8_t Sf[2][2];
#pragma unroll
                for (int Ti = 0; Ti < 2; ++Ti) { Sf[Ti][0] = ck_frag(ST[Ti], 0); Sf[Ti][1] = ck_frag(ST[Ti], 1); }
#pragma unroll
                for (int Ti = 0; Ti < 2; ++Ti) { sf[64 * (Ti * 2 + 0)] = __builtin_bit_cast(v4u, Sf[Ti][0]); sf[64 * (Ti * 2 + 1)] = __builtin_bit_cast(v4u, Sf[Ti][1]); }
                asm volatile("s_waitcnt lgkmcnt(0)" : "+v"(rm[0]), "+v"(rm[1]), "+v"(rm[2]), "+v"(rm[3]), "+v"(rm[4]), "+v"(rm[5]), "+v"(rm[6]), "+v"(rm[7]) :: "memory");
                asm volatile("" : "+v"(rn[0]), "+v"(rn[1]), "+v"(rn[2]), "+v"(rn[3]));
#pragma unroll
                for (int To = 0; To < 2; ++To) { f32x16 sn = ck_unpack(rn[To * 2], rn[To * 2 + 1]);
#pragma unroll
                    for (int Ti = 0; Ti < 2; ++Ti)
#pragma unroll
                        for (int s = 0; s < 2; ++s) sn = ck_mm(__builtin_bit_cast(bf16x8_t, rm[(Ti * 2 + To) * 2 + s]), Sf[Ti][s], sn);
                    ST[To] = sn; }
                LDS_WAIT(); __builtin_amdgcn_s_barrier();
            }
            LDS_WAIT(); __builtin_amdgcn_s_barrier();
        } else {
            const int Tn = f.wave - 2, t = lane & 31, h = lane >> 5;
            const unsigned voff = (unsigned)(32 * Tn + 16 * ((t >> 2) & 1) + 4 * (t >> 3) + (t & 3)) + (unsigned)(4 * CW) * (unsigned)(d ? 1 - h : h);
            const float* ysu = WSP(float, WS_YS) + (size_t)d * MALL * CW + hd * 64;
            LDS_WAIT(); __builtin_amdgcn_s_barrier();
            LDS_WAIT(); __builtin_amdgcn_s_barrier();
            int sl = 0;
            for (int c = 0; c < CK_NCH; ++c) {
                const LAS v4u* sp = SL + sl * 24 * 64 + lane; sl = sl == 2 ? 0 : sl + 1;
                const LAS v4u* sf = SFB + ((c & 1) * 2 + Tn) * 4 * 64 + lane;
                v4u rs[4], rp[4], ry[2];
#pragma unroll
                for (int k = 0; k < 4; ++k) rs[k] = sf[64 * k];
#pragma unroll
                for (int k = 0; k < 4; ++k) rp[k] = sp[64 * (16 + k)];
                ry[0] = sp[64 * (20 + 2 * Tn)]; ry[1] = sp[64 * (21 + 2 * Tn)];
                asm volatile("s_waitcnt lgkmcnt(0)" : "+v"(rs[0]), "+v"(rs[1]), "+v"(rs[2]), "+v"(rs[3]), "+v"(rp[0]), "+v"(rp[1]), "+v"(rp[2]), "+v"(rp[3]), "+v"(ry[0]), "+v"(ry[1]) :: "memory");
                f32x16 yv = ck_unpack(ry[0], ry[1]);
#pragma unroll
                for (int k = 0; k < 4; ++k) yv = ck_mm(__builtin_bit_cast(bf16x8_t, rp[k]), __builtin_bit_cast(bf16x8_t, rs[k]), yv);
                { const int st0 = c * CK_C; int seg, pos0;
                  if (st0 < CTXL) { seg = MLAT + b * CTXL; pos0 = d ? (CTXL - 1 - st0) : st0; } else { seg = b * SEQ; pos0 = d ? (SEQ - 1 - (st0 - CTXL)) : (st0 - CTXL); }
                  const int mb = seg + pos0 - (d ? 4 : 0);
#pragma unroll
                  for (int i = 0; i < 16; ++i) { const int ci = (i & 3) + 8 * (i >> 2); const int mi = d ? mb - ci : mb + ci;
                    if (CHECK == 0) ((float*)ysu + (size_t)mi * CW)[voff] = yv[i]; else asm volatile("" :: "v"(yv[i])); } }
                LDS_WAIT(); __builtin_amdgcn_s_barrier();
            }
        }
        __syncthreads();
    }
}
#ifndef NA_BSLOTS
#define NA_BSLOTS 0
#endif
constexpr int GP_LAYER0 = 3, GP_PER_LAYER = 12, GP_FINAL = GP_LAYER0 + GP_PER_LAYER * DEPTH, GP_COUNT = GP_FINAL + 1;
#ifndef MK_ONE_LAUNCH
#define MK_ONE_LAUNCH 1
#endif
__global__ void __launch_bounds__(NWAVES * 64, 2) fwd(Args A) {
    extern __shared__ __attribute__((aligned(16))) unsigned char lds_raw[];
    Frame f;
    f.lds = (LAS unsigned char*)lds_raw;
    f.tid = threadIdx.x; f.lane = f.tid & 63; f.wave = __builtin_amdgcn_readfirstlane(f.tid >> 6);
    f.G = gridDim.x; { const int bx = blockIdx.x; f.vcu = (f.G % 8 == 0) ? (bx % 8) * (f.G / 8) + bx / 8 : bx; }
    f.ws = (GAS unsigned char*)A.ws;
    volatile LAS unsigned* MISC = (volatile LAS unsigned*)(f.lds + MISC_OFF);
    for (int u = f.tid; u < (LDS_BYTES - LDSCTL_OFF) / 4; u += NWAVES * 64) ((LAS unsigned*)(f.lds + LDSCTL_OFF))[u] = 0u;
    __syncthreads();
    unsigned* ctl = (unsigned*)WSP(unsigned, WS_CTL);
    XcdBarrier bar; bar.bar = ctl + CW_BAR; bar.x = 0; bar.st = MISC + 8; bar.wv = f.wave;
    if (A.use_bar) bar = xcd_barrier_post(ctl + CW_BAR, MISC + 8, f.wave);
    const int lo = A.gp_lo, hi = A.gp_hi;
#define IN(k) (lo <= (k) && (k) < hi)
#define BAR_AFTER(k) do { if (IN(k) && hi > (k) + 1) xcd_barrier(bar); } while (0)

    if (IN(0)) { ph_convert(f); ph_lora_weights(f); }
    BAR_AFTER(0);
    if (IN(1)) ph_modsum(f);
    BAR_AFTER(1);
    if (IN(2)) ph_setup2(f);
    BAR_AFTER(2);
    for (int l = 0; l < DEPTH; ++l) {
        const int g0 = GP_LAYER0 + GP_PER_LAYER * l;
        const bool lastl = (l == DEPTH - 1);
        const int mrows = lastl ? MLAT : MALL;
        if (IN(g0 + 0) && l > 0) ph_rs<11>(f, 0, WSP(float, WS_MOD) + (size_t)((l - 1) * 3 + 2) * MODW + 5 * DM, WSP(float, WS_GK) + (size_t)((l * 2 + 0) * 3 + 2) * DM);
        if (l > 0) BAR_AFTER(g0 + 0);
        if (IN(g0 + 1)) {
            launder_ws(f); pg8::Gemm g{WSP(bf16, WS_XN), WSP(bf16, WS_WIN) + (size_t)l * INP * DM, MALL, INP, DM}; pg8::StaticOrder S; S.init(MALL, INP, f.G, (int)blockIdx.x);
            EpiScaleBias E{WSP(bf16, WS_Y1), INP, WSP(float, WS_RS), WSP(float, WS_BIAS1) + (size_t)l * 3 * INP, INP};
            pg8::gemm_phase<EpiScaleBias, pg8::StaticOrder, true, true>(f.lds, g, S, E, f.wave);
        }
        BAR_AFTER(g0 + 1);
        if (IN(g0 + 2)) { ph_prep(f, l); ph_vat(f); ph_lora2(f, l); }
        BAR_AFTER(g0 + 2);
#if defined(SEQ_SCAN)
        if (IN(g0 + 3)) { for (int s_ = f.vcu; s_ < 1024; s_ += f.G) ph_na(f, l, s_, 1); if (!lastl) ph_ctxattn(f, 0); }
        if (IN(g0 + 4)) { launder_ws(f);
            const attn_body::AttnTensors AT{(const attn_body::bf16*)WSP(bf16, WS_QBP), (const attn_body::bf16*)WSP(bf16, WS_KBP), (const attn_body::bf16*)WSP(bf16, WS_VBP), (attn_body::bf16*)WSP(bf16, WS_OB)};
            attn_body::attn_phase<8>((char*)lds_raw, AT, f.vcu, f.G, f.wave);
        }
        if (IN(g0 + 5)) ph_scan2(f, l);
#if defined(CHUNK_CHECK)
        if (IN(g0 + 5)) { xcd_barrier(bar); ph_scanA<0>(f, l); xcd_barrier(bar); ph_scanB<1>(f, l, 0, f.G); }
#endif
#else
        if (IN(g0 + 3)) { ph_scanA<0>(f, l);
#if defined(PROBE_A2)
            ph_scanA<PROBE_A2 - 1>(f, l);
#endif
        }
        BAR_AFTER(g0 + 3);
        if (IN(g0 + 4)) {
            if (f.G == 256) {
                if (f.vcu < 64) { ph_scanB<0>(f, l, 0, f.G);
#if defined(PROBE_B2)
                    ph_scanB<PROBE_B2 - 1>(f, l, 0, f.G);
#endif
                    ph_na(f, l, 960 + f.vcu, NA_BSLOTS);
                } else if (NA_BSLOTS) ph_na(f, l, 5 * (f.vcu - 64), 5); else if (f.vcu < 128) ph_na(f, l, 6 * (f.vcu - 64), 6); else ph_na(f, l, 384 + 5 * (f.vcu - 128), 5); }
            else { ph_scanB<0>(f, l, 0, f.G); for (int s_ = f.vcu; s_ < 1024; s_ += f.G) ph_na(f, l, s_, 1); }
            if (!lastl) ph_ctxattn(f, 128);
        }
        if (IN(g0 + 5)) { __syncthreads(); launder_ws(f);
            const attn_body::AttnTensors AT{(const attn_body::bf16*)WSP(bf16, WS_QBP), (const attn_body::bf16*)WSP(bf16, WS_KBP), (const attn_body::bf16*)WSP(bf16, WS_VBP), (attn_body::bf16*)WSP(bf16, WS_OB)};
            attn_body::attn_phase<8>((char*)lds_raw, AT, f.vcu, f.G, f.wave);
        }
#endif
        BAR_AFTER(g0 + 5);
        if (IN(g0 + 6)) ph_mix(f, l, mrows);
        BAR_AFTER(g0 + 6);
        if (IN(g0 + 7)) {
            launder_ws(f); pg8::Gemm g{WSP(bf16, WS_MIX), WSP(bf16, WS_WOUT) + (size_t)l * DM * DM, MLAT, DM, DM}; pg8::StaticOrder S; S.init(MLAT, DM, f.G, (int)blockIdx.x);
            EpiResGateNorm E{WSP(float, WS_H), WSP(float, WS_MOD) + (size_t)l * 3 * MODW + 2 * DM, WSP(float, WS_GK) + (size_t)(l * 2 + 1) * 3 * DM, WSP(bf16, WS_XN), WSP(float, WS_SSP) + (size_t)MALL * 32};
            pg8::gemm_phase<EpiResGateNorm, pg8::StaticOrder, true, true>(f.lds, g, S, E, f.wave);
            if (!lastl) { pg8::Gemm g2{WSP(bf16, WS_MIX), WSP(bf16, WS_WOUT) + (size_t)l * DM * DM, MALL, DM, 256, DM}; CtxSplitOrder S2{f.G, (int)blockIdx.x, 8, 256}; EpiPartial E2{WSP(float, WS_PART), 256};
                pg8::gemm_phase<EpiPartial, CtxSplitOrder, true, true>(f.lds, g2, S2, E2, f.wave); }
        }
        BAR_AFTER(g0 + 7);
        if (IN(g0 + 8)) { const float* gate_ = WSP(float, WS_MOD) + (size_t)(l * 3 + 2) * MODW + 2 * DM; const float* gk_ = WSP(float, WS_GK) + (size_t)((l * 2 + 1) * 3 + 2) * DM;
            if (lastl) ph_rs<0>(f, 1, gate_, gk_); else ph_rs<8>(f, 1, gate_, gk_); }
        BAR_AFTER(g0 + 8);
        if (IN(g0 + 9)) {
            launder_ws(f); pg8::Gemm g{WSP(bf16, WS_XN), WSP(bf16, WS_WUP) + (size_t)l * UPN * DM, mrows, UPN, DM}; pg8::StaticOrder S; S.init(mrows, UPN, f.G, (int)blockIdx.x);
            const float* cw_ = karg_in(I_CONVW) + (size_t)l * 3 * DFF; const float* cb_ = karg_in(I_CONVB) + (size_t)l * DFF;
            EpiConvGlu E{WSP(bf16, WS_HB), WSP(bf16, WS_U), WSP(float, WS_RS) + MALL, WSP(float, WS_BIAS3) + (size_t)l * 3 * UPN, cw_, cb_};
            pg8::gemm_phase<EpiConvGlu, pg8::StaticOrder, true, true>(f.lds, g, S, E, f.wave);
        }
        BAR_AFTER(g0 + 9);
        if (IN(g0 + 10)) ph_convfix(f, l, mrows);
        BAR_AFTER(g0 + 10);
        if (IN(g0 + 11)) {
            launder_ws(f); pg8::Gemm g{WSP(bf16, WS_HB), WSP(bf16, WS_WDN) + (size_t)l * DM * DFF, MLAT, DM, DFF}; pg8::StaticOrder S; S.init(MLAT, DM, f.G, (int)blockIdx.x);
            EpiResGateNorm E{WSP(float, WS_H), WSP(float, WS_MOD) + (size_t)l * 3 * MODW + 5 * DM, lastl ? (const float*)nullptr : (const float*)(WSP(float, WS_GK) + (size_t)((l + 1) * 2 + 0) * 3 * DM), WSP(bf16, WS_XN), WSP(float, WS_SSP)};
            pg8::gemm_phase<EpiResGateNorm, pg8::StaticOrder, true, true>(f.lds, g, S, E, f.wave);
            if (!lastl) { pg8::Gemm g2{WSP(bf16, WS_HB), WSP(bf16, WS_WDN) + (size_t)l * DM * DFF, MALL, DM, 512, DFF}; CtxSplitOrder S2{f.G, (int)blockIdx.x, 11, 512}; EpiPartial E2{WSP(float, WS_PART), 512};
                pg8::gemm_phase<EpiPartial, CtxSplitOrder, true, true>(f.lds, g2, S2, E2, f.wave); }
        }
        BAR_AFTER(g0 + 11);
    }
    if (IN(GP_FINAL)) ph_final(f);
#if defined(CK_READOUT)
    if (IN(GP_FINAL)) { xcd_barrier(bar);
        if (blockIdx.x == 0 && f.tid == 0) { const float* cw_ = (const float*)(f.ws + WS_CTL) + 8192; const float e_ = __hip_atomic_load(cw_, __ATOMIC_RELAXED, __HIP_MEMORY_SCOPE_AGENT), r_ = __hip_atomic_load(cw_ + 1, __ATOMIC_RELAXED, __HIP_MEMORY_SCOPE_AGENT);
            const float m_ = __builtin_bit_cast(float, __hip_atomic_load((const unsigned*)cw_ + 2, __ATOMIC_RELAXED, __HIP_MEMORY_SCOPE_AGENT));
            float v_ = (CK_READOUT == 1) ? sqrtf(e_ / r_) : m_;
            if (CK_READOUT == 1 && v_ == v_ && v_ > 0.f) v_ = exp2f(rintf(log2f(v_) * 8.0f) * 0.125f);
            float* o_ = (float*)karg_in(33); o_[0] = (v_ == v_) ? fminf(v_ * 1.0e6f, 1.0e9f) : 4.0e9f; } }
#elif defined(CHUNK_CHECK)
    if (IN(GP_FINAL)) { const float* cw_ = (const float*)(f.ws + WS_CTL) + 8192; const float e_ = __hip_atomic_load(cw_, __ATOMIC_RELAXED, __HIP_MEMORY_SCOPE_AGENT), r_ = __hip_atomic_load(cw_ + 1, __ATOMIC_RELAXED, __HIP_MEMORY_SCOPE_AGENT);
        if (!(e_ <= CHUNK_CHECK * r_)) { __syncthreads(); float* o_ = (float*)karg_in(33); for (int i = f.vcu * 512 + f.tid; i < MLAT * DM; i += f.G * 512) o_[i] = __builtin_nanf(""); } }
#endif
#undef IN
#undef BAR_AFTER
}

extern "C" void kernel_launch(void* const* d_in, const int* in_sizes, int n_in, void* d_out, int out_size, void* d_ws, size_t ws_size, hipStream_t stream) {
    static int grid = 0;
    if (grid == 0) {
        if (n_in != 33 || in_sizes[0] != MLAT * DM || out_size != MLAT * DM || ws_size < WS_END) {
            fprintf(stderr, "kernel_launch: unexpected shapes (n_in %d, in0 %d, out %d, ws %zu); nothing launched\n", n_in, n_in > 0 ? in_sizes[0] : -1, out_size, ws_size); grid = -1; return; }
        int dev = 0, cus = 0;
        if (hipGetDevice(&dev) != hipSuccess || hipDeviceGetAttribute(&cus, hipDeviceAttributeMultiprocessorCount, dev) != hipSuccess) { grid = -1; return; }
        if (hipFuncSetAttribute((const void*)fwd, hipFuncAttributeMaxDynamicSharedMemorySize, LDS_BYTES) != hipSuccess) { fprintf(stderr, "kernel_launch: hipFuncSetAttribute failed\n"); grid = -1; return; }
        (void)hipGetLastError();
        grid = cus;
    }
    if (grid < 0) return;
    if (hipMemsetAsync((char*)d_ws + WS_CTL, 0, CTL_ZERO_BYTES, stream) != hipSuccess) return;
    Args a{};
    for (int i = 0; i < 33; ++i) a.in[i] = (const float*)d_in[i];
    a.out = (float*)d_out; a.ws = (unsigned char*)d_ws; a.pad = 0;
#if MK_ONE_LAUNCH
    a.gp_lo = 0; a.gp_hi = GP_COUNT; a.use_bar = 1;
    hipLaunchKernelGGL(fwd, dim3(grid), dim3(NWAVES * 64), LDS_BYTES, stream, a);
#else
    for (int gp = 0; gp < GP_COUNT; ++gp) {
        a.gp_lo = gp; a.gp_hi = gp + 1; a.use_bar = 0;
        hipLaunchKernelGGL(fwd, dim3(grid), dim3(NWAVES * 64), LDS_BYTES, stream, a);
    }
#endif
}
```
